# Optimizing an MI355X kernel written in HIP

```python
import jax, jax.numpy as jnp
from jax import lax
import numpy as np

D_MODEL = 1024
BATCH = 16
SEQ = 256
DEPTH = 1
DEC_BATCH = 4
DEC_SEQ = 4096
PAST_LEN = 512

GRID_W = 64
N_HEADS = 8
N_KV = 2
GROUP = N_HEADS // N_KV
HEAD_DIM = 128
R_HEADS = 8
R_DK = 64
R_DV = 128
D_FF = 2816
CONV_W = 3
CHUNK = 128
Q_BLOCK = 128
ROPE_THETA = 10000.0
EPS = 1e-6

ATT_Q = N_HEADS * HEAD_DIM
ATT_KV = N_KV * HEAD_DIM
RET_QK = R_HEADS * R_DK
RET_V = R_HEADS * R_DV
IN_SPLITS = (ATT_Q, ATT_KV, ATT_KV, RET_QK, RET_QK, RET_V, RET_V, D_MODEL, D_MODEL)
D_IN = ATT_Q + 2 * ATT_KV + 2 * RET_QK + 2 * RET_V + 2 * D_MODEL

kernel_name = "hybrid_retention_gqa_dit_step"


def rms_scale(x):
    xf = x.astype(jnp.float32)
    return xf * lax.rsqrt(jnp.mean(xf * xf, axis=-1, keepdims=True) + EPS)


def rmsnorm(x, g):
    return (rms_scale(x) * g.astype(jnp.float32)).astype(x.dtype)


def rope_1d(x, pos):
    half = x.shape[-1] // 2
    inv = ROPE_THETA ** (-jnp.arange(half, dtype=jnp.float32) / half)
    ang = pos.astype(jnp.float32)[:, None] * inv[None, :]
    cos, sin = jnp.cos(ang), jnp.sin(ang)
    x1 = x[..., :half].astype(jnp.float32)
    x2 = x[..., half:].astype(jnp.float32)
    return jnp.concatenate([x1 * cos - x2 * sin, x2 * cos + x1 * sin], axis=-1).astype(x.dtype)


def rope_2d(x):
    L = x.shape[-2]
    rows = L // GRID_W
    t = jnp.arange(rows * GRID_W)
    half = x.shape[-1] // 2
    return jnp.concatenate([rope_1d(x[..., :half], t // GRID_W), rope_1d(x[..., half:], t % GRID_W)], axis=-1)


def adaln(cond, w_mod, b_mod):
    m = jax.nn.silu(cond) @ w_mod + b_mod
    return jnp.split(m[..., None, :], 6, axis=-1)


def attend_blocks(q, k, v):
    B, KV, G, Lq, hd = q.shape
    nb = Lq // Q_BLOCK
    qb = q.reshape(B, KV, G, nb, Q_BLOCK, hd).transpose(3, 0, 1, 2, 4, 5)
    scale = hd ** -0.5

    def one_block(qblk):
        s = jnp.einsum("bkgqd,bksd->bkgqs", qblk, k, preferred_element_type=jnp.float32) * scale
        p = jax.nn.softmax(s, axis=-1)
        return jnp.einsum("bkgqs,bksd->bkgqd", p.astype(v.dtype), v)

    o = lax.map(one_block, qb)
    o = o.transpose(1, 2, 3, 0, 4, 5).reshape(B, KV * G, Lq, hd)
    return o.transpose(0, 2, 1, 3).reshape(B, Lq, KV * G * hd)


def retention_scan(q, k, v, log_gamma, s0):
    B, H, L, dk = q.shape
    dv = v.shape[-1]
    n = L // CHUNK
    qc = q.reshape(B, H, n, CHUNK, dk)
    kc = k.reshape(B, H, n, CHUNK, dk)
    vc = v.reshape(B, H, n, CHUNK, dv)
    i = jnp.arange(CHUNK, dtype=jnp.float32)
    lg = log_gamma[:, None]
    diff = i[:, None] - i[None, :]
    intra_decay = jnp.where(diff >= 0, jnp.exp(lg[:, :, None] * jnp.maximum(diff, 0.0)), 0.0)
    q_decay = jnp.exp(lg * (i + 1.0))
    k_decay = jnp.exp(lg * (CHUNK - 1.0 - i))
    chunk_decay = jnp.exp(log_gamma * CHUNK)[None, :, None, None]
    scores = jnp.einsum("bhnid,bhnjd->bhnij", qc, kc, preferred_element_type=jnp.float32)
    scores = scores * intra_decay[None, :, None]
    intra = jnp.einsum("bhnij,bhnjv->bhniv", scores, vc.astype(jnp.float32))
    kv = jnp.einsum("bhnjd,bhnjv->nbhdv", kc.astype(jnp.float32) * k_decay[None, :, None, :, None],
                    vc.astype(jnp.float32))

    def step(s, kv_n):
        return chunk_decay * s + kv_n, s

    s_final, s_prev = lax.scan(step, s0.astype(jnp.float32), kv)
    cross = jnp.einsum("bhnid,nbhdv->bhniv", qc.astype(jnp.float32) * q_decay[None, :, None, :, None], s_prev)
    return (intra + cross).reshape(B, H, L, dv), s_final


def retention_branch(rq, rk, rv, rg, pos, dec_f, dec_b, s0_f, s0_b):
    B, L, _ = rq.shape
    q = rope_1d(rq.reshape(B, L, R_HEADS, R_DK).transpose(0, 2, 1, 3), pos)
    k = rope_1d(rk.reshape(B, L, R_HEADS, R_DK).transpose(0, 2, 1, 3), pos) * (R_DK ** -0.5)
    v = rv.reshape(B, L, R_HEADS, R_DV).transpose(0, 2, 1, 3)
    lg_f = jax.nn.log_sigmoid(dec_f.astype(jnp.float32))
    lg_b = jax.nn.log_sigmoid(dec_b.astype(jnp.float32))
    o_f, s_f = retention_scan(q, k, v, lg_f, s0_f)
    o_b, s_b = retention_scan(q[:, :, ::-1], k[:, :, ::-1], v[:, :, ::-1], lg_b, s0_b)
    o = rms_scale(o_f + o_b[:, :, ::-1])
    o = o.transpose(0, 2, 1, 3).reshape(B, L, RET_V)
    return jax.nn.silu(rg.astype(jnp.float32)) * o, s_f, s_b


def token_mixer(h, w_in, q_g, k_g, dec_f, dec_b, w_att_o, w_ret_o, w_out, ret_pos, latent_ctx):
    B, L, _ = h.shape
    z = h @ w_in
    q, k, v, rq, rk, rv, rg, ga, gr = jnp.split(z, np.cumsum(IN_SPLITS)[:-1].tolist(), axis=-1)
    q = rmsnorm(q.reshape(B, L, N_KV, GROUP, HEAD_DIM), q_g).transpose(0, 2, 3, 1, 4)
    k = rmsnorm(k.reshape(B, L, N_KV, HEAD_DIM), k_g).transpose(0, 2, 1, 3)
    v = v.reshape(B, L, N_KV, HEAD_DIM).transpose(0, 2, 1, 3)
    if latent_ctx is None:
        k_all, v_all = k, v
        s0_f = jnp.zeros((B, R_HEADS, R_DK, R_DV), jnp.float32)
        s0_b = s0_f
    else:
        ck, cv, s0_f, s0_b = latent_ctx
        q = rope_2d(q)
        k = rope_2d(k)
        k_all = jnp.concatenate([k, ck.astype(k.dtype)], axis=2)
        v_all = jnp.concatenate([v, cv.astype(v.dtype)], axis=2)
    ya = attend_blocks(q, k_all, v_all)
    yr, s_f, s_b = retention_branch(rq, rk, rv, rg, ret_pos, dec_f, dec_b, s0_f, s0_b)
    y = jax.nn.sigmoid(ga) * (ya @ w_att_o) + jax.nn.sigmoid(gr) * (yr.astype(h.dtype) @ w_ret_o)
    return y @ w_out, (k, v, s_f, s_b)


def conv_ffn(h, w_up, conv_w, conv_b, w_down):
    L = h.shape[1]
    u = h @ w_up
    up = jnp.pad(u, ((0, 0), (1, 1), (0, 0)))
    uc = conv_w[0] * up[:, :L] + conv_w[1] * up[:, 1:L + 1] + conv_w[2] * up[:, 2:L + 2] + conv_b
    a, g = jnp.split(uc, 2, axis=-1)
    return (jax.nn.silu(g) * a) @ w_down


def setup_inputs(seed: int = 0) -> dict:
    key = jax.random.key(seed)
    ks = jax.random.split(key, 26)

    def nrm(k, shape, s):
        return jax.random.normal(k, shape, jnp.float32) * s

    base_decay = jnp.log(2.0 ** (5.0 + jnp.arange(R_HEADS, dtype=jnp.float32)) - 1.0)
    return {
        "x_prompt": nrm(ks[0], (BATCH, SEQ, D_MODEL), 1.0),
        "x_sample": nrm(ks[1], (DEC_BATCH, DEC_SEQ, D_MODEL), 1.0),
        "c": nrm(ks[2], (DEC_BATCH, D_MODEL), 1.0),
        "cache_k": nrm(ks[3], (DEC_BATCH, DEPTH, N_KV, PAST_LEN, HEAD_DIM), 1.0),
        "cache_v": nrm(ks[4], (DEC_BATCH, DEPTH, N_KV, PAST_LEN, HEAD_DIM), 1.0),
        "state_ret_fwd": nrm(ks[5], (DEC_BATCH, DEPTH, R_HEADS, R_DK, R_DV), 1.0),
        "state_ret_bwd": nrm(ks[6], (DEC_BATCH, DEPTH, R_HEADS, R_DK, R_DV), 1.0),
        "c_ctx": nrm(ks[7], (D_MODEL,), 1.0),
        "norm1_g": 1.0 + nrm(ks[8], (DEPTH, D_MODEL), 0.05),
        "norm2_g": 1.0 + nrm(ks[9], (DEPTH, D_MODEL), 0.05),
        "w_mod": nrm(ks[10], (DEPTH, D_MODEL, 6 * D_MODEL), D_MODEL ** -0.5),
        "b_mod": nrm(ks[11], (DEPTH, 6 * D_MODEL), 0.02),
        "w_in": nrm(ks[12], (DEPTH, D_MODEL, D_IN), D_MODEL ** -0.5),
        "q_norm_g": 1.0 + nrm(ks[13], (DEPTH, HEAD_DIM), 0.05),
        "k_norm_g": 1.0 + nrm(ks[14], (DEPTH, HEAD_DIM), 0.05),
        "decay_fwd": base_decay + nrm(ks[15], (DEPTH, R_HEADS), 0.1),
        "decay_bwd": base_decay + nrm(ks[16], (DEPTH, R_HEADS), 0.1),
        "w_att_o": nrm(ks[17], (DEPTH, ATT_Q, D_MODEL), ATT_Q ** -0.5),
        "w_ret_o": nrm(ks[18], (DEPTH, RET_V, D_MODEL), RET_V ** -0.5),
        "w_out": nrm(ks[19], (DEPTH, D_MODEL, D_MODEL), D_MODEL ** -0.5),
        "w_up": nrm(ks[20], (DEPTH, D_MODEL, 2 * D_FF), D_MODEL ** -0.5),
        "conv_w": nrm(ks[21], (DEPTH, CONV_W, 2 * D_FF), CONV_W ** -0.5),
        "conv_b": nrm(ks[22], (DEPTH, 2 * D_FF), 0.02),
        "w_down": nrm(ks[23], (DEPTH, D_FF, D_MODEL), D_FF ** -0.5),
        "final_g": 1.0 + nrm(ks[24], (D_MODEL,), 0.05),
    }


def reference(x_prompt, x_sample, c, cache_k, cache_v, state_ret_fwd, state_ret_bwd, c_ctx,
              norm1_g, norm2_g, w_mod, b_mod, w_in, q_norm_g, k_norm_g, decay_fwd, decay_bwd,
              w_att_o, w_ret_o, w_out, w_up, conv_w, conv_b, w_down, final_g):
    ctx_p = x_prompt.shape[1]
    ctx_s = cache_k.shape[3]
    lat = x_sample.shape[1]
    pos_ctx = jnp.arange(ctx_p)
    pos_lat = ctx_s + jnp.arange(lat)
    xp, xs = x_prompt, x_sample
    nk, nv, nsf, nsb = [], [], [], []
    for l in range(DEPTH):
        mix_w = (w_in[l], q_norm_g[l], k_norm_g[l], decay_fwd[l], decay_bwd[l], w_att_o[l], w_ret_o[l], w_out[l])
        sh1, sc1, g1, sh2, sc2, g2 = adaln(c_ctx, w_mod[l], b_mod[l])
        h = rmsnorm(xp, norm1_g[l]) * (1.0 + sc1) + sh1
        y, (k_c, v_c, sf_c, sb_c) = token_mixer(h, *mix_w, pos_ctx, None)
        xp = xp + g1 * y
        h = rmsnorm(xp, norm2_g[l]) * (1.0 + sc2) + sh2
        xp = xp + g2 * conv_ffn(h, w_up[l], conv_w[l], conv_b[l], w_down[l])
        nk.append(k_c)
        nv.append(v_c)
        nsf.append(sf_c)
        nsb.append(sb_c)
        sh1, sc1, g1, sh2, sc2, g2 = adaln(c, w_mod[l], b_mod[l])
        h = rmsnorm(xs, norm1_g[l]) * (1.0 + sc1) + sh1
        ctx = (cache_k[:, l], cache_v[:, l], state_ret_fwd[:, l], state_ret_bwd[:, l])
        y, _ = token_mixer(h, *mix_w, pos_lat, ctx)
        xs = xs + g1 * y
        h = rmsnorm(xs, norm2_g[l]) * (1.0 + sc2) + sh2
        xs = xs + g2 * conv_ffn(h, w_up[l], conv_w[l], conv_b[l], w_down[l])
    y_prompt = rmsnorm(xp, final_g)
    y_sample = rmsnorm(xs, final_g)
    new_cache_k = jnp.stack(nk, axis=1)
    new_cache_v = jnp.stack(nv, axis=1)
    new_state_ret_fwd = jnp.stack(nsf, axis=1)
    new_state_ret_bwd = jnp.stack(nsb, axis=1)
    return (y_prompt, y_sample, new_cache_k, new_cache_v, new_state_ret_fwd, new_state_ret_bwd)
```

```cpp
#include <hip/hip_runtime.h>
#include <hip/hip_bf16.h>
#include <cstdio>
#include <cstdint>

constexpr int DM = 1024, NB = 16, SEQ = 256, DB = 4, DSEQ = 4096, PAST = 512, GRIDW = 64;
constexpr int NH = 8, NKV = 2, HD = 128, RH = 8, RDK = 64, RDV = 128, DFF = 2816, CHUNK = 128;
constexpr int MP = NB * SEQ, ML = DB * DSEQ, MT = MP + ML;
constexpr int DIN = 6656, SKV = DSEQ + PAST;
constexpr int NUP = 2 * DFF;
constexpr float EPS = 1e-6f;
constexpr int NCHUNK = MT / CHUNK;
constexpr int NITEM = NCHUNK * RH;

#define GAS __attribute__((address_space(1)))
#define LAS __attribute__((address_space(3)))
typedef unsigned short bf16_t;
typedef short bf16x8 __attribute__((ext_vector_type(8)));
typedef short s16x4 __attribute__((ext_vector_type(4)));
typedef float f32x4 __attribute__((ext_vector_type(4)));
typedef float f32x2 __attribute__((ext_vector_type(2)));
typedef float f32x16 __attribute__((ext_vector_type(16)));
typedef unsigned u32x4 __attribute__((ext_vector_type(4)));
typedef unsigned u32x2 __attribute__((ext_vector_type(2)));
typedef GAS unsigned gu32;

constexpr size_t MiB = 1u << 20;
constexpr size_t WS_CTL = 0, CTL_ZERO_BYTES = 64 * 1024;
constexpr size_t WS_MOD = 1 * MiB;
constexpr size_t WS_BUP = 1 * MiB + 128 * 1024;
constexpr size_t WS_SSQ1 = 1 * MiB + 256 * 1024;
constexpr size_t WS_SSQ2 = 1 * MiB + 384 * 1024;
constexpr size_t WS_WA = 2 * MiB;
constexpr size_t WS_WB = 16 * MiB;
constexpr size_t WS_WC = 20 * MiB;
constexpr size_t WS_WD = 22 * MiB;
constexpr size_t WS_H = 28 * MiB;
constexpr size_t WS_Q = 68 * MiB;
constexpr size_t WS_KALL = 108 * MiB, WS_VALL = 117 * MiB, WS_KP = 126 * MiB, WS_VP = 128 * MiB;
constexpr size_t WS_RQ = 132 * MiB, WS_RK = 152 * MiB, WS_RV = 172 * MiB, WS_SRG = 212 * MiB, WS_END = 252 * MiB;
constexpr size_t WS_Y = WS_RQ;
constexpr size_t WS_ACT = WS_Q;
constexpr size_t WS_EDGE_U = WS_SRG, WS_EDGE_UC = WS_SRG + 4 * MiB;
static_assert((size_t)DIN * DM * 2 <= 14 * MiB && (size_t)MT * DM * 2 == 40 * MiB && (size_t)NITEM * 2 * RDK * RDV * 2 == 40 * MiB, "ws map");
static_assert((size_t)DB * NKV * SKV * HD * 2 <= 9 * MiB && (size_t)NB * NKV * SEQ * HD * 2 <= 2 * MiB, "ws map kv");
static_assert(WS_ACT + (size_t)MT * DFF * 2 <= WS_SRG && (size_t)80 * 2 * NUP * 4 <= 4 * MiB, "ws map act");
constexpr size_t OUT_Y = 0, OUT_CK = (size_t)MT * DM, OUT_CV = OUT_CK + (size_t)NB * NKV * SEQ * HD, OUT_SF = OUT_CV + (size_t)NB * NKV * SEQ * HD, OUT_SB = OUT_SF + (size_t)NB * RH * RDK * RDV;

#define LDS_WAIT() asm volatile("s_waitcnt lgkmcnt(0)" ::: "memory")
#define VM_WAIT() asm volatile("s_waitcnt vmcnt(0)" ::: "memory")
#define RLX_AGENT __ATOMIC_RELAXED, __HIP_MEMORY_SCOPE_AGENT
__device__ __forceinline__ unsigned f2bf(float f) { unsigned u = __builtin_bit_cast(unsigned, f); return (u + 0x7fffu + ((u >> 16) & 1u)) >> 16; }
__device__ __forceinline__ unsigned pk2(float lo, float hi) { return f2bf(lo) | (f2bf(hi) << 16); }
__device__ __forceinline__ float bflo(unsigned w) { return __builtin_bit_cast(float, w << 16); }
__device__ __forceinline__ float bfhi(unsigned w) { return __builtin_bit_cast(float, w & 0xffff0000u); }
__device__ __forceinline__ float bf2f(bf16_t h) { return __builtin_bit_cast(float, (unsigned)h << 16); }
__device__ __forceinline__ int swap25(int p) { return (p & ~0x24) | ((p & 4) << 3) | ((p & 32) >> 3); }
__device__ __forceinline__ float sigmoidf_(float x) { return 1.0f / (1.0f + __expf(-x)); }
__device__ __forceinline__ float siluf_(float x) { return x / (1.0f + __expf(-x)); }
__device__ __forceinline__ int lane_id_() { int l; asm volatile("v_mbcnt_lo_u32_b32 %0, -1, 0\n\tv_mbcnt_hi_u32_b32 %0, -1, %0" : "=v"(l)); return l; }
__device__ __forceinline__ float wave_sum(float v) {
#pragma unroll
    for (int o = 1; o < 64; o <<= 1) v += __shfl_xor(v, o);
    return v;
}
__device__ __forceinline__ void sincos_rev(float ang, float& c, float& s) {
    double rev = (double)ang * 0.15915494309189533577; rev -= __builtin_rint(rev);
    const float fr = (float)rev; s = __builtin_amdgcn_sinf(fr); c = __builtin_amdgcn_cosf(fr);
}
__device__ __forceinline__ float rope_inv(int i) { return exp2f(-(float)i * (13.287712379549449f / 32.0f)); }

#define XB_TMO      128
#define XB_XCNT(j)  (256  + 64 * (j))
#define XB_XSUB(j)  (1280 + 64 * (j))
#define XB_XGEN(j)  (2304 + 64 * (j))
#define XB_TOP      3328
#define XB_TOPGEN   3392
#define XCD_BAR_WORDS 3456
#define XB_SPIN_CAP (1u << 20)
__device__ __forceinline__ unsigned xb_ld(unsigned* p)              { return __hip_atomic_load(p, __ATOMIC_RELAXED, __HIP_MEMORY_SCOPE_AGENT); }
__device__ __forceinline__ unsigned xb_add(unsigned* p, unsigned v) { return __hip_atomic_fetch_add(p, v, __ATOMIC_RELAXED, __HIP_MEMORY_SCOPE_AGENT); }
__device__ __forceinline__ unsigned xb_xcc_id() { return (unsigned)__builtin_amdgcn_s_getreg((3 << 11) | 20) & 0xFu; }
#define XB_SPIN(cond, bar) do { unsigned _sp = 0; while (cond) { __builtin_amdgcn_s_sleep(1); \
    if ((++_sp & 255u) == 0u) { if (xb_ld(&(bar)[XB_TMO])) break; if (_sp > XB_SPIN_CAP) { atomicAdd(&(bar)[XB_TMO], 1u); break; } } } } while (0)
struct XcdBarrier { unsigned* bar; unsigned x; volatile LAS unsigned* st; int wave; };
__device__ __forceinline__ XcdBarrier xcd_barrier_post(unsigned* bar, volatile LAS unsigned* st, int wave) {
    XcdBarrier b; b.bar = bar; b.x = xb_xcc_id(); b.st = st; b.wave = wave;
    if (wave == 0 && lane_id_() == 0) (void)xb_add(&bar[XB_XCNT(b.x)], 1u);
    return b;
}
__device__ __forceinline__ void xcd_barrier_complete(unsigned* bar, unsigned x, unsigned& nloc, unsigned& nx) {
    const unsigned G = gridDim.x * gridDim.y * gridDim.z;
    unsigned sum, cnt, mine, sp = 0u;
    for (;;) {
        sum = 0u; cnt = 0u; mine = 0u;
#pragma unroll
        for (unsigned j = 0; j < 16; ++j) { const unsigned c = xb_ld(&bar[XB_XCNT(j)]); sum += c; cnt += (c > 0u) ? 1u : 0u; mine = (j == x) ? c : mine; }
        if (sum == G) break;
        __builtin_amdgcn_s_sleep(1);
        if ((++sp & 255u) == 0u) { if (xb_ld(&bar[XB_TMO])) break; if (sp > XB_SPIN_CAP) { atomicAdd(&bar[XB_TMO], 1u); break; } }
    }
    nloc = mine > 0u ? mine : 1u; nx = cnt > 0u ? cnt : 1u;
}
__device__ __forceinline__ void xcd_barrier(const XcdBarrier& b) {
    asm volatile("s_waitcnt vmcnt(0)" ::: "memory");
    __syncthreads();
    if (b.wave == 0 && lane_id_() == 0) {
        unsigned* bar = b.bar;
        __builtin_amdgcn_s_waitcnt(0);
        unsigned nloc = b.st[0], nx = b.st[1];
        if (nloc == 0u) { xcd_barrier_complete(bar, b.x, nloc, nx); b.st[0] = nloc; b.st[1] = nx; }
        const unsigned old = xb_add(&bar[XB_XSUB(b.x)], 1u);
        const unsigned gen = old / nloc;
        if (old + 1u == (gen + 1u) * nloc) {
            __builtin_amdgcn_fence(__ATOMIC_RELEASE, "agent");
            asm volatile("s_waitcnt vmcnt(0)" ::: "memory");
            const unsigned og = xb_add(&bar[XB_TOP], 1u);
            const unsigned tg = og / nx;
            if (og + 1u == (tg + 1u) * nx) xb_add(&bar[XB_TOPGEN], 1u);
            else XB_SPIN(xb_ld(&bar[XB_TOPGEN]) == tg, bar);
            __builtin_amdgcn_fence(__ATOMIC_ACQUIRE, "agent");
            xb_add(&bar[XB_XGEN(b.x)], 1u);
            asm volatile("s_waitcnt vmcnt(0)" ::: "memory");
        } else {
            XB_SPIN(xb_ld(&bar[XB_XGEN(b.x)]) == gen, bar);
            __builtin_amdgcn_fence(__ATOMIC_ACQUIRE, "agent");
            asm volatile("s_waitcnt vmcnt(0)" ::: "memory");
        }
    }
    __syncthreads();
}

namespace pg8 {
constexpr int BM = 256, BK = 64, HALF = 128, HTB = HALF * BK * 2, STAGE_BYTES = 8 * HTB, NXCD = 8, WGM = 8;
__host__ __device__ __forceinline__ int lds_byte(int r, int c) { const int st = (r >> 4) * 2 + (c >> 5), rr = r & 15, cc = c & 31, ob = rr * 64 + cc * 2; return st * 1024 + (ob ^ (((ob >> 9) & 1) << 5)); }
__host__ __device__ __forceinline__ void stage_rc(int b, int& R, int& C) { const int st = b / 1024, sb = b % 1024, swz = sb ^ (((sb >> 9) & 1) << 5); R = (st >> 1) * 16 + swz / 64; C = (st & 1) * 32 + (swz % 64) / 2; }
__host__ __device__ __forceinline__ int perm32(int rho) { const int n = rho >> 4, i = rho & 15; return 8 * (i >> 2) + 4 * n + (i & 3); }
struct Unit { int pm, pn; };
struct Gemm { const bf16_t* A; const bf16_t* Bt; int M, N, K, lda, ldb, jt; long jumpA; };
struct StaticOrder {
    int nM, nN, nwg, G, c;
    __host__ __device__ void init(int M, int N, int G_, int c_) { nM = M / BM; nN = N / BM; nwg = nM * nN; G = G_; c = c_; }
    __host__ __device__ bool next(int i, Unit& u) const {
        const long L = (long)i * G + c; if (L >= nwg) return false;
        int wgid = (int)L; { const int q = nwg / NXCD, r = nwg % NXCD, xcd = wgid % NXCD, off = wgid / NXCD; wgid = (xcd < r ? xcd * (q + 1) : r * (q + 1) + (xcd - r) * q) + off; }
        const int nig = WGM * nN, gid = wgid / nig, fm = gid * WGM, gsz = (nM - fm) < WGM ? (nM - fm) : WGM;
        u.pm = fm + ((wgid % nig) % gsz); u.pn = (wgid % nig) / gsz; return true;
    }
};
template <class Epi, class Sched>
__device__ __forceinline__ void gemm_phase(LAS unsigned char* lds, const Gemm g, const Sched& S, const Epi& E, const int wid) {
    const int lane = lane_id_(), tid = wid * 64 + lane, wr = wid >> 2, wc = wid & 3, fr = lane & 15, fq = lane >> 4;
    const int nt = g.K / BK;
    unsigned voffA[2], voffB[2];
#pragma unroll
    for (int i = 0; i < 2; ++i) { int R, C; stage_rc(tid * 16 + i * 8192, R, C); const int Rb = (R & ~31) + perm32(R & 31);
        voffA[i] = (unsigned)(R * g.lda + C) * 2u; voffB[i] = (unsigned)(Rb * g.ldb + C) * 2u; }
    const size_t kstep = (size_t)(BK * 2);
    const size_t hstepA = (size_t)HALF * g.lda * 2, hstepB = (size_t)HALF * g.ldb * 2;
    const size_t tstepA = 2 * hstepA, tstepB = 2 * hstepB;
    const unsigned ldsw = (unsigned)wid * 1024u;
    const int aoff = lds_byte(wr * 64 + fr, fq * 8), boff = lds_byte(wc * 32 + fr, fq * 8);
#define PG8_SA(b, h) (((b) * 2 + (h)) * HTB)
#define PG8_SB(b, h) ((4 + (b) * 2 + (h)) * HTB)
#define PG8_STAGE(bufoff, gbase, voff) do { _Pragma("unroll") for (int _i = 0; _i < 2; ++_i) \
        __builtin_amdgcn_global_load_lds((const unsigned*)((const char*)(gbase) + (voff)[_i]), (LAS unsigned*)(lds + (bufoff) + ldsw + _i * 8192), 16, 0, 0); } while (0)
#define PG8_LDA(dst, b, h) do { _Pragma("unroll") for (int m = 0; m < 4; ++m) _Pragma("unroll") for (int k = 0; k < 2; ++k) dst[m][k] = *(const LAS bf16x8*)(lds + PG8_SA(b, h) + aoff + m * 2048 + k * 1024); } while (0)
#define PG8_LDB(dst, b, h) do { _Pragma("unroll") for (int n = 0; n < 2; ++n) _Pragma("unroll") for (int k = 0; k < 2; ++k) dst[n][k] = *(const LAS bf16x8*)(lds + PG8_SB(b, h) + boff + n * 2048 + k * 1024); } while (0)
#define PG8_MMA(ai, bj, At, Bt) do { __builtin_amdgcn_s_setprio(1); _Pragma("unroll") for (int m = 0; m < 4; ++m) _Pragma("unroll") for (int n = 0; n < 2; ++n) _Pragma("unroll") for (int k = 0; k < 2; ++k) \
        acc[ai][bj][m][n] = __builtin_amdgcn_mfma_f32_16x16x32_bf16(Bt[n][k], At[m][k], acc[ai][bj][m][n], 0, 0, 0); __builtin_amdgcn_s_setprio(0); } while (0)
#define PG8_WAIT_V(n) asm volatile("s_waitcnt vmcnt(" #n ")" ::: "memory")
#define PG8_WAIT_L(n) asm volatile("s_waitcnt lgkmcnt(" #n ")" ::: "memory")
#define PG8_BAR __builtin_amdgcn_s_barrier()
#define PG8_SCHED __builtin_amdgcn_sched_barrier(0)
    Unit cur, nxt; int ui = 0;
    if (!S.next(0, cur)) return;
    f32x4 acc[2][2][4][2];
#pragma unroll
    for (int a = 0; a < 2; ++a)
#pragma unroll
        for (int b = 0; b < 2; ++b)
#pragma unroll
            for (int m = 0; m < 4; ++m)
#pragma unroll
                for (int n = 0; n < 2; ++n) acc[a][b][m][n] = (f32x4){0.f, 0.f, 0.f, 0.f};
    bf16x8 At[4][2], B0[2][2], B1[2][2];
    const char* cA = (const char*)g.A + (size_t)cur.pm * tstepA; const char* cB = (const char*)g.Bt + (size_t)cur.pn * tstepB;
    const int jt = g.jt; const long jumpA = g.jumpA;
#define PG8_KA(base, t) ((base) + (size_t)(t) * kstep + ((t) >= jt ? jumpA : 0L))
    PG8_STAGE(PG8_SB(0, 0), cB, voffB); PG8_STAGE(PG8_SB(0, 1), cB + hstepB, voffB); PG8_STAGE(PG8_SA(0, 0), cA, voffA); PG8_STAGE(PG8_SA(0, 1), cA + hstepA, voffA);
    if (wr == 1) PG8_BAR;
    PG8_WAIT_V(2); PG8_BAR;
    PG8_STAGE(PG8_SB(1, 0), cB + kstep, voffB); PG8_STAGE(PG8_SA(1, 0), PG8_KA(cA, 1), voffA); PG8_STAGE(PG8_SB(1, 1), cB + hstepB + kstep, voffB);
    PG8_WAIT_V(6); PG8_BAR;
    for (;;) {
        const bool has_next = S.next(ui + 1, nxt);
        const char* nA = has_next ? (const char*)g.A + (size_t)nxt.pm * tstepA : cA; const char* nB = has_next ? (const char*)g.Bt + (size_t)nxt.pn * tstepB : cB;
        for (int seg = 0; seg < (Epi::MID_T >= 0 ? 2 : 1); ++seg) {
        const int tb = (Epi::MID_T >= 0 && seg == 1) ? Epi::MID_T : 0, te = (Epi::MID_T >= 0 && seg == 0) ? Epi::MID_T : nt;
        if constexpr (Epi::MID_T >= 0) { if (seg == 1) E.mid(acc, cur, wr, wc, fr, fq); }
        for (int t = tb; t < te; t += 2) {
            const bool last = (t == nt - 2);
            const char* a1 = PG8_KA(cA, t + 1);
            const char* a2 = last ? nA : PG8_KA(cA, t + 2); const char* b2 = last ? nB : cB + (size_t)(t + 2) * kstep;
            const char* a3 = last ? PG8_KA(nA, 1) : PG8_KA(cA, t + 3); const char* b3 = b2 + kstep;
            PG8_LDB(B0, 0, 0); PG8_LDB(B1, 0, 1); PG8_SCHED; PG8_LDA(At, 0, 0); PG8_STAGE(PG8_SA(1, 1), a1 + hstepA, voffA);
            PG8_WAIT_V(8); PG8_WAIT_L(0); PG8_BAR; PG8_MMA(0, 0, At, B0); PG8_MMA(0, 1, At, B1); PG8_BAR; PG8_SCHED;
            PG8_LDA(At, 0, 1); PG8_STAGE(PG8_SB(0, 0), b2, voffB); PG8_STAGE(PG8_SB(0, 1), b2 + hstepB, voffB); PG8_STAGE(PG8_SA(0, 0), a2, voffA);
            PG8_WAIT_V(8); PG8_WAIT_L(0); PG8_BAR; PG8_MMA(1, 0, At, B0); PG8_MMA(1, 1, At, B1); PG8_BAR; PG8_SCHED;
            PG8_LDB(B0, 1, 0); PG8_LDB(B1, 1, 1); PG8_SCHED; PG8_LDA(At, 1, 0); PG8_STAGE(PG8_SA(0, 1), a2 + hstepA, voffA);
            PG8_WAIT_V(8); PG8_WAIT_L(0); PG8_BAR; PG8_MMA(0, 0, At, B0); PG8_MMA(0, 1, At, B1); PG8_BAR; PG8_SCHED;
            PG8_LDA(At, 1, 1); PG8_STAGE(PG8_SB(1, 0), b3, voffB); PG8_STAGE(PG8_SB(1, 1), b3 + hstepB, voffB); PG8_STAGE(PG8_SA(1, 0), a3, voffA);
            PG8_WAIT_V(8); PG8_WAIT_L(0); PG8_BAR; PG8_MMA(1, 0, At, B0); PG8_MMA(1, 1, At, B1); PG8_BAR; PG8_SCHED;
        }
        }
        if (wr == 0) PG8_BAR;
        E.epi(acc, cur, wr, wc, fr, fq, wid, lane);
        if (!has_next) break;
#pragma unroll
        for (int a = 0; a < 2; ++a)
#pragma unroll
            for (int b = 0; b < 2; ++b)
#pragma unroll
                for (int m = 0; m < 4; ++m)
#pragma unroll
                    for (int n = 0; n < 2; ++n) acc[a][b][m][n] = (f32x4){0.f, 0.f, 0.f, 0.f};
        cur = nxt; cA = nA; cB = nB; ++ui;
        if (wr == 1) PG8_BAR;
    }
    PG8_WAIT_V(0);
    PG8_BAR;
#undef PG8_KA
#undef PG8_SA
#undef PG8_SB
#undef PG8_STAGE
#undef PG8_LDA
#undef PG8_LDB
#undef PG8_MMA
#undef PG8_WAIT_V
#undef PG8_WAIT_L
#undef PG8_BAR
#undef PG8_SCHED
}
}

typedef f32x4 AccT[2][2][4][2];
#define PIN8(a, i, j) asm volatile("" : "+v"(a[i][j][0][0]), "+v"(a[i][j][0][1]), "+v"(a[i][j][1][0]), "+v"(a[i][j][1][1]), "+v"(a[i][j][2][0]), "+v"(a[i][j][2][1]), "+v"(a[i][j][3][0]), "+v"(a[i][j][3][1]))
#define PINACC(a) do { PIN8(a, 0, 0); PIN8(a, 0, 1); PIN8(a, 1, 0); PIN8(a, 1, 1); } while (0)
#define RAW_BAR() do { asm volatile("s_waitcnt lgkmcnt(0)" ::: "memory"); __builtin_amdgcn_s_barrier(); asm volatile("" ::: "memory"); } while (0)
__device__ __forceinline__ u32x4 pack8(const f32x4 a, const f32x4 b) { u32x4 w; w.x = pk2(a[0], a[1]); w.y = pk2(a[2], a[3]); w.z = pk2(b[0], b[1]); w.w = pk2(b[2], b[3]); return w; }
__device__ __forceinline__ void unpack8(const u32x4 w, f32x4& a, f32x4& b) { a = (f32x4){bflo(w.x), bfhi(w.x), bflo(w.y), bfhi(w.y)}; b = (f32x4){bflo(w.z), bfhi(w.z), bflo(w.w), bfhi(w.w)}; }

struct EpiIn {
    static constexpr int MID_T = -1;
    bf16_t *Q, *KALL, *VALL, *KP, *VP, *RQ, *RK, *RV, *SRG, *GA, *GR; float *ock, *ocv; const float *qg, *kg; LAS float* P;
    __device__ __forceinline__ void mid(AccT&, const pg8::Unit&, int, int, int, int) const {}
    __device__ __forceinline__ void epi(AccT& acc, const pg8::Unit& u, int wr, int wc, int fr, int fq, int wid, int lane) const {
        asm volatile("" : "+v"(fr), "+v"(fq));
        const int pn = u.pn, pm = u.pm; const bool latent = pm >= 16;
        const int lb = (pm - 16) >> 4, t0 = latent ? ((pm - 16) & 15) * 256 : 0;
        const int rl0 = 64 * wr + fr, cw8 = 32 * wc + 8 * fq;
        const size_t grow0 = (size_t)pm * 256;
        if (pn <= 4) {
#pragma unroll
            for (int ai = 0; ai < 2; ++ai)
#pragma unroll
                for (int m = 0; m < 4; ++m)
#pragma unroll
                    for (int bj = 0; bj < 2; ++bj) { const f32x4 a = acc[ai][bj][m][0], b = acc[ai][bj][m][1];
                        float s = (a[0] * a[0] + a[1] * a[1]) + (a[2] * a[2] + a[3] * a[3]) + (b[0] * b[0] + b[1] * b[1]) + (b[2] * b[2] + b[3] * b[3]);
                        s += __shfl_xor(s, 16); s += __shfl_xor(s, 32);
                        if (fq == 0) P[((128 * ai + rl0 + 16 * m) * 2 + bj) * 4 + wc] = s; }
            RAW_BAR();
            const float* gain = pn < 4 ? qg : kg;
            const int d0 = 64 * (wc >> 1) + 8 * fq + 4 * (wc & 1);
            const f32x4 g0 = *(const f32x4*)(gain + d0), g1 = *(const f32x4*)(gain + d0 + 32);
            float inv[4];
#pragma unroll
            for (int e = 0; e < 4; ++e) inv[e] = rope_inv(8 * fq + 4 * (wc & 1) + e);
#pragma unroll
            for (int ai = 0; ai < 2; ++ai)
#pragma unroll
                for (int m = 0; m < 4; ++m) { const int r = 128 * ai + rl0 + 16 * m, t = t0 + r;
                    f32x4 cs = {1.f, 1.f, 1.f, 1.f}, sn = {0.f, 0.f, 0.f, 0.f};
                    if (latent) { const float pos = (float)((wc >> 1) == 0 ? (t >> 6) : (t & 63));
#pragma unroll
                        for (int e = 0; e < 4; ++e) { float c_, s_; sincos_rev(pos * inv[e], c_, s_); cs[e] = c_; sn[e] = s_; } }
#pragma unroll
                    for (int bj = 0; bj < 2; ++bj) { const f32x4 pp = *(const LAS f32x4*)&P[(r * 2 + bj) * 4];
                        const float rstd = __builtin_amdgcn_rsqf(((pp[0] + pp[1]) + (pp[2] + pp[3])) * (1.0f / 128.0f) + EPS);
                        const f32x4 x1 = acc[ai][bj][m][0] * rstd * g0, x2 = acc[ai][bj][m][1] * rstd * g1;
                        const f32x4 o1 = x1 * cs - x2 * sn, o2 = x2 * cs + x1 * sn;
                        const u32x4 w = pack8(o1, o2);
                        if (pn < 4) { *(u32x4*)(Q + (grow0 + r) * 1024 + 128 * (2 * pn + bj) + cw8) = w; }
                        else if (latent) { *(u32x4*)(KALL + ((size_t)(lb * 2 + bj) * SKV + t) * 128 + cw8) = w; }
                        else { const size_t o = ((size_t)(pm * 2 + bj) * 256 + t) * 128;
                            *(u32x4*)(KP + o + cw8) = w; *(f32x4*)(ock + o + d0) = o1; *(f32x4*)(ock + o + d0 + 32) = o2; } } }
        } else if (pn == 5) {
#pragma unroll
            for (int ai = 0; ai < 2; ++ai)
#pragma unroll
                for (int m = 0; m < 4; ++m) { const int r = 128 * ai + rl0 + 16 * m, t = t0 + r;
#pragma unroll
                    for (int bj = 0; bj < 2; ++bj) { const f32x4 a = acc[ai][bj][m][0], b = acc[ai][bj][m][1]; const u32x4 w = pack8(a, b);
                        if (latent) { *(u32x4*)(VALL + ((size_t)(lb * 2 + bj) * SKV + t) * 128 + cw8) = w; }
                        else { const size_t o = ((size_t)(pm * 2 + bj) * 256 + t) * 128 + cw8;
                            *(u32x4*)(VP + o) = w; *(f32x4*)(ocv + o) = a; *(f32x4*)(ocv + o + 4) = b; } } }
        } else if (pn <= 9) {
            const float sc = pn >= 8 ? 0.125f : 1.0f; bf16_t* dst = RQ + (pn >= 8 ? (WS_RK - WS_RQ) / 2 : 0); const int cb = 256 * ((pn - 6) & 1);
            float inv[4];
#pragma unroll
            for (int e = 0; e < 4; ++e) inv[e] = rope_inv(8 * fq + 4 * (wc & 1) + e);
#pragma unroll
            for (int ai = 0; ai < 2; ++ai)
#pragma unroll
                for (int m = 0; m < 4; ++m) { const int r = 128 * ai + rl0 + 16 * m, t = t0 + r; const float pos = (float)(latent ? PAST + t : t);
                    f32x4 cs, sn;
#pragma unroll
                    for (int e = 0; e < 4; ++e) { float c_, s_; sincos_rev(pos * inv[e], c_, s_); cs[e] = c_ * sc; sn[e] = s_ * sc; }
#pragma unroll
                    for (int bj = 0; bj < 2; ++bj) { const f32x4 x1 = acc[ai][bj][m][0], x2 = acc[ai][bj][m][1];
                        *(u32x4*)(dst + (grow0 + r) * 512 + cb + 128 * bj + cw8) = pack8(x1 * cs - x2 * sn, x2 * cs + x1 * sn); } }
        } else {
            const int kind = (pn - 10) >> 2; bf16_t* dst = kind < 2 ? RV + (size_t)kind * ((WS_SRG - WS_RV) / 2) : GA + (size_t)(kind - 2) * MT * DM; const int cb = 256 * ((pn - 10) & 3);
#pragma unroll
            for (int ai = 0; ai < 2; ++ai)
#pragma unroll
                for (int m = 0; m < 4; ++m) { const int r = 128 * ai + rl0 + 16 * m;
#pragma unroll
                    for (int bj = 0; bj < 2; ++bj) { f32x4 a = acc[ai][bj][m][0], b = acc[ai][bj][m][1];
                        if (kind == 1) { _Pragma("unroll") for (int e = 0; e < 4; ++e) { a[e] = siluf_(a[e]); b[e] = siluf_(b[e]); } }
                        else if (kind >= 2) { _Pragma("unroll") for (int e = 0; e < 4; ++e) { a[e] = sigmoidf_(a[e]); b[e] = sigmoidf_(b[e]); } }
                        *(u32x4*)(dst + (grow0 + r) * 1024 + cb + 128 * bj + cw8) = pack8(a, b); } }
        }
    }
};

struct EpiMix {
    static constexpr int MID_T = 16;
    const bf16_t *GA, *GR; bf16_t* Y;
    __device__ __forceinline__ void mid(AccT& acc, const pg8::Unit& u, int wr, int wc, int fr, int fq) const {
        unsigned lo = (unsigned)(((64 * wr + fr) * 1024 + 32 * wc + 8 * fq) * 2); asm volatile("" : "+v"(lo));
        const size_t ub = ((size_t)u.pm * 256 * 1024 + 256 * u.pn) * 2; const char* ga = (const char*)GA + ub; const char* gr = (const char*)GR + ub;
#pragma unroll
        for (int ai = 0; ai < 2; ++ai)
#pragma unroll
            for (int m = 0; m < 4; ++m)
#pragma unroll
                for (int bj = 0; bj < 2; ++bj) { const unsigned o = lo + (unsigned)(((128 * ai + 16 * m) * 1024 + 128 * bj) * 2);
                    f32x4 a0, a1, r0, r1; unpack8(*(const u32x4*)(ga + o), a0, a1); unpack8(*(const u32x4*)(gr + o), r0, r1);
#pragma unroll
                    for (int e = 0; e < 4; ++e) { acc[ai][bj][m][0][e] *= a0[e] * __builtin_amdgcn_rcpf(fmaxf(r0[e], 1e-30f)); acc[ai][bj][m][1][e] *= a1[e] * __builtin_amdgcn_rcpf(fmaxf(r1[e], 1e-30f)); }
                    if (bj) asm volatile("" ::: "memory"); }
    }
    __device__ __forceinline__ void epi(AccT& acc, const pg8::Unit& u, int wr, int wc, int fr, int fq, int wid, int lane) const {
        unsigned lo = (unsigned)(((64 * wr + fr) * 1024 + 32 * wc + 8 * fq) * 2); asm volatile("" : "+v"(lo));
        const size_t ub = ((size_t)u.pm * 256 * 1024 + 256 * u.pn) * 2; const char* gr = (const char*)GR + ub; char* y = (char*)Y + ub;
#pragma unroll
        for (int ai = 0; ai < 2; ++ai)
#pragma unroll
            for (int m = 0; m < 4; ++m)
#pragma unroll
                for (int bj = 0; bj < 2; ++bj) { const unsigned o = lo + (unsigned)(((128 * ai + 16 * m) * 1024 + 128 * bj) * 2);
                    f32x4 r0, r1; unpack8(*(const u32x4*)(gr + o), r0, r1);
                    *(u32x4*)(y + o) = pack8(acc[ai][bj][m][0] * r0, acc[ai][bj][m][1] * r1); if (bj) asm volatile("" ::: "memory"); }
    }
};

struct EpiRes1 {
    static constexpr int MID_T = -1;
    const float *xp, *xs, *mod, *g2n; float *X1, *ssq; bf16_t* A2;
    __device__ __forceinline__ void mid(AccT&, const pg8::Unit&, int, int, int, int) const {}
    __device__ __forceinline__ void epi(AccT& acc, const pg8::Unit& u, int wr, int wc, int fr, int fq, int wid, int lane) const {
        asm volatile("" : "+v"(fr), "+v"(fq));
        const int pm = u.pm, v = pm < 16 ? 0 : 1 + ((pm - 16) >> 4);
        const float* mv = mod + (size_t)v * 6144; const float* xsrc = pm < 16 ? xp + (size_t)pm * 256 * 1024 : xs + (size_t)(pm - 16) * 256 * 1024;
        f32x4 g1[2][2], w2[2][2];
#pragma unroll
        for (int bj = 0; bj < 2; ++bj)
#pragma unroll
            for (int n = 0; n < 2; ++n) { const int c = 256 * u.pn + 128 * bj + 32 * wc + 8 * fq + 4 * n;
                g1[bj][n] = *(const f32x4*)(mv + 2048 + c); w2[bj][n] = *(const f32x4*)(g2n + c) * (*(const f32x4*)(mv + 4096 + c) + 1.0f); }
#pragma unroll
        for (int ai = 0; ai < 2; ++ai)
#pragma unroll
            for (int m = 0; m < 4; ++m) { const int r = 128 * ai + 64 * wr + 16 * m + fr; float s = 0.f;
#pragma unroll
                for (int bj = 0; bj < 2; ++bj) { const size_t o = (size_t)r * 1024 + 256 * u.pn + 128 * bj + 32 * wc + 8 * fq;
                    const f32x4 x0 = *(const f32x4*)(xsrc + o) + g1[bj][0] * acc[ai][bj][m][0], x1 = *(const f32x4*)(xsrc + o + 4) + g1[bj][1] * acc[ai][bj][m][1];
                    float* dst = X1 + (size_t)pm * 256 * 1024 + o; *(f32x4*)dst = x0; *(f32x4*)(dst + 4) = x1;
                    *(u32x4*)(A2 + (size_t)pm * 256 * 1024 + o) = pack8(x0 * w2[bj][0], x1 * w2[bj][1]);
                    s += (x0[0] * x0[0] + x0[1] * x0[1]) + (x0[2] * x0[2] + x0[3] * x0[3]) + (x1[0] * x1[0] + x1[1] * x1[1]) + (x1[2] * x1[2] + x1[3] * x1[3]); }
                s += __shfl_xor(s, 16); s += __shfl_xor(s, 32);
                if (fq == 0) atomicAdd(ssq + (size_t)pm * 256 + r, s); }
    }
};

struct EpiRes2 {
    static constexpr int MID_T = -1;
    const float* mod; float *X, *ssq;
    __device__ __forceinline__ void mid(AccT&, const pg8::Unit&, int, int, int, int) const {}
    __device__ __forceinline__ void epi(AccT& acc, const pg8::Unit& u, int wr, int wc, int fr, int fq, int wid, int lane) const {
        asm volatile("" : "+v"(fr), "+v"(fq));
        const int pm = u.pm, v = pm < 16 ? 0 : 1 + ((pm - 16) >> 4); const float* mv = mod + (size_t)v * 6144;
        f32x4 g2[2][2];
#pragma unroll
        for (int bj = 0; bj < 2; ++bj)
#pragma unroll
            for (int n = 0; n < 2; ++n) g2[bj][n] = *(const f32x4*)(mv + 5120 + 256 * u.pn + 128 * bj + 32 * wc + 8 * fq + 4 * n);
#pragma unroll
        for (int ai = 0; ai < 2; ++ai)
#pragma unroll
            for (int m = 0; m < 4; ++m) { const int r = 128 * ai + 64 * wr + 16 * m + fr; float s = 0.f;
#pragma unroll
                for (int bj = 0; bj < 2; ++bj) { float* p = X + ((size_t)pm * 256 + r) * 1024 + 256 * u.pn + 128 * bj + 32 * wc + 8 * fq;
                    const f32x4 x0 = *(const f32x4*)p + g2[bj][0] * acc[ai][bj][m][0], x1 = *(const f32x4*)(p + 4) + g2[bj][1] * acc[ai][bj][m][1];
                    *(f32x4*)p = x0; *(f32x4*)(p + 4) = x1;
                    s += (x0[0] * x0[0] + x0[1] * x0[1]) + (x0[2] * x0[2] + x0[3] * x0[3]) + (x1[0] * x1[0] + x1[1] * x1[1]) + (x1[2] * x1[2] + x1[3] * x1[3]); }
                s += __shfl_xor(s, 16); s += __shfl_xor(s, 32);
                if (fq == 0) atomicAdd(ssq + (size_t)pm * 256 + r, s); }
    }
};

__device__ __forceinline__ float dpp_up(float cur, float old) {
    return __builtin_bit_cast(float, __builtin_amdgcn_update_dpp(__builtin_bit_cast(int, old), __builtin_bit_cast(int, cur), 0x111, 0xF, 0xF, false)); }
__device__ __forceinline__ float dpp_dn(float cur, float old) {
    return __builtin_bit_cast(float, __builtin_amdgcn_update_dpp(__builtin_bit_cast(int, old), __builtin_bit_cast(int, cur), 0x101, 0xF, 0xF, false)); }
__device__ __forceinline__ float dpp_ror1(float x) {
    return __builtin_bit_cast(float, __builtin_amdgcn_update_dpp(0, __builtin_bit_cast(int, x), 0x121, 0xF, 0xF, false)); }
__device__ __forceinline__ float dpp_rol1(float x) {
    return __builtin_bit_cast(float, __builtin_amdgcn_update_dpp(0, __builtin_bit_cast(int, x), 0x12F, 0xF, 0xF, false)); }
struct EpiConv {
    static constexpr int MID_T = -1;
    const float *ssq, *bup, *cw, *cbias; bf16_t* ACT; float *EU, *EUC; LAS float* E;
    __device__ __forceinline__ void mid(AccT&, const pg8::Unit&, int, int, int, int) const {}
    __device__ __forceinline__ void epi(AccT& acc, const pg8::Unit& u, int wr, int wc, int fr, int fq, int wid, int lane) const {
        const int pm = u.pm, pn = u.pn, v = pm < 16 ? 0 : 1 + ((pm - 16) >> 4); const bool latent = pm >= 16;
        unsigned cw8 = (unsigned)(32 * wc + 8 * fq), rl = (unsigned)(64 * wr + fr); asm volatile("" : "+v"(cw8), "+v"(rl));
        {   const float* bp = bup + (size_t)v * NUP + 256 * pn; const float* sp = ssq + (size_t)pm * 256;
#pragma unroll
            for (int ai = 0; ai < 2; ++ai)
#pragma unroll
                for (int m = 0; m < 4; ++m) { const float rs = __builtin_amdgcn_rsqf(sp[rl + 128 * ai + 16 * m] * (1.0f / 1024.0f) + EPS);
#pragma unroll
                    for (int bj = 0; bj < 2; ++bj)
#pragma unroll
                        for (int n = 0; n < 2; ++n) acc[ai][bj][m][n] = acc[ai][bj][m][n] * rs; }
#pragma unroll
            for (int bj = 0; bj < 2; ++bj)
#pragma unroll
                for (int n = 0; n < 2; ++n) { const f32x4 bb = *(const f32x4*)(bp + 128 * bj + cw8 + 4 * n);
#pragma unroll
                    for (int ai = 0; ai < 2; ++ai)
#pragma unroll
                        for (int m = 0; m < 4; ++m) acc[ai][bj][m][n] += bb; }
            PINACC(acc); }
        float* eu = EU + (size_t)pm * 2 * NUP + 256 * pn; float* euc = EUC + (size_t)pm * 2 * NUP + 256 * pn;
#pragma unroll
        for (int ai = 0; ai < 2; ++ai)
#pragma unroll
            for (int bj = 0; bj < 2; ++bj)
#pragma unroll
                for (int n = 0; n < 2; ++n) { const unsigned ci = 128 * bj + cw8 + 4 * n; const int grp = 2 * ai + wr;
                    if (fr == 0) { *(LAS f32x4*)&E[(grp * 2 + 0) * 256 + ci] = acc[ai][bj][0][n]; if (latent && grp == 0) *(f32x4*)(eu + ci) = acc[ai][bj][0][n]; }
                    if (fr == 15) { *(LAS f32x4*)&E[(grp * 2 + 1) * 256 + ci] = acc[ai][bj][3][n]; if (latent && grp == 3) *(f32x4*)(eu + NUP + ci) = acc[ai][bj][3][n]; } }
        RAW_BAR();
        const float* cwp = cw + 128 * pn; const float* cbp = cbias + 128 * pn; char* actp = (char*)ACT + ((size_t)pm * 256 * DFF + 128 * pn) * 2;
#pragma unroll
        for (int ai = 0; ai < 2; ++ai) { const int grp = 2 * ai + wr;
#pragma unroll
            for (int n = 0; n < 2; ++n)
#pragma unroll
                for (int bj = 0; bj < 2; ++bj) { const unsigned ci = 128 * bj + cw8 + 4 * n, ch = (bj ? DFF : 0) + cw8 + 4 * n;
                    const f32x4 w0 = *(const f32x4*)(cwp + ch), w1 = *(const f32x4*)(cwp + NUP + ch), w2 = *(const f32x4*)(cwp + 2 * NUP + ch), cb = *(const f32x4*)(cbp + ch);
                    f32x4 pe = {0.f, 0.f, 0.f, 0.f}, ne = {0.f, 0.f, 0.f, 0.f};
                    if (grp > 0) pe = *(const LAS f32x4*)&E[((grp - 1) * 2 + 1) * 256 + ci];
                    if (grp < 3) ne = *(const LAS f32x4*)&E[((grp + 1) * 2 + 0) * 256 + ci];
#pragma unroll
                    for (int e = 0; e < 4; ++e) { const float u0 = acc[ai][bj][0][n][e], u1 = acc[ai][bj][1][n][e], u2 = acc[ai][bj][2][n][e], u3 = acc[ai][bj][3][n][e];
                        const float p0 = dpp_up(u0, pe[e]), p1 = dpp_up(u1, dpp_ror1(u0)), p2 = dpp_up(u2, dpp_ror1(u1)), p3 = dpp_up(u3, dpp_ror1(u2));
                        const float n0 = dpp_dn(u0, dpp_rol1(u1)), n1 = dpp_dn(u1, dpp_rol1(u2)), n2 = dpp_dn(u2, dpp_rol1(u3)), n3 = dpp_dn(u3, ne[e]);
                        acc[ai][bj][0][n][e] = w0[e] * p0 + w1[e] * u0 + w2[e] * n0 + cb[e]; acc[ai][bj][1][n][e] = w0[e] * p1 + w1[e] * u1 + w2[e] * n1 + cb[e];
                        acc[ai][bj][2][n][e] = w0[e] * p2 + w1[e] * u2 + w2[e] * n2 + cb[e]; acc[ai][bj][3][n][e] = w0[e] * p3 + w1[e] * u3 + w2[e] * n3 + cb[e]; }
                    if (latent) { if (fr == 0 && grp == 0) *(f32x4*)(euc + ci) = acc[ai][bj][0][n];
                                  if (fr == 15 && grp == 3) *(f32x4*)(euc + NUP + ci) = acc[ai][bj][3][n]; }
                    asm volatile("" : "+v"(acc[ai][bj][0][n]), "+v"(acc[ai][bj][1][n]), "+v"(acc[ai][bj][2][n]), "+v"(acc[ai][bj][3][n]) :: "memory"); }
#pragma unroll
            for (int m = 0; m < 4; ++m) { f32x4 o0, o1;
#pragma unroll
                for (int e = 0; e < 4; ++e) { o0[e] = siluf_(acc[ai][1][m][0][e]) * acc[ai][0][m][0][e]; o1[e] = siluf_(acc[ai][1][m][1][e]) * acc[ai][0][m][1][e]; }
                *(u32x4*)(actp + ((rl + 128 * ai + 16 * m) * DFF + cw8) * 2) = pack8(o0, o1); asm volatile("" ::: "memory"); } }
    }
};

constexpr int NWAVES = 8, NTHR = 512;
constexpr int RING_BYTES = 131072, SPARE_OFF = RING_BYTES, SPARE_BYTES = 16384, MISC_OFF = SPARE_OFF + SPARE_BYTES, LDS_BYTES = MISC_OFF + 256;
struct Args {
    const float *x_prompt, *x_sample, *c, *cache_k, *cache_v, *st_f, *st_b, *c_ctx, *norm1_g, *norm2_g, *w_mod, *b_mod, *w_in, *q_g, *k_g, *dec_f, *dec_b,
                *w_att_o, *w_ret_o, *w_out, *w_up, *conv_w, *conv_b, *w_down, *final_g;
    float* out; unsigned char* ws; int ph_lo, ph_hi;
};
struct Frame { LAS unsigned char* lds; int tid, lane, wave, G, bid; };
typedef const __attribute__((address_space(4))) Args CArgs;

template <class F> __device__ __forceinline__ void transpose_item(const float* W, int ldw, bf16_t* WT, int ldd, int kofs, int k0, int n0, F srccol, LAS float* scr, int lane) {
    const int sc = srccol(n0 + (lane & 31));
#pragma unroll 8
    for (int i = 0; i < 32; ++i) { const int kk = 2 * i + (lane >> 5); scr[kk * 33 + (lane & 31)] = W[(size_t)(k0 + kk) * ldw + sc]; }
    LDS_WAIT(); asm volatile("" ::: "memory");
    const int c = lane & 7;
#pragma unroll
    for (int j = 0; j < 4; ++j) { const int n = (lane >> 3) + 8 * j; const LAS float* s = scr + (8 * c) * 33 + n;
        u32x4 o; o.x = pk2(s[0 * 33], s[1 * 33]); o.y = pk2(s[2 * 33], s[3 * 33]); o.z = pk2(s[4 * 33], s[5 * 33]); o.w = pk2(s[6 * 33], s[7 * 33]);
        *(u32x4*)(WT + (size_t)(n0 + n) * ldd + kofs + k0 + 8 * c) = o; }
    LDS_WAIT(); asm volatile("" ::: "memory");
}
struct ColId { __device__ int operator()(int n) const { return n; } };
struct ColIn { __device__ int operator()(int n) const { return (n < 1280 || (n >= 1536 && n < 2560)) ? swap25(n) : n; } };
struct ColUp { __device__ int operator()(int n) const { const int t = n >> 8, j = n & 255; return j < 128 ? 128 * t + j : DFF + 128 * t + (j - 128); } };

template <class F> __device__ __forceinline__ void gemv5_block(const Frame& F_, const float* W, int ldw, int n0, F srccol, const LAS float* a, LAS float* red, const float* bias, float* out, int ldo) {
    const int col = srccol(n0 + F_.lane); float acc[5] = {0.f, 0.f, 0.f, 0.f, 0.f};
    const int kb = F_.wave * 128;
    const float* wp = W + (size_t)kb * ldw + col;
#pragma unroll 1
    for (int k8 = 0; k8 < 128; k8 += 8) { float w[8];
#pragma unroll
        for (int j = 0; j < 8; ++j) { w[j] = *wp; wp += ldw; }
#pragma unroll
        for (int j = 0; j < 8; ++j)
#pragma unroll
            for (int v = 0; v < 5; ++v) acc[v] += a[v * 1024 + kb + k8 + j] * w[j]; }
#pragma unroll
    for (int v = 0; v < 5; ++v) red[(F_.wave * 5 + v) * 64 + F_.lane] = acc[v];
    __syncthreads();
    if (F_.tid < 320) { const int v = F_.tid >> 6, l = F_.tid & 63; float s = bias ? bias[n0 + l] : 0.f;
#pragma unroll
        for (int w = 0; w < 8; ++w) s += red[(w * 5 + v) * 64 + l];
        out[(size_t)v * ldo + n0 + l] = s; }
    __syncthreads();
}

__device__ __forceinline__ void phase0(const Frame& F, CArgs& A) {
    unsigned char* ws = A.ws;
    if (F.bid < 96) {
        LAS float* a = (LAS float*)F.lds; LAS float* red = a + 5 * 1024;
        for (int i = F.tid; i < 5 * 1024; i += NTHR) { const int v = i >> 10, k = i & 1023; const float cv = v == 0 ? A.c_ctx[k] : A.c[(v - 1) * 1024 + k]; a[i] = siluf_(cv); }
        __syncthreads();
        gemv5_block(F, A.w_mod, 6144, F.bid * 64, ColId(), a, red, A.b_mod, (float*)(ws + WS_MOD), 6144);
    }
    LAS float* scr = (LAS float*)(F.lds + 32768 + F.wave * 8704);
    const int gw = ((F.bid + 160) % F.G) * NWAVES + F.wave, NGW = F.G * NWAVES;
    constexpr int I_IN = 16 * (DIN / 32), I_O = 16 * 32, I_DN = (DFF / 64) * 32;
    constexpr int NIT = I_IN + 3 * I_O + I_DN;
    for (int it = gw; it < NIT; it += NGW) {
        int r = it;
        if (r < I_IN) { transpose_item(A.w_in, DIN, (bf16_t*)(ws + WS_WA), 1024, 0, 64 * (r / (DIN / 32)), 32 * (r % (DIN / 32)), ColIn(), scr, F.lane); continue; } r -= I_IN;
        if (r < I_O) { transpose_item(A.w_att_o, 1024, (bf16_t*)(ws + WS_WB), 2048, 0, 64 * (r / 32), 32 * (r % 32), ColId(), scr, F.lane); continue; } r -= I_O;
        if (r < I_O) { transpose_item(A.w_ret_o, 1024, (bf16_t*)(ws + WS_WB), 2048, 1024, 64 * (r / 32), 32 * (r % 32), ColId(), scr, F.lane); continue; } r -= I_O;
        if (r < I_O) { transpose_item(A.w_out, 1024, (bf16_t*)(ws + WS_WC), 1024, 0, 64 * (r / 32), 32 * (r % 32), ColId(), scr, F.lane); continue; } r -= I_O;
        transpose_item(A.w_down, 1024, (bf16_t*)(ws + WS_WD), DFF, 0, 64 * (r / 32), 32 * (r % 32), ColId(), scr, F.lane);
    }
    const int gt = F.bid * NTHR + F.tid, NGT = F.G * NTHR;
    for (int i = gt; i < DB * NKV * PAST * 16; i += NGT) { const int c8 = i & 15, row = i >> 4, t = row % PAST, bk = row / PAST;
        const size_t so = (size_t)row * 128, dofs = ((size_t)bk * SKV + DSEQ + t) * 128 + c8 * 8;
        f32x4 k0, k1; { const int p0 = c8 * 8, d0 = swap25(p0), d1 = swap25(p0 + 4); k0 = *(const f32x4*)(A.cache_k + so + d0); k1 = *(const f32x4*)(A.cache_k + so + d1); }
        *(u32x4*)((bf16_t*)(ws + WS_KALL) + dofs) = pack8(k0, k1);
        const f32x4 v0 = *(const f32x4*)(A.cache_v + so + c8 * 8), v1 = *(const f32x4*)(A.cache_v + so + c8 * 8 + 4);
        *(u32x4*)((bf16_t*)(ws + WS_VALL) + dofs) = pack8(v0, v1); }
    for (int i = gt; i < MT; i += NGT) { ((float*)(ws + WS_SSQ1))[i] = 0.f; ((float*)(ws + WS_SSQ2))[i] = 0.f; }
}

__device__ __forceinline__ void phase1(const Frame& F, CArgs& A) {
    unsigned char* ws = A.ws; const float* mod = (const float*)(ws + WS_MOD);
    if (F.bid >= 128 && F.bid < 128 + NUP / 64) {
        LAS float* a = (LAS float*)F.lds; LAS float* red = a + 5 * 1024;
        for (int i = F.tid; i < 5 * 1024; i += NTHR) a[i] = mod[(size_t)(i >> 10) * 6144 + 3072 + (i & 1023)];
        __syncthreads();
        gemv5_block(F, A.w_up, NUP, (F.bid - 128) * 64, ColUp(), a, red, nullptr, (float*)(ws + WS_BUP), NUP);
    }
    bf16_t* H = (bf16_t*)(ws + WS_H);
    constexpr int RPW = MT / (256 * NWAVES);
    const int row0 = (F.bid * NWAVES + F.wave) * RPW;
    int vcur = -1; f32x4 w1[4], s1[4];
    for (int r = row0; r < row0 + RPW; ++r) {
        const int v = r < MP ? 0 : 1 + (r - MP) / DSEQ;
        if (v != vcur) { vcur = v; const float* mv = mod + (size_t)v * 6144;
#pragma unroll
            for (int j = 0; j < 4; ++j) { const int k = 4 * F.lane + 256 * j; w1[j] = *(const f32x4*)(A.norm1_g + k) * (*(const f32x4*)(mv + 1024 + k) + 1.0f); s1[j] = *(const f32x4*)(mv + k); } }
        const float* xr = r < MP ? A.x_prompt + (size_t)r * 1024 : A.x_sample + (size_t)(r - MP) * 1024;
        f32x4 x[4]; float s = 0.f;
#pragma unroll
        for (int j = 0; j < 4; ++j) { x[j] = *(const f32x4*)(xr + 4 * F.lane + 256 * j); s += (x[j][0] * x[j][0] + x[j][1] * x[j][1]) + (x[j][2] * x[j][2] + x[j][3] * x[j][3]); }
        const float rstd = 1.0f / sqrtf(wave_sum(s) * (1.0f / 1024.0f) + EPS);
#pragma unroll
        for (int j = 0; j < 4; ++j) { const f32x4 h = x[j] * rstd * w1[j] + s1[j]; u32x2 o; o.x = pk2(h[0], h[1]); o.y = pk2(h[2], h[3]); *(u32x2*)(H + (size_t)r * 1024 + 4 * F.lane + 256 * j) = o; }
    }
}

__device__ __forceinline__ float log_sigmoid_(float x) { return -log1pf(__expf(-x)); }
__device__ __forceinline__ s16x4 tr_read16(const LAS bf16_t* p) { typedef short v4s __attribute__((ext_vector_type(4))); return __builtin_bit_cast(s16x4, __builtin_amdgcn_ds_read_tr16_b64_v4i16((LAS v4s*)p)); }
#define MK8(L, H) (bf16x8){L[0], L[1], L[2], L[3], H[0], H[1], H[2], H[3]}
constexpr int KLD = 72, VLD = 136;

__device__ __forceinline__ void phase_r1(const Frame& F, CArgs& A) {
    unsigned char* ws = A.ws;
    {
        LAS float* scr = (LAS float*)(F.lds + F.wave * 8704);
        const int gw = F.bid * NWAVES + F.wave, NGW = F.G * NWAVES;
        for (int it = gw; it < 16 * (NUP / 32); it += NGW) transpose_item(A.w_up, NUP, (bf16_t*)(ws + WS_WA), 1024, 0, 64 * (it / (NUP / 32)), 32 * (it % (NUP / 32)), ColUp(), scr, F.lane);
        __syncthreads();
    }
    const bf16_t* RKb = (const bf16_t*)(ws + WS_RK); const bf16_t* RVb = (const bf16_t*)(ws + WS_RV); bf16_t* KVS = (bf16_t*)(ws + WS_H);
    LAS bf16_t* kf = (LAS bf16_t*)F.lds; LAS bf16_t* kb = kf + 128 * KLD; LAS bf16_t* vl = kb + 128 * KLD;
    for (int item = F.bid; item < NITEM; item += F.G) {
        const int cg = item >> 3, h = item & 7; const size_t row0 = (size_t)cg * 128;
        const float lgf = log_sigmoid_(A.dec_f[h]) * 1.4426950408889634f, lgb = log_sigmoid_(A.dec_b[h]) * 1.4426950408889634f;
#pragma unroll
        for (int i = 0; i < 2; ++i) { const int ci = F.tid + i * NTHR, j = ci >> 3, c8 = ci & 7;
            f32x4 a, b; unpack8(*(const u32x4*)(RKb + (row0 + j) * 512 + 64 * h + 8 * c8), a, b);
            const float df = __builtin_amdgcn_exp2f(lgf * (float)(127 - j)), db = __builtin_amdgcn_exp2f(lgb * (float)j);
            *(LAS u32x4*)(kf + j * KLD + 8 * c8) = pack8(a * df, b * df); *(LAS u32x4*)(kb + j * KLD + 8 * c8) = pack8(a * db, b * db); }
#pragma unroll
        for (int i = 0; i < 4; ++i) { const int ci = F.tid + i * NTHR, j = ci >> 4, c8 = ci & 15;
            *(LAS u32x4*)(vl + j * VLD + 8 * c8) = *(const u32x4*)(RVb + (row0 + j) * 1024 + 128 * h + 8 * c8); }
        __syncthreads();
        const int dir = F.wave >> 2, mt = F.wave & 3, g = F.lane >> 4, q = (F.lane & 15) >> 2, p = F.lane & 3, l15 = F.lane & 15;
        const LAS bf16_t* ks = dir ? kb : kf;
        bf16x8 af[4];
#pragma unroll
        for (int s = 0; s < 4; ++s) { const LAS bf16_t* ap = ks + (32 * s + 8 * g + q) * KLD + 16 * mt + 4 * p; const s16x4 lo = tr_read16(ap), hi = tr_read16(ap + 4 * KLD); af[s] = MK8(lo, hi); }
        bf16_t* dst = KVS + ((size_t)item * 2 + dir) * (64 * 128);
#pragma unroll
        for (int nt = 0; nt < 8; ++nt) { f32x4 acc = {0.f, 0.f, 0.f, 0.f};
#pragma unroll
            for (int s = 0; s < 4; ++s) { const LAS bf16_t* bp = vl + (32 * s + 8 * g + q) * VLD + 16 * nt + 4 * p; const s16x4 lo = tr_read16(bp), hi = tr_read16(bp + 4 * VLD);
                acc = __builtin_amdgcn_mfma_f32_16x16x32_bf16(af[s], MK8(lo, hi), acc, 0, 0, 0); }
#pragma unroll
            for (int e = 0; e < 4; ++e) dst[(16 * mt + 4 * g + e) * 128 + 16 * nt + l15] = (bf16_t)f2bf(acc[e]); }
        __syncthreads();
    }
}

__device__ __forceinline__ void phase_scan(const Frame& F, CArgs& A) {
    bf16_t* KVS = (bf16_t*)(A.ws + WS_H);
    const int gt = F.bid * NTHR + F.tid, NGT = F.G * NTHR;
    for (int w = gt; w < 320 * 2048; w += NGT) {
        const int e4 = (w & 2047) * 4, chain = w >> 11, dir = chain & 1, h = (chain >> 1) & 7, s = chain >> 4;
        const int nch = s < 16 ? 2 : 32, c0 = s < 16 ? 2 * s : 32 + 32 * (s - 16);
        const float lg = log_sigmoid_((dir ? A.dec_b : A.dec_f)[h]), dec = __expf(lg * 128.0f);
        const int pr = e4 >> 7, dv = e4 & 127, lr = swap25(pr);
        f32x4 st = {0.f, 0.f, 0.f, 0.f};
        if (s >= 16) st = *(const f32x4*)((dir ? A.st_b : A.st_f) + (((size_t)(s - 16) * 8 + h) * 64 + lr) * 128 + dv);
        for (int i = 0; i < nch; ++i) { const int n = dir ? nch - 1 - i : i;
            bf16_t* p = KVS + ((size_t)((c0 + n) * 8 + h) * 2 + dir) * 8192 + e4;
            const u32x2 kv = *(const u32x2*)p; u32x2 o; o.x = pk2(st[0], st[1]); o.y = pk2(st[2], st[3]); *(u32x2*)p = o;
            st = st * dec + (f32x4){bflo(kv.x), bfhi(kv.x), bflo(kv.y), bfhi(kv.y)}; }
        if (s < 16) *(f32x4*)(A.out + (dir ? OUT_SB : OUT_SF) + (((size_t)s * 8 + h) * 64 + lr) * 128 + dv) = st;
    }
}

namespace att {
constexpr int D = 128, NW = 8, QBLK = 32, KVBLK = 64;
constexpr float SCALE = 0.088388347648318440f, THR = 8.f;
constexpr size_t SHM_V = KVBLK * D * 2, SHM_K = KVBLK * D * 2, SHM_ATTN = 2 * SHM_V + 2 * SHM_K + NW * 64 * 4;
#define KSWZ(row, colB) ((row) * 256 + ((colB) ^ (((row) & 7) << 4)))
#define SBAR() __builtin_amdgcn_sched_barrier(0)
__device__ __forceinline__ int crow(int r, int hi) { return (r & 3) + 8 * (r >> 2) + 4 * hi; }
__device__ __forceinline__ unsigned cvtpk(float lo, float hi) { unsigned r; asm volatile("v_cvt_pk_bf16_f32 %0, %1, %2" : "=v"(r) : "v"(lo), "v"(hi)); return r; }
__device__ __forceinline__ void partialSM(f32x16& p0, f32x16& p1, float& m_reg, float& mn, float& alpha) {
  constexpr float C = SCALE * 1.4426950408889634f;
  float pmax = p0[0]; for (int r = 1; r < 16; ++r) pmax = fmaxf(pmax, p0[r]); for (int r = 0; r < 16; ++r) pmax = fmaxf(pmax, p1[r]);
  { auto rr = __builtin_amdgcn_permlane32_swap(__float_as_uint(pmax), __float_as_uint(pmax), false, false);
    pmax = fmaxf(__uint_as_float(rr[0]), __uint_as_float(rr[1])); }
  if (__builtin_expect(__all(pmax - m_reg <= THR / SCALE), 1)) { mn = m_reg; alpha = 1.f; }
  else { mn = fmaxf(m_reg, pmax); alpha = __builtin_amdgcn_exp2f((m_reg - mn) * C); m_reg = mn; }
  float mnC = -mn * C;
  for (int r = 0; r < 16; ++r) p0[r] = fmaf(p0[r], C, mnC); for (int r = 0; r < 16; ++r) p1[r] = fmaf(p1[r], C, mnC);
  for (int r = 0; r < 16; ++r) p0[r] = __builtin_amdgcn_exp2f(p0[r]);
}
__device__ __forceinline__ void finishSM(f32x16& p0, f32x16& p1, float alpha, float& l_reg, bf16x8& pa0, bf16x8& pa1, bf16x8& pa2, bf16x8& pa3) {
  for (int r = 0; r < 16; ++r) p1[r] = __builtin_amdgcn_exp2f(p1[r]);
  float ps = 0; for (int r = 0; r < 16; ++r) ps += p0[r]; for (int r = 0; r < 16; ++r) ps += p1[r];
  { auto rr = __builtin_amdgcn_permlane32_swap(__float_as_uint(ps), __float_as_uint(ps), false, false);
    ps = __uint_as_float(rr[0]) + __uint_as_float(rr[1]); }
  l_reg = l_reg * alpha + ps;
#define PK4(P, BASE, OUT) do { unsigned a0 = cvtpk(P[BASE + 0], P[BASE + 1]), a1 = cvtpk(P[BASE + 2], P[BASE + 3]);   \
    unsigned b0 = cvtpk(P[BASE + 4], P[BASE + 5]), b1 = cvtpk(P[BASE + 6], P[BASE + 7]);                              \
    auto r0 = __builtin_amdgcn_permlane32_swap(a0, b0, false, false); auto r1 = __builtin_amdgcn_permlane32_swap(a1, b1, false, false); \
    u32x4 w = {r0[0], r1[0], r0[1], r1[1]}; OUT = *reinterpret_cast<bf16x8*>(&w); } while (0)
  PK4(p0, 0, pa0); PK4(p0, 8, pa1); PK4(p1, 0, pa2); PK4(p1, 8, pa3);
#undef PK4
}
__device__ __forceinline__ void qkt(f32x16& p0, f32x16& p1, const bf16_t* Ks, const bf16x8* qr, int r32, int hi) {
  p0 = f32x16{}; p1 = f32x16{};
  for (int d0 = 0; d0 < 8; ++d0) { int cb = (d0 * 16 + hi * 8) * 2;
    bf16x8 b0 = *reinterpret_cast<const bf16x8*>((const char*)Ks + KSWZ(r32, cb));
    bf16x8 b1 = *reinterpret_cast<const bf16x8*>((const char*)Ks + KSWZ(32 + r32, cb));
    p0 = __builtin_amdgcn_mfma_f32_32x32x16_bf16(b0, qr[d0], p0, 0, 0, 0);
    p1 = __builtin_amdgcn_mfma_f32_32x32x16_bf16(b1, qr[d0], p1, 0, 0, 0); }
}
__device__ __forceinline__ int v_st(int k, int c) { const int kk = (k & ~0xC) | ((k & 4) << 1) | ((k & 8) >> 1); return ((kk >> 3) * 4 + (c >> 5)) * 512 + ((kk & 7) * 32 + (c & 31)) * 2; }
__device__ __forceinline__ int v_rd_base(int lane) { return ((lane & 3) << 3) | (((lane >> 2) & 3) << 6) | (((lane >> 4) & 1) << 5) | (((lane >> 5) & 1) << 8); }
constexpr int v_rd_off(int d0, int ks, int half) { return d0 * 512 + ks * 4096 + half * 2048; }
template <int OFF> __device__ __forceinline__ s16x4 tr_read(int vb) { s16x4 r; asm volatile("ds_read_b64_tr_b16 %0, %1 offset:%2" : "=&v"(r) : "v"(vb), "i"(OFF) : "memory"); return r; }
template <int D0> __device__ __forceinline__ void pv_one(f32x16& od, int vb, bf16x8 pa0, bf16x8 pa1, bf16x8 pa2, bf16x8 pa3) {
  const s16x4 l0 = tr_read<v_rd_off(D0, 0, 0)>(vb), h0 = tr_read<v_rd_off(D0, 0, 1)>(vb), l1 = tr_read<v_rd_off(D0, 1, 0)>(vb), h1 = tr_read<v_rd_off(D0, 1, 1)>(vb);
  const s16x4 l2 = tr_read<v_rd_off(D0, 2, 0)>(vb), h2 = tr_read<v_rd_off(D0, 2, 1)>(vb), l3 = tr_read<v_rd_off(D0, 3, 0)>(vb), h3 = tr_read<v_rd_off(D0, 3, 1)>(vb);
  asm volatile("s_waitcnt lgkmcnt(0)" ::: "memory"); SBAR();
  od = __builtin_amdgcn_mfma_f32_32x32x16_bf16(pa0, MK8(l0, h0), od, 0, 0, 0);
  od = __builtin_amdgcn_mfma_f32_32x32x16_bf16(pa1, MK8(l1, h1), od, 0, 0, 0);
  od = __builtin_amdgcn_mfma_f32_32x32x16_bf16(pa2, MK8(l2, h2), od, 0, 0, 0);
  od = __builtin_amdgcn_mfma_f32_32x32x16_bf16(pa3, MK8(l3, h3), od, 0, 0, 0);
}
__device__ __forceinline__ void pv_d0(f32x16* o, int vb, bf16x8 pa0, bf16x8 pa1, bf16x8 pa2, bf16x8 pa3) {
  pv_one<0>(o[0], vb, pa0, pa1, pa2, pa3); pv_one<1>(o[1], vb, pa0, pa1, pa2, pa3); pv_one<2>(o[2], vb, pa0, pa1, pa2, pa3); pv_one<3>(o[3], vb, pa0, pa1, pa2, pa3);
}
template <int LDQ>
__device__ __forceinline__ void attn_dense_body(const bf16_t* Qb, const bf16_t* __restrict__ Kh, const bf16_t* __restrict__ Vh, bf16_t* Ob, int seq, char* lds, const int wid) {
  constexpr int LDK = 128;
  const int lane = lane_id_(), tid = wid * 64 + lane, r32 = lane & 31, hi = lane >> 5;
  bf16_t* V_lds = (bf16_t*)lds; bf16_t* K_lds = (bf16_t*)(lds + 2 * SHM_V);
  float* ws = (float*)(lds + 2 * SHM_V + 2 * SHM_K) + wid * 64; float* li_l = ws; float* al_l = ws + 32;
  float m_reg = -1e30f, l_reg = 0; f32x16 o[4] = {}; bf16x8 qr[8];
  const bf16_t* Qw = Qb + (long)(wid * QBLK + r32) * LDQ + hi * 8;
#pragma unroll
  for (int d0 = 0; d0 < 8; ++d0) qr[d0] = *reinterpret_cast<const bf16x8*>(Qw + d0 * 16);
  const int sr = tid >> 4, sc = (tid & 15) * 8, vst0 = v_st(sr, sc), vst1 = v_st(32 + sr, sc);
  const int vb0 = (int)(uintptr_t)V_lds + v_rd_base(lane);
  struct { bf16x8 vs0, vs1, ks0, ks1; } sr_[2];
#define SLOAD(i, k0) do { sr_[i].vs0 = *(const bf16x8*)(&Vh[(long)((k0) + sr) * LDK + sc]); sr_[i].vs1 = *(const bf16x8*)(&Vh[(long)((k0) + 32 + sr) * LDK + sc]); \
    sr_[i].ks0 = *(const bf16x8*)(&Kh[(long)((k0) + sr) * LDK + sc]); sr_[i].ks1 = *(const bf16x8*)(&Kh[(long)((k0) + 32 + sr) * LDK + sc]); } while (0)
#define SWRITE(b, i) do { *(bf16x8*)((char*)V_lds + (b) * SHM_V + vst0) = sr_[i].vs0;          \
    *(bf16x8*)((char*)V_lds + (b) * SHM_V + vst1) = sr_[i].vs1; int kc = sc * 2;               \
    *(bf16x8*)((char*)K_lds + (b) * SHM_K + KSWZ(sr, kc)) = sr_[i].ks0;                       \
    *(bf16x8*)((char*)K_lds + (b) * SHM_K + KSWZ(32 + sr, kc)) = sr_[i].ks1; } while (0)
#define SWAIT() asm volatile("s_waitcnt vmcnt(4)" ::: "memory")
#define RESC(a) do { if (__any((a) < 1.f)) { if (hi == 0) al_l[r32] = (a); asm volatile("s_waitcnt lgkmcnt(0)" ::: "memory"); \
    for (int d = 0; d < 4; ++d) for (int r = 0; r < 16; ++r) o[d][r] *= al_l[crow(r, hi)]; } } while (0)
  f32x16 pA0, pA1, pB0, pB1; float mnA, mnB, alA, alB; bf16x8 pa0, pa1, pa2, pa3; const int NT = seq / KVBLK;
  constexpr int SE = 0, SO = 1;
  SLOAD(SE, 0); asm volatile("s_waitcnt vmcnt(0)" ::: "memory"); SWRITE(0, SE); __syncthreads();
  qkt(pA0, pA1, K_lds, qr, r32, hi); partialSM(pA0, pA1, m_reg, mnA, alA);
  SLOAD(SO, KVBLK); if (2 < NT) SLOAD(SE, 2 * KVBLK);
  SWAIT(); SWRITE(1, SO); __syncthreads();
  for (int j = 1; j + 1 < NT; j += 2) {
    SBAR(); qkt(pB0, pB1, (bf16_t*)((char*)K_lds + SHM_K), qr, r32, hi);
    finishSM(pA0, pA1, alA, l_reg, pa0, pa1, pa2, pa3); SBAR();
    SLOAD(SO, (j + 2) * KVBLK); SBAR();
    pv_d0(o, vb0, pa0, pa1, pa2, pa3); partialSM(pB0, pB1, m_reg, mnB, alB);
    __syncthreads(); SWAIT(); SWRITE(0, SE);
    RESC(alB); __syncthreads();
    SBAR(); qkt(pA0, pA1, K_lds, qr, r32, hi);
    finishSM(pB0, pB1, alB, l_reg, pa0, pa1, pa2, pa3); SBAR();
    if (j + 3 < NT) SLOAD(SE, (j + 3) * KVBLK); SBAR();
    pv_d0(o, vb0 + (int)SHM_V, pa0, pa1, pa2, pa3); partialSM(pA0, pA1, m_reg, mnA, alA);
    __syncthreads(); SWAIT(); SWRITE(1, SO);
    RESC(alA); __syncthreads();
  }
  SBAR(); qkt(pB0, pB1, (bf16_t*)((char*)K_lds + SHM_K), qr, r32, hi);
  finishSM(pA0, pA1, alA, l_reg, pa0, pa1, pa2, pa3); SBAR();
  pv_d0(o, vb0, pa0, pa1, pa2, pa3); partialSM(pB0, pB1, m_reg, mnB, alB);
  __syncthreads(); RESC(alB);
  finishSM(pB0, pB1, alB, l_reg, pa0, pa1, pa2, pa3); SBAR();
  pv_d0(o, vb0 + (int)SHM_V, pa0, pa1, pa2, pa3);
  if (hi == 0) li_l[r32] = l_reg; asm volatile("s_waitcnt lgkmcnt(0)" ::: "memory");
  float rli[16];
#pragma unroll
  for (int r = 0; r < 16; ++r) rli[r] = __builtin_amdgcn_rcpf(li_l[crow(r, hi)]);
  bf16_t* Ow = Ob + (long)(wid * QBLK) * LDQ;
#pragma unroll
  for (int r = 0; r < 16; ++r) { int orow = crow(r, hi);
    for (int d0 = 0; d0 < 4; ++d0) Ow[(long)orow * LDQ + d0 * 32 + r32] = (bf16_t)f2bf(o[d0][r] * rli[r]); }
  __syncthreads();
#undef SLOAD
#undef SWRITE
#undef SWAIT
#undef RESC
}
#undef KSWZ
#undef SBAR
}

__device__ __forceinline__ void r3_item(const Frame& F, CArgs& A, int item) {
    unsigned char* ws = A.ws;
    const bf16_t* RQb = (const bf16_t*)(ws + WS_RQ); const bf16_t* RKb = (const bf16_t*)(ws + WS_RK); bf16_t* RVb = (bf16_t*)(ws + WS_RV);
    const bf16_t* SRGb = (const bf16_t*)(ws + WS_SRG); const bf16_t* KVS = (const bf16_t*)(ws + WS_H);
    LAS bf16_t* kl = (LAS bf16_t*)F.lds; LAS bf16_t* vl = kl + 128 * KLD; LAS bf16_t* sl = vl + 128 * VLD; LAS bf16_t* pl = sl + 128 * VLD + F.wave * (16 * VLD);
    const int cg = item >> 3, h = item & 7; const size_t row0 = (size_t)cg * 128;
    const float lgf = log_sigmoid_(A.dec_f[h]) * 1.4426950408889634f, lgb = log_sigmoid_(A.dec_b[h]) * 1.4426950408889634f;
#pragma unroll
    for (int i = 0; i < 2; ++i) { const int ci = F.tid + i * NTHR, j = ci >> 3, c8 = ci & 7;
        *(LAS u32x4*)(kl + j * KLD + 8 * c8) = *(const u32x4*)(RKb + (row0 + j) * 512 + 64 * h + 8 * c8); }
#pragma unroll
    for (int i = 0; i < 4; ++i) { const int ci = F.tid + i * NTHR, j = ci >> 4, c8 = ci & 15;
        *(LAS u32x4*)(vl + j * VLD + 8 * c8) = *(const u32x4*)(RVb + (row0 + j) * 1024 + 128 * h + 8 * c8);
        *(LAS u32x4*)(sl + j * VLD + 8 * c8) = *(const u32x4*)(KVS + (size_t)item * 2 * 8192 + (size_t)j * 128 + 8 * c8); }
    int lane_ = F.lane; asm volatile("" : "+v"(lane_));
    const int g = lane_ >> 4, l15 = lane_ & 15, q = l15 >> 2, p = lane_ & 3, w = F.wave;
    bf16x8 qf[2];
#pragma unroll
    for (int s = 0; s < 2; ++s) qf[s] = *(const bf16x8*)(RQb + (row0 + 16 * w + l15) * 512 + 64 * h + 32 * s + 8 * g);
    __syncthreads();
#pragma unroll
    for (int nt = 0; nt < 8; ++nt) { f32x4 sacc = {0.f, 0.f, 0.f, 0.f};
#pragma unroll
        for (int s = 0; s < 2; ++s) { const bf16x8 kfr = *(const LAS bf16x8*)(kl + (16 * nt + l15) * KLD + 32 * s + 8 * g); sacc = __builtin_amdgcn_mfma_f32_16x16x32_bf16(qf[s], kfr, sacc, 0, 0, 0); }
        const int j = 16 * nt + l15;
#pragma unroll
        for (int e = 0; e < 4; ++e) { const int i = 16 * w + 4 * g + e, df = i - j;
            const float dm = (df >= 0 ? __builtin_amdgcn_exp2f(lgf * (float)df) : 0.f) + (df <= 0 ? __builtin_amdgcn_exp2f(lgb * (float)(-df)) : 0.f);
            pl[(4 * g + e) * VLD + j] = (bf16_t)f2bf(sacc[e] * dm); } }
    LDS_WAIT(); asm volatile("" ::: "memory");
    bf16x8 pa[4], qa[4];
#pragma unroll
    for (int s = 0; s < 4; ++s) pa[s] = *(const LAS bf16x8*)(pl + l15 * VLD + 32 * s + 8 * g);
    { const int i = 16 * w + l15; const float qdf = __builtin_amdgcn_exp2f(lgf * (float)(i + 1)), qdb = __builtin_amdgcn_exp2f(lgb * (float)(128 - i));
#pragma unroll
      for (int s = 0; s < 2; ++s) { f32x4 a, b; unpack8(__builtin_bit_cast(u32x4, qf[s]), a, b); qa[s] = __builtin_bit_cast(bf16x8, pack8(a * qdf, b * qdf)); qa[2 + s] = __builtin_bit_cast(bf16x8, pack8(a * qdb, b * qdb)); } }
    f32x4 oacc[8];
#pragma unroll
    for (int nt = 0; nt < 8; ++nt) { f32x4 acc = {0.f, 0.f, 0.f, 0.f};
#pragma unroll
        for (int s = 0; s < 4; ++s) { const LAS bf16_t* bp = vl + (32 * s + 8 * g + q) * VLD + 16 * nt + 4 * p; const s16x4 lo = tr_read16(bp), hi = tr_read16(bp + 4 * VLD);
            acc = __builtin_amdgcn_mfma_f32_16x16x32_bf16(pa[s], MK8(lo, hi), acc, 0, 0, 0); }
#pragma unroll
        for (int s = 0; s < 4; ++s) { const LAS bf16_t* bp = sl + (32 * s + 8 * g + q) * VLD + 16 * nt + 4 * p; const s16x4 lo = tr_read16(bp), hi = tr_read16(bp + 4 * VLD);
            acc = __builtin_amdgcn_mfma_f32_16x16x32_bf16(qa[s], MK8(lo, hi), acc, 0, 0, 0); }
        oacc[nt] = acc; }
    f32x4 ss = {0.f, 0.f, 0.f, 0.f};
#pragma unroll
    for (int nt = 0; nt < 8; ++nt) ss += oacc[nt] * oacc[nt];
#pragma unroll
    for (int e = 0; e < 4; ++e) { float s = ss[e]; s += __shfl_xor(s, 1); s += __shfl_xor(s, 2); s += __shfl_xor(s, 4); s += __shfl_xor(s, 8); ss[e] = __builtin_amdgcn_rsqf(s * (1.0f / 128.0f) + EPS); }
#pragma unroll
    for (int nt = 0; nt < 8; ++nt)
#pragma unroll
        for (int e = 0; e < 4; ++e) { const size_t o = (row0 + 16 * w + 4 * g + e) * 1024 + 128 * h + 16 * nt + l15;
            RVb[o] = (bf16_t)f2bf(bf2f(SRGb[o]) * oacc[nt][e] * ss[e]); }
    __syncthreads();
}

__device__ __forceinline__ void phase_attn(const Frame& F, CArgs& A) {
    unsigned char* ws = A.ws; bf16_t* Q = (bf16_t*)(ws + WS_Q);
    const int x = F.bid & 7, c = F.bid >> 3;
    const int nun = F.bid < NB * NH ? 3 : 2;
    for (int i = 0; i < nun; ++i) {
        const bf16_t *Kh, *Vh; bf16_t* Qb; int seq;
        if (i < 2) { const int lb = x >> 1, kvh = x & 1, uu = c + 32 * i, hq = kvh * 4 + (uu >> 4), qb = uu & 15;
            Kh = (const bf16_t*)(ws + WS_KALL) + (size_t)(lb * 2 + kvh) * SKV * 128; Vh = (const bf16_t*)(ws + WS_VALL) + (size_t)(lb * 2 + kvh) * SKV * 128;
            Qb = Q + ((size_t)MP + (size_t)lb * DSEQ + qb * 256) * 1024 + hq * 128; seq = SKV; }
        else { const int b = F.bid >> 3, hq = F.bid & 7, kvh = hq >> 2;
            Kh = (const bf16_t*)(ws + WS_KP) + (size_t)(b * 2 + kvh) * SEQ * 128; Vh = (const bf16_t*)(ws + WS_VP) + (size_t)(b * 2 + kvh) * SEQ * 128;
            Qb = Q + (size_t)b * SEQ * 1024 + hq * 128; seq = SEQ; }
        att::attn_dense_body<1024>(Qb, Kh, Vh, Qb, seq, (char*)F.lds, F.wave);
    }
    { const int nb = F.bid >= 128 ? 6 : 4, i0 = F.bid >= 128 ? 512 + (F.bid - 128) * 6 : F.bid * 4;
      for (int i = 0; i < nb; ++i) r3_item(F, A, i0 + i); }
}

__device__ __forceinline__ void phase_fix(const Frame& F, CArgs& A) {
    unsigned char* ws = A.ws; const float* EU = (const float*)(ws + WS_EDGE_U); const float* EUC = (const float*)(ws + WS_EDGE_UC); bf16_t* ACT = (bf16_t*)(ws + WS_ACT);
    const int gt = F.bid * NTHR + F.tid, NGT = F.G * NTHR;
    for (int i = gt; i < 64 * 2 * DFF; i += NGT) { const int j = i % DFF, e = (i / DFF) & 1, pm = 16 + i / (2 * DFF), jt = (pm - 16) & 15;
        if ((e == 0 && jt == 0) || (e == 1 && jt == 15)) continue;
        const int pmn = e ? pm + 1 : pm - 1, na = 256 * (j >> 7) + (j & 127), ng = na + 128, tap = e ? 2 : 0;
        const float ua = EUC[((size_t)pm * 2 + e) * NUP + na] + A.conv_w[(size_t)tap * NUP + j] * EU[((size_t)pmn * 2 + (1 - e)) * NUP + na];
        const float ug = EUC[((size_t)pm * 2 + e) * NUP + ng] + A.conv_w[(size_t)tap * NUP + DFF + j] * EU[((size_t)pmn * 2 + (1 - e)) * NUP + ng];
        ACT[((size_t)pm * 256 + (e ? 255 : 0)) * DFF + j] = (bf16_t)f2bf(siluf_(ug) * ua); }
}

__device__ __forceinline__ void phase_final(const Frame& F, CArgs& A) {
    const float* ssq = (const float*)(A.ws + WS_SSQ2);
    constexpr int RPW = MT / (256 * NWAVES);
    const int row0 = (F.bid * NWAVES + F.wave) * RPW;
    f32x4 fg[4];
#pragma unroll
    for (int j = 0; j < 4; ++j) fg[j] = *(const f32x4*)(A.final_g + 4 * F.lane + 256 * j);
    for (int r = row0; r < row0 + RPW; ++r) { const float rstd = 1.0f / sqrtf(ssq[r] * (1.0f / 1024.0f) + EPS); float* p = A.out + (size_t)r * 1024;
#pragma unroll
        for (int j = 0; j < 4; ++j) { f32x4* q = (f32x4*)(p + 4 * F.lane + 256 * j); *q = *q * rstd * fg[j]; } }
}

constexpr int N_PHASES = 12;
__global__ void __launch_bounds__(NTHR, 2) fwd_kernel(Args A_) {
    CArgs& A = *(CArgs*)__builtin_amdgcn_kernarg_segment_ptr();
    extern __shared__ __attribute__((aligned(16))) unsigned char lds_raw[];
    Frame F; F.lds = (LAS unsigned char*)lds_raw; F.wave = __builtin_amdgcn_readfirstlane(threadIdx.x >> 6); F.lane = lane_id_(); F.tid = F.wave * 64 + F.lane; F.G = gridDim.x; F.bid = blockIdx.x;
    volatile LAS unsigned* MISC = (volatile LAS unsigned*)(F.lds + MISC_OFF);
    if (F.tid < 64) MISC[F.tid] = 0u;
    __syncthreads();
    unsigned char* ws = A.ws;
    XcdBarrier bar = xcd_barrier_post((unsigned*)(ws + WS_CTL), MISC + 8, F.wave);
    const int lo = A.ph_lo, hi = A.ph_hi;
#ifdef ONLY_PHASE
#define IN(k) ((k) == ONLY_PHASE)
#else
#define IN(k) (lo <= (k) && (k) < hi)
#endif
#define SEAM(k) do { if (IN(k) && IN((k) + 1)) xcd_barrier(bar); F.lane = lane_id_(); F.tid = F.wave * 64 + F.lane; } while (0)
    LAS float* spare = (LAS float*)(F.lds + SPARE_OFF);
    const int NOJ = 1 << 30;
    if (IN(0)) { phase0(F, A); } SEAM(0);
    if (IN(1)) { phase1(F, A); } SEAM(1);
    if (IN(2)) {
        pg8::Gemm g{(const bf16_t*)(ws + WS_H), (const bf16_t*)(ws + WS_WA), MT, DIN, DM, DM, DM, NOJ, 0};
        pg8::StaticOrder S; S.init(MT, DIN, F.G, F.bid);
        EpiIn E{(bf16_t*)(ws + WS_Q), (bf16_t*)(ws + WS_KALL), (bf16_t*)(ws + WS_VALL), (bf16_t*)(ws + WS_KP), (bf16_t*)(ws + WS_VP), (bf16_t*)(ws + WS_RQ), (bf16_t*)(ws + WS_RK),
                (bf16_t*)(ws + WS_RV), (bf16_t*)(ws + WS_SRG), (bf16_t*)A.out, (bf16_t*)A.out + (size_t)MT * DM, A.out + OUT_CK, A.out + OUT_CV, A.q_g, A.k_g, spare};
        pg8::gemm_phase(F.lds, g, S, E, F.wave);
    } SEAM(2);
    if (IN(3)) { phase_r1(F, A); } SEAM(3);
    if (IN(4)) { phase_scan(F, A); } SEAM(4);
    if (IN(5)) { phase_attn(F, A); } SEAM(5);
    if (IN(6)) {
        pg8::Gemm g{(const bf16_t*)(ws + WS_Q), (const bf16_t*)(ws + WS_WB), MT, DM, 2 * DM, DM, 2 * DM, 16, (long)(WS_RV - WS_Q) - 16 * 128};
        pg8::StaticOrder S; S.init(MT, DM, F.G, F.bid);
        EpiMix E{(const bf16_t*)A.out, (const bf16_t*)A.out + (size_t)MT * DM, (bf16_t*)(ws + WS_Y)};
        pg8::gemm_phase(F.lds, g, S, E, F.wave);
    } SEAM(6);
    if (IN(7)) {
        pg8::Gemm g{(const bf16_t*)(ws + WS_Y), (const bf16_t*)(ws + WS_WC), MT, DM, DM, DM, DM, NOJ, 0};
        pg8::StaticOrder S; S.init(MT, DM, F.G, F.bid);
        EpiRes1 E{A.x_prompt, A.x_sample, (const float*)(ws + WS_MOD), A.norm2_g, A.out, (float*)(ws + WS_SSQ1), (bf16_t*)(ws + WS_H)};
        pg8::gemm_phase(F.lds, g, S, E, F.wave);
    } SEAM(7);
    if (IN(8)) {
        pg8::Gemm g{(const bf16_t*)(ws + WS_H), (const bf16_t*)(ws + WS_WA), MT, NUP, DM, DM, DM, NOJ, 0};
        pg8::StaticOrder S; S.init(MT, NUP, F.G, F.bid);
        EpiConv E{(const float*)(ws + WS_SSQ1), (const float*)(ws + WS_BUP), A.conv_w, A.conv_b, (bf16_t*)(ws + WS_ACT), (float*)(ws + WS_EDGE_U), (float*)(ws + WS_EDGE_UC), spare};
        pg8::gemm_phase(F.lds, g, S, E, F.wave);
    } SEAM(8);
    if (IN(9)) { phase_fix(F, A); } SEAM(9);
    if (IN(10)) {
        pg8::Gemm g{(const bf16_t*)(ws + WS_ACT), (const bf16_t*)(ws + WS_WD), MT, DM, DFF, DFF, DFF, NOJ, 0};
        pg8::StaticOrder S; S.init(MT, DM, F.G, F.bid);
        EpiRes2 E{(const float*)(ws + WS_MOD), A.out, (float*)(ws + WS_SSQ2)};
        pg8::gemm_phase(F.lds, g, S, E, F.wave);
    } SEAM(10);
    if (IN(11)) { phase_final(F, A); }
#undef IN
#undef SEAM
}

#ifndef MK_SPLIT
#define MK_SPLIT 0
#endif
extern "C" void kernel_launch(void* const* d_in, const int* in_sizes, int n_in, void* d_out, int out_size, void* d_ws, size_t ws_size, hipStream_t stream) {
    static int grid = 0;
    if (grid == 0) {
        if (n_in != 25 || ws_size < WS_END) { fprintf(stderr, "kernel_launch: unexpected n_in %d / ws %zu\n", n_in, ws_size); grid = -1; return; }
        int dev = 0, cus = 0, per_cu = 0;
        hipGetDevice(&dev); hipDeviceGetAttribute(&cus, hipDeviceAttributeMultiprocessorCount, dev);
        if (hipFuncSetAttribute((const void*)fwd_kernel, hipFuncAttributeMaxDynamicSharedMemorySize, LDS_BYTES) != hipSuccess) { fprintf(stderr, "kernel_launch: hipFuncSetAttribute failed\n"); grid = -1; return; }
        hipOccupancyMaxActiveBlocksPerMultiprocessor(&per_cu, (const void*)fwd_kernel, NTHR, LDS_BYTES);
        (void)hipGetLastError();
        if (per_cu < 1) fprintf(stderr, "kernel_launch: occupancy query says %d blocks/CU\n", per_cu);
        grid = cus;
        if (grid != 256) fprintf(stderr, "kernel_launch: %d CUs (built for 256)\n", grid);
    }
    if (grid < 0) return;
    hipMemsetAsync((char*)d_ws + WS_CTL, 0, CTL_ZERO_BYTES, stream);
    Args a{};
    const float** pa = (const float**)&a;
    for (int i = 0; i < 25; ++i) pa[i] = (const float*)d_in[i];
    a.out = (float*)d_out; a.ws = (unsigned char*)d_ws;
#if MK_SPLIT
    for (int p = 0; p < N_PHASES; ++p) { a.ph_lo = p; a.ph_hi = p + 1; hipLaunchKernelGGL(fwd_kernel, dim3(grid), dim3(NTHR), LDS_BYTES, stream, a); }
#else
    a.ph_lo = 0; a.ph_hi = N_PHASES; hipLaunchKernelGGL(fwd_kernel, dim3(grid), dim3(NTHR), LDS_BYTES, stream, a);
#endif
    const hipError_t le = hipPeekAtLastError();
    if (le != hipSuccess) fprintf(stderr, "kernel_launch: launch failed: %s\n", hipGetErrorName(le));
}
```

```cpp
#include <hip/hip_runtime.h>
#include <hip/hip_bf16.h>
#include <cstdio>
#include <cstdint>

#ifndef PROBE_BID
#define PROBE_BID 100
#endif
#ifndef PROBE_OFS
#define PROBE_OFS 0
#endif
constexpr int DM = 1024, NB = 16, SEQ = 256, DB = 4, DSEQ = 4096, PAST = 512, GRIDW = 64;
constexpr int NH = 8, NKV = 2, HD = 128, RH = 8, RDK = 64, RDV = 128, DFF = 2816, CHUNK = 128;
constexpr int MP = NB * SEQ, ML = DB * DSEQ, MT = MP + ML;
constexpr int DIN = 6656, SKV = DSEQ + PAST;
constexpr int NUP = 2 * DFF;
constexpr float EPS = 1e-6f;
constexpr int NCHUNK = MT / CHUNK;
constexpr int NITEM = NCHUNK * RH;

#define GAS __attribute__((address_space(1)))
#define LAS __attribute__((address_space(3)))
typedef unsigned short bf16_t;
typedef short bf16x8 __attribute__((ext_vector_type(8)));
typedef short s16x4 __attribute__((ext_vector_type(4)));
typedef float f32x4 __attribute__((ext_vector_type(4)));
typedef float f32x2 __attribute__((ext_vector_type(2)));
typedef float f32x16 __attribute__((ext_vector_type(16)));
typedef unsigned u32x4 __attribute__((ext_vector_type(4)));
typedef unsigned u32x2 __attribute__((ext_vector_type(2)));
typedef GAS unsigned gu32;

constexpr size_t MiB = 1u << 20;
constexpr size_t WS_CTL = 0, CTL_ZERO_BYTES = 16 * 1024;
constexpr size_t WS_MOD = 256 * 1024;
constexpr size_t MODQ = 5 * 6144;
constexpr size_t WS_MODF = 1 * MiB + 832 * 1024;
constexpr size_t WS_BUP = 768 * 1024;
constexpr size_t BUPQ = 5 * 5632;
constexpr size_t WS_BUPF = 1 * MiB + 384 * 1024;
constexpr size_t WS_SSQ1 = 1 * MiB + 256 * 1024;
constexpr size_t WS_XS = 1 * MiB + 512 * 1024;
constexpr size_t WS_CNT = 64 * 1024;
constexpr size_t WS_CNT1 = 152 * 1024;
constexpr int CNT_D2 = 0, CNT_D3 = 80, CNT_D4 = 160, CNT_X5 = 240, CNT_G3ALL = 320;
constexpr size_t WS_WA = 2 * MiB;
constexpr size_t WS_WB = 16 * MiB;
constexpr size_t WS_WC = 20 * MiB;
constexpr size_t WS_WD = 22 * MiB;
constexpr size_t WS_H = 28 * MiB;
constexpr size_t WS_Q = 68 * MiB;
constexpr size_t WS_KALL = 108 * MiB, WS_VALL = 117 * MiB, WS_KP = 126 * MiB, WS_VP = 128 * MiB;
constexpr size_t WS_RQ = 132 * MiB, WS_RK = 152 * MiB, WS_RV = 172 * MiB, WS_SRG = 212 * MiB, WS_END = 252 * MiB;
constexpr size_t WS_Y = WS_RQ;
constexpr size_t WS_X1B = WS_SRG;
constexpr size_t WS_ACT = WS_Q;
constexpr size_t WS_EDGE_U = 178 * MiB, WS_EDGE_UC = 182 * MiB;
static_assert((size_t)DIN * DM * 2 <= 14 * MiB && (size_t)MT * DM * 2 == 40 * MiB && (size_t)NITEM * 2 * RDK * RDV * 2 == 40 * MiB, "ws map");
static_assert((size_t)DB * NKV * SKV * HD * 2 <= 9 * MiB && (size_t)NB * NKV * SEQ * HD * 2 <= 2 * MiB, "ws map kv");
static_assert(WS_ACT + (size_t)MT * DFF * 2 <= WS_EDGE_U && (size_t)80 * 2 * NUP * 4 <= 4 * MiB && WS_EDGE_UC + 4 * MiB <= WS_X1B, "ws map act");
static_assert(WS_CNT + 321 * 256 <= WS_CNT1 && WS_CNT1 + (481 + 82) * 64 <= WS_MOD && WS_MOD + 4 * MODQ * 4 <= WS_BUP && WS_BUP + 4 * BUPQ * 4 <= WS_SSQ1 && WS_SSQ1 + (size_t)MT * 4 <= WS_BUPF
              && WS_BUPF + BUPQ * 4 <= WS_XS && WS_XS + (size_t)80 * 4 * 256 * 4 <= WS_MODF && WS_MODF + MODQ * 4 <= WS_WA, "ws map: small buffers");
constexpr size_t OUT_Y = 0, OUT_CK = (size_t)MT * DM, OUT_CV = OUT_CK + (size_t)NB * NKV * SEQ * HD, OUT_SF = OUT_CV + (size_t)NB * NKV * SEQ * HD, OUT_SB = OUT_SF + (size_t)NB * RH * RDK * RDV;

#define LDS_WAIT() asm volatile("s_waitcnt lgkmcnt(0)" ::: "memory")
#define VM_WAIT() asm volatile("s_waitcnt vmcnt(0)" ::: "memory")
#define RLX_AGENT __ATOMIC_RELAXED, __HIP_MEMORY_SCOPE_AGENT
typedef __bf16 bf16x2_t __attribute__((ext_vector_type(2)));
__device__ __forceinline__ unsigned pk2(float lo, float hi) { const f32x2 v = {lo, hi}; return __builtin_bit_cast(unsigned, __builtin_convertvector(v, bf16x2_t)); }
__device__ __forceinline__ unsigned f2bf(float f) { return pk2(f, 0.f) & 0xffffu; }
__device__ __forceinline__ float bflo(unsigned w) { return __builtin_bit_cast(float, w << 16); }
__device__ __forceinline__ float bfhi(unsigned w) { return __builtin_bit_cast(float, w & 0xffff0000u); }
__device__ __forceinline__ float bf2f(bf16_t h) { return __builtin_bit_cast(float, (unsigned)h << 16); }
__device__ __forceinline__ int swap25(int p) { return (p & ~0x24) | ((p & 4) << 3) | ((p & 32) >> 3); }
__device__ __forceinline__ float sigmoidf_(float x) { return __builtin_amdgcn_rcpf(1.0f + __builtin_amdgcn_exp2f(-1.4426950408889634f * x)); }
__device__ __forceinline__ float siluf_(float x) { return x * __builtin_amdgcn_rcpf(1.0f + __builtin_amdgcn_exp2f(-1.4426950408889634f * x)); }
__device__ __forceinline__ int lane_id_() { int l; asm volatile("v_mbcnt_lo_u32_b32 %0, -1, 0\n\tv_mbcnt_hi_u32_b32 %0, -1, %0" : "=v"(l)); return l; }
__device__ __forceinline__ f32x4 sum4q(const float* p, size_t q) { return (*(const f32x4*)p + *(const f32x4*)(p + q)) + (*(const f32x4*)(p + 2 * q) + *(const f32x4*)(p + 3 * q)); }
__device__ __forceinline__ float wave_sum(float v) {
#pragma unroll
    for (int o = 1; o < 64; o <<= 1) v += __shfl_xor(v, o);
    return v;
}
__device__ __forceinline__ void sincos_rev(float ang, float& c, float& s) {
    double rev = (double)ang * 0.15915494309189533577; rev -= __builtin_rint(rev);
    const float fr = (float)rev; s = __builtin_amdgcn_sinf(fr); c = __builtin_amdgcn_cosf(fr);
}
__device__ __forceinline__ float rope_inv(int i) { return exp2f(-(float)i * (13.287712379549449f / 32.0f)); }

#define XB_TMO      128
#define XB_XCNT(j)  (256  + 64 * (j))
#define XB_XSUB(j)  (1280 + 64 * (j))
#define XB_XGEN(j)  (2304 + 64 * (j))
#define XB_TOP      3328
#define XB_TOPGEN   3392
#define XCD_BAR_WORDS 3456
#define XB_SPIN_CAP (1u << 20)
__device__ __forceinline__ unsigned xb_ld(unsigned* p)              { return __hip_atomic_load(p, __ATOMIC_RELAXED, __HIP_MEMORY_SCOPE_AGENT); }
__device__ __forceinline__ unsigned xb_add(unsigned* p, unsigned v) { return __hip_atomic_fetch_add(p, v, __ATOMIC_RELAXED, __HIP_MEMORY_SCOPE_AGENT); }
__device__ __forceinline__ unsigned xb_xcc_id() { return (unsigned)__builtin_amdgcn_s_getreg((3 << 11) | 20) & 0xFu; }
#define XB_SPIN(cond, bar) do { unsigned _sp = 0; while (cond) { __builtin_amdgcn_s_sleep(1); \
    if ((++_sp & 255u) == 0u) { if (xb_ld(&(bar)[XB_TMO])) break; if (_sp > XB_SPIN_CAP) { atomicAdd(&(bar)[XB_TMO], 1u); break; } } } } while (0)
struct XcdBarrier { unsigned* bar; unsigned x; volatile LAS unsigned* st; int wave; };
__device__ __forceinline__ XcdBarrier xcd_barrier_post(unsigned* bar, volatile LAS unsigned* st, int wave) {
    XcdBarrier b; b.bar = bar; b.x = xb_xcc_id(); b.st = st; b.wave = wave;
    if (wave == 0 && lane_id_() == 0) (void)xb_add(&bar[XB_XCNT(b.x)], 1u);
    return b;
}
__device__ __forceinline__ void xcd_barrier_complete(unsigned* bar, unsigned x, unsigned& nloc, unsigned& nx) {
    const unsigned G = gridDim.x * gridDim.y * gridDim.z;
    unsigned sum, cnt, mine, sp = 0u;
    for (;;) {
        sum = 0u; cnt = 0u; mine = 0u;
#pragma unroll
        for (unsigned j = 0; j < 16; ++j) { const unsigned c = xb_ld(&bar[XB_XCNT(j)]); sum += c; cnt += (c > 0u) ? 1u : 0u; mine = (j == x) ? c : mine; }
        if (sum == G) break;
        __builtin_amdgcn_s_sleep(1);
        if ((++sp & 255u) == 0u) { if (xb_ld(&bar[XB_TMO])) break; if (sp > XB_SPIN_CAP) { atomicAdd(&bar[XB_TMO], 1u); break; } }
    }
    nloc = mine > 0u ? mine : 1u; nx = cnt > 0u ? cnt : 1u;
}
__device__ __forceinline__ void xcd_barrier(const XcdBarrier& b) {
    asm volatile("s_waitcnt vmcnt(0)" ::: "memory");
    __syncthreads();
    if (b.wave == 0 && lane_id_() == 0) {
        unsigned* bar = b.bar;
        __builtin_amdgcn_s_waitcnt(0);
        unsigned nloc = b.st[0], nx = b.st[1];
        if (nloc == 0u) { xcd_barrier_complete(bar, b.x, nloc, nx); b.st[0] = nloc; b.st[1] = nx; }
        const unsigned old = xb_add(&bar[XB_XSUB(b.x)], 1u);
        const unsigned gen = old / nloc;
        if (old + 1u == (gen + 1u) * nloc) {
            __builtin_amdgcn_fence(__ATOMIC_RELEASE, "agent");
            asm volatile("s_waitcnt vmcnt(0)" ::: "memory");
            const unsigned og = xb_add(&bar[XB_TOP], 1u);
            const unsigned tg = og / nx;
            if (og + 1u == (tg + 1u) * nx) xb_add(&bar[XB_TOPGEN], 1u);
            else XB_SPIN(xb_ld(&bar[XB_TOPGEN]) == tg, bar);
            __builtin_amdgcn_fence(__ATOMIC_ACQUIRE, "agent");
            xb_add(&bar[XB_XGEN(b.x)], 1u);
            asm volatile("s_waitcnt vmcnt(0)" ::: "memory");
        } else {
            XB_SPIN(xb_ld(&bar[XB_XGEN(b.x)]) == gen, bar);
            __builtin_amdgcn_fence(__ATOMIC_ACQUIRE, "agent");
            asm volatile("s_waitcnt vmcnt(0)" ::: "memory");
        }
    }
    __syncthreads();
}

namespace pg8 {
constexpr int BM = 256, BK = 64, HALF = 128, HTB = HALF * BK * 2, STAGE_BYTES = 8 * HTB, NXCD = 8, WGM = 8;
__host__ __device__ __forceinline__ int lds_byte(int r, int c) { const int st = (r >> 4) * 2 + (c >> 5), rr = r & 15, cc = c & 31, ob = rr * 64 + cc * 2; return st * 1024 + (ob ^ (((ob >> 9) & 1) << 5)); }
__host__ __device__ __forceinline__ void stage_rc(int b, int& R, int& C) { const int st = b / 1024, sb = b % 1024, swz = sb ^ (((sb >> 9) & 1) << 5); R = (st >> 1) * 16 + swz / 64; C = (st & 1) * 32 + (swz % 64) / 2; }
__host__ __device__ __forceinline__ int perm32(int rho) { const int n = rho >> 4, i = rho & 15; return 8 * (i >> 2) + 4 * n + (i & 3); }
struct Unit { int pm, pn; };
struct Gemm { const bf16_t* A; const bf16_t* Bt; int M, N, K, lda, ldb, jt; long jumpA; };
struct StaticOrder {
    int nM, nN, nwg, G, c; bool in_order;
    __host__ __device__ void init(int M, int N, int G_, int c_, bool io = false) { nM = M / BM; nN = N / BM; nwg = nM * nN; G = G_; c = c_; in_order = io; }
    __host__ __device__ bool next(int i, Unit& u) const {
        const long L = (long)i * G + c; if (L >= nwg) return false;
        int wgid = (int)L; { const int q = nwg / NXCD, r = nwg % NXCD, xcd = wgid % NXCD, off = wgid / NXCD; wgid = (xcd < r ? xcd * (q + 1) : r * (q + 1) + (xcd - r) * q) + off; }
        const int nig = WGM * nN, gid = wgid / nig, fm = gid * WGM, gsz = (nM - fm) < WGM ? (nM - fm) : WGM;
        u.pm = fm + ((wgid % nig) % gsz); u.pn = (wgid % nig) / gsz;
        if (in_order) u.pn = u.pn < 6 ? 8 + u.pn : u.pn < 14 ? u.pn - 6 : u.pn;
        return true;
    }
    __device__ __forceinline__ void a_ready(const Unit&, int) const {}
};
template <class Epi, class Sched>
__device__ __forceinline__ void gemm_phase(LAS unsigned char* lds, const Gemm g, const Sched& S, const Epi& E, const int wid) {
    const int lane = lane_id_(), tid = wid * 64 + lane, wr = wid >> 2, wc = wid & 3, fr = lane & 15, fq = lane >> 4;
    const int nt = g.K / BK;
    unsigned voffA[2], voffB[2];
#pragma unroll
    for (int i = 0; i < 2; ++i) { int R, C; stage_rc(tid * 16 + i * 8192, R, C); const int Rb = (R & ~31) + perm32(R & 31);
        voffA[i] = (unsigned)(R * g.lda + C) * 2u; voffB[i] = (unsigned)(Rb * g.ldb + C) * 2u; }
    const size_t kstep = (size_t)(BK * 2);
    const size_t hstepA = (size_t)HALF * g.lda * 2, hstepB = (size_t)HALF * g.ldb * 2;
    const size_t tstepA = 2 * hstepA, tstepB = 2 * hstepB;
    const unsigned ldsw = (unsigned)wid * 1024u;
    const int aoff = lds_byte(wr * 64 + fr, fq * 8), boff = lds_byte(wc * 32 + fr, fq * 8);
#define PG8_SA(b, h) (((b) * 2 + (h)) * HTB)
#define PG8_SB(b, h) ((4 + (b) * 2 + (h)) * HTB)
#define PG8_STAGE(bufoff, gbase, voff) do { _Pragma("unroll") for (int _i = 0; _i < 2; ++_i) \
        __builtin_amdgcn_global_load_lds((const unsigned*)((const char*)(gbase) + (voff)[_i]), (LAS unsigned*)(lds + (bufoff) + ldsw + _i * 8192), 16, 0, 0); } while (0)
#define PG8_LDA(dst, b, h) do { _Pragma("unroll") for (int m = 0; m < 4; ++m) _Pragma("unroll") for (int k = 0; k < 2; ++k) dst[m][k] = *(const LAS bf16x8*)(lds + PG8_SA(b, h) + aoff + m * 2048 + k * 1024); } while (0)
#define PG8_LDB(dst, b, h) do { _Pragma("unroll") for (int n = 0; n < 2; ++n) _Pragma("unroll") for (int k = 0; k < 2; ++k) dst[n][k] = *(const LAS bf16x8*)(lds + PG8_SB(b, h) + boff + n * 2048 + k * 1024); } while (0)
#define PG8_MMA(ai, bj, At, Bt) do { __builtin_amdgcn_s_setprio(1); _Pragma("unroll") for (int m = 0; m < 4; ++m) _Pragma("unroll") for (int n = 0; n < 2; ++n) _Pragma("unroll") for (int k = 0; k < 2; ++k) \
        acc[ai][bj][m][n] = __builtin_amdgcn_mfma_f32_16x16x32_bf16(Bt[n][k], At[m][k], acc[ai][bj][m][n], 0, 0, 0); __builtin_amdgcn_s_setprio(0); } while (0)
#define PG8_WAIT_V(n) asm volatile("s_waitcnt vmcnt(" #n ")" ::: "memory")
#define PG8_WAIT_L(n) asm volatile("s_waitcnt lgkmcnt(" #n ")" ::: "memory")
#define PG8_BAR __builtin_amdgcn_s_barrier()
#define PG8_SCHED __builtin_amdgcn_sched_barrier(0)
    Unit cur, nxt; int ui = 0;
    if (!S.next(0, cur)) return;
    f32x4 acc[2][2][4][2];
#pragma unroll
    for (int a = 0; a < 2; ++a)
#pragma unroll
        for (int b = 0; b < 2; ++b)
#pragma unroll
            for (int m = 0; m < 4; ++m)
#pragma unroll
                for (int n = 0; n < 2; ++n) acc[a][b][m][n] = (f32x4){0.f, 0.f, 0.f, 0.f};
    bf16x8 At[4][2], B0[2][2], B1[2][2];
    const char* cA = (const char*)g.A + (size_t)cur.pm * tstepA; const char* cB = (const char*)g.Bt + (size_t)cur.pn * tstepB;
    const int jt = g.jt; const long jumpA = g.jumpA;
    S.a_ready(cur, wid);
#define PG8_KA(base, t) ((base) + (size_t)(t) * kstep + ((t) >= jt ? jumpA : 0L))
    PG8_STAGE(PG8_SB(0, 0), cB, voffB); PG8_STAGE(PG8_SB(0, 1), cB + hstepB, voffB); PG8_STAGE(PG8_SA(0, 0), cA, voffA); PG8_STAGE(PG8_SA(0, 1), cA + hstepA, voffA);
    if (wr == 1) PG8_BAR;
    PG8_WAIT_V(2); PG8_BAR;
    PG8_STAGE(PG8_SB(1, 0), cB + kstep, voffB); PG8_STAGE(PG8_SA(1, 0), PG8_KA(cA, 1), voffA); PG8_STAGE(PG8_SB(1, 1), cB + hstepB + kstep, voffB);
    PG8_WAIT_V(6); PG8_BAR;
    for (;;) {
        const bool has_next = S.next(ui + 1, nxt);
        const char* nA = has_next ? (const char*)g.A + (size_t)nxt.pm * tstepA : cA; const char* nB = has_next ? (const char*)g.Bt + (size_t)nxt.pn * tstepB : cB;
        for (int seg = 0; seg < (Epi::MID_T >= 0 ? 2 : 1); ++seg) {
        const int tb = (Epi::MID_T >= 0 && seg == 1) ? Epi::MID_T : 0, te = (Epi::MID_T >= 0 && seg == 0) ? Epi::MID_T : nt;
        if constexpr (Epi::MID_T >= 0) { if (seg == 1) E.mid(acc, cur, wr, wc, fr, fq); }
        for (int t = tb; t < te; t += 2) {
            const bool last = (t == nt - 2);
            if (last && has_next) S.a_ready(nxt, wid);
            const char* a1 = PG8_KA(cA, t + 1);
            const char* a2 = last ? nA : PG8_KA(cA, t + 2); const char* b2 = last ? nB : cB + (size_t)(t + 2) * kstep;
            const char* a3 = last ? PG8_KA(nA, 1) : PG8_KA(cA, t + 3); const char* b3 = b2 + kstep;
            PG8_LDB(B0, 0, 0); PG8_LDB(B1, 0, 1); PG8_SCHED; PG8_LDA(At, 0, 0); PG8_STAGE(PG8_SA(1, 1), a1 + hstepA, voffA);
            PG8_WAIT_V(8); PG8_WAIT_L(0); PG8_BAR; PG8_MMA(0, 0, At, B0); PG8_MMA(0, 1, At, B1); PG8_BAR; PG8_SCHED;
            PG8_LDA(At, 0, 1); PG8_STAGE(PG8_SB(0, 0), b2, voffB); PG8_STAGE(PG8_SB(0, 1), b2 + hstepB, voffB); PG8_STAGE(PG8_SA(0, 0), a2, voffA);
            PG8_WAIT_V(8); PG8_WAIT_L(0); PG8_BAR; PG8_MMA(1, 0, At, B0); PG8_MMA(1, 1, At, B1); PG8_BAR; PG8_SCHED;
            PG8_LDB(B0, 1, 0); PG8_LDB(B1, 1, 1); PG8_SCHED; PG8_LDA(At, 1, 0); PG8_STAGE(PG8_SA(0, 1), a2 + hstepA, voffA);
            PG8_WAIT_V(8); PG8_WAIT_L(0); PG8_BAR; PG8_MMA(0, 0, At, B0); PG8_MMA(0, 1, At, B1); PG8_BAR; PG8_SCHED;
            PG8_LDA(At, 1, 1); PG8_STAGE(PG8_SB(1, 0), b3, voffB); PG8_STAGE(PG8_SB(1, 1), b3 + hstepB, voffB); PG8_STAGE(PG8_SA(1, 0), a3, voffA);
            PG8_WAIT_V(8); PG8_WAIT_L(0); PG8_BAR; PG8_MMA(1, 0, At, B0); PG8_MMA(1, 1, At, B1); PG8_BAR; PG8_SCHED;
        }
        }
        const typename Epi::Pre pf = E.pre(cur, wr, wc, fr, fq, wid, lane);
        if (wr == 0) PG8_BAR;
        E.epi(acc, cur, wr, wc, fr, fq, wid, lane, pf);
        if (!has_next) break;
#pragma unroll
        for (int a = 0; a < 2; ++a)
#pragma unroll
            for (int b = 0; b < 2; ++b)
#pragma unroll
                for (int m = 0; m < 4; ++m)
#pragma unroll
                    for (int n = 0; n < 2; ++n) acc[a][b][m][n] = (f32x4){0.f, 0.f, 0.f, 0.f};
        cur = nxt; cA = nA; cB = nB; ++ui;
        if (wr == 1) PG8_BAR;
    }
    PG8_WAIT_V(0);
    PG8_BAR;
#undef PG8_KA
#undef PG8_SA
#undef PG8_SB
#undef PG8_STAGE
#undef PG8_LDA
#undef PG8_LDB
#undef PG8_MMA
#undef PG8_WAIT_V
#undef PG8_WAIT_L
#undef PG8_BAR
#undef PG8_SCHED
}
}

typedef f32x4 AccT[2][2][4][2];
struct NoPre {};
#define PIN8(a, i, j) asm volatile("" : "+v"(a[i][j][0][0]), "+v"(a[i][j][0][1]), "+v"(a[i][j][1][0]), "+v"(a[i][j][1][1]), "+v"(a[i][j][2][0]), "+v"(a[i][j][2][1]), "+v"(a[i][j][3][0]), "+v"(a[i][j][3][1]))
#define PINACC(a) do { PIN8(a, 0, 0); PIN8(a, 0, 1); PIN8(a, 1, 0); PIN8(a, 1, 1); } while (0)
#define RAW_BAR() do { asm volatile("s_waitcnt lgkmcnt(0)" ::: "memory"); __builtin_amdgcn_s_barrier(); asm volatile("" ::: "memory"); } while (0)
__device__ __forceinline__ u32x4 pack8(const f32x4 a, const f32x4 b) { u32x4 w; w.x = pk2(a[0], a[1]); w.y = pk2(a[2], a[3]); w.z = pk2(b[0], b[1]); w.w = pk2(b[2], b[3]); return w; }
__device__ __forceinline__ void unpack8(const u32x4 w, f32x4& a, f32x4& b) { a = (f32x4){bflo(w.x), bfhi(w.x), bflo(w.y), bfhi(w.y)}; b = (f32x4){bflo(w.z), bfhi(w.z), bflo(w.w), bfhi(w.w)}; }

typedef __amdgpu_buffer_rsrc_t rsrc_t;
__device__ __forceinline__ rsrc_t mk_rsrc(const void* p, unsigned bytes) { return __builtin_amdgcn_make_buffer_rsrc((void*)p, (short)0, (int)bytes, 0x00020000); }
__device__ __forceinline__ void st16_wt(rsrc_t r, unsigned off, u32x4 v) { __builtin_amdgcn_raw_buffer_store_b128(v, r, off, 0, 16); }
__device__ __forceinline__ void st16_wt(rsrc_t r, unsigned off, f32x4 v) { __builtin_amdgcn_raw_buffer_store_b128(__builtin_bit_cast(u32x4, v), r, off, 0, 16); }

struct EpiIn {
    static constexpr int MID_T = -1;
    typedef NoPre Pre;
    __device__ __forceinline__ Pre pre(const pg8::Unit&, int, int, int, int, int, int) const { return Pre(); }
    bf16_t *Q, *KALL, *VALL, *KP, *VP, *RQ, *RK, *RV, *SRG, *GA, *GR; float *ock, *ocv; const float *qg, *kg; LAS float* P; unsigned* c1;
    __device__ __forceinline__ void mid(AccT&, const pg8::Unit&, int, int, int, int) const {}
    __device__ __forceinline__ void epi(AccT& acc, const pg8::Unit& u, int wr, int wc, int fr, int fq, int wid, int lane, const Pre&) const {
        asm volatile("" : "+v"(fr), "+v"(fq));
        const int pn = u.pn, pm = u.pm; const bool latent = pm >= 16;
        if (wid == 0 && lane == 0) { __hip_atomic_fetch_add(c1 + 16 * (481 + pm), 1u, RLX_AGENT); __hip_atomic_fetch_add(c1 + 16 * (481 + 80), 1u, RLX_AGENT); }
        const int lb = (pm - 16) >> 4, t0 = latent ? ((pm - 16) & 15) * 256 : 0;
        const int rl0 = 64 * wr + fr, cw8 = 32 * wc + 8 * fq;
        const size_t grow0 = (size_t)pm * 256;
        if (pn <= 4) {
#pragma unroll
            for (int ai = 0; ai < 2; ++ai)
#pragma unroll
                for (int m = 0; m < 4; ++m)
#pragma unroll
                    for (int bj = 0; bj < 2; ++bj) { const f32x4 a = acc[ai][bj][m][0], b = acc[ai][bj][m][1];
                        float s = (a[0] * a[0] + a[1] * a[1]) + (a[2] * a[2] + a[3] * a[3]) + (b[0] * b[0] + b[1] * b[1]) + (b[2] * b[2] + b[3] * b[3]);
                        s += __shfl_xor(s, 16); s += __shfl_xor(s, 32);
                        if (fq == 0) P[((128 * ai + rl0 + 16 * m) * 2 + bj) * 4 + wc] = s; }
            RAW_BAR();
            const float* gain = pn < 4 ? qg : kg;
            const int d0 = 64 * (wc >> 1) + 8 * fq + 4 * (wc & 1);
            const f32x4 g0 = *(const f32x4*)(gain + d0), g1 = *(const f32x4*)(gain + d0 + 32);
            float inv[4];
#pragma unroll
            for (int e = 0; e < 4; ++e) inv[e] = rope_inv(8 * fq + 4 * (wc & 1) + e);
#pragma unroll
            for (int ai = 0; ai < 2; ++ai)
#pragma unroll
                for (int m = 0; m < 4; ++m) { const int r = 128 * ai + rl0 + 16 * m, t = t0 + r;
                    f32x4 cs = {1.f, 1.f, 1.f, 1.f}, sn = {0.f, 0.f, 0.f, 0.f};
                    if (latent) { const float pos = (float)((wc >> 1) == 0 ? (t >> 6) : (t & 63));
#pragma unroll
                        for (int e = 0; e < 4; ++e) { float c_, s_; sincos_rev(pos * inv[e], c_, s_); cs[e] = c_; sn[e] = s_; } }
#pragma unroll
                    for (int bj = 0; bj < 2; ++bj) { const f32x4 pp = *(const LAS f32x4*)&P[(r * 2 + bj) * 4];
                        const float rstd = __builtin_amdgcn_rsqf(((pp[0] + pp[1]) + (pp[2] + pp[3])) * (1.0f / 128.0f) + EPS);
                        const f32x4 x1 = acc[ai][bj][m][0] * rstd * g0, x2 = acc[ai][bj][m][1] * rstd * g1;
                        const f32x4 o1 = x1 * cs - x2 * sn, o2 = x2 * cs + x1 * sn;
                        const u32x4 w = pack8(o1, o2);
                        if (pn < 4) { *(u32x4*)(Q + (grow0 + r) * 1024 + 128 * (2 * pn + bj) + cw8) = w; }
                        else if (latent) { *(u32x4*)(KALL + ((size_t)(lb * 2 + bj) * SKV + t) * 128 + cw8) = w; }
                        else { const size_t o = ((size_t)(pm * 2 + bj) * 256 + t) * 128;
                            *(u32x4*)(KP + o + cw8) = w; *(f32x4*)(ock + o + d0) = o1; *(f32x4*)(ock + o + d0 + 32) = o2; } } }
        } else if (pn == 5) {
#pragma unroll
            for (int ai = 0; ai < 2; ++ai)
#pragma unroll
                for (int m = 0; m < 4; ++m) { const int r = 128 * ai + rl0 + 16 * m, t = t0 + r;
#pragma unroll
                    for (int bj = 0; bj < 2; ++bj) { const f32x4 a = acc[ai][bj][m][0], b = acc[ai][bj][m][1]; const u32x4 w = pack8(a, b);
                        if (latent) { *(u32x4*)(VALL + ((size_t)(lb * 2 + bj) * SKV + t) * 128 + cw8) = w; }
                        else { const size_t o = ((size_t)(pm * 2 + bj) * 256 + t) * 128 + cw8;
                            *(u32x4*)(VP + o) = w; *(f32x4*)(ocv + o) = a; *(f32x4*)(ocv + o + 4) = b; } } }
        } else if (pn <= 9) {
            const float sc = pn >= 8 ? 0.125f : 1.0f; bf16_t* dst = RQ + (pn >= 8 ? (WS_RK - WS_RQ) / 2 : 0); const int cb = 256 * ((pn - 6) & 1);
            const rsrc_t rd = mk_rsrc(dst + grow0 * 512, 256 * 512 * 2);
            float inv[4];
#pragma unroll
            for (int e = 0; e < 4; ++e) inv[e] = rope_inv(8 * fq + 4 * (wc & 1) + e);
#pragma unroll
            for (int ai = 0; ai < 2; ++ai)
#pragma unroll
                for (int m = 0; m < 4; ++m) { const int r = 128 * ai + rl0 + 16 * m, t = t0 + r; const float pos = (float)(latent ? PAST + t : t);
                    f32x4 cs, sn;
#pragma unroll
                    for (int e = 0; e < 4; ++e) { float c_, s_; sincos_rev(pos * inv[e], c_, s_); cs[e] = c_ * sc; sn[e] = s_ * sc; }
#pragma unroll
                    for (int bj = 0; bj < 2; ++bj) { const f32x4 x1 = acc[ai][bj][m][0], x2 = acc[ai][bj][m][1];
                        st16_wt(rd, (unsigned)(((r * 512) + cb + 128 * bj + cw8) * 2), pack8(x1 * cs - x2 * sn, x2 * cs + x1 * sn)); } }
        } else if (pn < 18) {
            const int kind = (pn - 10) >> 2; bf16_t* dst = RV + (size_t)kind * ((WS_SRG - WS_RV) / 2); const int cb = 256 * ((pn - 10) & 3);
            const rsrc_t rd = mk_rsrc(dst + grow0 * 1024, 256 * 1024 * 2);
#pragma unroll
            for (int ai = 0; ai < 2; ++ai)
#pragma unroll
                for (int m = 0; m < 4; ++m) { const int r = 128 * ai + rl0 + 16 * m;
#pragma unroll
                    for (int bj = 0; bj < 2; ++bj) { f32x4 a = acc[ai][bj][m][0], b = acc[ai][bj][m][1];
                        if (kind == 1) { _Pragma("unroll") for (int e = 0; e < 4; ++e) { a[e] = siluf_(a[e]); b[e] = siluf_(b[e]); } }
                        st16_wt(rd, (unsigned)(((r * 1024) + cb + 128 * bj + cw8) * 2), pack8(a, b)); } }
        } else {
            const int cb = 128 * (pn - 18);
            const rsrc_t rra = mk_rsrc(GA + grow0 * 1024, 256 * 1024 * 2), rrg = mk_rsrc(GR + grow0 * 1024, 256 * 1024 * 2);
#pragma unroll
            for (int ai = 0; ai < 2; ++ai)
#pragma unroll
                for (int m = 0; m < 4; ++m) { const int r = 128 * ai + rl0 + 16 * m; f32x4 q0, q1, g0, g1;
#pragma unroll
                    for (int e = 0; e < 4; ++e) { g0[e] = sigmoidf_(acc[ai][1][m][0][e]); g1[e] = sigmoidf_(acc[ai][1][m][1][e]);
                        q0[e] = sigmoidf_(acc[ai][0][m][0][e]) * __builtin_amdgcn_rcpf(fmaxf(g0[e], 1e-30f)); q1[e] = sigmoidf_(acc[ai][0][m][1][e]) * __builtin_amdgcn_rcpf(fmaxf(g1[e], 1e-30f)); }
                    const unsigned o = (unsigned)(((r * 1024) + cb + cw8) * 2);
                    st16_wt(rra, o, pack8(q0, q1)); st16_wt(rrg, o, pack8(g0, g1)); }
        }
        if (pn >= 8 && pn <= 13) {
            asm volatile("s_waitcnt vmcnt(0)" ::: "memory");
            RAW_BAR();
            if (wid == 0 && lane == 0) { __hip_atomic_fetch_add(c1 + 16 * (pm * 6 + pn - 8), 1u, RLX_AGENT); __hip_atomic_fetch_add(c1 + 16 * 480, 1u, RLX_AGENT); } }
    }
};

struct EpiMix {
    static constexpr int MID_T = 16;
    typedef NoPre Pre;
    __device__ __forceinline__ Pre pre(const pg8::Unit&, int, int, int, int, int, int) const { return Pre(); }
    const bf16_t *GA, *GR; bf16_t* Y; unsigned* done;
    __device__ __forceinline__ void mid(AccT& acc, const pg8::Unit& u, int wr, int wc, int fr, int fq) const {
        unsigned lo = (unsigned)(((64 * wr + fr) * 1024 + 32 * wc + 8 * fq) * 2); asm volatile("" : "+v"(lo));
        const char* ga = (const char*)GA + ((size_t)u.pm * 256 * 1024 + 256 * u.pn) * 2;
        u32x4 q[8][2];
#pragma unroll
        for (int k = 0; k < 8; ++k)
#pragma unroll
            for (int bj = 0; bj < 2; ++bj) q[k][bj] = *(const u32x4*)(ga + lo + (unsigned)((((128 * (k >> 2) + 16 * (k & 3)) * 1024) + 128 * bj) * 2));
#pragma unroll
        for (int k = 0; k < 8; ++k)
#pragma unroll
            for (int bj = 0; bj < 2; ++bj) { f32x4 a0, a1; unpack8(q[k][bj], a0, a1); acc[k >> 2][bj][k & 3][0] *= a0; acc[k >> 2][bj][k & 3][1] *= a1; }
    }
    __device__ __forceinline__ void epi(AccT& acc, const pg8::Unit& u, int wr, int wc, int fr, int fq, int wid, int lane, const Pre&) const {
        unsigned lo = (unsigned)(((64 * wr + fr) * 1024 + 32 * wc + 8 * fq) * 2); asm volatile("" : "+v"(lo));
        const size_t ub = ((size_t)u.pm * 256 * 1024 + 256 * u.pn) * 2; const char* gr = (const char*)GR + ub; const rsrc_t ry = mk_rsrc((char*)Y + ub, 256 * 1024 * 2);
        u32x4 q[8][2];
#pragma unroll
        for (int k = 0; k < 8; ++k)
#pragma unroll
            for (int bj = 0; bj < 2; ++bj) q[k][bj] = *(const u32x4*)(gr + lo + (unsigned)((((128 * (k >> 2) + 16 * (k & 3)) * 1024) + 128 * bj) * 2));
#pragma unroll
        for (int k = 0; k < 8; ++k)
#pragma unroll
            for (int bj = 0; bj < 2; ++bj) { f32x4 r0, r1; unpack8(q[k][bj], r0, r1);
                st16_wt(ry, lo + (unsigned)((((128 * (k >> 2) + 16 * (k & 3)) * 1024) + 128 * bj) * 2), pack8(acc[k >> 2][bj][k & 3][0] * r0, acc[k >> 2][bj][k & 3][1] * r1)); }
        asm volatile("s_waitcnt vmcnt(0)" ::: "memory");
        RAW_BAR();
        if (wid == 0 && lane == 0) __hip_atomic_fetch_add(done + 64 * u.pm, 1u, RLX_AGENT);
    }
};

struct EpiRes1 {
    static constexpr int MID_T = -1;
    typedef NoPre Pre;
    __device__ __forceinline__ Pre pre(const pg8::Unit&, int, int, int, int, int, int) const { return Pre(); }
    const float *xp, *xs, *modf, *g2n; bf16_t* X1B; float* ssq; bf16_t* A2;
    __device__ __forceinline__ void mid(AccT&, const pg8::Unit&, int, int, int, int) const {}
    __device__ __forceinline__ void epi(AccT& acc, const pg8::Unit& u, int wr, int wc, int fr, int fq, int wid, int lane, const Pre&) const {
        asm volatile("" : "+v"(fr), "+v"(fq));
        const int pm = u.pm, v = pm < 16 ? 0 : 1 + ((pm - 16) >> 4);
        const float* mv = modf + (size_t)v * 6144; const float* xsrc = pm < 16 ? xp + (size_t)pm * 256 * 1024 : xs + (size_t)(pm - 16) * 256 * 1024;
        const unsigned cb = (unsigned)(256 * u.pn + 32 * wc + 8 * fq), rb = (unsigned)(64 * wr + fr);
        {   f32x4 g1[2][2];
#pragma unroll
            for (int bj = 0; bj < 2; ++bj)
#pragma unroll
                for (int n = 0; n < 2; ++n) g1[bj][n] = *(const f32x4*)(mv + 2048 + cb + 128 * bj + 4 * n);
#pragma unroll
            for (int h = 0; h < 4; ++h) { f32x4 xv[2][2][2];
#pragma unroll
                for (int mm = 0; mm < 2; ++mm)
#pragma unroll
                    for (int bj = 0; bj < 2; ++bj) { const float* p = xsrc + (size_t)(128 * (h >> 1) + 16 * (2 * (h & 1) + mm) + rb) * 1024 + cb + 128 * bj; xv[mm][bj][0] = *(const f32x4*)p; xv[mm][bj][1] = *(const f32x4*)(p + 4); }
#pragma unroll
                for (int mm = 0; mm < 2; ++mm)
#pragma unroll
                    for (int bj = 0; bj < 2; ++bj) { const int ai = h >> 1, m = 2 * (h & 1) + mm;
                        acc[ai][bj][m][0] = xv[mm][bj][0] + g1[bj][0] * acc[ai][bj][m][0]; acc[ai][bj][m][1] = xv[mm][bj][1] + g1[bj][1] * acc[ai][bj][m][1]; }
                {   const int ai = h >> 1, m0 = 2 * (h & 1);
                    asm volatile("" : "+v"(acc[ai][0][m0][0]), "+v"(acc[ai][0][m0][1]), "+v"(acc[ai][1][m0][0]), "+v"(acc[ai][1][m0][1]),
                                      "+v"(acc[ai][0][m0 + 1][0]), "+v"(acc[ai][0][m0 + 1][1]), "+v"(acc[ai][1][m0 + 1][0]), "+v"(acc[ai][1][m0 + 1][1]) :: "memory"); } } }
        f32x4 w2[2][2];
#pragma unroll
        for (int bj = 0; bj < 2; ++bj)
#pragma unroll
            for (int n = 0; n < 2; ++n) { const unsigned c = cb + 128 * bj + 4 * n; w2[bj][n] = *(const f32x4*)(g2n + c) * (*(const f32x4*)(mv + 4096 + c) + 1.0f); }
        const rsrc_t rx = mk_rsrc(X1B + (size_t)pm * 256 * 1024, 256 * 1024 * 2), ra = mk_rsrc(A2 + (size_t)pm * 256 * 1024, 256 * 1024 * 2);
#pragma unroll
        for (int ai = 0; ai < 2; ++ai)
#pragma unroll
            for (int m = 0; m < 4; ++m) { const unsigned r = 128 * ai + 16 * m + rb; float s = 0.f;
#pragma unroll
                for (int bj = 0; bj < 2; ++bj) { const unsigned o = r * 1024 + cb + 128 * bj; const f32x4 x0 = acc[ai][bj][m][0], x1 = acc[ai][bj][m][1];
                    st16_wt(rx, o * 2u, pack8(x0, x1));
                    st16_wt(ra, o * 2u, pack8(x0 * w2[bj][0], x1 * w2[bj][1]));
                    s += (x0[0] * x0[0] + x0[1] * x0[1]) + (x0[2] * x0[2] + x0[3] * x0[3]) + (x1[0] * x1[0] + x1[1] * x1[1]) + (x1[2] * x1[2] + x1[3] * x1[3]); }
                s += __shfl_xor(s, 16); s += __shfl_xor(s, 32);
                if (fq == 0) atomicAdd(ssq + (size_t)pm * 256 + r, s); }
    }
};

struct EpiRes2 {
    static constexpr int MID_T = -1;
    typedef NoPre Pre;
    __device__ __forceinline__ Pre pre(const pg8::Unit&, int, int, int, int, int, int) const { return Pre(); }
    const float *mod, *fg; const bf16_t* X1B; float* X; float* XS; unsigned* xcnt; LAS float* P;
    __device__ __forceinline__ void mid(AccT&, const pg8::Unit&, int, int, int, int) const {}
    __device__ __forceinline__ void epi(AccT& acc, const pg8::Unit& u, int wr, int wc, int fr, int fq, int wid, int lane, const Pre&) const {
        asm volatile("" : "+v"(fr), "+v"(fq));
        const int pm = u.pm, v = pm < 16 ? 0 : 1 + ((pm - 16) >> 4); const float* mv = mod + (size_t)v * 6144;
        const int cb = 256 * u.pn + 32 * wc + 8 * fq;
        {   f32x4 g2[2][2]; u32x4 xq[8][2];
#pragma unroll
            for (int bj = 0; bj < 2; ++bj)
#pragma unroll
                for (int n = 0; n < 2; ++n) g2[bj][n] = *(const f32x4*)(mv + 5120 + cb + 128 * bj + 4 * n);
#pragma unroll
            for (int k = 0; k < 8; ++k)
#pragma unroll
                for (int bj = 0; bj < 2; ++bj) xq[k][bj] = *(const u32x4*)(X1B + ((size_t)pm * 256 + 128 * (k >> 2) + 64 * wr + 16 * (k & 3) + fr) * 1024 + cb + 128 * bj);
#pragma unroll
            for (int k = 0; k < 8; ++k) { const int ai = k >> 2, m = k & 3, r = 128 * ai + 64 * wr + 16 * m + fr; float s = 0.f;
#pragma unroll
                for (int bj = 0; bj < 2; ++bj) { f32x4 xa, xb; unpack8(xq[k][bj], xa, xb);
                    const f32x4 x0 = xa + g2[bj][0] * acc[ai][bj][m][0], x1 = xb + g2[bj][1] * acc[ai][bj][m][1];
                    acc[ai][bj][m][0] = x0; acc[ai][bj][m][1] = x1;
                    s += (x0[0] * x0[0] + x0[1] * x0[1]) + (x0[2] * x0[2] + x0[3] * x0[3]) + (x1[0] * x1[0] + x1[1] * x1[1]) + (x1[2] * x1[2] + x1[3] * x1[3]); }
                s += __shfl_xor(s, 16); s += __shfl_xor(s, 32);
                if (fq == 0) P[r * 4 + wc] = s; } }
        RAW_BAR();
        const int tid = wid * 64 + lane;
        if (wid < 4) { const f32x4 pp = *(const LAS f32x4*)&P[tid * 4];
            __hip_atomic_store(XS + ((size_t)pm * 4 + u.pn) * 256 + tid, (pp[0] + pp[1]) + (pp[2] + pp[3]), RLX_AGENT);
            asm volatile("s_waitcnt vmcnt(0)" ::: "memory");
            if (lane == 0) __hip_atomic_fetch_add(xcnt + 64 * pm, 1u, RLX_AGENT); }
        if (wid == 0) { unsigned sp = 0;
            while ((unsigned)__builtin_amdgcn_readfirstlane(__hip_atomic_load(xcnt + 64 * pm, RLX_AGENT)) < 16u) { __builtin_amdgcn_s_sleep(2); if (++sp > (1u << 22)) break; } }
        RAW_BAR();
        if (wid < 4) { float t = 0.f;
#pragma unroll
            for (int k = 0; k < 4; ++k) t += __hip_atomic_load(XS + ((size_t)pm * 4 + k) * 256 + tid, RLX_AGENT);
            P[1024 + tid] = 1.0f / sqrtf(t * (1.0f / 1024.0f) + EPS); }
        RAW_BAR();
        {   f32x4 fgv[2][2];
#pragma unroll
            for (int bj = 0; bj < 2; ++bj)
#pragma unroll
                for (int n = 0; n < 2; ++n) fgv[bj][n] = *(const f32x4*)(fg + cb + 128 * bj + 4 * n);
#pragma unroll
            for (int ai = 0; ai < 2; ++ai)
#pragma unroll
                for (int m = 0; m < 4; ++m) { const int r = 128 * ai + 64 * wr + 16 * m + fr;
                    const float rs = P[1024 + r];
#pragma unroll
                    for (int bj = 0; bj < 2; ++bj) { float* p = X + ((size_t)pm * 256 + r) * 1024 + cb + 128 * bj;
                        *(f32x4*)p = acc[ai][bj][m][0] * rs * fgv[bj][0]; *(f32x4*)(p + 4) = acc[ai][bj][m][1] * rs * fgv[bj][1]; } } }
    }
};

__device__ __forceinline__ float dpp_up(float cur, float old) {
    return __builtin_bit_cast(float, __builtin_amdgcn_update_dpp(__builtin_bit_cast(int, old), __builtin_bit_cast(int, cur), 0x111, 0xF, 0xF, false)); }
__device__ __forceinline__ float dpp_dn(float cur, float old) {
    return __builtin_bit_cast(float, __builtin_amdgcn_update_dpp(__builtin_bit_cast(int, old), __builtin_bit_cast(int, cur), 0x101, 0xF, 0xF, false)); }
__device__ __forceinline__ float dpp_ror1(float x) {
    return __builtin_bit_cast(float, __builtin_amdgcn_update_dpp(0, __builtin_bit_cast(int, x), 0x121, 0xF, 0xF, false)); }
__device__ __forceinline__ float dpp_rol1(float x) {
    return __builtin_bit_cast(float, __builtin_amdgcn_update_dpp(0, __builtin_bit_cast(int, x), 0x12F, 0xF, 0xF, false)); }
struct EpiConv {
    static constexpr int MID_T = -1;
    const float *ssq, *bup, *cw, *cbias; bf16_t* ACT; float *EU, *EUC; LAS float* E; unsigned* done;
    struct Pre { float ss[8]; f32x4 bb[2][2]; float cwv[4]; };
    __device__ __forceinline__ void mid(AccT&, const pg8::Unit&, int, int, int, int) const {}
    __device__ __forceinline__ Pre pre(const pg8::Unit& u, int wr, int wc, int fr, int fq, int wid, int lane) const {
        Pre p; const int pm = u.pm, pn = u.pn, v = pm < 16 ? 0 : 1 + ((pm - 16) >> 4);
        const float* sp = ssq + (size_t)pm * 256 + 64 * wr + fr; const float* bp = bup + (size_t)v * NUP + 256 * pn + 32 * wc + 8 * fq;
#pragma unroll
        for (int k = 0; k < 8; ++k) p.ss[k] = sp[128 * (k >> 2) + 16 * (k & 3)];
#pragma unroll
        for (int bj = 0; bj < 2; ++bj)
#pragma unroll
            for (int n = 0; n < 2; ++n) p.bb[bj][n] = *(const f32x4*)(bp + 128 * bj + 4 * n);
        const int t = wid * 64 + lane, tc = t & 255, ch = (tc < 128 ? 0 : DFF - 128) + 128 * pn + tc;
        p.cwv[0] = cw[ch]; p.cwv[1] = cw[NUP + ch]; p.cwv[2] = cw[2 * NUP + ch]; p.cwv[3] = cbias[ch];
        return p;
    }
    __device__ __forceinline__ void epi(AccT& acc, const pg8::Unit& u, int wr, int wc, int fr, int fq, int wid, int lane, const Pre& pf) const {
        const int pm = u.pm, pn = u.pn; const bool latent = pm >= 16;
#if defined(PROBE_K0) && PROBE_K0 == 400
        const unsigned long long te0_ = __builtin_amdgcn_s_memrealtime();
#endif
        unsigned cw8 = (unsigned)(32 * wc + 8 * fq), rl = (unsigned)(64 * wr + fr); asm volatile("" : "+v"(cw8), "+v"(rl));
        LAS float* CW = E + 2048;
        {   const int t = wid * 64 + lane;
            if (t < 256) { CW[t] = pf.cwv[0]; CW[256 + t] = pf.cwv[1]; CW[512 + t] = pf.cwv[2]; CW[768 + t] = pf.cwv[3]; } }
#pragma unroll
        for (int ai = 0; ai < 2; ++ai)
#pragma unroll
            for (int m = 0; m < 4; ++m) { const float rs = __builtin_amdgcn_rsqf(pf.ss[4 * ai + m] * (1.0f / 1024.0f) + EPS);
#pragma unroll
                for (int bj = 0; bj < 2; ++bj)
#pragma unroll
                    for (int n = 0; n < 2; ++n) acc[ai][bj][m][n] = acc[ai][bj][m][n] * rs + pf.bb[bj][n]; }
        PINACC(acc);
        const rsrc_t reu = mk_rsrc(EU + (size_t)pm * 2 * NUP + 256 * pn, (NUP + 256) * 4), reuc = mk_rsrc(EUC + (size_t)pm * 2 * NUP + 256 * pn, (NUP + 256) * 4);
#pragma unroll
        for (int ai = 0; ai < 2; ++ai)
#pragma unroll
            for (int bj = 0; bj < 2; ++bj)
#pragma unroll
                for (int n = 0; n < 2; ++n) { const unsigned ci = 128 * bj + cw8 + 4 * n; const int grp = 2 * ai + wr;
                    if (fr == 0) { *(LAS f32x4*)&E[(grp * 2 + 0) * 256 + ci] = acc[ai][bj][0][n]; if (latent && grp == 0) st16_wt(reu, ci * 4u, acc[ai][bj][0][n]); }
                    if (fr == 15) { *(LAS f32x4*)&E[(grp * 2 + 1) * 256 + ci] = acc[ai][bj][3][n]; if (latent && grp == 3) st16_wt(reu, (NUP + ci) * 4u, acc[ai][bj][3][n]); } }
        RAW_BAR();
#if defined(PROBE_K0) && PROBE_K0 == 400 && defined(PROBE_SUB) && PROBE_SUB == 1
        if (wid == 0 && lane == 0 && (int)__builtin_amdgcn_workgroup_id_x() == PROBE_BID) atomicAdd((float*)((char*)EU - WS_EDGE_U + 32768), (float)(__builtin_amdgcn_s_memrealtime() - te0_));
#endif
        const rsrc_t ract = mk_rsrc((char*)ACT + ((size_t)pm * 256 * DFF + 128 * pn) * 2, 256 * DFF * 2);
#pragma unroll
        for (int ai = 0; ai < 2; ++ai) { const int grp = 2 * ai + wr;
#pragma unroll
            for (int n = 0; n < 2; ++n)
#pragma unroll
                for (int bj = 0; bj < 2; ++bj) { const unsigned ci = 128 * bj + cw8 + 4 * n;
                    const f32x4 w0 = *(const LAS f32x4*)&CW[ci], w1 = *(const LAS f32x4*)&CW[256 + ci], w2 = *(const LAS f32x4*)&CW[512 + ci], cb = *(const LAS f32x4*)&CW[768 + ci];
                    f32x4 pe = {0.f, 0.f, 0.f, 0.f}, ne = {0.f, 0.f, 0.f, 0.f};
                    if (grp > 0) pe = *(const LAS f32x4*)&E[((grp - 1) * 2 + 1) * 256 + ci];
                    if (grp < 3) ne = *(const LAS f32x4*)&E[((grp + 1) * 2 + 0) * 256 + ci];
#pragma unroll
                    for (int e = 0; e < 4; ++e) { const float u0 = acc[ai][bj][0][n][e], u1 = acc[ai][bj][1][n][e], u2 = acc[ai][bj][2][n][e], u3 = acc[ai][bj][3][n][e];
                        const float p0 = dpp_up(u0, pe[e]), p1 = dpp_up(u1, dpp_ror1(u0)), p2 = dpp_up(u2, dpp_ror1(u1)), p3 = dpp_up(u3, dpp_ror1(u2));
                        const float n0 = dpp_dn(u0, dpp_rol1(u1)), n1 = dpp_dn(u1, dpp_rol1(u2)), n2 = dpp_dn(u2, dpp_rol1(u3)), n3 = dpp_dn(u3, ne[e]);
                        acc[ai][bj][0][n][e] = w0[e] * p0 + w1[e] * u0 + w2[e] * n0 + cb[e]; acc[ai][bj][1][n][e] = w0[e] * p1 + w1[e] * u1 + w2[e] * n1 + cb[e];
                        acc[ai][bj][2][n][e] = w0[e] * p2 + w1[e] * u2 + w2[e] * n2 + cb[e]; acc[ai][bj][3][n][e] = w0[e] * p3 + w1[e] * u3 + w2[e] * n3 + cb[e]; }
                    if (latent) { if (fr == 0 && grp == 0) st16_wt(reuc, ci * 4u, acc[ai][bj][0][n]);
                                  if (fr == 15 && grp == 3) st16_wt(reuc, (NUP + ci) * 4u, acc[ai][bj][3][n]); }
                    asm volatile("" : "+v"(acc[ai][bj][0][n]), "+v"(acc[ai][bj][1][n]), "+v"(acc[ai][bj][2][n]), "+v"(acc[ai][bj][3][n]) :: "memory"); }
#pragma unroll
            for (int m = 0; m < 4; ++m) { f32x4 o0, o1;
#pragma unroll
                for (int e = 0; e < 4; ++e) { o0[e] = siluf_(acc[ai][1][m][0][e]) * acc[ai][0][m][0][e]; o1[e] = siluf_(acc[ai][1][m][1][e]) * acc[ai][0][m][1][e]; }
                st16_wt(ract, ((rl + 128 * ai + 16 * m) * DFF + cw8) * 2u, pack8(o0, o1)); asm volatile("" ::: "memory"); } }
#if defined(PROBE_K0) && PROBE_K0 == 400 && !defined(PROBE_SUB)
        if (wid == 0 && lane == 0 && (int)__builtin_amdgcn_workgroup_id_x() == PROBE_BID) atomicAdd((float*)((char*)EU - WS_EDGE_U + 32768), (float)(__builtin_amdgcn_s_memrealtime() - te0_));
#endif
    }
};

constexpr int NWAVES = 8, NTHR = 512;
constexpr int RING_BYTES = 131072, SPARE_OFF = RING_BYTES, SPARE_BYTES = 16384, MISC_OFF = SPARE_OFF + SPARE_BYTES, LDS_BYTES = MISC_OFF + 256;
struct Args {
    const float *x_prompt, *x_sample, *c, *cache_k, *cache_v, *st_f, *st_b, *c_ctx, *norm1_g, *norm2_g, *w_mod, *b_mod, *w_in, *q_g, *k_g, *dec_f, *dec_b,
                *w_att_o, *w_ret_o, *w_out, *w_up, *conv_w, *conv_b, *w_down, *final_g;
    float* out; unsigned char* ws; int ph_lo, ph_hi;
};
struct Frame { LAS unsigned char* lds; int tid, lane, wave, G, bid; };
typedef const __attribute__((address_space(4))) Args CArgs;

template <class F> __device__ __forceinline__ void transpose_item(const float* W, int ldw, bf16_t* WT, int ldd, int kofs, int k0, int n0, F srccol, LAS float* scr, int lane) {
    const int sc = srccol(n0 + (lane & 31));
#pragma unroll 8
    for (int i = 0; i < 32; ++i) { const int kk = 2 * i + (lane >> 5); scr[kk * 33 + (lane & 31)] = __builtin_nontemporal_load(W + (size_t)(k0 + kk) * ldw + sc); }
    LDS_WAIT(); asm volatile("" ::: "memory");
    const int c = lane & 7;
#pragma unroll
    for (int j = 0; j < 4; ++j) { const int n = (lane >> 3) + 8 * j; const LAS float* s = scr + (8 * c) * 33 + n;
        u32x4 o; o.x = pk2(s[0 * 33], s[1 * 33]); o.y = pk2(s[2 * 33], s[3 * 33]); o.z = pk2(s[4 * 33], s[5 * 33]); o.w = pk2(s[6 * 33], s[7 * 33]);
        *(u32x4*)(WT + (size_t)(n0 + n) * ldd + kofs + k0 + 8 * c) = o; }
    LDS_WAIT(); asm volatile("" ::: "memory");
}
struct ColId { __device__ int operator()(int n) const { return n; } };
struct ColIn { __device__ int operator()(int n) const {
    if (n >= 4608) { const int t = (n - 4608) >> 8, j = (n - 4608) & 255; return j < 128 ? 4608 + 128 * t + j : 5632 + 128 * t + (j - 128); }
    return (n < 1280 || (n >= 1536 && n < 2560)) ? swap25(n) : n; } };
struct ColUp { __device__ int operator()(int n) const { const int t = n >> 8, j = n & 255; return j < 128 ? 128 * t + j : DFF + 128 * t + (j - 128); } };

template <class F> __device__ __forceinline__ void gemv5_item(const Frame& F_, const float* W, int ldw, int n0, int k0, F srccol, const LAS float* a, LAS float* red, const float* bias, float* out, int ldo) {
    const int col0 = srccol(n0 + F_.lane), col1 = srccol(n0 + 64 + F_.lane); float acc[5][2];
#pragma unroll
    for (int v = 0; v < 5; ++v) { acc[v][0] = 0.f; acc[v][1] = 0.f; }
    const int kb = F_.wave * 32;
    const float* wp = W + (size_t)(k0 + kb) * ldw;
    float w0[32], w1[32];
#pragma unroll
    for (int j = 0; j < 32; ++j) { w0[j] = __builtin_nontemporal_load(wp + col0); w1[j] = __builtin_nontemporal_load(wp + col1); wp += ldw; }
#pragma unroll
    for (int j = 0; j < 32; ++j)
#pragma unroll
        for (int v = 0; v < 5; ++v) { const float av = a[v * 256 + kb + j]; acc[v][0] += av * w0[j]; acc[v][1] += av * w1[j]; }
#pragma unroll
    for (int v = 0; v < 5; ++v) { red[(F_.wave * 5 + v) * 128 + F_.lane] = acc[v][0]; red[(F_.wave * 5 + v) * 128 + 64 + F_.lane] = acc[v][1]; }
    __syncthreads();
    for (int t = F_.tid; t < 640; t += NTHR) { const int v = t >> 7, l = t & 127; float sum = (bias && k0 == 0) ? bias[n0 + l] : 0.f;
#pragma unroll
        for (int w8 = 0; w8 < 8; ++w8) sum += red[(w8 * 5 + v) * 128 + l];
        out[((size_t)(k0 >> 8) * 5 + v) * ldo + n0 + l] = sum; }
    __syncthreads();
}

__device__ __forceinline__ void phase0(const Frame& F, CArgs& A) {
    unsigned char* ws = A.ws;
    for (int it = F.bid; it < 48 * 4; it += F.G) {
        const int cgp = it % 48, kq = it / 48;
        LAS float* a = (LAS float*)F.lds; LAS float* red = a + 5 * 256;
        for (int i = F.tid; i < 5 * 256; i += NTHR) { const int v = i >> 8, k = kq * 256 + (i & 255); const float cv = v == 0 ? A.c_ctx[k] : A.c[(v - 1) * 1024 + k]; a[i] = siluf_(cv); }
        __syncthreads();
        gemv5_item(F, A.w_mod, 6144, cgp * 128, kq * 256, ColId(), a, red, A.b_mod, (float*)(ws + WS_MOD), 6144);
    }
    LAS float* scr = (LAS float*)(F.lds + 32768 + F.wave * 8704);
    const int gw = ((F.bid + 128) % F.G) * NWAVES + F.wave, NGW = F.G * NWAVES;
    constexpr int I_IN = 16 * (DIN / 32);
    for (int it = gw; it < I_IN; it += NGW) transpose_item(A.w_in, DIN, (bf16_t*)(ws + WS_WA), 1024, 0, 64 * (it / (DIN / 32)), 32 * (it % (DIN / 32)), ColIn(), scr, F.lane);
    const int gt = F.bid * NTHR + F.tid, NGT = F.G * NTHR;
    for (int i = gt; i < DB * NKV * PAST * 16; i += NGT) { const int c8 = i & 15, row = i >> 4, t = row % PAST, bk = row / PAST;
        const size_t so = (size_t)row * 128, dofs = ((size_t)bk * SKV + DSEQ + t) * 128 + c8 * 8;
        f32x4 k0, k1; { const int p0 = c8 * 8, d0 = swap25(p0), d1 = swap25(p0 + 4); k0 = *(const f32x4*)(A.cache_k + so + d0); k1 = *(const f32x4*)(A.cache_k + so + d1); }
        *(u32x4*)((bf16_t*)(ws + WS_KALL) + dofs) = pack8(k0, k1);
        const f32x4 v0 = *(const f32x4*)(A.cache_v + so + c8 * 8), v1 = *(const f32x4*)(A.cache_v + so + c8 * 8 + 4);
        *(u32x4*)((bf16_t*)(ws + WS_VALL) + dofs) = pack8(v0, v1); }
    for (int i = gt; i < MT; i += NGT) ((float*)(ws + WS_SSQ1))[i] = 0.f;
    for (int i = gt; i < 321 * 64; i += NGT) ((unsigned*)(ws + WS_CNT))[i] = 0u;
    for (int i = gt; i < (481 + 81) * 16; i += NGT) ((unsigned*)(ws + WS_CNT1))[i] = 0u;
#if defined(PROBE_K0) && PROBE_K0 == 400
    if (gt == 0) *(float*)(ws + 32768) = 0.f;
#endif
}

__device__ __forceinline__ void phase1(const Frame& F, CArgs& A) {
    unsigned char* ws = A.ws; const float* mod = (const float*)(ws + WS_MOD);
    for (int it = F.bid; it < (NUP / 128) * 4; it += F.G) {
        const int cgp = it % (NUP / 128), kq = it / (NUP / 128);
        LAS float* a = (LAS float*)F.lds; LAS float* red = a + 5 * 256;
        for (int i = F.tid; i < 5 * 256; i += NTHR) { const float* p = mod + (size_t)(i >> 8) * 6144 + 3072 + kq * 256 + (i & 255); a[i] = (p[0] + p[MODQ]) + (p[2 * MODQ] + p[3 * MODQ]); }
        __syncthreads();
        gemv5_item(F, A.w_up, NUP, cgp * 128, kq * 256, ColUp(), a, red, nullptr, (float*)(ws + WS_BUP), NUP);
    }
    for (int i = F.bid * NTHR + F.tid; i < 5 * 6144; i += F.G * NTHR) ((float*)(ws + WS_MODF))[i] = (mod[i] + mod[i + MODQ]) + (mod[i + 2 * MODQ] + mod[i + 3 * MODQ]);
    bf16_t* H = (bf16_t*)(ws + WS_H);
    constexpr int RPW = MT / (256 * NWAVES);
    const int row0 = (F.bid * NWAVES + F.wave) * RPW;
    int vcur = -1; f32x4 w1[4], s1[4];
#pragma unroll 1
    for (int rb = row0; rb < row0 + RPW; rb += 5) {
        f32x4 x[5][4];
#pragma unroll
        for (int i = 0; i < 5; ++i) { const int r = rb + i; const float* xr = r < MP ? A.x_prompt + (size_t)r * 1024 : A.x_sample + (size_t)(r - MP) * 1024;
#pragma unroll
            for (int j = 0; j < 4; ++j) x[i][j] = __builtin_nontemporal_load((const f32x4*)(xr + 8 * F.lane + 4 * (j & 1) + 512 * (j >> 1))); }
#pragma unroll
        for (int i = 0; i < 5; ++i) { const int r = rb + i;
            const int v = r < MP ? 0 : 1 + (r - MP) / DSEQ;
            if (v != vcur) { vcur = v; const float* mv = mod + (size_t)v * 6144;
#pragma unroll
                for (int j = 0; j < 4; ++j) { const int k = 8 * F.lane + 4 * (j & 1) + 512 * (j >> 1); w1[j] = *(const f32x4*)(A.norm1_g + k) * (sum4q(mv + 1024 + k, MODQ) + 1.0f); s1[j] = sum4q(mv + k, MODQ); } }
            float s = 0.f;
#pragma unroll
            for (int j = 0; j < 4; ++j) s += (x[i][j][0] * x[i][j][0] + x[i][j][1] * x[i][j][1]) + (x[i][j][2] * x[i][j][2] + x[i][j][3] * x[i][j][3]);
            const float rstd = __builtin_amdgcn_rsqf(wave_sum(s) * (1.0f / 1024.0f) + EPS);
#pragma unroll
            for (int jj = 0; jj < 2; ++jj) { const f32x4 h0 = x[i][2 * jj] * rstd * w1[2 * jj] + s1[2 * jj], h1 = x[i][2 * jj + 1] * rstd * w1[2 * jj + 1] + s1[2 * jj + 1];
                *(u32x4*)(H + (size_t)r * 1024 + 8 * F.lane + 512 * jj) = pack8(h0, h1); } }
    }
}

__device__ __forceinline__ float log_sigmoid_(float x) { return -log1pf(__expf(-x)); }
__device__ __forceinline__ s16x4 tr_read16(const LAS bf16_t* p) { typedef short v4s __attribute__((ext_vector_type(4))); return __builtin_bit_cast(s16x4, __builtin_amdgcn_ds_read_tr16_b64_v4i16((LAS v4s*)p)); }
#define MK8(L, H) (bf16x8){L[0], L[1], L[2], L[3], H[0], H[1], H[2], H[3]}
constexpr int KLD = 72, VLD = 136;
__device__ __forceinline__ int vsw(int r, int c8) { return 256 * r + 16 * (c8 ^ (((r & 3) << 1) | (((r >> 3) & 1) << 3))); }
__device__ __forceinline__ int vsw_tr(int R, int col) { return vsw(R, col >> 3) + 2 * (col & 7); }

__device__ const unsigned char R1_PORD[80] = {0, 1, 2, 3, 4, 5, 6, 7, 12, 13, 14, 15, 16, 17, 18, 19, 28, 29, 30, 31, 32, 33, 34, 35, 40, 41, 42, 43, 44, 45, 46, 47, 52, 53, 54, 55, 56, 57, 58, 59, 68, 69, 70, 71, 72, 73, 74, 75,
    8, 9, 10, 11, 20, 21, 22, 23, 24, 25, 26, 27, 36, 37, 38, 39, 48, 49, 50, 51, 60, 61, 62, 63, 64, 65, 66, 67, 76, 77, 78, 79};
__device__ __forceinline__ int r1_item_of(int i) { return (int)R1_PORD[i >> 4] * 16 + (i & 15); }
__device__ __forceinline__ void spin_ge(unsigned* p, unsigned need) { unsigned sp = 0;
    while ((unsigned)__builtin_amdgcn_readfirstlane(__hip_atomic_load(p, RLX_AGENT)) < need) { __builtin_amdgcn_s_sleep(2); if (++sp > (1u << 22)) break; } }
__device__ __forceinline__ void r1_wait(const Frame& F, unsigned* c1, int item, volatile LAS unsigned* alld) {
    if (F.wave == 0 && *alld == 0u) { const int pm = item >> 4, h = item & 7;
        const bool all = (unsigned)__builtin_amdgcn_readfirstlane(__hip_atomic_load(c1 + 16 * 480, RLX_AGENT)) >= 480u
                      && (unsigned)__builtin_amdgcn_readfirstlane(__hip_atomic_load(c1 + 16 * (481 + 80), RLX_AGENT)) >= 2080u;
        spin_ge(c1 + 16 * (pm * 6 + (h >> 2)), 1u); spin_ge(c1 + 16 * (pm * 6 + 2 + (h >> 1)), 1u);
        spin_ge(c1 + 16 * (481 + pm), 26u);
        __builtin_amdgcn_fence(__ATOMIC_ACQUIRE, "agent"); asm volatile("s_waitcnt vmcnt(0)" ::: "memory");
        if (all) *alld = 1u; }
    __syncthreads();
}
__device__ __forceinline__ void phase_r1(const Frame& F, CArgs& A) {
    unsigned char* ws = A.ws; unsigned* c1 = (unsigned*)(ws + WS_CNT1);
    volatile LAS unsigned* alld = (volatile LAS unsigned*)(F.lds + MISC_OFF) + 17;
    if (F.tid == 0) *alld = 0u;
    __syncthreads();
    const bf16_t* RKb = (const bf16_t*)(ws + WS_RK); const bf16_t* RVb = (const bf16_t*)(ws + WS_RV); bf16_t* KVS = (bf16_t*)(ws + WS_H);
    LAS bf16_t* kf = (LAS bf16_t*)F.lds; LAS bf16_t* kb = kf + 128 * KLD; LAS bf16_t* vl = kb + 128 * KLD; LAS bf16_t* ol = vl + 128 * 128 + F.wave * (16 * VLD);
    u32x4 pk_[2], pv_[4];
#define R1_LOAD(it) do { const int cg_ = (it) >> 3, h_ = (it) & 7; const size_t r0_ = (size_t)cg_ * 128; \
        _Pragma("unroll") for (int i = 0; i < 2; ++i) { const int ci = F.tid + i * NTHR; pk_[i] = *(const u32x4*)(RKb + (r0_ + (ci >> 3)) * 512 + 64 * h_ + 8 * (ci & 7)); } \
        _Pragma("unroll") for (int i = 0; i < 4; ++i) { const int ci = F.tid + i * NTHR; pv_[i] = *(const u32x4*)(RVb + (r0_ + (ci >> 4)) * 1024 + 128 * h_ + 8 * (ci & 15)); } } while (0)
    const int n1 = F.bid >= 32 ? (768 - (F.bid - 32) + 223) / 224 : 0, cntp = n1 + 2;
#define R1_POS(n) ((n) < n1 ? (F.bid - 32) + 224 * (n) : 768 + F.bid + 256 * ((n) - n1))
    { r1_wait(F, c1, r1_item_of(R1_POS(0)), alld); R1_LOAD(r1_item_of(R1_POS(0))); }
    for (int n = 0; n < cntp; ++n) { const int item = r1_item_of(R1_POS(n));
        const int h = item & 7;
        const float lgf = log_sigmoid_(A.dec_f[h]) * 1.4426950408889634f, lgb = log_sigmoid_(A.dec_b[h]) * 1.4426950408889634f;
#pragma unroll
        for (int i = 0; i < 2; ++i) { const int ci = F.tid + i * NTHR, j = ci >> 3, c8 = ci & 7;
            f32x4 a, b; unpack8(pk_[i], a, b);
            const float df = __builtin_amdgcn_exp2f(lgf * (float)(127 - j)), db = __builtin_amdgcn_exp2f(lgb * (float)j);
            *(LAS u32x4*)(kf + j * KLD + 8 * c8) = pack8(a * df, b * df); *(LAS u32x4*)(kb + j * KLD + 8 * c8) = pack8(a * db, b * db); }
#pragma unroll
        for (int i = 0; i < 4; ++i) { const int ci = F.tid + i * NTHR, j = ci >> 4, c8 = ci & 15; *(LAS u32x4*)((LAS char*)vl + vsw(j, c8)) = pv_[i]; }
        __syncthreads();
        if (n + 1 < cntp) { r1_wait(F, c1, r1_item_of(R1_POS(n + 1)), alld); R1_LOAD(r1_item_of(R1_POS(n + 1))); }
        const int dir = F.wave >> 2, mt = F.wave & 3, g = F.lane >> 4, q = (F.lane & 15) >> 2, p = F.lane & 3, l15 = F.lane & 15;
        const LAS bf16_t* ks = dir ? kb : kf;
        bf16x8 af[4];
#pragma unroll
        for (int s = 0; s < 4; ++s) { const LAS bf16_t* ap = ks + (32 * s + 8 * g + q) * KLD + 16 * mt + 4 * p; const s16x4 lo = tr_read16(ap), hi = tr_read16(ap + 4 * KLD); af[s] = MK8(lo, hi); }
#pragma unroll
        for (int nt = 0; nt < 8; ++nt) { f32x4 acc = {0.f, 0.f, 0.f, 0.f};
#pragma unroll
            for (int s = 0; s < 4; ++s) { const int R0 = 32 * s + 8 * g + q, col = 16 * nt + 4 * p;
                const s16x4 lo = tr_read16((const LAS bf16_t*)((const LAS char*)vl + vsw_tr(R0, col))), hi = tr_read16((const LAS bf16_t*)((const LAS char*)vl + vsw_tr(R0 + 4, col)));
                acc = __builtin_amdgcn_mfma_f32_16x16x32_bf16(af[s], MK8(lo, hi), acc, 0, 0, 0); }
#pragma unroll
            for (int e = 0; e < 4; ++e) ol[(4 * g + e) * VLD + 16 * nt + l15] = (bf16_t)f2bf(acc[e]); }
        LDS_WAIT(); asm volatile("" ::: "memory");
        bf16_t* dst = KVS + ((size_t)item * 2 + dir) * (64 * 128) + (size_t)(16 * mt + (F.lane >> 2)) * 128 + (F.lane & 3) * 32;
#pragma unroll
        for (int c = 0; c < 4; ++c) *(u32x4*)(dst + 8 * c) = *(const LAS u32x4*)(ol + (F.lane >> 2) * VLD + (F.lane & 3) * 32 + 8 * c);
        __syncthreads();
    }
#undef R1_LOAD
#undef R1_POS
}

__device__ __forceinline__ void phase_scan(const Frame& F, CArgs& A) {
    bf16_t* KVS = (bf16_t*)(A.ws + WS_H);
    const int gt = F.bid * NTHR + F.tid, NGT = F.G * NTHR;
    for (int i = gt; i < 5 * NUP; i += NGT) { const float* p = (const float*)(A.ws + WS_BUP) + i; ((float*)(A.ws + WS_BUPF))[i] = (p[0] + p[BUPQ]) + (p[2 * BUPQ] + p[3 * BUPQ]); }
    constexpr size_t CST = (size_t)8 * 2 * 8192;
    if (NGT * 4 == 256 * 2048) {
        u32x2 kv[4][2]; bf16_t* basep[4]; float decp[4];
#pragma unroll
        for (int k = 0; k < 4; ++k) { const int w = gt + k * NGT, e4 = (w & 2047) * 4, chain = w >> 11, dir = chain & 1, h = (chain >> 1) & 7, sq = chain >> 4;
            decp[k] = __expf(log_sigmoid_((dir ? A.dec_b : A.dec_f)[h]) * 128.0f);
            basep[k] = KVS + ((size_t)(2 * sq * 8 + h) * 2 + dir) * 8192 + e4;
            kv[k][0] = *(const u32x2*)(basep[k] + (size_t)(dir ? 1 : 0) * CST); kv[k][1] = *(const u32x2*)(basep[k] + (size_t)(dir ? 0 : 1) * CST); }
#pragma unroll
        for (int k = 0; k < 4; ++k) { const int w = gt + k * NGT, e4 = (w & 2047) * 4, chain = w >> 11, dir = chain & 1, h = (chain >> 1) & 7, sq = chain >> 4;
            const int pr = e4 >> 7, dv = e4 & 127, lr = swap25(pr);
            f32x4 st = {0.f, 0.f, 0.f, 0.f};
#pragma unroll
            for (int i = 0; i < 2; ++i) { u32x2 o; o.x = pk2(st[0], st[1]); o.y = pk2(st[2], st[3]); *(u32x2*)(basep[k] + (size_t)(dir ? 1 - i : i) * CST) = o;
                st = st * decp[k] + (f32x4){bflo(kv[k][i].x), bfhi(kv[k][i].x), bflo(kv[k][i].y), bfhi(kv[k][i].y)}; }
            *(f32x4*)(A.out + (dir ? OUT_SB : OUT_SF) + (((size_t)sq * 8 + h) * 64 + lr) * 128 + dv) = st; }
    }
    for (int w = (NGT * 4 == 256 * 2048) ? gt + 4 * NGT : gt; w < 320 * 2048; w += NGT) {
        const int e4 = (w & 2047) * 4, chain = w >> 11, dir = chain & 1, h = (chain >> 1) & 7, s = chain >> 4;
        const int nch = s < 16 ? 2 : 32, c0 = s < 16 ? 2 * s : 32 + 32 * (s - 16);
        const float lg = log_sigmoid_((dir ? A.dec_b : A.dec_f)[h]), dec = __expf(lg * 128.0f);
        const int pr = e4 >> 7, dv = e4 & 127, lr = swap25(pr);
        f32x4 st = {0.f, 0.f, 0.f, 0.f};
        if (s >= 16) st = *(const f32x4*)((dir ? A.st_b : A.st_f) + (((size_t)(s - 16) * 8 + h) * 64 + lr) * 128 + dv);
        bf16_t* base = KVS + ((size_t)(c0 * 8 + h) * 2 + dir) * 8192 + e4;
        if (s < 16) {
            u32x2 kv[2];
#pragma unroll
            for (int i = 0; i < 2; ++i) kv[i] = *(const u32x2*)(base + (size_t)(dir ? 1 - i : i) * CST);
#pragma unroll
            for (int i = 0; i < 2; ++i) { u32x2 o; o.x = pk2(st[0], st[1]); o.y = pk2(st[2], st[3]); *(u32x2*)(base + (size_t)(dir ? 1 - i : i) * CST) = o;
                st = st * dec + (f32x4){bflo(kv[i].x), bfhi(kv[i].x), bflo(kv[i].y), bfhi(kv[i].y)}; }
        } else {
            u32x2 kv[32];
#pragma unroll
            for (int i = 0; i < 32; ++i) kv[i] = *(const u32x2*)(base + (size_t)(dir ? 31 - i : i) * CST);
#pragma unroll
            for (int i = 0; i < 32; ++i) { u32x2 o; o.x = pk2(st[0], st[1]); o.y = pk2(st[2], st[3]); *(u32x2*)(base + (size_t)(dir ? 31 - i : i) * CST) = o;
                st = st * dec + (f32x4){bflo(kv[i].x), bfhi(kv[i].x), bflo(kv[i].y), bfhi(kv[i].y)}; }
        }
        if (s < 16) *(f32x4*)(A.out + (dir ? OUT_SB : OUT_SF) + (((size_t)s * 8 + h) * 64 + lr) * 128 + dv) = st;
    }
}

namespace att {
constexpr int D = 128, NW = 8, QBLK = 32, KVBLK = 64;
constexpr float SCALE = 0.088388347648318440f, THR = 8.f;
constexpr size_t SHM_V = KVBLK * D * 2, SHM_K = KVBLK * D * 2, SHM_ATTN = 2 * SHM_V + 2 * SHM_K + NW * 64 * 4;
#define KSWZ(row, colB) ((row) * 256 + ((colB) ^ (((row) & 7) << 4)))
#define SBAR() __builtin_amdgcn_sched_barrier(0)
__device__ __forceinline__ int crow(int r, int hi) { return (r & 3) + 8 * (r >> 2) + 4 * hi; }
__device__ __forceinline__ unsigned cvtpk(float lo, float hi) { unsigned r; asm volatile("v_cvt_pk_bf16_f32 %0, %1, %2" : "=v"(r) : "v"(lo), "v"(hi)); return r; }
__device__ __forceinline__ void partialSM(f32x16& p0, f32x16& p1, float& m_reg, float& mn, float& alpha) {
  constexpr float C = SCALE * 1.4426950408889634f;
  float pmax = p0[0]; for (int r = 1; r < 16; ++r) pmax = fmaxf(pmax, p0[r]); for (int r = 0; r < 16; ++r) pmax = fmaxf(pmax, p1[r]);
  { auto rr = __builtin_amdgcn_permlane32_swap(__float_as_uint(pmax), __float_as_uint(pmax), false, false);
    pmax = fmaxf(__uint_as_float(rr[0]), __uint_as_float(rr[1])); }
  if (__builtin_expect(__all(pmax - m_reg <= THR / SCALE), 1)) { mn = m_reg; alpha = 1.f; }
  else { mn = fmaxf(m_reg, pmax); alpha = __builtin_amdgcn_exp2f((m_reg - mn) * C); m_reg = mn; }
  float mnC = -mn * C;
  for (int r = 0; r < 16; ++r) p0[r] = fmaf(p0[r], C, mnC); for (int r = 0; r < 16; ++r) p1[r] = fmaf(p1[r], C, mnC);
  for (int r = 0; r < 16; ++r) p0[r] = __builtin_amdgcn_exp2f(p0[r]);
}
__device__ __forceinline__ void finishSM(f32x16& p0, f32x16& p1, float alpha, float& l_reg, bf16x8& pa0, bf16x8& pa1, bf16x8& pa2, bf16x8& pa3) {
  for (int r = 0; r < 16; ++r) p1[r] = __builtin_amdgcn_exp2f(p1[r]);
  float ps = 0; for (int r = 0; r < 16; ++r) ps += p0[r]; for (int r = 0; r < 16; ++r) ps += p1[r];
  { auto rr = __builtin_amdgcn_permlane32_swap(__float_as_uint(ps), __float_as_uint(ps), false, false);
    ps = __uint_as_float(rr[0]) + __uint_as_float(rr[1]); }
  l_reg = l_reg * alpha + ps;
#define PK4(P, BASE, OUT) do { unsigned a0 = cvtpk(P[BASE + 0], P[BASE + 1]), a1 = cvtpk(P[BASE + 2], P[BASE + 3]);   \
    unsigned b0 = cvtpk(P[BASE + 4], P[BASE + 5]), b1 = cvtpk(P[BASE + 6], P[BASE + 7]);                              \
    auto r0 = __builtin_amdgcn_permlane32_swap(a0, b0, false, false); auto r1 = __builtin_amdgcn_permlane32_swap(a1, b1, false, false); \
    u32x4 w = {r0[0], r1[0], r0[1], r1[1]}; OUT = *reinterpret_cast<bf16x8*>(&w); } while (0)
  PK4(p0, 0, pa0); PK4(p0, 8, pa1); PK4(p1, 0, pa2); PK4(p1, 8, pa3);
#undef PK4
}
__device__ __forceinline__ void qkt(f32x16& p0, f32x16& p1, const bf16_t* Ks, const bf16x8* qr, int r32, int hi) {
  p0 = f32x16{}; p1 = f32x16{};
  for (int d0 = 0; d0 < 8; ++d0) { int cb = (d0 * 16 + hi * 8) * 2;
    bf16x8 b0 = *reinterpret_cast<const bf16x8*>((const char*)Ks + KSWZ(r32, cb));
    bf16x8 b1 = *reinterpret_cast<const bf16x8*>((const char*)Ks + KSWZ(32 + r32, cb));
    p0 = __builtin_amdgcn_mfma_f32_32x32x16_bf16(b0, qr[d0], p0, 0, 0, 0);
    p1 = __builtin_amdgcn_mfma_f32_32x32x16_bf16(b1, qr[d0], p1, 0, 0, 0); }
}
__device__ __forceinline__ int v_st(int k, int c) { const int kk = (k & ~0xC) | ((k & 4) << 1) | ((k & 8) >> 1); return ((kk >> 3) * 4 + (c >> 5)) * 512 + ((kk & 7) * 32 + (c & 31)) * 2; }
__device__ __forceinline__ int v_rd_base(int lane) { return ((lane & 3) << 3) | (((lane >> 2) & 3) << 6) | (((lane >> 4) & 1) << 5) | (((lane >> 5) & 1) << 8); }
constexpr int v_rd_off(int d0, int ks, int half) { return d0 * 512 + ks * 4096 + half * 2048; }
template <int OFF> __device__ __forceinline__ s16x4 tr_read(int vb) { s16x4 r; asm volatile("ds_read_b64_tr_b16 %0, %1 offset:%2" : "=&v"(r) : "v"(vb), "i"(OFF) : "memory"); return r; }
template <int D0> __device__ __forceinline__ void pv_one(f32x16& od, int vb, bf16x8 pa0, bf16x8 pa1, bf16x8 pa2, bf16x8 pa3) {
  const s16x4 l0 = tr_read<v_rd_off(D0, 0, 0)>(vb), h0 = tr_read<v_rd_off(D0, 0, 1)>(vb), l1 = tr_read<v_rd_off(D0, 1, 0)>(vb), h1 = tr_read<v_rd_off(D0, 1, 1)>(vb);
  const s16x4 l2 = tr_read<v_rd_off(D0, 2, 0)>(vb), h2 = tr_read<v_rd_off(D0, 2, 1)>(vb), l3 = tr_read<v_rd_off(D0, 3, 0)>(vb), h3 = tr_read<v_rd_off(D0, 3, 1)>(vb);
  asm volatile("s_waitcnt lgkmcnt(0)" ::: "memory"); SBAR();
  od = __builtin_amdgcn_mfma_f32_32x32x16_bf16(pa0, MK8(l0, h0), od, 0, 0, 0);
  od = __builtin_amdgcn_mfma_f32_32x32x16_bf16(pa1, MK8(l1, h1), od, 0, 0, 0);
  od = __builtin_amdgcn_mfma_f32_32x32x16_bf16(pa2, MK8(l2, h2), od, 0, 0, 0);
  od = __builtin_amdgcn_mfma_f32_32x32x16_bf16(pa3, MK8(l3, h3), od, 0, 0, 0);
}
__device__ __forceinline__ void pv_d0(f32x16* o, int vb, bf16x8 pa0, bf16x8 pa1, bf16x8 pa2, bf16x8 pa3) {
  pv_one<0>(o[0], vb, pa0, pa1, pa2, pa3); pv_one<1>(o[1], vb, pa0, pa1, pa2, pa3); pv_one<2>(o[2], vb, pa0, pa1, pa2, pa3); pv_one<3>(o[3], vb, pa0, pa1, pa2, pa3);
}
template <int LDQ>
__device__ __forceinline__ void attn_dense_body(const bf16_t* Qb, const bf16_t* __restrict__ Kh, const bf16_t* __restrict__ Vh, bf16_t* Ob, int seq, char* lds, const int wid) {
  constexpr int LDK = 128;
  const int lane = lane_id_(), tid = wid * 64 + lane, r32 = lane & 31, hi = lane >> 5;
  bf16_t* V_lds = (bf16_t*)lds; bf16_t* K_lds = (bf16_t*)(lds + 2 * SHM_V);
  float* ws = (float*)(lds + 2 * SHM_V + 2 * SHM_K) + wid * 64; float* li_l = ws; float* al_l = ws + 32;
  float m_reg = -1e30f, l_reg = 0; f32x16 o[4] = {}; bf16x8 qr[8];
  const bf16_t* Qw = Qb + (long)(wid * QBLK + r32) * LDQ + hi * 8;
#pragma unroll
  for (int d0 = 0; d0 < 8; ++d0) qr[d0] = *reinterpret_cast<const bf16x8*>(Qw + d0 * 16);
  const int sr = tid >> 4, sc = (tid & 15) * 8, vst0 = v_st(sr, sc), vst1 = v_st(32 + sr, sc);
  const int vb0 = (int)(uintptr_t)V_lds + v_rd_base(lane);
  struct { bf16x8 vs0, vs1, ks0, ks1; } sr_[2];
#define SLOAD(i, k0) do { sr_[i].vs0 = *(const bf16x8*)(&Vh[(long)((k0) + sr) * LDK + sc]); sr_[i].vs1 = *(const bf16x8*)(&Vh[(long)((k0) + 32 + sr) * LDK + sc]); \
    sr_[i].ks0 = *(const bf16x8*)(&Kh[(long)((k0) + sr) * LDK + sc]); sr_[i].ks1 = *(const bf16x8*)(&Kh[(long)((k0) + 32 + sr) * LDK + sc]); } while (0)
#define SWRITE(b, i) do { *(bf16x8*)((char*)V_lds + (b) * SHM_V + vst0) = sr_[i].vs0;          \
    *(bf16x8*)((char*)V_lds + (b) * SHM_V + vst1) = sr_[i].vs1; int kc = sc * 2;               \
    *(bf16x8*)((char*)K_lds + (b) * SHM_K + KSWZ(sr, kc)) = sr_[i].ks0;                       \
    *(bf16x8*)((char*)K_lds + (b) * SHM_K + KSWZ(32 + sr, kc)) = sr_[i].ks1; } while (0)
#define SWAIT() asm volatile("s_waitcnt vmcnt(4)" ::: "memory")
#define RESC(a) do { if (__any((a) < 1.f)) { if (hi == 0) al_l[r32] = (a); asm volatile("s_waitcnt lgkmcnt(0)" ::: "memory"); \
    for (int d = 0; d < 4; ++d) for (int r = 0; r < 16; ++r) o[d][r] *= al_l[crow(r, hi)]; } } while (0)
  f32x16 pA0, pA1, pB0, pB1; float mnA, mnB, alA, alB; bf16x8 pa0, pa1, pa2, pa3; const int NT = seq / KVBLK;
  constexpr int SE = 0, SO = 1;
  SLOAD(SE, 0); asm volatile("s_waitcnt vmcnt(0)" ::: "memory"); SWRITE(0, SE); __syncthreads();
  qkt(pA0, pA1, K_lds, qr, r32, hi); partialSM(pA0, pA1, m_reg, mnA, alA);
  SLOAD(SO, KVBLK); if (2 < NT) SLOAD(SE, 2 * KVBLK);
  SWAIT(); SWRITE(1, SO); __syncthreads();
  for (int j = 1; j + 1 < NT; j += 2) {
    SBAR(); qkt(pB0, pB1, (bf16_t*)((char*)K_lds + SHM_K), qr, r32, hi);
    finishSM(pA0, pA1, alA, l_reg, pa0, pa1, pa2, pa3); SBAR();
    SLOAD(SO, (j + 2) * KVBLK); SBAR();
    pv_d0(o, vb0, pa0, pa1, pa2, pa3); partialSM(pB0, pB1, m_reg, mnB, alB);
    __syncthreads(); SWAIT(); SWRITE(0, SE);
    RESC(alB); __syncthreads();
    SBAR(); qkt(pA0, pA1, K_lds, qr, r32, hi);
    finishSM(pB0, pB1, alB, l_reg, pa0, pa1, pa2, pa3); SBAR();
    if (j + 3 < NT) SLOAD(SE, (j + 3) * KVBLK); SBAR();
    pv_d0(o, vb0 + (int)SHM_V, pa0, pa1, pa2, pa3); partialSM(pA0, pA1, m_reg, mnA, alA);
    __syncthreads(); SWAIT(); SWRITE(1, SO);
    RESC(alA); __syncthreads();
  }
  SBAR(); qkt(pB0, pB1, (bf16_t*)((char*)K_lds + SHM_K), qr, r32, hi);
  finishSM(pA0, pA1, alA, l_reg, pa0, pa1, pa2, pa3); SBAR();
  pv_d0(o, vb0, pa0, pa1, pa2, pa3); partialSM(pB0, pB1, m_reg, mnB, alB);
  __syncthreads(); RESC(alB);
  finishSM(pB0, pB1, alB, l_reg, pa0, pa1, pa2, pa3); SBAR();
  pv_d0(o, vb0 + (int)SHM_V, pa0, pa1, pa2, pa3);
  if (hi == 0) li_l[r32] = l_reg; asm volatile("s_waitcnt lgkmcnt(0)" ::: "memory");
  float rli[16];
#pragma unroll
  for (int r = 0; r < 16; ++r) rli[r] = __builtin_amdgcn_rcpf(li_l[crow(r, hi)]);
  bf16_t* Ow = Ob + (long)(wid * QBLK) * LDQ;
#pragma unroll
  for (int r = 0; r < 16; ++r) { int orow = crow(r, hi);
    for (int d0 = 0; d0 < 4; ++d0) Ow[(long)orow * LDQ + d0 * 32 + r32] = (bf16_t)f2bf(o[d0][r] * rli[r]); }
  __syncthreads();
#undef SLOAD
#undef SWRITE
#undef SWAIT
#undef RESC
}
#undef KSWZ
#undef SBAR
}

struct R3Regs { u32x4 k[2], v[4], s[4], srg[4]; bf16x8 q[2]; };
__device__ __forceinline__ void r3_load(const Frame& F, CArgs& A, int item, R3Regs& R) {
    unsigned char* ws = A.ws;
    const bf16_t* RQb = (const bf16_t*)(ws + WS_RQ); const bf16_t* RKb = (const bf16_t*)(ws + WS_RK); const bf16_t* RVb = (const bf16_t*)(ws + WS_RV);
    const bf16_t* SRGb = (const bf16_t*)(ws + WS_SRG); const bf16_t* KVS = (const bf16_t*)(ws + WS_H);
    const int cg = item >> 3, h = item & 7; const size_t row0 = (size_t)cg * 128;
#pragma unroll
    for (int i = 0; i < 2; ++i) { const int ci = F.tid + i * NTHR; R.k[i] = *(const u32x4*)(RKb + (row0 + (ci >> 3)) * 512 + 64 * h + 8 * (ci & 7)); }
#pragma unroll
    for (int i = 0; i < 4; ++i) { const int ci = F.tid + i * NTHR, j = ci >> 4, c8 = ci & 15;
        R.v[i] = *(const u32x4*)(RVb + (row0 + j) * 1024 + 128 * h + 8 * c8);
        R.s[i] = *(const u32x4*)(KVS + (size_t)item * 2 * 8192 + (size_t)j * 128 + 8 * c8); }
    const size_t gofs = (row0 + 16 * F.wave + (F.lane >> 2)) * 1024 + 128 * h + (F.lane & 3) * 32;
#pragma unroll
    for (int c = 0; c < 4; ++c) R.srg[c] = *(const u32x4*)(SRGb + gofs + 8 * c);
#pragma unroll
    for (int s = 0; s < 2; ++s) R.q[s] = *(const bf16x8*)(RQb + (row0 + 16 * F.wave + (F.lane & 15)) * 512 + 64 * h + 32 * s + 8 * (F.lane >> 4));
}
__device__ __forceinline__ void r3_item(const Frame& F, CArgs& A, int item, int item_next, R3Regs& R) {
    unsigned char* ws = A.ws; bf16_t* RVb = (bf16_t*)(ws + WS_RV);
    LAS bf16_t* kl = (LAS bf16_t*)F.lds; LAS bf16_t* vl = kl + 128 * KLD; LAS bf16_t* sl = vl + 128 * 128; LAS bf16_t* pl = sl + 128 * 128 + F.wave * (16 * VLD);
    const int cg = item >> 3, h = item & 7; const size_t row0 = (size_t)cg * 128;
    const float lgf = log_sigmoid_(A.dec_f[h]) * 1.4426950408889634f, lgb = log_sigmoid_(A.dec_b[h]) * 1.4426950408889634f;
#pragma unroll
    for (int i = 0; i < 2; ++i) { const int ci = F.tid + i * NTHR; *(LAS u32x4*)(kl + (ci >> 3) * KLD + 8 * (ci & 7)) = R.k[i]; }
#pragma unroll
    for (int i = 0; i < 4; ++i) { const int ci = F.tid + i * NTHR, j = ci >> 4, c8 = ci & 15; *(LAS u32x4*)((LAS char*)vl + vsw(j, c8)) = R.v[i]; *(LAS u32x4*)((LAS char*)sl + vsw(j, c8)) = R.s[i]; }
    int lane_ = F.lane; asm volatile("" : "+v"(lane_));
    const int g = lane_ >> 4, l15 = lane_ & 15, q = l15 >> 2, p = lane_ & 3, w = F.wave;
    const size_t gofs = (row0 + 16 * w + (lane_ >> 2)) * 1024 + 128 * h + (lane_ & 3) * 32;
    u32x4 srg_[4]; bf16x8 qf[2];
#pragma unroll
    for (int c = 0; c < 4; ++c) srg_[c] = R.srg[c];
#pragma unroll
    for (int s = 0; s < 2; ++s) qf[s] = R.q[s];
    __syncthreads();
    if (item_next >= 0) r3_load(F, A, item_next, R);
    float rf[4], rb[4];
#pragma unroll
    for (int e = 0; e < 4; ++e) { const float fi = (float)(16 * w + 4 * g + e); rf[e] = __builtin_amdgcn_exp2f(lgf * fi); rb[e] = __builtin_amdgcn_exp2f(-lgb * fi); }
#pragma unroll
    for (int nt = 0; nt < 8; ++nt) { f32x4 sacc = {0.f, 0.f, 0.f, 0.f};
#pragma unroll
        for (int s = 0; s < 2; ++s) { const bf16x8 kfr = *(const LAS bf16x8*)(kl + (16 * nt + l15) * KLD + 32 * s + 8 * g); sacc = __builtin_amdgcn_mfma_f32_16x16x32_bf16(qf[s], kfr, sacc, 0, 0, 0); }
        const int j = 16 * nt + l15;
        if (nt < w) {
            const float cf = __builtin_amdgcn_exp2f(-lgf * (float)j);
#pragma unroll
            for (int e = 0; e < 4; ++e) pl[(4 * g + e) * VLD + j] = (bf16_t)f2bf(sacc[e] * (rf[e] * cf));
        } else if (nt > w) {
            const float cb = __builtin_amdgcn_exp2f(lgb * (float)j);
#pragma unroll
            for (int e = 0; e < 4; ++e) pl[(4 * g + e) * VLD + j] = (bf16_t)f2bf(sacc[e] * (rb[e] * cb));
        } else {
            const float cf = __builtin_amdgcn_exp2f(-lgf * (float)j), cb = __builtin_amdgcn_exp2f(lgb * (float)j);
#pragma unroll
            for (int e = 0; e < 4; ++e) { const int df = 16 * w + 4 * g + e - j;
                const float dm = (df >= 0 ? rf[e] * cf : 0.f) + (df <= 0 ? rb[e] * cb : 0.f);
                pl[(4 * g + e) * VLD + j] = (bf16_t)f2bf(sacc[e] * dm); } } }
    LDS_WAIT(); asm volatile("" ::: "memory");
    bf16x8 pa[4], qa[4];
#pragma unroll
    for (int s = 0; s < 4; ++s) pa[s] = *(const LAS bf16x8*)(pl + l15 * VLD + 32 * s + 8 * g);
    { const int i = 16 * w + l15; const float qdf = __builtin_amdgcn_exp2f(lgf * (float)(i + 1)), qdb = __builtin_amdgcn_exp2f(lgb * (float)(128 - i));
#pragma unroll
      for (int s = 0; s < 2; ++s) { f32x4 a, b; unpack8(__builtin_bit_cast(u32x4, qf[s]), a, b); qa[s] = __builtin_bit_cast(bf16x8, pack8(a * qdf, b * qdf)); qa[2 + s] = __builtin_bit_cast(bf16x8, pack8(a * qdb, b * qdb)); } }
    f32x4 oacc[8];
#pragma unroll
    for (int nt = 0; nt < 8; ++nt) { f32x4 acc = {0.f, 0.f, 0.f, 0.f};
#pragma unroll
        for (int s = 0; s < 4; ++s) { const int R0 = 32 * s + 8 * g + q, col = 16 * nt + 4 * p;
            const s16x4 lo = tr_read16((const LAS bf16_t*)((const LAS char*)vl + vsw_tr(R0, col))), hi = tr_read16((const LAS bf16_t*)((const LAS char*)vl + vsw_tr(R0 + 4, col)));
            acc = __builtin_amdgcn_mfma_f32_16x16x32_bf16(pa[s], MK8(lo, hi), acc, 0, 0, 0); }
#pragma unroll
        for (int s = 0; s < 4; ++s) { const int R0 = 32 * s + 8 * g + q, col = 16 * nt + 4 * p;
            const s16x4 lo = tr_read16((const LAS bf16_t*)((const LAS char*)sl + vsw_tr(R0, col))), hi = tr_read16((const LAS bf16_t*)((const LAS char*)sl + vsw_tr(R0 + 4, col)));
            acc = __builtin_amdgcn_mfma_f32_16x16x32_bf16(qa[s], MK8(lo, hi), acc, 0, 0, 0); }
        oacc[nt] = acc; }
    f32x4 ss = {0.f, 0.f, 0.f, 0.f};
#pragma unroll
    for (int nt = 0; nt < 8; ++nt) ss += oacc[nt] * oacc[nt];
#pragma unroll
    for (int e = 0; e < 4; ++e) { float s = ss[e]; s += __shfl_xor(s, 1); s += __shfl_xor(s, 2); s += __shfl_xor(s, 4); s += __shfl_xor(s, 8); ss[e] = __builtin_amdgcn_rsqf(s * (1.0f / 128.0f) + EPS); }
#pragma unroll
    for (int nt = 0; nt < 8; ++nt)
#pragma unroll
        for (int e = 0; e < 4; ++e) pl[(4 * g + e) * VLD + 16 * nt + l15] = (bf16_t)f2bf(oacc[nt][e] * ss[e]);
    LDS_WAIT(); asm volatile("" ::: "memory");
#pragma unroll
    for (int c = 0; c < 4; ++c) { f32x4 o0, o1, g0, g1; unpack8(*(const LAS u32x4*)(pl + (lane_ >> 2) * VLD + (lane_ & 3) * 32 + 8 * c), o0, o1); unpack8(srg_[c], g0, g1);
        *(u32x4*)(RVb + gofs + 8 * c) = pack8(o0 * g0, o1 * g1); }
    __syncthreads();
}

__device__ __forceinline__ void phase_attn(const Frame& F, CArgs& A) {
    unsigned char* ws = A.ws; bf16_t* Q = (bf16_t*)(ws + WS_Q);
    {
        LAS float* scr = (LAS float*)(F.lds + F.wave * 8704);
        const int gw = F.bid * NWAVES + F.wave, NGW = F.G * NWAVES;
        constexpr int I_O = 16 * 32, NIT = 3 * I_O;
        for (int it = gw; it < NIT; it += NGW) {
            int r = it;
            if (r < I_O) { transpose_item(A.w_att_o, 1024, (bf16_t*)(ws + WS_WB), 2048, 0, 64 * (r / 32), 32 * (r % 32), ColId(), scr, F.lane); continue; } r -= I_O;
            if (r < I_O) { transpose_item(A.w_ret_o, 1024, (bf16_t*)(ws + WS_WB), 2048, 1024, 64 * (r / 32), 32 * (r % 32), ColId(), scr, F.lane); continue; } r -= I_O;
            transpose_item(A.w_out, 1024, (bf16_t*)(ws + WS_WC), 1024, 0, 64 * (r / 32), 32 * (r % 32), ColId(), scr, F.lane);
        }
        __syncthreads();
    }
    const int x = F.bid & 7, c = F.bid >> 3;
    const int nun = F.bid < NB * NH ? 3 : 2;
    const int grp = c % 3, r3pos = grp == 2 ? nun : grp;
#pragma nounroll
    for (int i = 0; i <= nun; ++i) {
      if (i == r3pos) {
#if defined(PROBE_K0) && PROBE_K0 == 200
        const unsigned long long t0_ = __builtin_amdgcn_s_memrealtime();
#endif
        const int nb = F.bid >= 128 ? 6 : 4, i0 = F.bid >= 128 ? 512 + (F.bid - 128) * 6 : F.bid * 4;
        Frame F2 = F; F2.lane = lane_id_(); F2.tid = F2.wave * 64 + F2.lane;
        R3Regs R; r3_load(F2, A, i0, R);
        for (int k = 0; k < nb; ++k) r3_item(F2, A, i0 + k, k + 1 < nb ? i0 + k + 1 : -1, R);
#if defined(PROBE_K0) && PROBE_K0 == 200
        if (F.bid == PROBE_BID && F.tid == 0) *(float*)(A.ws + 32768) = (float)(__builtin_amdgcn_s_memrealtime() - t0_);
#endif
      }
      if (i < nun) {
        const bf16_t *Kh, *Vh; bf16_t* Qb; int seq;
        if (i < 2) { const int lb = x >> 1, kvh = x & 1, uu = c + 32 * i, hq = kvh * 4 + (uu >> 4), qb = uu & 15;
            Kh = (const bf16_t*)(ws + WS_KALL) + (size_t)(lb * 2 + kvh) * SKV * 128; Vh = (const bf16_t*)(ws + WS_VALL) + (size_t)(lb * 2 + kvh) * SKV * 128;
            Qb = Q + ((size_t)MP + (size_t)lb * DSEQ + qb * 256) * 1024 + hq * 128; seq = SKV; }
        else { const int b = F.bid >> 3, hq = F.bid & 7, kvh = hq >> 2;
            Kh = (const bf16_t*)(ws + WS_KP) + (size_t)(b * 2 + kvh) * SEQ * 128; Vh = (const bf16_t*)(ws + WS_VP) + (size_t)(b * 2 + kvh) * SEQ * 128;
            Qb = Q + (size_t)b * SEQ * 1024 + hq * 128; seq = SEQ; }
        att::attn_dense_body<1024>(Qb, Kh, Vh, Qb, seq, (char*)F.lds, F.wave);
      }
    }
}

struct OneUnit { int pm, pn; __device__ __forceinline__ bool next(int i, pg8::Unit& u) const { if (i) return false; u.pm = pm; u.pn = pn; return true; }
    __device__ __forceinline__ void a_ready(const pg8::Unit&, int) const {} };
constexpr int NU2 = 0, NU3 = 320, NU4 = (MT / 256) * (NUP / 256), NU5 = 320, NUTOT = NU2 + NU3 + NU4 + NU5;
__device__ __forceinline__ void fix_panel(const Frame& F, CArgs& A, int pm) {
    unsigned char* ws = A.ws; const float* EU = (const float*)(ws + WS_EDGE_U); const float* EUC = (const float*)(ws + WS_EDGE_UC); bf16_t* ACT = (bf16_t*)(ws + WS_ACT);
    const int jt = (pm - 16) & 15;
    for (int i = F.tid; i < 2 * DFF; i += NTHR) { const int j = i % DFF, e = i / DFF;
        if ((e == 0 && jt == 0) || (e == 1 && jt == 15)) continue;
        const int pmn = e ? pm + 1 : pm - 1, na = 256 * (j >> 7) + (j & 127), ng = na + 128, tap = e ? 2 : 0;
        const float ua = EUC[((size_t)pm * 2 + e) * NUP + na] + A.conv_w[(size_t)tap * NUP + j] * EU[((size_t)pmn * 2 + (1 - e)) * NUP + na];
        const float ug = EUC[((size_t)pm * 2 + e) * NUP + ng] + A.conv_w[(size_t)tap * NUP + DFF + j] * EU[((size_t)pmn * 2 + (1 - e)) * NUP + ng];
        ACT[((size_t)pm * 256 + (e ? 255 : 0)) * DFF + j] = (bf16_t)f2bf(siluf_(ug) * ua); }
}
__device__ __forceinline__ void g3_unit(const Frame& F, CArgs& A, int idx) {
    unsigned char* ws = A.ws; unsigned* cnt = (unsigned*)(ws + WS_CNT); const int pm = idx >> 2, pn = idx & 3;
    OneUnit S{pm, pn};
    pg8::Gemm g{(const bf16_t*)(ws + WS_Y), (const bf16_t*)(ws + WS_WC), MT, DM, DM, DM, DM, 1 << 30, 0};
    EpiRes1 E{A.x_prompt, A.x_sample, (const float*)(ws + WS_MODF), A.norm2_g, (bf16_t*)(ws + WS_X1B), (float*)(ws + WS_SSQ1), (bf16_t*)(ws + WS_H)};
    pg8::gemm_phase(F.lds, g, S, E, F.wave);
    asm volatile("s_waitcnt vmcnt(0)" ::: "memory");
    __syncthreads();
    if (F.wave == 0 && lane_id_() == 0) { __hip_atomic_fetch_add(cnt + 64 * (CNT_D3 + pm), 1u, RLX_AGENT); __hip_atomic_fetch_add(cnt + 64 * CNT_G3ALL, 1u, RLX_AGENT); }
}
__device__ __forceinline__ void phase_mix(const Frame& F, CArgs& A) {
    unsigned char* ws = A.ws; unsigned* cnt = (unsigned*)(ws + WS_CNT);
    const int v = (F.bid & 7) * (F.G >> 3) + (F.bid >> 3);
#if defined(PROBE_K0) && (PROBE_K0 == 301 || PROBE_K0 == 302)
    const unsigned long long tmix0_ = __builtin_amdgcn_s_memrealtime();
#endif
    {   struct G2Run { int v, n; __device__ __forceinline__ bool next(int i, pg8::Unit& u) const { if (i >= n) return false; const int l = i == 0 ? v : 256 + v; u.pm = l >> 2; u.pn = l & 3; return true; }
            __device__ __forceinline__ void a_ready(const pg8::Unit&, int) const {} };
        G2Run S{v, v < 64 ? 2 : 1};
        pg8::Gemm g{(const bf16_t*)(ws + WS_Q), (const bf16_t*)(ws + WS_WB), MT, DM, 2 * DM, DM, 2 * DM, 16, (long)(WS_RV - WS_Q) - 16 * 128};
        EpiMix E{(const bf16_t*)A.out, (const bf16_t*)A.out + (size_t)MT * DM, (bf16_t*)(ws + WS_Y), cnt + 64 * CNT_D2};
        pg8::gemm_phase(F.lds, g, S, E, F.wave);
    }
#if defined(PROBE_K0) && PROBE_K0 == 300
    const unsigned long long t0_ = __builtin_amdgcn_s_memrealtime();
#endif
#if defined(PROBE_K0) && PROBE_K0 == 301
    if (v == PROBE_BID && F.tid == 0) *(float*)(ws + 32768) = (float)(__builtin_amdgcn_s_memrealtime() - tmix0_);
#endif
    if (v >= 64) { const int idx = v - 64, pm = idx >> 2;
        if (F.wave == 0) { spin_ge(cnt + 64 * (CNT_D2 + pm), 4u); __builtin_amdgcn_fence(__ATOMIC_ACQUIRE, "agent"); asm volatile("s_waitcnt vmcnt(0)" ::: "memory"); }
        __syncthreads();
        g3_unit(F, A, idx);
        __syncthreads();
        LAS float* scr = (LAS float*)(F.lds + F.wave * 8704);
        constexpr int I_DN = (DFF / 64) * 32, I_UP = 16 * (NUP / 32);
        for (int it = (v - 64) * NWAVES + F.wave; it < I_DN + I_UP; it += (F.G - 64) * NWAVES) {
            if (it < I_DN) transpose_item(A.w_down, 1024, (bf16_t*)(ws + WS_WD), DFF, 0, 64 * (it / 32), 32 * (it % 32), ColId(), scr, F.lane);
            else { const int r = it - I_DN; transpose_item(A.w_up, NUP, (bf16_t*)(ws + WS_WA), 1024, 0, 64 * (r / (NUP / 32)), 32 * (r % (NUP / 32)), ColUp(), scr, F.lane); } }
    }
#if defined(PROBE_K0) && PROBE_K0 == 300
    if (v == PROBE_BID && F.tid == 0) *(float*)(ws + 32768) = (float)(__builtin_amdgcn_s_memrealtime() - t0_);
#endif
#if defined(PROBE_K0) && PROBE_K0 == 302
    if (v == PROBE_BID && F.tid == 0) *(float*)(ws + 32768) = (float)(__builtin_amdgcn_s_memrealtime() - tmix0_);
#endif
}
__device__ __forceinline__ void phase_stream(const Frame& F, CArgs& A) {
    unsigned char* ws = A.ws; unsigned* cnt = (unsigned*)(ws + WS_CNT);
    LAS float* spare = (LAS float*)(F.lds + SPARE_OFF);
    const int NOJ = 1 << 30;
    const int v = (F.bid & 7) * (F.G >> 3) + (F.bid >> 3);
#if defined(PROBE_K0) && PROBE_K0 >= 100 && PROBE_K0 < 200
    unsigned long long tacc_ = 0, tl_ = __builtin_amdgcn_s_memrealtime();
#define SPROBE(cat) do { const unsigned long long tn_ = __builtin_amdgcn_s_memrealtime(); if ((cat) == PROBE_K0 - 100 || PROBE_K0 - 100 == 3) tacc_ += tn_ - tl_; tl_ = tn_; } while (0)
#else
#define SPROBE(cat) do { } while (0)
#endif
    const int nG4 = v < 64 ? 8 : v < 192 ? 7 : v < 224 ? 6 : 5, nG5 = v >= 192 ? 2 : 1;
    if (v >= 64 && v < 192) g3_unit(F, A, 192 + (v - 64));
    SPROBE(0);
    {   struct G4Run { int v, n; unsigned* d3; unsigned* g3all; volatile LAS unsigned* alld; unsigned* d4; mutable int p0, p1;
            __device__ __forceinline__ void publish(int pm) const {
                if (pm >= 0) { asm volatile("s_waitcnt vmcnt(0)" ::: "memory"); if (lane_id_() == 0) __hip_atomic_fetch_add(d4 + 64 * pm, 1u, RLX_AGENT); } }
            __device__ __forceinline__ bool next(int r, pg8::Unit& u) const { if (r >= n) return false;
                const int l = r < 5 ? 256 * r + v : r == 5 ? 1280 + v : r == 6 ? 1504 + v : 1696 + v;
                const int sr = l / 176, rem = l % 176, blk = rem < 160 ? rem >> 5 : 5, w = rem < 160 ? rem & 31 : rem - 160;
                u.pm = 8 * sr + (w & 7); u.pn = 4 * blk + (w >> 3); return true; }
            __device__ __forceinline__ void a_ready(const pg8::Unit& u, int wid) const {
                publish(p0); p0 = p1; p1 = u.pm;
                if (wid == 0 && *alld == 0u) {
                    const bool all = (unsigned)__builtin_amdgcn_readfirstlane(__hip_atomic_load(g3all, RLX_AGENT)) >= 320u;
                    spin_ge(d3 + 64 * u.pm, 4u);
                    if (u.pm >= 63) spin_ge(g3all, 320u);
                    __builtin_amdgcn_fence(__ATOMIC_ACQUIRE, "agent"); asm volatile("s_waitcnt vmcnt(0)" ::: "memory");
                    if (all) *alld = 1u; }
                asm volatile("" ::: "memory"); __builtin_amdgcn_s_barrier(); asm volatile("" ::: "memory"); } };
        volatile LAS unsigned* alld = (volatile LAS unsigned*)(F.lds + MISC_OFF) + 16;
        if (F.tid == 0) *alld = 0u;
        __syncthreads();
        G4Run S{v, nG4, cnt + 64 * CNT_D3, cnt + 64 * CNT_G3ALL, alld, cnt + 64 * CNT_D4, -1, -1};
        pg8::Gemm g{(const bf16_t*)(ws + WS_H), (const bf16_t*)(ws + WS_WA), MT, NUP, DM, DM, DM, NOJ, 0};
        EpiConv E{(const float*)(ws + WS_SSQ1), (const float*)(ws + WS_BUPF), A.conv_w, A.conv_b, (bf16_t*)(ws + WS_ACT), (float*)(ws + WS_EDGE_U), (float*)(ws + WS_EDGE_UC), spare, cnt + 64 * CNT_D4};
        pg8::gemm_phase(F.lds, g, S, E, F.wave);
        S.publish(S.p0); S.publish(S.p1);
    }
    SPROBE(1);
    for (int j = 0; j < nG5; ++j) { const int l = j == 0 ? ((v + 64) & 255) : 256 + (v - 192), pm = l >> 2, pn = l & 3;
        if (F.wave == 0) { spin_ge(cnt + 64 * (CNT_D4 + pm), 176u);
            if (pm >= 16) { const int jt = (pm - 16) & 15; if (jt > 0) spin_ge(cnt + 64 * (CNT_D4 + pm - 1), 176u); if (jt < 15) spin_ge(cnt + 64 * (CNT_D4 + pm + 1), 176u); }
            __builtin_amdgcn_fence(__ATOMIC_ACQUIRE, "agent"); asm volatile("s_waitcnt vmcnt(0)" ::: "memory"); }
        __syncthreads();
        if (pm >= 16) { fix_panel(F, A, pm); asm volatile("s_waitcnt vmcnt(0)" ::: "memory"); __syncthreads(); }
        SPROBE(0);
        OneUnit S{pm, pn};
        pg8::Gemm g{(const bf16_t*)(ws + WS_ACT), (const bf16_t*)(ws + WS_WD), MT, DM, DFF, DFF, DFF, NOJ, 0};
        EpiRes2 E{(const float*)(ws + WS_MODF), A.final_g, (const bf16_t*)(ws + WS_X1B), A.out, (float*)(ws + WS_XS), cnt + 64 * CNT_X5, spare};
        pg8::gemm_phase(F.lds, g, S, E, F.wave);
        SPROBE(2);
    }
#if defined(PROBE_K0) && PROBE_K0 >= 100 && PROBE_K0 < 200
    if (v == PROBE_BID && F.tid == 0) *(float*)(ws + 32768) = (float)tacc_;
#endif
}

constexpr int N_PHASES = 8;
__global__ void __launch_bounds__(NTHR, 2) fwd_kernel(Args A_) {
    CArgs& A = *(CArgs*)__builtin_amdgcn_kernarg_segment_ptr();
    extern __shared__ __attribute__((aligned(16))) unsigned char lds_raw[];
    Frame F; F.lds = (LAS unsigned char*)lds_raw; F.wave = __builtin_amdgcn_readfirstlane(threadIdx.x >> 6); F.lane = lane_id_(); F.tid = F.wave * 64 + F.lane; F.G = gridDim.x; F.bid = blockIdx.x;
    volatile LAS unsigned* MISC = (volatile LAS unsigned*)(F.lds + MISC_OFF);
    if (F.tid < 64) MISC[F.tid] = 0u;
    __syncthreads();
    unsigned char* ws = A.ws;
    XcdBarrier bar = xcd_barrier_post((unsigned*)(ws + WS_CTL), MISC + 8, F.wave);
    const int lo = A.ph_lo, hi = A.ph_hi;
#ifdef ONLY_PHASE
#define IN(k) ((k) == ONLY_PHASE)
#else
#define IN(k) (lo <= (k) && (k) < hi)
#endif
#ifdef PROBE_K0
    unsigned long long tA_ = __builtin_amdgcn_s_memrealtime();
#define PROBE_AT(k) do { if ((k) == PROBE_K0 - 1) tA_ = __builtin_amdgcn_s_memrealtime(); \
    if ((k) == PROBE_K1 && F.bid == 0 && F.tid == 0) { const unsigned long long tB_ = __builtin_amdgcn_s_memrealtime(); *(float*)(ws + 32768) = (float)(tB_ - tA_) - 100.0f * PROBE_OFS; } } while (0)
#else
#define PROBE_AT(k) do { } while (0)
#endif
#define SEAM(k) do { if (IN(k) && IN((k) + 1)) xcd_barrier(bar); F.lane = lane_id_(); F.tid = F.wave * 64 + F.lane; PROBE_AT(k); } while (0)
    LAS float* spare = (LAS float*)(F.lds + SPARE_OFF);
    const int NOJ = 1 << 30;
    if (IN(0)) { phase0(F, A); } SEAM(0);
    if (IN(1)) { phase1(F, A); } SEAM(1);
    if (IN(2)) {
        pg8::Gemm g{(const bf16_t*)(ws + WS_H), (const bf16_t*)(ws + WS_WA), MT, DIN, DM, DM, DM, NOJ, 0};
        pg8::StaticOrder S; S.init(MT, DIN, F.G, F.bid, true);
        EpiIn E{(bf16_t*)(ws + WS_Q), (bf16_t*)(ws + WS_KALL), (bf16_t*)(ws + WS_VALL), (bf16_t*)(ws + WS_KP), (bf16_t*)(ws + WS_VP), (bf16_t*)(ws + WS_RQ), (bf16_t*)(ws + WS_RK),
                (bf16_t*)(ws + WS_RV), (bf16_t*)(ws + WS_SRG), (bf16_t*)A.out, (bf16_t*)A.out + (size_t)MT * DM, A.out + OUT_CK, A.out + OUT_CV, A.q_g, A.k_g, spare, (unsigned*)(ws + WS_CNT1)};
        pg8::gemm_phase(F.lds, g, S, E, F.wave);
        phase_r1(F, A);
    } SEAM(2);
    if (IN(4)) { phase_scan(F, A); } SEAM(4);
    if (IN(5)) { phase_attn(F, A); } SEAM(5);
    if (IN(6)) { phase_mix(F, A); } SEAM(6);
    if (IN(7)) { phase_stream(F, A); }
#ifdef PROBE_K0
    {
        PROBE_AT(7);
        xcd_barrier(bar);
        const float sc_ = 1.0f + sqrtf(*(const float*)(ws + 32768) * 1e-7f);
        for (int i = F.bid * NTHR + F.tid; i < NB * NKV * SEQ * HD; i += F.G * NTHR) A.out[OUT_CV + i] *= sc_;
    }
#endif
#undef IN
#undef SEAM
}

#ifndef MK_SPLIT
#define MK_SPLIT 0
#endif
extern "C" void kernel_launch(void* const* d_in, const int* in_sizes, int n_in, void* d_out, int out_size, void* d_ws, size_t ws_size, hipStream_t stream) {
    static int grid = 0;
    if (grid == 0) {
        if (n_in != 25 || ws_size < WS_END) { fprintf(stderr, "kernel_launch: unexpected n_in %d / ws %zu\n", n_in, ws_size); grid = -1; return; }
        int dev = 0, cus = 0, per_cu = 0;
        hipGetDevice(&dev); hipDeviceGetAttribute(&cus, hipDeviceAttributeMultiprocessorCount, dev);
        if (hipFuncSetAttribute((const void*)fwd_kernel, hipFuncAttributeMaxDynamicSharedMemorySize, LDS_BYTES) != hipSuccess) { fprintf(stderr, "kernel_launch: hipFuncSetAttribute failed\n"); grid = -1; return; }
        hipOccupancyMaxActiveBlocksPerMultiprocessor(&per_cu, (const void*)fwd_kernel, NTHR, LDS_BYTES);
        (void)hipGetLastError();
        if (per_cu < 1) fprintf(stderr, "kernel_launch: occupancy query says %d blocks/CU\n", per_cu);
        grid = cus;
        if (grid != 256) fprintf(stderr, "kernel_launch: %d CUs (built for 256)\n", grid);
    }
    if (grid < 0) return;
    hipMemsetAsync((char*)d_ws + WS_CTL, 0, CTL_ZERO_BYTES, stream);
    Args a{};
    const float** pa = (const float**)&a;
    for (int i = 0; i < 25; ++i) pa[i] = (const float*)d_in[i];
    a.out = (float*)d_out; a.ws = (unsigned char*)d_ws;
#if MK_SPLIT
    for (int p = 0; p < N_PHASES; ++p) { a.ph_lo = p; a.ph_hi = p + 1; hipLaunchKernelGGL(fwd_kernel, dim3(grid), dim3(NTHR), LDS_BYTES, stream, a); }
#else
    a.ph_lo = 0; a.ph_hi = N_PHASES; hipLaunchKernelGGL(fwd_kernel, dim3(grid), dim3(NTHR), LDS_BYTES, stream, a);
#endif
    const hipError_t le = hipPeekAtLastError();
    if (le != hipSuccess) fprintf(stderr, "kernel_launch: launch failed: %s\n", hipGetErrorName(le));
}
```

```cpp
#include <hip/hip_runtime.h>
#include <hip/hip_bf16.h>
#include <cstdio>
#include <cstdint>

#ifndef PROBE_BID
#define PROBE_BID 100
#endif
#ifndef PROBE_OFS
#define PROBE_OFS 0
#endif
constexpr int DM = 1024, NB = 16, SEQ = 256, DB = 4, DSEQ = 4096, PAST = 512, GRIDW = 64;
constexpr int NH = 8, NKV = 2, HD = 128, RH = 8, RDK = 64, RDV = 128, DFF = 2816, CHUNK = 128;
constexpr int MP = NB * SEQ, ML = DB * DSEQ, MT = MP + ML;
constexpr int DIN = 6656, SKV = DSEQ + PAST;
constexpr int NUP = 2 * DFF;
constexpr float EPS = 1e-6f;
constexpr int NCHUNK = MT / CHUNK;
constexpr int NITEM = NCHUNK * RH;

#define GAS __attribute__((address_space(1)))
#define LAS __attribute__((address_space(3)))
typedef unsigned short bf16_t;
typedef short bf16x8 __attribute__((ext_vector_type(8)));
typedef short s16x4 __attribute__((ext_vector_type(4)));
typedef float f32x4 __attribute__((ext_vector_type(4)));
typedef float f32x2 __attribute__((ext_vector_type(2)));
typedef float f32x16 __attribute__((ext_vector_type(16)));
typedef unsigned u32x4 __attribute__((ext_vector_type(4)));
typedef unsigned u32x2 __attribute__((ext_vector_type(2)));
typedef GAS unsigned gu32;

constexpr size_t MiB = 1u << 20;
constexpr size_t WS_CTL = 0, CTL_ZERO_BYTES = 16 * 1024;
constexpr size_t WS_MOD = 256 * 1024;
constexpr size_t MODQ = 5 * 6144;
constexpr size_t WS_MODF = 1 * MiB + 832 * 1024;
constexpr size_t WS_BUP = 768 * 1024;
constexpr size_t BUPQ = 5 * 5632;
constexpr size_t WS_BUPF = 1 * MiB + 384 * 1024;
constexpr size_t WS_SSQ1 = 1 * MiB + 256 * 1024;
constexpr size_t WS_XS = 1 * MiB + 512 * 1024;
constexpr size_t WS_CNT = 64 * 1024;
constexpr size_t WS_CNT1 = 152 * 1024;
constexpr int CNT_D2 = 0, CNT_D3 = 80, CNT_D4 = 160, CNT_X5 = 240, CNT_G3ALL = 320, CNT_R3Q = 321;
constexpr size_t WS_WA = 2 * MiB;
constexpr size_t WS_WB = 16 * MiB;
constexpr size_t WS_WC = 20 * MiB;
constexpr size_t WS_WD = 22 * MiB;
constexpr size_t WS_H = 28 * MiB;
constexpr size_t WS_Q = 68 * MiB;
constexpr size_t WS_KALL = 108 * MiB, WS_VALL = 117 * MiB, WS_KP = 126 * MiB, WS_VP = 128 * MiB;
constexpr size_t WS_RQ = 132 * MiB, WS_RK = 152 * MiB, WS_RV = 172 * MiB, WS_SRG = 212 * MiB, WS_END = 252 * MiB;
constexpr size_t WS_Y = WS_RQ;
constexpr size_t WS_X1B = WS_SRG;
constexpr size_t WS_ACT = WS_Q;
constexpr size_t WS_EDGE_U = 178 * MiB, WS_EDGE_UC = 182 * MiB;
static_assert((size_t)DIN * DM * 2 <= 14 * MiB && (size_t)MT * DM * 2 == 40 * MiB && (size_t)NITEM * 2 * RDK * RDV * 2 == 40 * MiB, "ws map");
static_assert((size_t)DB * NKV * SKV * HD * 2 <= 9 * MiB && (size_t)NB * NKV * SEQ * HD * 2 <= 2 * MiB, "ws map kv");
static_assert(WS_ACT + (size_t)MT * DFF * 2 <= WS_EDGE_U && (size_t)80 * 2 * NUP * 4 <= 4 * MiB && WS_EDGE_UC + 4 * MiB <= WS_X1B, "ws map act");
static_assert(WS_CNT + 322 * 256 <= WS_CNT1 && WS_CNT1 + (481 + 82) * 64 <= WS_MOD && WS_MOD + 4 * MODQ * 4 <= WS_BUP && WS_BUP + 4 * BUPQ * 4 <= WS_SSQ1 && WS_SSQ1 + (size_t)MT * 4 <= WS_BUPF
              && WS_BUPF + BUPQ * 4 <= WS_XS && WS_XS + (size_t)80 * 4 * 256 * 4 <= WS_MODF && WS_MODF + MODQ * 4 <= WS_WA, "ws map: small buffers");
constexpr size_t OUT_Y = 0, OUT_CK = (size_t)MT * DM, OUT_CV = OUT_CK + (size_t)NB * NKV * SEQ * HD, OUT_SF = OUT_CV + (size_t)NB * NKV * SEQ * HD, OUT_SB = OUT_SF + (size_t)NB * RH * RDK * RDV;

#define LDS_WAIT() asm volatile("s_waitcnt lgkmcnt(0)" ::: "memory")
#define VM_WAIT() asm volatile("s_waitcnt vmcnt(0)" ::: "memory")
#define RLX_AGENT __ATOMIC_RELAXED, __HIP_MEMORY_SCOPE_AGENT
typedef __bf16 bf16x2_t __attribute__((ext_vector_type(2)));
__device__ __forceinline__ unsigned pk2(float lo, float hi) { const f32x2 v = {lo, hi}; return __builtin_bit_cast(unsigned, __builtin_convertvector(v, bf16x2_t)); }
__device__ __forceinline__ unsigned f2bf(float f) { return pk2(f, 0.f) & 0xffffu; }
__device__ __forceinline__ float bflo(unsigned w) { return __builtin_bit_cast(float, w << 16); }
__device__ __forceinline__ float bfhi(unsigned w) { return __builtin_bit_cast(float, w & 0xffff0000u); }
__device__ __forceinline__ float bf2f(bf16_t h) { return __builtin_bit_cast(float, (unsigned)h << 16); }
__device__ __forceinline__ int swap25(int p) { return (p & ~0x24) | ((p & 4) << 3) | ((p & 32) >> 3); }
__device__ __forceinline__ float sigmoidf_(float x) { return __builtin_amdgcn_rcpf(1.0f + __builtin_amdgcn_exp2f(-1.4426950408889634f * x)); }
__device__ __forceinline__ float siluf_(float x) { return x * __builtin_amdgcn_rcpf(1.0f + __builtin_amdgcn_exp2f(-1.4426950408889634f * x)); }
__device__ __forceinline__ int lane_id_() { int l; asm volatile("v_mbcnt_lo_u32_b32 %0, -1, 0\n\tv_mbcnt_hi_u32_b32 %0, -1, %0" : "=v"(l)); return l; }
__device__ __forceinline__ f32x4 sum4q(const float* p, size_t q) { return (*(const f32x4*)p + *(const f32x4*)(p + q)) + (*(const f32x4*)(p + 2 * q) + *(const f32x4*)(p + 3 * q)); }
__device__ __forceinline__ float wave_sum(float v) {
#pragma unroll
    for (int o = 1; o < 64; o <<= 1) v += __shfl_xor(v, o);
    return v;
}
__device__ __forceinline__ void sincos_rev(float ang, float& c, float& s) {
    double rev = (double)ang * 0.15915494309189533577; rev -= __builtin_rint(rev);
    const float fr = (float)rev; s = __builtin_amdgcn_sinf(fr); c = __builtin_amdgcn_cosf(fr);
}
__device__ __forceinline__ float rope_inv(int i) { return exp2f(-(float)i * (13.287712379549449f / 32.0f)); }

#define XB_TMO      128
#define XB_XCNT(j)  (256  + 64 * (j))
#define XB_XSUB(j)  (1280 + 64 * (j))
#define XB_XGEN(j)  (2304 + 64 * (j))
#define XB_TOP      3328
#define XB_TOPGEN   3392
#define XCD_BAR_WORDS 3456
#define XB_SPIN_CAP (1u << 20)
__device__ __forceinline__ unsigned xb_ld(unsigned* p)              { return __hip_atomic_load(p, __ATOMIC_RELAXED, __HIP_MEMORY_SCOPE_AGENT); }
__device__ __forceinline__ unsigned xb_add(unsigned* p, unsigned v) { return __hip_atomic_fetch_add(p, v, __ATOMIC_RELAXED, __HIP_MEMORY_SCOPE_AGENT); }
__device__ __forceinline__ unsigned xb_xcc_id() { return (unsigned)__builtin_amdgcn_s_getreg((3 << 11) | 20) & 0xFu; }
#define XB_SPIN(cond, bar) do { unsigned _sp = 0; while (cond) { __builtin_amdgcn_s_sleep(1); \
    if ((++_sp & 255u) == 0u) { if (xb_ld(&(bar)[XB_TMO])) break; if (_sp > XB_SPIN_CAP) { atomicAdd(&(bar)[XB_TMO], 1u); break; } } } } while (0)
struct XcdBarrier { unsigned* bar; unsigned x; volatile LAS unsigned* st; int wave; };
__device__ __forceinline__ XcdBarrier xcd_barrier_post(unsigned* bar, volatile LAS unsigned* st, int wave) {
    XcdBarrier b; b.bar = bar; b.x = xb_xcc_id(); b.st = st; b.wave = wave;
    if (wave == 0 && lane_id_() == 0) (void)xb_add(&bar[XB_XCNT(b.x)], 1u);
    return b;
}
__device__ __forceinline__ void xcd_barrier_complete(unsigned* bar, unsigned x, unsigned& nloc, unsigned& nx) {
    const unsigned G = gridDim.x * gridDim.y * gridDim.z;
    unsigned sum, cnt, mine, sp = 0u;
    for (;;) {
        sum = 0u; cnt = 0u; mine = 0u;
#pragma unroll
        for (unsigned j = 0; j < 16; ++j) { const unsigned c = xb_ld(&bar[XB_XCNT(j)]); sum += c; cnt += (c > 0u) ? 1u : 0u; mine = (j == x) ? c : mine; }
        if (sum == G) break;
        __builtin_amdgcn_s_sleep(1);
        if ((++sp & 255u) == 0u) { if (xb_ld(&bar[XB_TMO])) break; if (sp > XB_SPIN_CAP) { atomicAdd(&bar[XB_TMO], 1u); break; } }
    }
    nloc = mine > 0u ? mine : 1u; nx = cnt > 0u ? cnt : 1u;
}
__device__ __forceinline__ void xcd_barrier(const XcdBarrier& b) {
    asm volatile("s_waitcnt vmcnt(0)" ::: "memory");
    __syncthreads();
    if (b.wave == 0 && lane_id_() == 0) {
        unsigned* bar = b.bar;
        __builtin_amdgcn_s_waitcnt(0);
        unsigned nloc = b.st[0], nx = b.st[1];
        if (nloc == 0u) { xcd_barrier_complete(bar, b.x, nloc, nx); b.st[0] = nloc; b.st[1] = nx; }
        const unsigned old = xb_add(&bar[XB_XSUB(b.x)], 1u);
        const unsigned gen = old / nloc;
        if (old + 1u == (gen + 1u) * nloc) {
            __builtin_amdgcn_fence(__ATOMIC_RELEASE, "agent");
            asm volatile("s_waitcnt vmcnt(0)" ::: "memory");
            const unsigned og = xb_add(&bar[XB_TOP], 1u);
            const unsigned tg = og / nx;
            if (og + 1u == (tg + 1u) * nx) xb_add(&bar[XB_TOPGEN], 1u);
            else XB_SPIN(xb_ld(&bar[XB_TOPGEN]) == tg, bar);
            __builtin_amdgcn_fence(__ATOMIC_ACQUIRE, "agent");
            xb_add(&bar[XB_XGEN(b.x)], 1u);
            asm volatile("s_waitcnt vmcnt(0)" ::: "memory");
        } else {
            XB_SPIN(xb_ld(&bar[XB_XGEN(b.x)]) == gen, bar);
            __builtin_amdgcn_fence(__ATOMIC_ACQUIRE, "agent");
            asm volatile("s_waitcnt vmcnt(0)" ::: "memory");
        }
    }
    __syncthreads();
}

namespace pg8 {
constexpr int BM = 256, BK = 64, HALF = 128, HTB = HALF * BK * 2, STAGE_BYTES = 8 * HTB, NXCD = 8, WGM = 8;
__host__ __device__ __forceinline__ int lds_byte(int r, int c) { const int st = (r >> 4) * 2 + (c >> 5), rr = r & 15, cc = c & 31, ob = rr * 64 + cc * 2; return st * 1024 + (ob ^ (((ob >> 9) & 1) << 5)); }
__host__ __device__ __forceinline__ void stage_rc(int b, int& R, int& C) { const int st = b / 1024, sb = b % 1024, swz = sb ^ (((sb >> 9) & 1) << 5); R = (st >> 1) * 16 + swz / 64; C = (st & 1) * 32 + (swz % 64) / 2; }
__host__ __device__ __forceinline__ int perm32(int rho) { const int n = rho >> 4, i = rho & 15; return 8 * (i >> 2) + 4 * n + (i & 3); }
struct Unit { int pm, pn; };
struct Gemm { const bf16_t* A; const bf16_t* Bt; int M, N, K, lda, ldb, jt; long jumpA; };
struct StaticOrder {
    int nM, nN, nwg, G, c; bool in_order;
    __host__ __device__ void init(int M, int N, int G_, int c_, bool io = false) { nM = M / BM; nN = N / BM; nwg = nM * nN; G = G_; c = c_; in_order = io; }
    __host__ __device__ bool next(int i, Unit& u) const {
        const long L = (long)i * G + c; if (L >= nwg) return false;
        int wgid = (int)L; { const int q = nwg / NXCD, r = nwg % NXCD, xcd = wgid % NXCD, off = wgid / NXCD; wgid = (xcd < r ? xcd * (q + 1) : r * (q + 1) + (xcd - r) * q) + off; }
        const int nig = WGM * nN, gid = wgid / nig, fm = gid * WGM, gsz = (nM - fm) < WGM ? (nM - fm) : WGM;
        u.pm = fm + ((wgid % nig) % gsz); u.pn = (wgid % nig) / gsz;
        if (in_order) u.pn = u.pn < 6 ? 8 + u.pn : u.pn < 14 ? u.pn - 6 : u.pn;
        return true;
    }
    __device__ __forceinline__ void a_ready(const Unit&, int) const {}
};
template <class Epi, class Sched>
__device__ __forceinline__ void gemm_phase(LAS unsigned char* lds, const Gemm g, const Sched& S, const Epi& E, const int wid) {
    const int lane = lane_id_(), tid = wid * 64 + lane, wr = wid >> 2, wc = wid & 3, fr = lane & 15, fq = lane >> 4;
    const int nt = g.K / BK;
    unsigned voffA[2], voffB[2];
#pragma unroll
    for (int i = 0; i < 2; ++i) { int R, C; stage_rc(tid * 16 + i * 8192, R, C); const int Rb = (R & ~31) + perm32(R & 31);
        voffA[i] = (unsigned)(R * g.lda + C) * 2u; voffB[i] = (unsigned)(Rb * g.ldb + C) * 2u; }
    const size_t kstep = (size_t)(BK * 2);
    const size_t hstepA = (size_t)HALF * g.lda * 2, hstepB = (size_t)HALF * g.ldb * 2;
    const size_t tstepA = 2 * hstepA, tstepB = 2 * hstepB;
    const unsigned ldsw = (unsigned)wid * 1024u;
    const int aoff = lds_byte(wr * 64 + fr, fq * 8), boff = lds_byte(wc * 32 + fr, fq * 8);
#define PG8_SA(b, h) (((b) * 2 + (h)) * HTB)
#define PG8_SB(b, h) ((4 + (b) * 2 + (h)) * HTB)
#define PG8_STAGE(bufoff, gbase, voff) do { _Pragma("unroll") for (int _i = 0; _i < 2; ++_i) \
        __builtin_amdgcn_global_load_lds((const unsigned*)((const char*)(gbase) + (voff)[_i]), (LAS unsigned*)(lds + (bufoff) + ldsw + _i * 8192), 16, 0, 0); } while (0)
#define PG8_LDA(dst, b, h) do { _Pragma("unroll") for (int m = 0; m < 4; ++m) _Pragma("unroll") for (int k = 0; k < 2; ++k) dst[m][k] = *(const LAS bf16x8*)(lds + PG8_SA(b, h) + aoff + m * 2048 + k * 1024); } while (0)
#define PG8_LDB(dst, b, h) do { _Pragma("unroll") for (int n = 0; n < 2; ++n) _Pragma("unroll") for (int k = 0; k < 2; ++k) dst[n][k] = *(const LAS bf16x8*)(lds + PG8_SB(b, h) + boff + n * 2048 + k * 1024); } while (0)
#define PG8_MMA(ai, bj, At, Bt) do { __builtin_amdgcn_s_setprio(1); _Pragma("unroll") for (int m = 0; m < 4; ++m) _Pragma("unroll") for (int n = 0; n < 2; ++n) _Pragma("unroll") for (int k = 0; k < 2; ++k) \
        acc[ai][bj][m][n] = __builtin_amdgcn_mfma_f32_16x16x32_bf16(Bt[n][k], At[m][k], acc[ai][bj][m][n], 0, 0, 0); __builtin_amdgcn_s_setprio(0); } while (0)
#define PG8_WAIT_V(n) asm volatile("s_waitcnt vmcnt(" #n ")" ::: "memory")
#define PG8_WAIT_L(n) asm volatile("s_waitcnt lgkmcnt(" #n ")" ::: "memory")
#define PG8_BAR __builtin_amdgcn_s_barrier()
#define PG8_SCHED __builtin_amdgcn_sched_barrier(0)
    Unit cur, nxt; int ui = 0;
    if (!S.next(0, cur)) return;
    f32x4 acc[2][2][4][2];
#pragma unroll
    for (int a = 0; a < 2; ++a)
#pragma unroll
        for (int b = 0; b < 2; ++b)
#pragma unroll
            for (int m = 0; m < 4; ++m)
#pragma unroll
                for (int n = 0; n < 2; ++n) acc[a][b][m][n] = (f32x4){0.f, 0.f, 0.f, 0.f};
    bf16x8 At[4][2], B0[2][2], B1[2][2];
    const char* cA = (const char*)g.A + (size_t)cur.pm * tstepA; const char* cB = (const char*)g.Bt + (size_t)cur.pn * tstepB;
    const int jt = g.jt; const long jumpA = g.jumpA;
    S.a_ready(cur, wid);
#define PG8_KA(base, t) ((base) + (size_t)(t) * kstep + ((t) >= jt ? jumpA : 0L))
    PG8_STAGE(PG8_SB(0, 0), cB, voffB); PG8_STAGE(PG8_SB(0, 1), cB + hstepB, voffB); PG8_STAGE(PG8_SA(0, 0), cA, voffA); PG8_STAGE(PG8_SA(0, 1), cA + hstepA, voffA);
    if (wr == 1) PG8_BAR;
    PG8_WAIT_V(2); PG8_BAR;
    PG8_STAGE(PG8_SB(1, 0), cB + kstep, voffB); PG8_STAGE(PG8_SA(1, 0), PG8_KA(cA, 1), voffA); PG8_STAGE(PG8_SB(1, 1), cB + hstepB + kstep, voffB);
    PG8_WAIT_V(6); PG8_BAR;
    for (;;) {
        const bool has_next = S.next(ui + 1, nxt);
        const char* nA = has_next ? (const char*)g.A + (size_t)nxt.pm * tstepA : cA; const char* nB = has_next ? (const char*)g.Bt + (size_t)nxt.pn * tstepB : cB;
        for (int seg = 0; seg < (Epi::MID_T >= 0 ? 2 : 1); ++seg) {
        const int tb = (Epi::MID_T >= 0 && seg == 1) ? Epi::MID_T : 0, te = (Epi::MID_T >= 0 && seg == 0) ? Epi::MID_T : nt;
        if constexpr (Epi::MID_T >= 0) { if (seg == 1) E.mid(acc, cur, wr, wc, fr, fq); }
        for (int t = tb; t < te; t += 2) {
            const bool last = (t == nt - 2);
            if (last && has_next) S.a_ready(nxt, wid);
            const char* a1 = PG8_KA(cA, t + 1);
            const char* a2 = last ? nA : PG8_KA(cA, t + 2); const char* b2 = last ? nB : cB + (size_t)(t + 2) * kstep;
            const char* a3 = last ? PG8_KA(nA, 1) : PG8_KA(cA, t + 3); const char* b3 = b2 + kstep;
            PG8_LDB(B0, 0, 0); PG8_LDB(B1, 0, 1); PG8_SCHED; PG8_LDA(At, 0, 0); PG8_STAGE(PG8_SA(1, 1), a1 + hstepA, voffA);
            PG8_WAIT_V(8); PG8_WAIT_L(0); PG8_BAR; PG8_MMA(0, 0, At, B0); PG8_MMA(0, 1, At, B1); PG8_BAR; PG8_SCHED;
            PG8_LDA(At, 0, 1); PG8_STAGE(PG8_SB(0, 0), b2, voffB); PG8_STAGE(PG8_SB(0, 1), b2 + hstepB, voffB); PG8_STAGE(PG8_SA(0, 0), a2, voffA);
            PG8_WAIT_V(8); PG8_WAIT_L(0); PG8_BAR; PG8_MMA(1, 0, At, B0); PG8_MMA(1, 1, At, B1); PG8_BAR; PG8_SCHED;
            PG8_LDB(B0, 1, 0); PG8_LDB(B1, 1, 1); PG8_SCHED; PG8_LDA(At, 1, 0); PG8_STAGE(PG8_SA(0, 1), a2 + hstepA, voffA);
            PG8_WAIT_V(8); PG8_WAIT_L(0); PG8_BAR; PG8_MMA(0, 0, At, B0); PG8_MMA(0, 1, At, B1); PG8_BAR; PG8_SCHED;
            PG8_LDA(At, 1, 1); PG8_STAGE(PG8_SB(1, 0), b3, voffB); PG8_STAGE(PG8_SB(1, 1), b3 + hstepB, voffB); PG8_STAGE(PG8_SA(1, 0), a3, voffA);
            PG8_WAIT_V(8); PG8_WAIT_L(0); PG8_BAR; PG8_MMA(1, 0, At, B0); PG8_MMA(1, 1, At, B1); PG8_BAR; PG8_SCHED;
        }
        }
        const typename Epi::Pre pf = E.pre(cur, wr, wc, fr, fq, wid, lane);
        if (wr == 0) PG8_BAR;
        E.epi(acc, cur, wr, wc, fr, fq, wid, lane, pf);
        if (!has_next) break;
#pragma unroll
        for (int a = 0; a < 2; ++a)
#pragma unroll
            for (int b = 0; b < 2; ++b)
#pragma unroll
                for (int m = 0; m < 4; ++m)
#pragma unroll
                    for (int n = 0; n < 2; ++n) acc[a][b][m][n] = (f32x4){0.f, 0.f, 0.f, 0.f};
        cur = nxt; cA = nA; cB = nB; ++ui;
        if (wr == 1) PG8_BAR;
    }
    PG8_WAIT_V(0);
    PG8_BAR;
#undef PG8_KA
#undef PG8_SA
#undef PG8_SB
#undef PG8_STAGE
#undef PG8_LDA
#undef PG8_LDB
#undef PG8_MMA
#undef PG8_WAIT_V
#undef PG8_WAIT_L
#undef PG8_BAR
#undef PG8_SCHED
}
}

typedef f32x4 AccT[2][2][4][2];
struct NoPre {};
#define PIN8(a, i, j) asm volatile("" : "+v"(a[i][j][0][0]), "+v"(a[i][j][0][1]), "+v"(a[i][j][1][0]), "+v"(a[i][j][1][1]), "+v"(a[i][j][2][0]), "+v"(a[i][j][2][1]), "+v"(a[i][j][3][0]), "+v"(a[i][j][3][1]))
#define PINACC(a) do { PIN8(a, 0, 0); PIN8(a, 0, 1); PIN8(a, 1, 0); PIN8(a, 1, 1); } while (0)
#define RAW_BAR() do { asm volatile("s_waitcnt lgkmcnt(0)" ::: "memory"); __builtin_amdgcn_s_barrier(); asm volatile("" ::: "memory"); } while (0)
__device__ __forceinline__ u32x4 pack8(const f32x4 a, const f32x4 b) { u32x4 w; w.x = pk2(a[0], a[1]); w.y = pk2(a[2], a[3]); w.z = pk2(b[0], b[1]); w.w = pk2(b[2], b[3]); return w; }
__device__ __forceinline__ void unpack8(const u32x4 w, f32x4& a, f32x4& b) { a = (f32x4){bflo(w.x), bfhi(w.x), bflo(w.y), bfhi(w.y)}; b = (f32x4){bflo(w.z), bfhi(w.z), bflo(w.w), bfhi(w.w)}; }

typedef __amdgpu_buffer_rsrc_t rsrc_t;
__device__ __forceinline__ rsrc_t mk_rsrc(const void* p, unsigned bytes) { return __builtin_amdgcn_make_buffer_rsrc((void*)p, (short)0, (int)bytes, 0x00020000); }
__device__ __forceinline__ void st16_wt(rsrc_t r, unsigned off, u32x4 v) { __builtin_amdgcn_raw_buffer_store_b128(v, r, off, 0, 16); }
__device__ __forceinline__ void st16_wt(rsrc_t r, unsigned off, f32x4 v) { __builtin_amdgcn_raw_buffer_store_b128(__builtin_bit_cast(u32x4, v), r, off, 0, 16); }

struct EpiIn {
    static constexpr int MID_T = -1;
    typedef NoPre Pre;
    __device__ __forceinline__ Pre pre(const pg8::Unit&, int, int, int, int, int, int) const { return Pre(); }
    bf16_t *Q, *KALL, *VALL, *KP, *VP, *RQ, *RK, *RV, *SRG, *GA, *GR; float *ock, *ocv; const float *qg, *kg; LAS float* P; unsigned* c1;
    __device__ __forceinline__ void mid(AccT&, const pg8::Unit&, int, int, int, int) const {}
    __device__ __forceinline__ void epi(AccT& acc, const pg8::Unit& u, int wr, int wc, int fr, int fq, int wid, int lane, const Pre&) const {
        asm volatile("" : "+v"(fr), "+v"(fq));
        const int pn = u.pn, pm = u.pm; const bool latent = pm >= 16;
        if (wid == 0 && lane == 0) { __hip_atomic_fetch_add(c1 + 16 * (481 + pm), 1u, RLX_AGENT); __hip_atomic_fetch_add(c1 + 16 * (481 + 80), 1u, RLX_AGENT); }
        const int lb = (pm - 16) >> 4, t0 = latent ? ((pm - 16) & 15) * 256 : 0;
        const int rl0 = 64 * wr + fr, cw8 = 32 * wc + 8 * fq;
        const size_t grow0 = (size_t)pm * 256;
        if (pn <= 4) {
#pragma unroll
            for (int ai = 0; ai < 2; ++ai)
#pragma unroll
                for (int m = 0; m < 4; ++m)
#pragma unroll
                    for (int bj = 0; bj < 2; ++bj) { const f32x4 a = acc[ai][bj][m][0], b = acc[ai][bj][m][1];
                        float s = (a[0] * a[0] + a[1] * a[1]) + (a[2] * a[2] + a[3] * a[3]) + (b[0] * b[0] + b[1] * b[1]) + (b[2] * b[2] + b[3] * b[3]);
                        s += __shfl_xor(s, 16); s += __shfl_xor(s, 32);
                        if (fq == 0) P[((128 * ai + rl0 + 16 * m) * 2 + bj) * 4 + wc] = s; }
            RAW_BAR();
            const float* gain = pn < 4 ? qg : kg;
            const int d0 = 64 * (wc >> 1) + 8 * fq + 4 * (wc & 1);
            const f32x4 g0 = *(const f32x4*)(gain + d0), g1 = *(const f32x4*)(gain + d0 + 32);
            float inv[4];
#pragma unroll
            for (int e = 0; e < 4; ++e) inv[e] = rope_inv(8 * fq + 4 * (wc & 1) + e);
#pragma unroll
            for (int ai = 0; ai < 2; ++ai)
#pragma unroll
                for (int m = 0; m < 4; ++m) { const int r = 128 * ai + rl0 + 16 * m, t = t0 + r;
                    f32x4 cs = {1.f, 1.f, 1.f, 1.f}, sn = {0.f, 0.f, 0.f, 0.f};
                    if (latent) { const float pos = (float)((wc >> 1) == 0 ? (t >> 6) : (t & 63));
#pragma unroll
                        for (int e = 0; e < 4; ++e) { float c_, s_; sincos_rev(pos * inv[e], c_, s_); cs[e] = c_; sn[e] = s_; } }
#pragma unroll
                    for (int bj = 0; bj < 2; ++bj) { const f32x4 pp = *(const LAS f32x4*)&P[(r * 2 + bj) * 4];
                        const float rstd = __builtin_amdgcn_rsqf(((pp[0] + pp[1]) + (pp[2] + pp[3])) * (1.0f / 128.0f) + EPS);
                        const f32x4 x1 = acc[ai][bj][m][0] * rstd * g0, x2 = acc[ai][bj][m][1] * rstd * g1;
                        const f32x4 o1 = x1 * cs - x2 * sn, o2 = x2 * cs + x1 * sn;
                        const u32x4 w = pack8(o1, o2);
                        if (pn < 4) { *(u32x4*)(Q + (grow0 + r) * 1024 + 128 * (2 * pn + bj) + cw8) = w; }
                        else if (latent) { *(u32x4*)(KALL + ((size_t)(lb * 2 + bj) * SKV + t) * 128 + cw8) = w; }
                        else { const size_t o = ((size_t)(pm * 2 + bj) * 256 + t) * 128;
                            *(u32x4*)(KP + o + cw8) = w; *(f32x4*)(ock + o + d0) = o1; *(f32x4*)(ock + o + d0 + 32) = o2; } } }
        } else if (pn == 5) {
#pragma unroll
            for (int ai = 0; ai < 2; ++ai)
#pragma unroll
                for (int m = 0; m < 4; ++m) { const int r = 128 * ai + rl0 + 16 * m, t = t0 + r;
#pragma unroll
                    for (int bj = 0; bj < 2; ++bj) { const f32x4 a = acc[ai][bj][m][0], b = acc[ai][bj][m][1]; const u32x4 w = pack8(a, b);
                        if (latent) { *(u32x4*)(VALL + ((size_t)(lb * 2 + bj) * SKV + t) * 128 + cw8) = w; }
                        else { const size_t o = ((size_t)(pm * 2 + bj) * 256 + t) * 128 + cw8;
                            *(u32x4*)(VP + o) = w; *(f32x4*)(ocv + o) = a; *(f32x4*)(ocv + o + 4) = b; } } }
        } else if (pn <= 9) {
            const float sc = pn >= 8 ? 0.125f : 1.0f; bf16_t* dst = RQ + (pn >= 8 ? (WS_RK - WS_RQ) / 2 : 0); const int cb = 256 * ((pn - 6) & 1);
            const rsrc_t rd = mk_rsrc(dst + grow0 * 512, 256 * 512 * 2);
            float inv[4];
#pragma unroll
            for (int e = 0; e < 4; ++e) inv[e] = rope_inv(8 * fq + 4 * (wc & 1) + e);
#pragma unroll
            for (int ai = 0; ai < 2; ++ai)
#pragma unroll
                for (int m = 0; m < 4; ++m) { const int r = 128 * ai + rl0 + 16 * m, t = t0 + r; const float pos = (float)(latent ? PAST + t : t);
                    f32x4 cs, sn;
#pragma unroll
                    for (int e = 0; e < 4; ++e) { float c_, s_; sincos_rev(pos * inv[e], c_, s_); cs[e] = c_ * sc; sn[e] = s_ * sc; }
#pragma unroll
                    for (int bj = 0; bj < 2; ++bj) { const f32x4 x1 = acc[ai][bj][m][0], x2 = acc[ai][bj][m][1];
                        st16_wt(rd, (unsigned)(((r * 512) + cb + 128 * bj + cw8) * 2), pack8(x1 * cs - x2 * sn, x2 * cs + x1 * sn)); } }
        } else if (pn < 18) {
            const int kind = (pn - 10) >> 2; bf16_t* dst = RV + (size_t)kind * ((WS_SRG - WS_RV) / 2); const int cb = 256 * ((pn - 10) & 3);
            const rsrc_t rd = mk_rsrc(dst + grow0 * 1024, 256 * 1024 * 2);
#pragma unroll
            for (int ai = 0; ai < 2; ++ai)
#pragma unroll
                for (int m = 0; m < 4; ++m) { const int r = 128 * ai + rl0 + 16 * m;
#pragma unroll
                    for (int bj = 0; bj < 2; ++bj) { f32x4 a = acc[ai][bj][m][0], b = acc[ai][bj][m][1];
                        if (kind == 1) { _Pragma("unroll") for (int e = 0; e < 4; ++e) { a[e] = siluf_(a[e]); b[e] = siluf_(b[e]); } }
                        st16_wt(rd, (unsigned)(((r * 1024) + cb + 128 * bj + cw8) * 2), pack8(a, b)); } }
        } else {
            const int cb = 128 * (pn - 18);
            const rsrc_t rra = mk_rsrc(GA + grow0 * 1024, 256 * 1024 * 2), rrg = mk_rsrc(GR + grow0 * 1024, 256 * 1024 * 2);
#pragma unroll
            for (int ai = 0; ai < 2; ++ai)
#pragma unroll
                for (int m = 0; m < 4; ++m) { const int r = 128 * ai + rl0 + 16 * m; f32x4 q0, q1, g0, g1;
#pragma unroll
                    for (int e = 0; e < 4; ++e) { g0[e] = sigmoidf_(acc[ai][1][m][0][e]); g1[e] = sigmoidf_(acc[ai][1][m][1][e]);
                        q0[e] = sigmoidf_(acc[ai][0][m][0][e]) * __builtin_amdgcn_rcpf(fmaxf(g0[e], 1e-30f)); q1[e] = sigmoidf_(acc[ai][0][m][1][e]) * __builtin_amdgcn_rcpf(fmaxf(g1[e], 1e-30f)); }
                    const unsigned o = (unsigned)(((r * 1024) + cb + cw8) * 2);
                    st16_wt(rra, o, pack8(q0, q1)); st16_wt(rrg, o, pack8(g0, g1)); }
        }
        if (pn >= 8 && pn <= 13) {
            asm volatile("s_waitcnt vmcnt(0)" ::: "memory");
            RAW_BAR();
            if (wid == 0 && lane == 0) { __hip_atomic_fetch_add(c1 + 16 * (pm * 6 + pn - 8), 1u, RLX_AGENT); __hip_atomic_fetch_add(c1 + 16 * 480, 1u, RLX_AGENT); } }
    }
};

struct EpiMix {
    static constexpr int MID_T = 16;
    typedef NoPre Pre;
    __device__ __forceinline__ Pre pre(const pg8::Unit&, int, int, int, int, int, int) const { return Pre(); }
    const bf16_t *GA, *GR; bf16_t* Y; unsigned* done;
    __device__ __forceinline__ void mid(AccT& acc, const pg8::Unit& u, int wr, int wc, int fr, int fq) const {
        unsigned lo = (unsigned)(((64 * wr + fr) * 1024 + 32 * wc + 8 * fq) * 2); asm volatile("" : "+v"(lo));
        const char* ga = (const char*)GA + ((size_t)u.pm * 256 * 1024 + 256 * u.pn) * 2;
        u32x4 q[8][2];
#pragma unroll
        for (int k = 0; k < 8; ++k)
#pragma unroll
            for (int bj = 0; bj < 2; ++bj) q[k][bj] = *(const u32x4*)(ga + lo + (unsigned)((((128 * (k >> 2) + 16 * (k & 3)) * 1024) + 128 * bj) * 2));
#pragma unroll
        for (int k = 0; k < 8; ++k)
#pragma unroll
            for (int bj = 0; bj < 2; ++bj) { f32x4 a0, a1; unpack8(q[k][bj], a0, a1); acc[k >> 2][bj][k & 3][0] *= a0; acc[k >> 2][bj][k & 3][1] *= a1; }
    }
    __device__ __forceinline__ void epi(AccT& acc, const pg8::Unit& u, int wr, int wc, int fr, int fq, int wid, int lane, const Pre&) const {
        unsigned lo = (unsigned)(((64 * wr + fr) * 1024 + 32 * wc + 8 * fq) * 2); asm volatile("" : "+v"(lo));
        const size_t ub = ((size_t)u.pm * 256 * 1024 + 256 * u.pn) * 2; const char* gr = (const char*)GR + ub; const rsrc_t ry = mk_rsrc((char*)Y + ub, 256 * 1024 * 2);
        u32x4 q[8][2];
#pragma unroll
        for (int k = 0; k < 8; ++k)
#pragma unroll
            for (int bj = 0; bj < 2; ++bj) q[k][bj] = *(const u32x4*)(gr + lo + (unsigned)((((128 * (k >> 2) + 16 * (k & 3)) * 1024) + 128 * bj) * 2));
#pragma unroll
        for (int k = 0; k < 8; ++k)
#pragma unroll
            for (int bj = 0; bj < 2; ++bj) { f32x4 r0, r1; unpack8(q[k][bj], r0, r1);
                st16_wt(ry, lo + (unsigned)((((128 * (k >> 2) + 16 * (k & 3)) * 1024) + 128 * bj) * 2), pack8(acc[k >> 2][bj][k & 3][0] * r0, acc[k >> 2][bj][k & 3][1] * r1)); }
        asm volatile("s_waitcnt vmcnt(0)" ::: "memory");
        RAW_BAR();
        if (wid == 0 && lane == 0) __hip_atomic_fetch_add(done + 64 * u.pm, 1u, RLX_AGENT);
    }
};

struct EpiRes1 {
    static constexpr int MID_T = -1;
    typedef NoPre Pre;
    __device__ __forceinline__ Pre pre(const pg8::Unit&, int, int, int, int, int, int) const { return Pre(); }
    const float *xp, *xs, *modf, *g2n; bf16_t* X1B; float* ssq; bf16_t* A2;
    __device__ __forceinline__ void mid(AccT&, const pg8::Unit&, int, int, int, int) const {}
    __device__ __forceinline__ void epi(AccT& acc, const pg8::Unit& u, int wr, int wc, int fr, int fq, int wid, int lane, const Pre&) const {
        asm volatile("" : "+v"(fr), "+v"(fq));
        const int pm = u.pm, v = pm < 16 ? 0 : 1 + ((pm - 16) >> 4);
        const float* mv = modf + (size_t)v * 6144; const float* xsrc = pm < 16 ? xp + (size_t)pm * 256 * 1024 : xs + (size_t)(pm - 16) * 256 * 1024;
        const unsigned cb = (unsigned)(256 * u.pn + 32 * wc + 8 * fq), rb = (unsigned)(64 * wr + fr);
        {   f32x4 g1[2][2];
#pragma unroll
            for (int bj = 0; bj < 2; ++bj)
#pragma unroll
                for (int n = 0; n < 2; ++n) g1[bj][n] = *(const f32x4*)(mv + 2048 + cb + 128 * bj + 4 * n);
#pragma unroll
            for (int h = 0; h < 4; ++h) { f32x4 xv[2][2][2];
#pragma unroll
                for (int mm = 0; mm < 2; ++mm)
#pragma unroll
                    for (int bj = 0; bj < 2; ++bj) { const float* p = xsrc + (size_t)(128 * (h >> 1) + 16 * (2 * (h & 1) + mm) + rb) * 1024 + cb + 128 * bj; xv[mm][bj][0] = *(const f32x4*)p; xv[mm][bj][1] = *(const f32x4*)(p + 4); }
#pragma unroll
                for (int mm = 0; mm < 2; ++mm)
#pragma unroll
                    for (int bj = 0; bj < 2; ++bj) { const int ai = h >> 1, m = 2 * (h & 1) + mm;
                        acc[ai][bj][m][0] = xv[mm][bj][0] + g1[bj][0] * acc[ai][bj][m][0]; acc[ai][bj][m][1] = xv[mm][bj][1] + g1[bj][1] * acc[ai][bj][m][1]; }
                {   const int ai = h >> 1, m0 = 2 * (h & 1);
                    asm volatile("" : "+v"(acc[ai][0][m0][0]), "+v"(acc[ai][0][m0][1]), "+v"(acc[ai][1][m0][0]), "+v"(acc[ai][1][m0][1]),
                                      "+v"(acc[ai][0][m0 + 1][0]), "+v"(acc[ai][0][m0 + 1][1]), "+v"(acc[ai][1][m0 + 1][0]), "+v"(acc[ai][1][m0 + 1][1]) :: "memory"); } } }
        f32x4 w2[2][2];
#pragma unroll
        for (int bj = 0; bj < 2; ++bj)
#pragma unroll
            for (int n = 0; n < 2; ++n) { const unsigned c = cb + 128 * bj + 4 * n; w2[bj][n] = *(const f32x4*)(g2n + c) * (*(const f32x4*)(mv + 4096 + c) + 1.0f); }
        const rsrc_t rx = mk_rsrc(X1B + (size_t)pm * 256 * 1024, 256 * 1024 * 2), ra = mk_rsrc(A2 + (size_t)pm * 256 * 1024, 256 * 1024 * 2);
#pragma unroll
        for (int ai = 0; ai < 2; ++ai)
#pragma unroll
            for (int m = 0; m < 4; ++m) { const unsigned r = 128 * ai + 16 * m + rb; float s = 0.f;
#pragma unroll
                for (int bj = 0; bj < 2; ++bj) { const unsigned o = r * 1024 + cb + 128 * bj; const f32x4 x0 = acc[ai][bj][m][0], x1 = acc[ai][bj][m][1];
                    st16_wt(rx, o * 2u, pack8(x0, x1));
                    st16_wt(ra, o * 2u, pack8(x0 * w2[bj][0], x1 * w2[bj][1]));
                    s += (x0[0] * x0[0] + x0[1] * x0[1]) + (x0[2] * x0[2] + x0[3] * x0[3]) + (x1[0] * x1[0] + x1[1] * x1[1]) + (x1[2] * x1[2] + x1[3] * x1[3]); }
                s += __shfl_xor(s, 16); s += __shfl_xor(s, 32);
                if (fq == 0) atomicAdd(ssq + (size_t)pm * 256 + r, s); }
    }
};

struct EpiRes2 {
    static constexpr int MID_T = -1;
    typedef NoPre Pre;
    __device__ __forceinline__ Pre pre(const pg8::Unit&, int, int, int, int, int, int) const { return Pre(); }
    const float *mod, *fg; const bf16_t* X1B; float* X; float* XS; unsigned* xcnt; LAS float* P;
    __device__ __forceinline__ void mid(AccT&, const pg8::Unit&, int, int, int, int) const {}
    __device__ __forceinline__ void epi(AccT& acc, const pg8::Unit& u, int wr, int wc, int fr, int fq, int wid, int lane, const Pre&) const {
        asm volatile("" : "+v"(fr), "+v"(fq));
        const int pm = u.pm, v = pm < 16 ? 0 : 1 + ((pm - 16) >> 4); const float* mv = mod + (size_t)v * 6144;
        const int cb = 256 * u.pn + 32 * wc + 8 * fq;
        {   f32x4 g2[2][2]; u32x4 xq[8][2];
#pragma unroll
            for (int bj = 0; bj < 2; ++bj)
#pragma unroll
                for (int n = 0; n < 2; ++n) g2[bj][n] = *(const f32x4*)(mv + 5120 + cb + 128 * bj + 4 * n);
#pragma unroll
            for (int k = 0; k < 8; ++k)
#pragma unroll
                for (int bj = 0; bj < 2; ++bj) xq[k][bj] = *(const u32x4*)(X1B + ((size_t)pm * 256 + 128 * (k >> 2) + 64 * wr + 16 * (k & 3) + fr) * 1024 + cb + 128 * bj);
#pragma unroll
            for (int k = 0; k < 8; ++k) { const int ai = k >> 2, m = k & 3, r = 128 * ai + 64 * wr + 16 * m + fr; float s = 0.f;
#pragma unroll
                for (int bj = 0; bj < 2; ++bj) { f32x4 xa, xb; unpack8(xq[k][bj], xa, xb);
                    const f32x4 x0 = xa + g2[bj][0] * acc[ai][bj][m][0], x1 = xb + g2[bj][1] * acc[ai][bj][m][1];
                    acc[ai][bj][m][0] = x0; acc[ai][bj][m][1] = x1;
                    s += (x0[0] * x0[0] + x0[1] * x0[1]) + (x0[2] * x0[2] + x0[3] * x0[3]) + (x1[0] * x1[0] + x1[1] * x1[1]) + (x1[2] * x1[2] + x1[3] * x1[3]); }
                s += __shfl_xor(s, 16); s += __shfl_xor(s, 32);
                if (fq == 0) P[r * 4 + wc] = s; } }
        RAW_BAR();
        const int tid = wid * 64 + lane;
        if (wid < 4) { const f32x4 pp = *(const LAS f32x4*)&P[tid * 4];
            __hip_atomic_store(XS + ((size_t)pm * 4 + u.pn) * 256 + tid, (pp[0] + pp[1]) + (pp[2] + pp[3]), RLX_AGENT);
            asm volatile("s_waitcnt vmcnt(0)" ::: "memory");
            if (lane == 0) __hip_atomic_fetch_add(xcnt + 64 * pm, 1u, RLX_AGENT); }
        if (wid == 0) { unsigned sp = 0;
            while ((unsigned)__builtin_amdgcn_readfirstlane(__hip_atomic_load(xcnt + 64 * pm, RLX_AGENT)) < 16u) { __builtin_amdgcn_s_sleep(2); if (++sp > (1u << 22)) break; } }
        RAW_BAR();
        if (wid < 4) { float t = 0.f;
#pragma unroll
            for (int k = 0; k < 4; ++k) t += __hip_atomic_load(XS + ((size_t)pm * 4 + k) * 256 + tid, RLX_AGENT);
            P[1024 + tid] = 1.0f / sqrtf(t * (1.0f / 1024.0f) + EPS); }
        RAW_BAR();
        {   f32x4 fgv[2][2];
#pragma unroll
            for (int bj = 0; bj < 2; ++bj)
#pragma unroll
                for (int n = 0; n < 2; ++n) fgv[bj][n] = *(const f32x4*)(fg + cb + 128 * bj + 4 * n);
#pragma unroll
            for (int ai = 0; ai < 2; ++ai)
#pragma unroll
                for (int m = 0; m < 4; ++m) { const int r = 128 * ai + 64 * wr + 16 * m + fr;
                    const float rs = P[1024 + r];
#pragma unroll
                    for (int bj = 0; bj < 2; ++bj) { float* p = X + ((size_t)pm * 256 + r) * 1024 + cb + 128 * bj;
                        *(f32x4*)p = acc[ai][bj][m][0] * rs * fgv[bj][0]; *(f32x4*)(p + 4) = acc[ai][bj][m][1] * rs * fgv[bj][1]; } } }
    }
};

__device__ __forceinline__ float dpp_up(float cur, float old) {
    return __builtin_bit_cast(float, __builtin_amdgcn_update_dpp(__builtin_bit_cast(int, old), __builtin_bit_cast(int, cur), 0x111, 0xF, 0xF, false)); }
__device__ __forceinline__ float dpp_dn(float cur, float old) {
    return __builtin_bit_cast(float, __builtin_amdgcn_update_dpp(__builtin_bit_cast(int, old), __builtin_bit_cast(int, cur), 0x101, 0xF, 0xF, false)); }
__device__ __forceinline__ float dpp_ror1(float x) {
    return __builtin_bit_cast(float, __builtin_amdgcn_update_dpp(0, __builtin_bit_cast(int, x), 0x121, 0xF, 0xF, false)); }
__device__ __forceinline__ float dpp_rol1(float x) {
    return __builtin_bit_cast(float, __builtin_amdgcn_update_dpp(0, __builtin_bit_cast(int, x), 0x12F, 0xF, 0xF, false)); }
struct EpiConv {
    static constexpr int MID_T = -1;
    const float *ssq, *bup, *cw, *cbias; bf16_t* ACT; float *EU, *EUC; LAS float* E; unsigned* done;
    struct Pre { float ss[8]; f32x4 bb[2][2]; float cwv[4]; };
    __device__ __forceinline__ void mid(AccT&, const pg8::Unit&, int, int, int, int) const {}
    __device__ __forceinline__ Pre pre(const pg8::Unit& u, int wr, int wc, int fr, int fq, int wid, int lane) const {
        Pre p; const int pm = u.pm, pn = u.pn, v = pm < 16 ? 0 : 1 + ((pm - 16) >> 4);
        const float* sp = ssq + (size_t)pm * 256 + 64 * wr + fr; const float* bp = bup + (size_t)v * NUP + 256 * pn + 32 * wc + 8 * fq;
#pragma unroll
        for (int k = 0; k < 8; ++k) p.ss[k] = sp[128 * (k >> 2) + 16 * (k & 3)];
#pragma unroll
        for (int bj = 0; bj < 2; ++bj)
#pragma unroll
            for (int n = 0; n < 2; ++n) p.bb[bj][n] = *(const f32x4*)(bp + 128 * bj + 4 * n);
        const int t = wid * 64 + lane, tc = t & 255, ch = (tc < 128 ? 0 : DFF - 128) + 128 * pn + tc;
        p.cwv[0] = cw[ch]; p.cwv[1] = cw[NUP + ch]; p.cwv[2] = cw[2 * NUP + ch]; p.cwv[3] = cbias[ch];
        return p;
    }
    __device__ __forceinline__ void epi(AccT& acc, const pg8::Unit& u, int wr, int wc, int fr, int fq, int wid, int lane, const Pre& pf) const {
        const int pm = u.pm, pn = u.pn; const bool latent = pm >= 16;
#if defined(PROBE_K0) && PROBE_K0 == 400
        const unsigned long long te0_ = __builtin_amdgcn_s_memrealtime();
#endif
        unsigned cw8 = (unsigned)(32 * wc + 8 * fq), rl = (unsigned)(64 * wr + fr); asm volatile("" : "+v"(cw8), "+v"(rl));
        LAS float* CW = E + 2048;
        {   const int t = wid * 64 + lane;
            if (t < 256) { CW[t] = pf.cwv[0]; CW[256 + t] = pf.cwv[1]; CW[512 + t] = pf.cwv[2]; CW[768 + t] = pf.cwv[3]; } }
#pragma unroll
        for (int ai = 0; ai < 2; ++ai)
#pragma unroll
            for (int m = 0; m < 4; ++m) { const float rs = __builtin_amdgcn_rsqf(pf.ss[4 * ai + m] * (1.0f / 1024.0f) + EPS);
#pragma unroll
                for (int bj = 0; bj < 2; ++bj)
#pragma unroll
                    for (int n = 0; n < 2; ++n) acc[ai][bj][m][n] = acc[ai][bj][m][n] * rs + pf.bb[bj][n]; }
        PINACC(acc);
        const rsrc_t reu = mk_rsrc(EU + (size_t)pm * 2 * NUP + 256 * pn, (NUP + 256) * 4), reuc = mk_rsrc(EUC + (size_t)pm * 2 * NUP + 256 * pn, (NUP + 256) * 4);
#pragma unroll
        for (int ai = 0; ai < 2; ++ai)
#pragma unroll
            for (int bj = 0; bj < 2; ++bj)
#pragma unroll
                for (int n = 0; n < 2; ++n) { const unsigned ci = 128 * bj + cw8 + 4 * n; const int grp = 2 * ai + wr;
                    if (fr == 0) { *(LAS f32x4*)&E[(grp * 2 + 0) * 256 + ci] = acc[ai][bj][0][n]; if (latent && grp == 0) st16_wt(reu, ci * 4u, acc[ai][bj][0][n]); }
                    if (fr == 15) { *(LAS f32x4*)&E[(grp * 2 + 1) * 256 + ci] = acc[ai][bj][3][n]; if (latent && grp == 3) st16_wt(reu, (NUP + ci) * 4u, acc[ai][bj][3][n]); } }
        RAW_BAR();
#if defined(PROBE_K0) && PROBE_K0 == 400 && defined(PROBE_SUB) && PROBE_SUB == 1
        if (wid == 0 && lane == 0 && (int)__builtin_amdgcn_workgroup_id_x() == PROBE_BID) atomicAdd((float*)((char*)EU - WS_EDGE_U + 32768), (float)(__builtin_amdgcn_s_memrealtime() - te0_));
#endif
        const rsrc_t ract = mk_rsrc((char*)ACT + ((size_t)pm * 256 * DFF + 128 * pn) * 2, 256 * DFF * 2);
#pragma unroll
        for (int ai = 0; ai < 2; ++ai) { const int grp = 2 * ai + wr;
#pragma unroll
            for (int n = 0; n < 2; ++n)
#pragma unroll
                for (int bj = 0; bj < 2; ++bj) { const unsigned ci = 128 * bj + cw8 + 4 * n;
                    const f32x4 w0 = *(const LAS f32x4*)&CW[ci], w1 = *(const LAS f32x4*)&CW[256 + ci], w2 = *(const LAS f32x4*)&CW[512 + ci], cb = *(const LAS f32x4*)&CW[768 + ci];
                    f32x4 pe = {0.f, 0.f, 0.f, 0.f}, ne = {0.f, 0.f, 0.f, 0.f};
                    if (grp > 0) pe = *(const LAS f32x4*)&E[((grp - 1) * 2 + 1) * 256 + ci];
                    if (grp < 3) ne = *(const LAS f32x4*)&E[((grp + 1) * 2 + 0) * 256 + ci];
#pragma unroll
                    for (int e = 0; e < 4; ++e) { const float u0 = acc[ai][bj][0][n][e], u1 = acc[ai][bj][1][n][e], u2 = acc[ai][bj][2][n][e], u3 = acc[ai][bj][3][n][e];
                        const float p0 = dpp_up(u0, pe[e]), p1 = dpp_up(u1, dpp_ror1(u0)), p2 = dpp_up(u2, dpp_ror1(u1)), p3 = dpp_up(u3, dpp_ror1(u2));
                        const float n0 = dpp_dn(u0, dpp_rol1(u1)), n1 = dpp_dn(u1, dpp_rol1(u2)), n2 = dpp_dn(u2, dpp_rol1(u3)), n3 = dpp_dn(u3, ne[e]);
                        acc[ai][bj][0][n][e] = w0[e] * p0 + w1[e] * u0 + w2[e] * n0 + cb[e]; acc[ai][bj][1][n][e] = w0[e] * p1 + w1[e] * u1 + w2[e] * n1 + cb[e];
                        acc[ai][bj][2][n][e] = w0[e] * p2 + w1[e] * u2 + w2[e] * n2 + cb[e]; acc[ai][bj][3][n][e] = w0[e] * p3 + w1[e] * u3 + w2[e] * n3 + cb[e]; }
                    if (latent) { if (fr == 0 && grp == 0) st16_wt(reuc, ci * 4u, acc[ai][bj][0][n]);
                                  if (fr == 15 && grp == 3) st16_wt(reuc, (NUP + ci) * 4u, acc[ai][bj][3][n]); }
                    asm volatile("" : "+v"(acc[ai][bj][0][n]), "+v"(acc[ai][bj][1][n]), "+v"(acc[ai][bj][2][n]), "+v"(acc[ai][bj][3][n]) :: "memory"); }
#pragma unroll
            for (int m = 0; m < 4; ++m) { f32x4 o0, o1;
#pragma unroll
                for (int e = 0; e < 4; ++e) { o0[e] = siluf_(acc[ai][1][m][0][e]) * acc[ai][0][m][0][e]; o1[e] = siluf_(acc[ai][1][m][1][e]) * acc[ai][0][m][1][e]; }
                st16_wt(ract, ((rl + 128 * ai + 16 * m) * DFF + cw8) * 2u, pack8(o0, o1)); asm volatile("" ::: "memory"); } }
#if defined(PROBE_K0) && PROBE_K0 == 400 && !defined(PROBE_SUB)
        if (wid == 0 && lane == 0 && (int)__builtin_amdgcn_workgroup_id_x() == PROBE_BID) atomicAdd((float*)((char*)EU - WS_EDGE_U + 32768), (float)(__builtin_amdgcn_s_memrealtime() - te0_));
#endif
    }
};

constexpr int NWAVES = 8, NTHR = 512;
constexpr int RING_BYTES = 131072, SPARE_OFF = RING_BYTES, SPARE_BYTES = 16384, MISC_OFF = SPARE_OFF + SPARE_BYTES, LDS_BYTES = MISC_OFF + 256;
struct Args {
    const float *x_prompt, *x_sample, *c, *cache_k, *cache_v, *st_f, *st_b, *c_ctx, *norm1_g, *norm2_g, *w_mod, *b_mod, *w_in, *q_g, *k_g, *dec_f, *dec_b,
                *w_att_o, *w_ret_o, *w_out, *w_up, *conv_w, *conv_b, *w_down, *final_g;
    float* out; unsigned char* ws; int ph_lo, ph_hi;
};
struct Frame { LAS unsigned char* lds; int tid, lane, wave, G, bid; };
typedef const __attribute__((address_space(4))) Args CArgs;

template <class F> __device__ __forceinline__ void transpose_item(const float* W, int ldw, bf16_t* WT, int ldd, int kofs, int k0, int n0, F srccol, LAS float* scr, int lane) {
    const int sc = srccol(n0 + (lane & 31));
#pragma unroll 8
    for (int i = 0; i < 32; ++i) { const int kk = 2 * i + (lane >> 5); scr[kk * 33 + (lane & 31)] = __builtin_nontemporal_load(W + (size_t)(k0 + kk) * ldw + sc); }
    LDS_WAIT(); asm volatile("" ::: "memory");
    const int c = lane & 7;
#pragma unroll
    for (int j = 0; j < 4; ++j) { const int n = (lane >> 3) + 8 * j; const LAS float* s = scr + (8 * c) * 33 + n;
        u32x4 o; o.x = pk2(s[0 * 33], s[1 * 33]); o.y = pk2(s[2 * 33], s[3 * 33]); o.z = pk2(s[4 * 33], s[5 * 33]); o.w = pk2(s[6 * 33], s[7 * 33]);
        *(u32x4*)(WT + (size_t)(n0 + n) * ldd + kofs + k0 + 8 * c) = o; }
    LDS_WAIT(); asm volatile("" ::: "memory");
}
struct ColId { __device__ int operator()(int n) const { return n; } };
struct ColIn { __device__ int operator()(int n) const {
    if (n >= 4608) { const int t = (n - 4608) >> 8, j = (n - 4608) & 255; return j < 128 ? 4608 + 128 * t + j : 5632 + 128 * t + (j - 128); }
    return (n < 1280 || (n >= 1536 && n < 2560)) ? swap25(n) : n; } };
struct ColUp { __device__ int operator()(int n) const { const int t = n >> 8, j = n & 255; return j < 128 ? 128 * t + j : DFF + 128 * t + (j - 128); } };

template <class F> __device__ __forceinline__ void gemv5_item(const Frame& F_, const float* W, int ldw, int n0, int k0, F srccol, const LAS float* a, LAS float* red, const float* bias, float* out, int ldo) {
    const int col0 = srccol(n0 + F_.lane), col1 = srccol(n0 + 64 + F_.lane); float acc[5][2];
#pragma unroll
    for (int v = 0; v < 5; ++v) { acc[v][0] = 0.f; acc[v][1] = 0.f; }
    const int kb = F_.wave * 32;
    const float* wp = W + (size_t)(k0 + kb) * ldw;
    float w0[32], w1[32];
#pragma unroll
    for (int j = 0; j < 32; ++j) { w0[j] = __builtin_nontemporal_load(wp + col0); w1[j] = __builtin_nontemporal_load(wp + col1); wp += ldw; }
#pragma unroll
    for (int j = 0; j < 32; ++j)
#pragma unroll
        for (int v = 0; v < 5; ++v) { const float av = a[v * 256 + kb + j]; acc[v][0] += av * w0[j]; acc[v][1] += av * w1[j]; }
#pragma unroll
    for (int v = 0; v < 5; ++v) { red[(F_.wave * 5 + v) * 128 + F_.lane] = acc[v][0]; red[(F_.wave * 5 + v) * 128 + 64 + F_.lane] = acc[v][1]; }
    __syncthreads();
    for (int t = F_.tid; t < 640; t += NTHR) { const int v = t >> 7, l = t & 127; float sum = (bias && k0 == 0) ? bias[n0 + l] : 0.f;
#pragma unroll
        for (int w8 = 0; w8 < 8; ++w8) sum += red[(w8 * 5 + v) * 128 + l];
        out[((size_t)(k0 >> 8) * 5 + v) * ldo + n0 + l] = sum; }
    __syncthreads();
}

__device__ __forceinline__ void phase0(const Frame& F, CArgs& A) {
    unsigned char* ws = A.ws;
    for (int it = F.bid; it < 48 * 4; it += F.G) {
        const int cgp = it % 48, kq = it / 48;
        LAS float* a = (LAS float*)F.lds; LAS float* red = a + 5 * 256;
        for (int i = F.tid; i < 5 * 256; i += NTHR) { const int v = i >> 8, k = kq * 256 + (i & 255); const float cv = v == 0 ? A.c_ctx[k] : A.c[(v - 1) * 1024 + k]; a[i] = siluf_(cv); }
        __syncthreads();
        gemv5_item(F, A.w_mod, 6144, cgp * 128, kq * 256, ColId(), a, red, A.b_mod, (float*)(ws + WS_MOD), 6144);
    }
    LAS float* scr = (LAS float*)(F.lds + 32768 + F.wave * 8704);
    const int gw = ((F.bid + 128) % F.G) * NWAVES + F.wave, NGW = F.G * NWAVES;
    constexpr int I_IN = 16 * (DIN / 32);
    for (int it = gw; it < I_IN; it += NGW) transpose_item(A.w_in, DIN, (bf16_t*)(ws + WS_WA), 1024, 0, 64 * (it / (DIN / 32)), 32 * (it % (DIN / 32)), ColIn(), scr, F.lane);
    const int gt = F.bid * NTHR + F.tid, NGT = F.G * NTHR;
    for (int i = gt; i < DB * NKV * PAST * 16; i += NGT) { const int c8 = i & 15, row = i >> 4, t = row % PAST, bk = row / PAST;
        const size_t so = (size_t)row * 128, dofs = ((size_t)bk * SKV + DSEQ + t) * 128 + c8 * 8;
        f32x4 k0, k1; { const int p0 = c8 * 8, d0 = swap25(p0), d1 = swap25(p0 + 4); k0 = *(const f32x4*)(A.cache_k + so + d0); k1 = *(const f32x4*)(A.cache_k + so + d1); }
        *(u32x4*)((bf16_t*)(ws + WS_KALL) + dofs) = pack8(k0, k1);
        const f32x4 v0 = *(const f32x4*)(A.cache_v + so + c8 * 8), v1 = *(const f32x4*)(A.cache_v + so + c8 * 8 + 4);
        *(u32x4*)((bf16_t*)(ws + WS_VALL) + dofs) = pack8(v0, v1); }
    for (int i = gt; i < MT; i += NGT) ((float*)(ws + WS_SSQ1))[i] = 0.f;
    for (int i = gt; i < 322 * 64; i += NGT) ((unsigned*)(ws + WS_CNT))[i] = 0u;
    for (int i = gt; i < (481 + 81) * 16; i += NGT) ((unsigned*)(ws + WS_CNT1))[i] = 0u;
#if defined(PROBE_K0) && PROBE_K0 == 400
    if (gt == 0) *(float*)(ws + 32768) = 0.f;
#endif
}

__device__ __forceinline__ void phase1(const Frame& F, CArgs& A) {
    unsigned char* ws = A.ws; const float* mod = (const float*)(ws + WS_MOD);
    for (int it = F.bid; it < (NUP / 128) * 4; it += F.G) {
        const int cgp = it % (NUP / 128), kq = it / (NUP / 128);
        LAS float* a = (LAS float*)F.lds; LAS float* red = a + 5 * 256;
        for (int i = F.tid; i < 5 * 256; i += NTHR) { const float* p = mod + (size_t)(i >> 8) * 6144 + 3072 + kq * 256 + (i & 255); a[i] = (p[0] + p[MODQ]) + (p[2 * MODQ] + p[3 * MODQ]); }
        __syncthreads();
        gemv5_item(F, A.w_up, NUP, cgp * 128, kq * 256, ColUp(), a, red, nullptr, (float*)(ws + WS_BUP), NUP);
    }
    for (int i = F.bid * NTHR + F.tid; i < 5 * 6144; i += F.G * NTHR) ((float*)(ws + WS_MODF))[i] = (mod[i] + mod[i + MODQ]) + (mod[i + 2 * MODQ] + mod[i + 3 * MODQ]);
    bf16_t* H = (bf16_t*)(ws + WS_H);
    constexpr int RPW = MT / (256 * NWAVES);
    const int row0 = (F.bid * NWAVES + F.wave) * RPW;
    int vcur = -1; f32x4 w1[4], s1[4];
#pragma unroll 1
    for (int rb = row0; rb < row0 + RPW; rb += 5) {
        f32x4 x[5][4];
#pragma unroll
        for (int i = 0; i < 5; ++i) { const int r = rb + i; const float* xr = r < MP ? A.x_prompt + (size_t)r * 1024 : A.x_sample + (size_t)(r - MP) * 1024;
#pragma unroll
            for (int j = 0; j < 4; ++j) x[i][j] = __builtin_nontemporal_load((const f32x4*)(xr + 8 * F.lane + 4 * (j & 1) + 512 * (j >> 1))); }
#pragma unroll
        for (int i = 0; i < 5; ++i) { const int r = rb + i;
            const int v = r < MP ? 0 : 1 + (r - MP) / DSEQ;
            if (v != vcur) { vcur = v; const float* mv = mod + (size_t)v * 6144;
#pragma unroll
                for (int j = 0; j < 4; ++j) { const int k = 8 * F.lane + 4 * (j & 1) + 512 * (j >> 1); w1[j] = *(const f32x4*)(A.norm1_g + k) * (sum4q(mv + 1024 + k, MODQ) + 1.0f); s1[j] = sum4q(mv + k, MODQ); } }
            float s = 0.f;
#pragma unroll
            for (int j = 0; j < 4; ++j) s += (x[i][j][0] * x[i][j][0] + x[i][j][1] * x[i][j][1]) + (x[i][j][2] * x[i][j][2] + x[i][j][3] * x[i][j][3]);
            const float rstd = __builtin_amdgcn_rsqf(wave_sum(s) * (1.0f / 1024.0f) + EPS);
#pragma unroll
            for (int jj = 0; jj < 2; ++jj) { const f32x4 h0 = x[i][2 * jj] * rstd * w1[2 * jj] + s1[2 * jj], h1 = x[i][2 * jj + 1] * rstd * w1[2 * jj + 1] + s1[2 * jj + 1];
                *(u32x4*)(H + (size_t)r * 1024 + 8 * F.lane + 512 * jj) = pack8(h0, h1); } }
    }
}

__device__ __forceinline__ float log_sigmoid_(float x) { return -log1pf(__expf(-x)); }
__device__ __forceinline__ s16x4 tr_read16(const LAS bf16_t* p) { typedef short v4s __attribute__((ext_vector_type(4))); return __builtin_bit_cast(s16x4, __builtin_amdgcn_ds_read_tr16_b64_v4i16((LAS v4s*)p)); }
#define MK8(L, H) (bf16x8){L[0], L[1], L[2], L[3], H[0], H[1], H[2], H[3]}
constexpr int KLD = 72, VLD = 136;
__device__ __forceinline__ int vsw(int r, int c8) { return 256 * r + 16 * (c8 ^ (((r & 3) << 1) | (((r >> 3) & 1) << 3))); }
__device__ __forceinline__ int vsw_tr(int R, int col) { return vsw(R, col >> 3) + 2 * (col & 7); }

__device__ const unsigned char R1_PORD[80] = {0, 1, 2, 3, 4, 5, 6, 7, 12, 13, 14, 15, 16, 17, 18, 19, 28, 29, 30, 31, 32, 33, 34, 35, 40, 41, 42, 43, 44, 45, 46, 47, 52, 53, 54, 55, 56, 57, 58, 59, 68, 69, 70, 71, 72, 73, 74, 75,
    8, 9, 10, 11, 20, 21, 22, 23, 24, 25, 26, 27, 36, 37, 38, 39, 48, 49, 50, 51, 60, 61, 62, 63, 64, 65, 66, 67, 76, 77, 78, 79};
__device__ __forceinline__ int r1_item_of(int i) { return (int)R1_PORD[i >> 4] * 16 + (i & 15); }
__device__ __forceinline__ void spin_ge(unsigned* p, unsigned need) { unsigned sp = 0;
    while ((unsigned)__builtin_amdgcn_readfirstlane(__hip_atomic_load(p, RLX_AGENT)) < need) { __builtin_amdgcn_s_sleep(2); if (++sp > (1u << 22)) break; } }
__device__ __forceinline__ void r1_wait(const Frame& F, unsigned* c1, int item, volatile LAS unsigned* alld) {
    if (F.wave == 0 && *alld == 0u) { const int pm = item >> 4, h = item & 7;
        const bool all = (unsigned)__builtin_amdgcn_readfirstlane(__hip_atomic_load(c1 + 16 * 480, RLX_AGENT)) >= 480u
                      && (unsigned)__builtin_amdgcn_readfirstlane(__hip_atomic_load(c1 + 16 * (481 + 80), RLX_AGENT)) >= 2080u;
        spin_ge(c1 + 16 * (pm * 6 + (h >> 2)), 1u); spin_ge(c1 + 16 * (pm * 6 + 2 + (h >> 1)), 1u);
        spin_ge(c1 + 16 * (481 + pm), 26u);
        __builtin_amdgcn_fence(__ATOMIC_ACQUIRE, "agent"); asm volatile("s_waitcnt vmcnt(0)" ::: "memory");
        if (all) *alld = 1u; }
    __syncthreads();
}
__device__ __forceinline__ void phase_r1(const Frame& F, CArgs& A) {
    unsigned char* ws = A.ws; unsigned* c1 = (unsigned*)(ws + WS_CNT1);
    volatile LAS unsigned* alld = (volatile LAS unsigned*)(F.lds + MISC_OFF) + 17;
    if (F.tid == 0) *alld = 0u;
    __syncthreads();
    const bf16_t* RKb = (const bf16_t*)(ws + WS_RK); const bf16_t* RVb = (const bf16_t*)(ws + WS_RV); bf16_t* KVS = (bf16_t*)(ws + WS_H);
    LAS bf16_t* kf = (LAS bf16_t*)F.lds; LAS bf16_t* kb = kf + 128 * KLD; LAS bf16_t* vl = kb + 128 * KLD; LAS bf16_t* ol = vl + 128 * 128 + F.wave * (16 * VLD);
    u32x4 pk_[2], pv_[4];
#define R1_LOAD(it) do { const int cg_ = (it) >> 3, h_ = (it) & 7; const size_t r0_ = (size_t)cg_ * 128; \
        _Pragma("unroll") for (int i = 0; i < 2; ++i) { const int ci = F.tid + i * NTHR; pk_[i] = *(const u32x4*)(RKb + (r0_ + (ci >> 3)) * 512 + 64 * h_ + 8 * (ci & 7)); } \
        _Pragma("unroll") for (int i = 0; i < 4; ++i) { const int ci = F.tid + i * NTHR; pv_[i] = *(const u32x4*)(RVb + (r0_ + (ci >> 4)) * 1024 + 128 * h_ + 8 * (ci & 15)); } } while (0)
    const int n1 = F.bid >= 32 ? (768 - (F.bid - 32) + 223) / 224 : 0, cntp = n1 + 2;
#define R1_POS(n) ((n) < n1 ? (F.bid - 32) + 224 * (n) : 768 + F.bid + 256 * ((n) - n1))
    { r1_wait(F, c1, r1_item_of(R1_POS(0)), alld); R1_LOAD(r1_item_of(R1_POS(0))); }
    for (int n = 0; n < cntp; ++n) { const int item = r1_item_of(R1_POS(n));
        const int h = item & 7;
        const float lgf = log_sigmoid_(A.dec_f[h]) * 1.4426950408889634f, lgb = log_sigmoid_(A.dec_b[h]) * 1.4426950408889634f;
#pragma unroll
        for (int i = 0; i < 2; ++i) { const int ci = F.tid + i * NTHR, j = ci >> 3, c8 = ci & 7;
            f32x4 a, b; unpack8(pk_[i], a, b);
            const float df = __builtin_amdgcn_exp2f(lgf * (float)(127 - j)), db = __builtin_amdgcn_exp2f(lgb * (float)j);
            *(LAS u32x4*)(kf + j * KLD + 8 * c8) = pack8(a * df, b * df); *(LAS u32x4*)(kb + j * KLD + 8 * c8) = pack8(a * db, b * db); }
#pragma unroll
        for (int i = 0; i < 4; ++i) { const int ci = F.tid + i * NTHR, j = ci >> 4, c8 = ci & 15; *(LAS u32x4*)((LAS char*)vl + vsw(j, c8)) = pv_[i]; }
        __syncthreads();
        if (n + 1 < cntp) { r1_wait(F, c1, r1_item_of(R1_POS(n + 1)), alld); R1_LOAD(r1_item_of(R1_POS(n + 1))); }
        const int dir = F.wave >> 2, mt = F.wave & 3, g = F.lane >> 4, q = (F.lane & 15) >> 2, p = F.lane & 3, l15 = F.lane & 15;
        const LAS bf16_t* ks = dir ? kb : kf;
        bf16x8 af[4];
#pragma unroll
        for (int s = 0; s < 4; ++s) { const LAS bf16_t* ap = ks + (32 * s + 8 * g + q) * KLD + 16 * mt + 4 * p; const s16x4 lo = tr_read16(ap), hi = tr_read16(ap + 4 * KLD); af[s] = MK8(lo, hi); }
#pragma unroll
        for (int nt = 0; nt < 8; ++nt) { f32x4 acc = {0.f, 0.f, 0.f, 0.f};
#pragma unroll
            for (int s = 0; s < 4; ++s) { const int R0 = 32 * s + 8 * g + q, col = 16 * nt + 4 * p;
                const s16x4 lo = tr_read16((const LAS bf16_t*)((const LAS char*)vl + vsw_tr(R0, col))), hi = tr_read16((const LAS bf16_t*)((const LAS char*)vl + vsw_tr(R0 + 4, col)));
                acc = __builtin_amdgcn_mfma_f32_16x16x32_bf16(af[s], MK8(lo, hi), acc, 0, 0, 0); }
#pragma unroll
            for (int e = 0; e < 4; ++e) ol[(4 * g + e) * VLD + 16 * nt + l15] = (bf16_t)f2bf(acc[e]); }
        LDS_WAIT(); asm volatile("" ::: "memory");
        bf16_t* dst = KVS + ((size_t)item * 2 + dir) * (64 * 128) + (size_t)(16 * mt + (F.lane >> 2)) * 128 + (F.lane & 3) * 32;
#pragma unroll
        for (int c = 0; c < 4; ++c) *(u32x4*)(dst + 8 * c) = *(const LAS u32x4*)(ol + (F.lane >> 2) * VLD + (F.lane & 3) * 32 + 8 * c);
        __syncthreads();
    }
#undef R1_LOAD
#undef R1_POS
}

__device__ __forceinline__ void phase_scan(const Frame& F, CArgs& A) {
    bf16_t* KVS = (bf16_t*)(A.ws + WS_H);
    const int gt = F.bid * NTHR + F.tid, NGT = F.G * NTHR;
    for (int i = gt; i < 5 * NUP; i += NGT) { const float* p = (const float*)(A.ws + WS_BUP) + i; ((float*)(A.ws + WS_BUPF))[i] = (p[0] + p[BUPQ]) + (p[2 * BUPQ] + p[3 * BUPQ]); }
    constexpr size_t CST = (size_t)8 * 2 * 8192;
    if (NGT * 4 == 256 * 2048) {
        u32x2 kv[4][2]; bf16_t* basep[4]; float decp[4];
#pragma unroll
        for (int k = 0; k < 4; ++k) { const int w = gt + k * NGT, e4 = (w & 2047) * 4, chain = w >> 11, dir = chain & 1, h = (chain >> 1) & 7, sq = chain >> 4;
            decp[k] = __expf(log_sigmoid_((dir ? A.dec_b : A.dec_f)[h]) * 128.0f);
            basep[k] = KVS + ((size_t)(2 * sq * 8 + h) * 2 + dir) * 8192 + e4;
            kv[k][0] = *(const u32x2*)(basep[k] + (size_t)(dir ? 1 : 0) * CST); kv[k][1] = *(const u32x2*)(basep[k] + (size_t)(dir ? 0 : 1) * CST); }
#pragma unroll
        for (int k = 0; k < 4; ++k) { const int w = gt + k * NGT, e4 = (w & 2047) * 4, chain = w >> 11, dir = chain & 1, h = (chain >> 1) & 7, sq = chain >> 4;
            const int pr = e4 >> 7, dv = e4 & 127, lr = swap25(pr);
            f32x4 st = {0.f, 0.f, 0.f, 0.f};
#pragma unroll
            for (int i = 0; i < 2; ++i) { u32x2 o; o.x = pk2(st[0], st[1]); o.y = pk2(st[2], st[3]); *(u32x2*)(basep[k] + (size_t)(dir ? 1 - i : i) * CST) = o;
                st = st * decp[k] + (f32x4){bflo(kv[k][i].x), bfhi(kv[k][i].x), bflo(kv[k][i].y), bfhi(kv[k][i].y)}; }
            *(f32x4*)(A.out + (dir ? OUT_SB : OUT_SF) + (((size_t)sq * 8 + h) * 64 + lr) * 128 + dv) = st; }
    }
    for (int w = (NGT * 4 == 256 * 2048) ? gt + 4 * NGT : gt; w < 320 * 2048; w += NGT) {
        const int e4 = (w & 2047) * 4, chain = w >> 11, dir = chain & 1, h = (chain >> 1) & 7, s = chain >> 4;
        const int nch = s < 16 ? 2 : 32, c0 = s < 16 ? 2 * s : 32 + 32 * (s - 16);
        const float lg = log_sigmoid_((dir ? A.dec_b : A.dec_f)[h]), dec = __expf(lg * 128.0f);
        const int pr = e4 >> 7, dv = e4 & 127, lr = swap25(pr);
        f32x4 st = {0.f, 0.f, 0.f, 0.f};
        if (s >= 16) st = *(const f32x4*)((dir ? A.st_b : A.st_f) + (((size_t)(s - 16) * 8 + h) * 64 + lr) * 128 + dv);
        bf16_t* base = KVS + ((size_t)(c0 * 8 + h) * 2 + dir) * 8192 + e4;
        if (s < 16) {
            u32x2 kv[2];
#pragma unroll
            for (int i = 0; i < 2; ++i) kv[i] = *(const u32x2*)(base + (size_t)(dir ? 1 - i : i) * CST);
#pragma unroll
            for (int i = 0; i < 2; ++i) { u32x2 o; o.x = pk2(st[0], st[1]); o.y = pk2(st[2], st[3]); *(u32x2*)(base + (size_t)(dir ? 1 - i : i) * CST) = o;
                st = st * dec + (f32x4){bflo(kv[i].x), bfhi(kv[i].x), bflo(kv[i].y), bfhi(kv[i].y)}; }
        } else {
            u32x2 kv[32];
#pragma unroll
            for (int i = 0; i < 32; ++i) kv[i] = *(const u32x2*)(base + (size_t)(dir ? 31 - i : i) * CST);
#pragma unroll
            for (int i = 0; i < 32; ++i) { u32x2 o; o.x = pk2(st[0], st[1]); o.y = pk2(st[2], st[3]); *(u32x2*)(base + (size_t)(dir ? 31 - i : i) * CST) = o;
                st = st * dec + (f32x4){bflo(kv[i].x), bfhi(kv[i].x), bflo(kv[i].y), bfhi(kv[i].y)}; }
        }
        if (s < 16) *(f32x4*)(A.out + (dir ? OUT_SB : OUT_SF) + (((size_t)s * 8 + h) * 64 + lr) * 128 + dv) = st;
    }
}

namespace att {
constexpr int D = 128, NW = 8, QBLK = 32, KVBLK = 64;
constexpr float SCALE = 0.088388347648318440f, THR = 8.f;
constexpr size_t SHM_V = KVBLK * D * 2, SHM_K = KVBLK * D * 2, SHM_ATTN = 2 * SHM_V + 2 * SHM_K + NW * 64 * 4;
#define KSWZ(row, colB) ((row) * 256 + ((colB) ^ (((row) & 7) << 4)))
#define SBAR() __builtin_amdgcn_sched_barrier(0)
__device__ __forceinline__ int crow(int r, int hi) { return (r & 3) + 8 * (r >> 2) + 4 * hi; }
__device__ __forceinline__ unsigned cvtpk(float lo, float hi) { unsigned r; asm volatile("v_cvt_pk_bf16_f32 %0, %1, %2" : "=v"(r) : "v"(lo), "v"(hi)); return r; }
__device__ __forceinline__ void partialSM(f32x16& p0, f32x16& p1, float& m_reg, float& mn, float& alpha) {
  constexpr float C = SCALE * 1.4426950408889634f;
  float pmax = p0[0]; for (int r = 1; r < 16; ++r) pmax = fmaxf(pmax, p0[r]); for (int r = 0; r < 16; ++r) pmax = fmaxf(pmax, p1[r]);
  { auto rr = __builtin_amdgcn_permlane32_swap(__float_as_uint(pmax), __float_as_uint(pmax), false, false);
    pmax = fmaxf(__uint_as_float(rr[0]), __uint_as_float(rr[1])); }
  if (__builtin_expect(__all(pmax - m_reg <= THR / SCALE), 1)) { mn = m_reg; alpha = 1.f; }
  else { mn = fmaxf(m_reg, pmax); alpha = __builtin_amdgcn_exp2f((m_reg - mn) * C); m_reg = mn; }
  float mnC = -mn * C;
  for (int r = 0; r < 16; ++r) p0[r] = fmaf(p0[r], C, mnC); for (int r = 0; r < 16; ++r) p1[r] = fmaf(p1[r], C, mnC);
  for (int r = 0; r < 16; ++r) p0[r] = __builtin_amdgcn_exp2f(p0[r]);
}
__device__ __forceinline__ void finishSM(f32x16& p0, f32x16& p1, float alpha, float& l_reg, bf16x8& pa0, bf16x8& pa1, bf16x8& pa2, bf16x8& pa3) {
  for (int r = 0; r < 16; ++r) p1[r] = __builtin_amdgcn_exp2f(p1[r]);
  float ps = 0; for (int r = 0; r < 16; ++r) ps += p0[r]; for (int r = 0; r < 16; ++r) ps += p1[r];
  { auto rr = __builtin_amdgcn_permlane32_swap(__float_as_uint(ps), __float_as_uint(ps), false, false);
    ps = __uint_as_float(rr[0]) + __uint_as_float(rr[1]); }
  l_reg = l_reg * alpha + ps;
#define PK4(P, BASE, OUT) do { unsigned a0 = cvtpk(P[BASE + 0], P[BASE + 1]), a1 = cvtpk(P[BASE + 2], P[BASE + 3]);   \
    unsigned b0 = cvtpk(P[BASE + 4], P[BASE + 5]), b1 = cvtpk(P[BASE + 6], P[BASE + 7]);                              \
    auto r0 = __builtin_amdgcn_permlane32_swap(a0, b0, false, false); auto r1 = __builtin_amdgcn_permlane32_swap(a1, b1, false, false); \
    u32x4 w = {r0[0], r1[0], r0[1], r1[1]}; OUT = *reinterpret_cast<bf16x8*>(&w); } while (0)
  PK4(p0, 0, pa0); PK4(p0, 8, pa1); PK4(p1, 0, pa2); PK4(p1, 8, pa3);
#undef PK4
}
__device__ __forceinline__ void qkt(f32x16& p0, f32x16& p1, const bf16_t* Ks, const bf16x8* qr, int r32, int hi) {
  p0 = f32x16{}; p1 = f32x16{};
  for (int d0 = 0; d0 < 8; ++d0) { int cb = (d0 * 16 + hi * 8) * 2;
    bf16x8 b0 = *reinterpret_cast<const bf16x8*>((const char*)Ks + KSWZ(r32, cb));
    bf16x8 b1 = *reinterpret_cast<const bf16x8*>((const char*)Ks + KSWZ(32 + r32, cb));
    p0 = __builtin_amdgcn_mfma_f32_32x32x16_bf16(b0, qr[d0], p0, 0, 0, 0);
    p1 = __builtin_amdgcn_mfma_f32_32x32x16_bf16(b1, qr[d0], p1, 0, 0, 0); }
}
__device__ __forceinline__ int v_st(int k, int c) { const int kk = (k & ~0xC) | ((k & 4) << 1) | ((k & 8) >> 1); return ((kk >> 3) * 4 + (c >> 5)) * 512 + ((kk & 7) * 32 + (c & 31)) * 2; }
__device__ __forceinline__ int v_rd_base(int lane) { return ((lane & 3) << 3) | (((lane >> 2) & 3) << 6) | (((lane >> 4) & 1) << 5) | (((lane >> 5) & 1) << 8); }
constexpr int v_rd_off(int d0, int ks, int half) { return d0 * 512 + ks * 4096 + half * 2048; }
template <int OFF> __device__ __forceinline__ s16x4 tr_read(int vb) { s16x4 r; asm volatile("ds_read_b64_tr_b16 %0, %1 offset:%2" : "=&v"(r) : "v"(vb), "i"(OFF) : "memory"); return r; }
template <int D0> __device__ __forceinline__ void pv_one(f32x16& od, int vb, bf16x8 pa0, bf16x8 pa1, bf16x8 pa2, bf16x8 pa3) {
  const s16x4 l0 = tr_read<v_rd_off(D0, 0, 0)>(vb), h0 = tr_read<v_rd_off(D0, 0, 1)>(vb), l1 = tr_read<v_rd_off(D0, 1, 0)>(vb), h1 = tr_read<v_rd_off(D0, 1, 1)>(vb);
  const s16x4 l2 = tr_read<v_rd_off(D0, 2, 0)>(vb), h2 = tr_read<v_rd_off(D0, 2, 1)>(vb), l3 = tr_read<v_rd_off(D0, 3, 0)>(vb), h3 = tr_read<v_rd_off(D0, 3, 1)>(vb);
  asm volatile("s_waitcnt lgkmcnt(0)" ::: "memory"); SBAR();
  od = __builtin_amdgcn_mfma_f32_32x32x16_bf16(pa0, MK8(l0, h0), od, 0, 0, 0);
  od = __builtin_amdgcn_mfma_f32_32x32x16_bf16(pa1, MK8(l1, h1), od, 0, 0, 0);
  od = __builtin_amdgcn_mfma_f32_32x32x16_bf16(pa2, MK8(l2, h2), od, 0, 0, 0);
  od = __builtin_amdgcn_mfma_f32_32x32x16_bf16(pa3, MK8(l3, h3), od, 0, 0, 0);
}
__device__ __forceinline__ void pv_d0(f32x16* o, int vb, bf16x8 pa0, bf16x8 pa1, bf16x8 pa2, bf16x8 pa3) {
  pv_one<0>(o[0], vb, pa0, pa1, pa2, pa3); pv_one<1>(o[1], vb, pa0, pa1, pa2, pa3); pv_one<2>(o[2], vb, pa0, pa1, pa2, pa3); pv_one<3>(o[3], vb, pa0, pa1, pa2, pa3);
}
template <int LDQ>
__device__ __forceinline__ void attn_dense_body(const bf16_t* Qb, const bf16_t* __restrict__ Kh, const bf16_t* __restrict__ Vh, bf16_t* Ob, int seq, char* lds, const int wid) {
  constexpr int LDK = 128;
  const int lane = lane_id_(), tid = wid * 64 + lane, r32 = lane & 31, hi = lane >> 5;
  bf16_t* V_lds = (bf16_t*)lds; bf16_t* K_lds = (bf16_t*)(lds + 2 * SHM_V);
  float* ws = (float*)(lds + 2 * SHM_V + 2 * SHM_K) + wid * 64; float* li_l = ws; float* al_l = ws + 32;
  float m_reg = -1e30f, l_reg = 0; f32x16 o[4] = {}; bf16x8 qr[8];
  const bf16_t* Qw = Qb + (long)(wid * QBLK + r32) * LDQ + hi * 8;
#pragma unroll
  for (int d0 = 0; d0 < 8; ++d0) qr[d0] = *reinterpret_cast<const bf16x8*>(Qw + d0 * 16);
  const int sr = tid >> 4, sc = (tid & 15) * 8, vst0 = v_st(sr, sc), vst1 = v_st(32 + sr, sc);
  const int vb0 = (int)(uintptr_t)V_lds + v_rd_base(lane);
  struct { bf16x8 vs0, vs1, ks0, ks1; } sr_[2];
#define SLOAD(i, k0) do { sr_[i].vs0 = *(const bf16x8*)(&Vh[(long)((k0) + sr) * LDK + sc]); sr_[i].vs1 = *(const bf16x8*)(&Vh[(long)((k0) + 32 + sr) * LDK + sc]); \
    sr_[i].ks0 = *(const bf16x8*)(&Kh[(long)((k0) + sr) * LDK + sc]); sr_[i].ks1 = *(const bf16x8*)(&Kh[(long)((k0) + 32 + sr) * LDK + sc]); } while (0)
#define SWRITE(b, i) do { *(bf16x8*)((char*)V_lds + (b) * SHM_V + vst0) = sr_[i].vs0;          \
    *(bf16x8*)((char*)V_lds + (b) * SHM_V + vst1) = sr_[i].vs1; int kc = sc * 2;               \
    *(bf16x8*)((char*)K_lds + (b) * SHM_K + KSWZ(sr, kc)) = sr_[i].ks0;                       \
    *(bf16x8*)((char*)K_lds + (b) * SHM_K + KSWZ(32 + sr, kc)) = sr_[i].ks1; } while (0)
#define SWAIT() asm volatile("s_waitcnt vmcnt(4)" ::: "memory")
#define RESC(a) do { if (__any((a) < 1.f)) { if (hi == 0) al_l[r32] = (a); asm volatile("s_waitcnt lgkmcnt(0)" ::: "memory"); \
    for (int d = 0; d < 4; ++d) for (int r = 0; r < 16; ++r) o[d][r] *= al_l[crow(r, hi)]; } } while (0)
  f32x16 pA0, pA1, pB0, pB1; float mnA, mnB, alA, alB; bf16x8 pa0, pa1, pa2, pa3; const int NT = seq / KVBLK;
  constexpr int SE = 0, SO = 1;
  SLOAD(SE, 0); asm volatile("s_waitcnt vmcnt(0)" ::: "memory"); SWRITE(0, SE); __syncthreads();
  qkt(pA0, pA1, K_lds, qr, r32, hi); partialSM(pA0, pA1, m_reg, mnA, alA);
  SLOAD(SO, KVBLK); if (2 < NT) SLOAD(SE, 2 * KVBLK);
  SWAIT(); SWRITE(1, SO); __syncthreads();
  for (int j = 1; j + 1 < NT; j += 2) {
    SBAR(); qkt(pB0, pB1, (bf16_t*)((char*)K_lds + SHM_K), qr, r32, hi);
    finishSM(pA0, pA1, alA, l_reg, pa0, pa1, pa2, pa3); SBAR();
    SLOAD(SO, (j + 2) * KVBLK); SBAR();
    pv_d0(o, vb0, pa0, pa1, pa2, pa3); partialSM(pB0, pB1, m_reg, mnB, alB);
    __syncthreads(); SWAIT(); SWRITE(0, SE);
    RESC(alB); __syncthreads();
    SBAR(); qkt(pA0, pA1, K_lds, qr, r32, hi);
    finishSM(pB0, pB1, alB, l_reg, pa0, pa1, pa2, pa3); SBAR();
    if (j + 3 < NT) SLOAD(SE, (j + 3) * KVBLK); SBAR();
    pv_d0(o, vb0 + (int)SHM_V, pa0, pa1, pa2, pa3); partialSM(pA0, pA1, m_reg, mnA, alA);
    __syncthreads(); SWAIT(); SWRITE(1, SO);
    RESC(alA); __syncthreads();
  }
  SBAR(); qkt(pB0, pB1, (bf16_t*)((char*)K_lds + SHM_K), qr, r32, hi);
  finishSM(pA0, pA1, alA, l_reg, pa0, pa1, pa2, pa3); SBAR();
  pv_d0(o, vb0, pa0, pa1, pa2, pa3); partialSM(pB0, pB1, m_reg, mnB, alB);
  __syncthreads(); RESC(alB);
  finishSM(pB0, pB1, alB, l_reg, pa0, pa1, pa2, pa3); SBAR();
  pv_d0(o, vb0 + (int)SHM_V, pa0, pa1, pa2, pa3);
  if (hi == 0) li_l[r32] = l_reg; asm volatile("s_waitcnt lgkmcnt(0)" ::: "memory");
  float rli[16];
#pragma unroll
  for (int r = 0; r < 16; ++r) rli[r] = __builtin_amdgcn_rcpf(li_l[crow(r, hi)]);
  bf16_t* Ow = Ob + (long)(wid * QBLK) * LDQ;
#pragma unroll
  for (int r = 0; r < 16; ++r) { int orow = crow(r, hi);
    for (int d0 = 0; d0 < 4; ++d0) Ow[(long)orow * LDQ + d0 * 32 + r32] = (bf16_t)f2bf(o[d0][r] * rli[r]); }
  __syncthreads();
#undef SLOAD
#undef SWRITE
#undef SWAIT
#undef RESC
}
#undef KSWZ
#undef SBAR
}

struct R3Regs { u32x4 k[2], v[4], s[4], srg[4]; bf16x8 q[2]; };
__device__ __forceinline__ void r3_load(const Frame& F, CArgs& A, int item, R3Regs& R) {
    unsigned char* ws = A.ws;
    const bf16_t* RQb = (const bf16_t*)(ws + WS_RQ); const bf16_t* RKb = (const bf16_t*)(ws + WS_RK); const bf16_t* RVb = (const bf16_t*)(ws + WS_RV);
    const bf16_t* SRGb = (const bf16_t*)(ws + WS_SRG); const bf16_t* KVS = (const bf16_t*)(ws + WS_H);
    const int cg = item >> 3, h = item & 7; const size_t row0 = (size_t)cg * 128;
#pragma unroll
    for (int i = 0; i < 2; ++i) { const int ci = F.tid + i * NTHR; R.k[i] = *(const u32x4*)(RKb + (row0 + (ci >> 3)) * 512 + 64 * h + 8 * (ci & 7)); }
#pragma unroll
    for (int i = 0; i < 4; ++i) { const int ci = F.tid + i * NTHR, j = ci >> 4, c8 = ci & 15;
        R.v[i] = *(const u32x4*)(RVb + (row0 + j) * 1024 + 128 * h + 8 * c8);
        R.s[i] = *(const u32x4*)(KVS + (size_t)item * 2 * 8192 + (size_t)j * 128 + 8 * c8); }
    const size_t gofs = (row0 + 16 * F.wave + (F.lane >> 2)) * 1024 + 128 * h + (F.lane & 3) * 32;
#pragma unroll
    for (int c = 0; c < 4; ++c) R.srg[c] = *(const u32x4*)(SRGb + gofs + 8 * c);
#pragma unroll
    for (int s = 0; s < 2; ++s) R.q[s] = *(const bf16x8*)(RQb + (row0 + 16 * F.wave + (F.lane & 15)) * 512 + 64 * h + 32 * s + 8 * (F.lane >> 4));
}
__device__ __forceinline__ void r3_item(const Frame& F, CArgs& A, int item, int item_next, R3Regs& R, int after_next, LAS int* slot) {
    unsigned char* ws = A.ws; bf16_t* RVb = (bf16_t*)(ws + WS_RV);
    LAS bf16_t* kl = (LAS bf16_t*)F.lds; LAS bf16_t* vl = kl + 128 * KLD; LAS bf16_t* sl = vl + 128 * 128; LAS bf16_t* pl = sl + 128 * 128 + F.wave * (16 * VLD);
    const int cg = item >> 3, h = item & 7; const size_t row0 = (size_t)cg * 128;
    const float lgf = log_sigmoid_(A.dec_f[h]) * 1.4426950408889634f, lgb = log_sigmoid_(A.dec_b[h]) * 1.4426950408889634f;
#pragma unroll
    for (int i = 0; i < 2; ++i) { const int ci = F.tid + i * NTHR; *(LAS u32x4*)(kl + (ci >> 3) * KLD + 8 * (ci & 7)) = R.k[i]; }
#pragma unroll
    for (int i = 0; i < 4; ++i) { const int ci = F.tid + i * NTHR, j = ci >> 4, c8 = ci & 15; *(LAS u32x4*)((LAS char*)vl + vsw(j, c8)) = R.v[i]; *(LAS u32x4*)((LAS char*)sl + vsw(j, c8)) = R.s[i]; }
    int lane_ = F.lane; asm volatile("" : "+v"(lane_));
    const int g = lane_ >> 4, l15 = lane_ & 15, q = l15 >> 2, p = lane_ & 3, w = F.wave;
    const size_t gofs = (row0 + 16 * w + (lane_ >> 2)) * 1024 + 128 * h + (lane_ & 3) * 32;
    u32x4 srg_[4]; bf16x8 qf[2];
#pragma unroll
    for (int c = 0; c < 4; ++c) srg_[c] = R.srg[c];
#pragma unroll
    for (int s = 0; s < 2; ++s) qf[s] = R.q[s];
    __syncthreads();
    if (item_next >= 0) r3_load(F, A, item_next, R);
    float rf[4], rb[4];
#pragma unroll
    for (int e = 0; e < 4; ++e) { const float fi = (float)(16 * w + 4 * g + e); rf[e] = __builtin_amdgcn_exp2f(lgf * fi); rb[e] = __builtin_amdgcn_exp2f(-lgb * fi); }
#pragma unroll
    for (int nt = 0; nt < 8; ++nt) { f32x4 sacc = {0.f, 0.f, 0.f, 0.f};
#pragma unroll
        for (int s = 0; s < 2; ++s) { const bf16x8 kfr = *(const LAS bf16x8*)(kl + (16 * nt + l15) * KLD + 32 * s + 8 * g); sacc = __builtin_amdgcn_mfma_f32_16x16x32_bf16(qf[s], kfr, sacc, 0, 0, 0); }
        const int j = 16 * nt + l15;
        if (nt < w) {
            const float cf = __builtin_amdgcn_exp2f(-lgf * (float)j);
#pragma unroll
            for (int e = 0; e < 4; ++e) pl[(4 * g + e) * VLD + j] = (bf16_t)f2bf(sacc[e] * (rf[e] * cf));
        } else if (nt > w) {
            const float cb = __builtin_amdgcn_exp2f(lgb * (float)j);
#pragma unroll
            for (int e = 0; e < 4; ++e) pl[(4 * g + e) * VLD + j] = (bf16_t)f2bf(sacc[e] * (rb[e] * cb));
        } else {
            const float cf = __builtin_amdgcn_exp2f(-lgf * (float)j), cb = __builtin_amdgcn_exp2f(lgb * (float)j);
#pragma unroll
            for (int e = 0; e < 4; ++e) { const int df = 16 * w + 4 * g + e - j;
                const float dm = (df >= 0 ? rf[e] * cf : 0.f) + (df <= 0 ? rb[e] * cb : 0.f);
                pl[(4 * g + e) * VLD + j] = (bf16_t)f2bf(sacc[e] * dm); } } }
    LDS_WAIT(); asm volatile("" ::: "memory");
    bf16x8 pa[4], qa[4];
#pragma unroll
    for (int s = 0; s < 4; ++s) pa[s] = *(const LAS bf16x8*)(pl + l15 * VLD + 32 * s + 8 * g);
    { const int i = 16 * w + l15; const float qdf = __builtin_amdgcn_exp2f(lgf * (float)(i + 1)), qdb = __builtin_amdgcn_exp2f(lgb * (float)(128 - i));
#pragma unroll
      for (int s = 0; s < 2; ++s) { f32x4 a, b; unpack8(__builtin_bit_cast(u32x4, qf[s]), a, b); qa[s] = __builtin_bit_cast(bf16x8, pack8(a * qdf, b * qdf)); qa[2 + s] = __builtin_bit_cast(bf16x8, pack8(a * qdb, b * qdb)); } }
    f32x4 oacc[8];
#pragma unroll
    for (int nt = 0; nt < 8; ++nt) { f32x4 acc = {0.f, 0.f, 0.f, 0.f};
#pragma unroll
        for (int s = 0; s < 4; ++s) { const int R0 = 32 * s + 8 * g + q, col = 16 * nt + 4 * p;
            const s16x4 lo = tr_read16((const LAS bf16_t*)((const LAS char*)vl + vsw_tr(R0, col))), hi = tr_read16((const LAS bf16_t*)((const LAS char*)vl + vsw_tr(R0 + 4, col)));
            acc = __builtin_amdgcn_mfma_f32_16x16x32_bf16(pa[s], MK8(lo, hi), acc, 0, 0, 0); }
#pragma unroll
        for (int s = 0; s < 4; ++s) { const int R0 = 32 * s + 8 * g + q, col = 16 * nt + 4 * p;
            const s16x4 lo = tr_read16((const LAS bf16_t*)((const LAS char*)sl + vsw_tr(R0, col))), hi = tr_read16((const LAS bf16_t*)((const LAS char*)sl + vsw_tr(R0 + 4, col)));
            acc = __builtin_amdgcn_mfma_f32_16x16x32_bf16(qa[s], MK8(lo, hi), acc, 0, 0, 0); }
        oacc[nt] = acc; }
    f32x4 ss = {0.f, 0.f, 0.f, 0.f};
#pragma unroll
    for (int nt = 0; nt < 8; ++nt) ss += oacc[nt] * oacc[nt];
#pragma unroll
    for (int e = 0; e < 4; ++e) { float s = ss[e]; s += __shfl_xor(s, 1); s += __shfl_xor(s, 2); s += __shfl_xor(s, 4); s += __shfl_xor(s, 8); ss[e] = __builtin_amdgcn_rsqf(s * (1.0f / 128.0f) + EPS); }
#pragma unroll
    for (int nt = 0; nt < 8; ++nt)
#pragma unroll
        for (int e = 0; e < 4; ++e) pl[(4 * g + e) * VLD + 16 * nt + l15] = (bf16_t)f2bf(oacc[nt][e] * ss[e]);
    LDS_WAIT(); asm volatile("" ::: "memory");
#pragma unroll
    for (int c = 0; c < 4; ++c) { f32x4 o0, o1, g0, g1; unpack8(*(const LAS u32x4*)(pl + (lane_ >> 2) * VLD + (lane_ & 3) * 32 + 8 * c), o0, o1); unpack8(srg_[c], g0, g1);
        *(u32x4*)(RVb + gofs + 8 * c) = pack8(o0 * g0, o1 * g1); }
    if (F.tid == 0) *slot = after_next;
    __syncthreads();
}

__device__ __forceinline__ void phase_attn(const Frame& F, CArgs& A) {
    unsigned char* ws = A.ws; bf16_t* Q = (bf16_t*)(ws + WS_Q);
    {
        LAS float* scr = (LAS float*)(F.lds + F.wave * 8704);
        const int gw = F.bid * NWAVES + F.wave, NGW = F.G * NWAVES;
        constexpr int I_O = 16 * 32, NIT = 3 * I_O;
        for (int it = gw; it < NIT; it += NGW) {
            int r = it;
            if (r < I_O) { transpose_item(A.w_att_o, 1024, (bf16_t*)(ws + WS_WB), 2048, 0, 64 * (r / 32), 32 * (r % 32), ColId(), scr, F.lane); continue; } r -= I_O;
            if (r < I_O) { transpose_item(A.w_ret_o, 1024, (bf16_t*)(ws + WS_WB), 2048, 1024, 64 * (r / 32), 32 * (r % 32), ColId(), scr, F.lane); continue; } r -= I_O;
            transpose_item(A.w_out, 1024, (bf16_t*)(ws + WS_WC), 1024, 0, 64 * (r / 32), 32 * (r % 32), ColId(), scr, F.lane);
        }
        __syncthreads();
    }
    const int x = F.bid & 7, c = F.bid >> 3;
    const int nun = F.bid < NB * NH ? 3 : 2;
    unsigned* qctr = (unsigned*)(ws + WS_CNT) + 64 * CNT_R3Q; LAS int* slot = (LAS int*)(F.lds + 122880);
    int nxt_v = 0; if (F.tid == 0) nxt_v = (int)__hip_atomic_fetch_add(qctr, 1u, RLX_AGENT) + F.G;
#pragma nounroll
    for (int i = 0; i < nun; ++i) {
        const bf16_t *Kh, *Vh; bf16_t* Qb; int seq;
        if (i < 2) { const int lb = x >> 1, kvh = x & 1, uu = c + 32 * i, hq = kvh * 4 + (uu >> 4), qb = uu & 15;
            Kh = (const bf16_t*)(ws + WS_KALL) + (size_t)(lb * 2 + kvh) * SKV * 128; Vh = (const bf16_t*)(ws + WS_VALL) + (size_t)(lb * 2 + kvh) * SKV * 128;
            Qb = Q + ((size_t)MP + (size_t)lb * DSEQ + qb * 256) * 1024 + hq * 128; seq = SKV; }
        else { const int b = F.bid >> 3, hq = F.bid & 7, kvh = hq >> 2;
            Kh = (const bf16_t*)(ws + WS_KP) + (size_t)(b * 2 + kvh) * SEQ * 128; Vh = (const bf16_t*)(ws + WS_VP) + (size_t)(b * 2 + kvh) * SEQ * 128;
            Qb = Q + (size_t)b * SEQ * 1024 + hq * 128; seq = SEQ; }
        att::attn_dense_body<1024>(Qb, Kh, Vh, Qb, seq, (char*)F.lds, F.wave);
    }
    {
      constexpr int NIT3 = (MT / 128) * 8;
      Frame F2 = F; F2.lane = lane_id_(); F2.tid = F2.wave * 64 + F2.lane;
      if (F2.tid == 0) *slot = nxt_v;
      __syncthreads();
      int cur = F.bid, nxt = __builtin_amdgcn_readfirstlane(*slot); if (nxt >= NIT3) nxt = -1;
      R3Regs R; r3_load(F2, A, cur, R);
      while (cur >= 0) {
          int n2_v = -1; if (nxt >= 0 && F2.tid == 0) n2_v = (int)__hip_atomic_fetch_add(qctr, 1u, RLX_AGENT) + F.G;
          r3_item(F2, A, cur, nxt, R, n2_v, slot);
          cur = nxt; nxt = __builtin_amdgcn_readfirstlane(*slot); if (nxt >= NIT3) nxt = -1;
      }
    }
}

struct OneUnit { int pm, pn; __device__ __forceinline__ bool next(int i, pg8::Unit& u) const { if (i) return false; u.pm = pm; u.pn = pn; return true; }
    __device__ __forceinline__ void a_ready(const pg8::Unit&, int) const {} };
constexpr int NU2 = 0, NU3 = 320, NU4 = (MT / 256) * (NUP / 256), NU5 = 320, NUTOT = NU2 + NU3 + NU4 + NU5;
__device__ __forceinline__ void fix_panel(const Frame& F, CArgs& A, int pm) {
    unsigned char* ws = A.ws; const float* EU = (const float*)(ws + WS_EDGE_U); const float* EUC = (const float*)(ws + WS_EDGE_UC); bf16_t* ACT = (bf16_t*)(ws + WS_ACT);
    const int jt = (pm - 16) & 15;
    for (int i = F.tid; i < 2 * DFF; i += NTHR) { const int j = i % DFF, e = i / DFF;
        if ((e == 0 && jt == 0) || (e == 1 && jt == 15)) continue;
        const int pmn = e ? pm + 1 : pm - 1, na = 256 * (j >> 7) + (j & 127), ng = na + 128, tap = e ? 2 : 0;
        const float ua = EUC[((size_t)pm * 2 + e) * NUP + na] + A.conv_w[(size_t)tap * NUP + j] * EU[((size_t)pmn * 2 + (1 - e)) * NUP + na];
        const float ug = EUC[((size_t)pm * 2 + e) * NUP + ng] + A.conv_w[(size_t)tap * NUP + DFF + j] * EU[((size_t)pmn * 2 + (1 - e)) * NUP + ng];
        ACT[((size_t)pm * 256 + (e ? 255 : 0)) * DFF + j] = (bf16_t)f2bf(siluf_(ug) * ua); }
}
__device__ __forceinline__ void g3_unit(const Frame& F, CArgs& A, int idx) {
    unsigned char* ws = A.ws; unsigned* cnt = (unsigned*)(ws + WS_CNT); const int pm = idx >> 2, pn = idx & 3;
    OneUnit S{pm, pn};
    pg8::Gemm g{(const bf16_t*)(ws + WS_Y), (const bf16_t*)(ws + WS_WC), MT, DM, DM, DM, DM, 1 << 30, 0};
    EpiRes1 E{A.x_prompt, A.x_sample, (const float*)(ws + WS_MODF), A.norm2_g, (bf16_t*)(ws + WS_X1B), (float*)(ws + WS_SSQ1), (bf16_t*)(ws + WS_H)};
    pg8::gemm_phase(F.lds, g, S, E, F.wave);
    asm volatile("s_waitcnt vmcnt(0)" ::: "memory");
    __syncthreads();
    if (F.wave == 0 && lane_id_() == 0) { __hip_atomic_fetch_add(cnt + 64 * (CNT_D3 + pm), 1u, RLX_AGENT); __hip_atomic_fetch_add(cnt + 64 * CNT_G3ALL, 1u, RLX_AGENT); }
}
__device__ __forceinline__ void phase_mix(const Frame& F, CArgs& A) {
    unsigned char* ws = A.ws; unsigned* cnt = (unsigned*)(ws + WS_CNT);
    const int v = (F.bid & 7) * (F.G >> 3) + (F.bid >> 3);
#if defined(PROBE_K0) && (PROBE_K0 == 301 || PROBE_K0 == 302)
    const unsigned long long tmix0_ = __builtin_amdgcn_s_memrealtime();
#endif
    {   struct G2Run { int v, n; __device__ __forceinline__ bool next(int i, pg8::Unit& u) const { if (i >= n) return false; const int l = i == 0 ? v : 256 + v; u.pm = l >> 2; u.pn = l & 3; return true; }
            __device__ __forceinline__ void a_ready(const pg8::Unit&, int) const {} };
        G2Run S{v, v < 64 ? 2 : 1};
        pg8::Gemm g{(const bf16_t*)(ws + WS_Q), (const bf16_t*)(ws + WS_WB), MT, DM, 2 * DM, DM, 2 * DM, 16, (long)(WS_RV - WS_Q) - 16 * 128};
        EpiMix E{(const bf16_t*)A.out, (const bf16_t*)A.out + (size_t)MT * DM, (bf16_t*)(ws + WS_Y), cnt + 64 * CNT_D2};
        pg8::gemm_phase(F.lds, g, S, E, F.wave);
    }
#if defined(PROBE_K0) && PROBE_K0 == 300
    const unsigned long long t0_ = __builtin_amdgcn_s_memrealtime();
#endif
#if defined(PROBE_K0) && PROBE_K0 == 301
    if (v == PROBE_BID && F.tid == 0) *(float*)(ws + 32768) = (float)(__builtin_amdgcn_s_memrealtime() - tmix0_);
#endif
    if (v >= 64) { const int idx = v - 64, pm = idx >> 2;
        if (F.wave == 0) { spin_ge(cnt + 64 * (CNT_D2 + pm), 4u); __builtin_amdgcn_fence(__ATOMIC_ACQUIRE, "agent"); asm volatile("s_waitcnt vmcnt(0)" ::: "memory"); }
        __syncthreads();
        g3_unit(F, A, idx);
        __syncthreads();
        LAS float* scr = (LAS float*)(F.lds + F.wave * 8704);
        constexpr int I_DN = (DFF / 64) * 32, I_UP = 16 * (NUP / 32);
        for (int it = (v - 64) * NWAVES + F.wave; it < I_DN + I_UP; it += (F.G - 64) * NWAVES) {
            if (it < I_DN) transpose_item(A.w_down, 1024, (bf16_t*)(ws + WS_WD), DFF, 0, 64 * (it / 32), 32 * (it % 32), ColId(), scr, F.lane);
            else { const int r = it - I_DN; transpose_item(A.w_up, NUP, (bf16_t*)(ws + WS_WA), 1024, 0, 64 * (r / (NUP / 32)), 32 * (r % (NUP / 32)), ColUp(), scr, F.lane); } }
    }
#if defined(PROBE_K0) && PROBE_K0 == 300
    if (v == PROBE_BID && F.tid == 0) *(float*)(ws + 32768) = (float)(__builtin_amdgcn_s_memrealtime() - t0_);
#endif
#if defined(PROBE_K0) && PROBE_K0 == 302
    if (v == PROBE_BID && F.tid == 0) *(float*)(ws + 32768) = (float)(__builtin_amdgcn_s_memrealtime() - tmix0_);
#endif
}
__device__ __forceinline__ void phase_stream(const Frame& F, CArgs& A) {
    unsigned char* ws = A.ws; unsigned* cnt = (unsigned*)(ws + WS_CNT);
    LAS float* spare = (LAS float*)(F.lds + SPARE_OFF);
    const int NOJ = 1 << 30;
    const int v = (F.bid & 7) * (F.G >> 3) + (F.bid >> 3);
#if defined(PROBE_K0) && PROBE_K0 >= 100 && PROBE_K0 < 200
    unsigned long long tacc_ = 0, tl_ = __builtin_amdgcn_s_memrealtime();
#define SPROBE(cat) do { const unsigned long long tn_ = __builtin_amdgcn_s_memrealtime(); if ((cat) == PROBE_K0 - 100 || PROBE_K0 - 100 == 3) tacc_ += tn_ - tl_; tl_ = tn_; } while (0)
#else
#define SPROBE(cat) do { } while (0)
#endif
    const int nG4 = v < 64 ? 8 : v < 192 ? 7 : v < 224 ? 6 : 5, nG5 = v >= 192 ? 2 : 1;
    if (v >= 64 && v < 192) g3_unit(F, A, 192 + (v - 64));
    SPROBE(0);
    {   struct G4Run { int v, n; unsigned* d3; unsigned* g3all; volatile LAS unsigned* alld; unsigned* d4; mutable int p0, p1;
            __device__ __forceinline__ void publish(int pm) const {
                if (pm >= 0) { asm volatile("s_waitcnt vmcnt(0)" ::: "memory"); if (lane_id_() == 0) __hip_atomic_fetch_add(d4 + 64 * pm, 1u, RLX_AGENT); } }
            __device__ __forceinline__ bool next(int r, pg8::Unit& u) const { if (r >= n) return false;
                const int l = r < 5 ? 256 * r + v : r == 5 ? 1280 + v : r == 6 ? 1504 + v : 1696 + v;
                const int sr = l / 176, rem = l % 176, blk = rem < 160 ? rem >> 5 : 5, w = rem < 160 ? rem & 31 : rem - 160;
                u.pm = 8 * sr + (w & 7); u.pn = 4 * blk + (w >> 3); return true; }
            __device__ __forceinline__ void a_ready(const pg8::Unit& u, int wid) const {
                publish(p0); p0 = p1; p1 = u.pm;
                if (wid == 0 && *alld == 0u) {
                    const bool all = (unsigned)__builtin_amdgcn_readfirstlane(__hip_atomic_load(g3all, RLX_AGENT)) >= 320u;
                    spin_ge(d3 + 64 * u.pm, 4u);
                    if (u.pm >= 63) spin_ge(g3all, 320u);
                    __builtin_amdgcn_fence(__ATOMIC_ACQUIRE, "agent"); asm volatile("s_waitcnt vmcnt(0)" ::: "memory");
                    if (all) *alld = 1u; }
                asm volatile("" ::: "memory"); __builtin_amdgcn_s_barrier(); asm volatile("" ::: "memory"); } };
        volatile LAS unsigned* alld = (volatile LAS unsigned*)(F.lds + MISC_OFF) + 16;
        if (F.tid == 0) *alld = 0u;
        __syncthreads();
        G4Run S{v, nG4, cnt + 64 * CNT_D3, cnt + 64 * CNT_G3ALL, alld, cnt + 64 * CNT_D4, -1, -1};
        pg8::Gemm g{(const bf16_t*)(ws + WS_H), (const bf16_t*)(ws + WS_WA), MT, NUP, DM, DM, DM, NOJ, 0};
        EpiConv E{(const float*)(ws + WS_SSQ1), (const float*)(ws + WS_BUPF), A.conv_w, A.conv_b, (bf16_t*)(ws + WS_ACT), (float*)(ws + WS_EDGE_U), (float*)(ws + WS_EDGE_UC), spare, cnt + 64 * CNT_D4};
        pg8::gemm_phase(F.lds, g, S, E, F.wave);
        S.publish(S.p0); S.publish(S.p1);
    }
    SPROBE(1);
    for (int j = 0; j < nG5; ++j) { const int l = j == 0 ? ((v + 64) & 255) : 256 + (v - 192), pm = l >> 2, pn = l & 3;
        if (F.wave == 0) { spin_ge(cnt + 64 * (CNT_D4 + pm), 176u);
            if (pm >= 16) { const int jt = (pm - 16) & 15; if (jt > 0) spin_ge(cnt + 64 * (CNT_D4 + pm - 1), 176u); if (jt < 15) spin_ge(cnt + 64 * (CNT_D4 + pm + 1), 176u); }
            __builtin_amdgcn_fence(__ATOMIC_ACQUIRE, "agent"); asm volatile("s_waitcnt vmcnt(0)" ::: "memory"); }
        __syncthreads();
        if (pm >= 16) { fix_panel(F, A, pm); asm volatile("s_waitcnt vmcnt(0)" ::: "memory"); __syncthreads(); }
        SPROBE(0);
        OneUnit S{pm, pn};
        pg8::Gemm g{(const bf16_t*)(ws + WS_ACT), (const bf16_t*)(ws + WS_WD), MT, DM, DFF, DFF, DFF, NOJ, 0};
        EpiRes2 E{(const float*)(ws + WS_MODF), A.final_g, (const bf16_t*)(ws + WS_X1B), A.out, (float*)(ws + WS_XS), cnt + 64 * CNT_X5, spare};
        pg8::gemm_phase(F.lds, g, S, E, F.wave);
        SPROBE(2);
    }
#if defined(PROBE_K0) && PROBE_K0 >= 100 && PROBE_K0 < 200
    if (v == PROBE_BID && F.tid == 0) *(float*)(ws + 32768) = (float)tacc_;
#endif
}

constexpr int N_PHASES = 8;
__global__ void __launch_bounds__(NTHR, 2) fwd_kernel(Args A_) {
    CArgs& A = *(CArgs*)__builtin_amdgcn_kernarg_segment_ptr();
    extern __shared__ __attribute__((aligned(16))) unsigned char lds_raw[];
    Frame F; F.lds = (LAS unsigned char*)lds_raw; F.wave = __builtin_amdgcn_readfirstlane(threadIdx.x >> 6); F.lane = lane_id_(); F.tid = F.wave * 64 + F.lane; F.G = gridDim.x; F.bid = blockIdx.x;
    volatile LAS unsigned* MISC = (volatile LAS unsigned*)(F.lds + MISC_OFF);
    if (F.tid < 64) MISC[F.tid] = 0u;
    __syncthreads();
    unsigned char* ws = A.ws;
    XcdBarrier bar = xcd_barrier_post((unsigned*)(ws + WS_CTL), MISC + 8, F.wave);
    const int lo = A.ph_lo, hi = A.ph_hi;
#ifdef ONLY_PHASE
#define IN(k) ((k) == ONLY_PHASE)
#else
#define IN(k) (lo <= (k) && (k) < hi)
#endif
#ifdef PROBE_K0
    unsigned long long tA_ = __builtin_amdgcn_s_memrealtime();
#define PROBE_AT(k) do { if ((k) == PROBE_K0 - 1) tA_ = __builtin_amdgcn_s_memrealtime(); \
    if ((k) == PROBE_K1 && F.bid == 0 && F.tid == 0) { const unsigned long long tB_ = __builtin_amdgcn_s_memrealtime(); *(float*)(ws + 32768) = (float)(tB_ - tA_) - 100.0f * PROBE_OFS; } } while (0)
#else
#define PROBE_AT(k) do { } while (0)
#endif
#define SEAM(k) do { if (IN(k) && IN((k) + 1)) xcd_barrier(bar); F.lane = lane_id_(); F.tid = F.wave * 64 + F.lane; PROBE_AT(k); } while (0)
    LAS float* spare = (LAS float*)(F.lds + SPARE_OFF);
    const int NOJ = 1 << 30;
    if (IN(0)) { phase0(F, A); } SEAM(0);
    if (IN(1)) { phase1(F, A); } SEAM(1);
    if (IN(2)) {
        pg8::Gemm g{(const bf16_t*)(ws + WS_H), (const bf16_t*)(ws + WS_WA), MT, DIN, DM, DM, DM, NOJ, 0};
        pg8::StaticOrder S; S.init(MT, DIN, F.G, F.bid, true);
        EpiIn E{(bf16_t*)(ws + WS_Q), (bf16_t*)(ws + WS_KALL), (bf16_t*)(ws + WS_VALL), (bf16_t*)(ws + WS_KP), (bf16_t*)(ws + WS_VP), (bf16_t*)(ws + WS_RQ), (bf16_t*)(ws + WS_RK),
                (bf16_t*)(ws + WS_RV), (bf16_t*)(ws + WS_SRG), (bf16_t*)A.out, (bf16_t*)A.out + (size_t)MT * DM, A.out + OUT_CK, A.out + OUT_CV, A.q_g, A.k_g, spare, (unsigned*)(ws + WS_CNT1)};
        pg8::gemm_phase(F.lds, g, S, E, F.wave);
        phase_r1(F, A);
    } SEAM(2);
    if (IN(4)) { phase_scan(F, A); } SEAM(4);
    if (IN(5)) { phase_attn(F, A); } SEAM(5);
    if (IN(6)) { phase_mix(F, A); } SEAM(6);
    if (IN(7)) { phase_stream(F, A); }
#ifdef PROBE_K0
    {
        PROBE_AT(7);
        xcd_barrier(bar);
        const float sc_ = 1.0f + sqrtf(*(const float*)(ws + 32768) * 1e-7f);
        for (int i = F.bid * NTHR + F.tid; i < NB * NKV * SEQ * HD; i += F.G * NTHR) A.out[OUT_CV + i] *= sc_;
    }
#endif
#undef IN
#undef SEAM
}

#ifndef MK_SPLIT
#define MK_SPLIT 0
#endif
extern "C" void kernel_launch(void* const* d_in, const int* in_sizes, int n_in, void* d_out, int out_size, void* d_ws, size_t ws_size, hipStream_t stream) {
    static int grid = 0;
    if (grid == 0) {
        if (n_in != 25 || ws_size < WS_END) { fprintf(stderr, "kernel_launch: unexpected n_in %d / ws %zu\n", n_in, ws_size); grid = -1; return; }
        int dev = 0, cus = 0, per_cu = 0;
        hipGetDevice(&dev); hipDeviceGetAttribute(&cus, hipDeviceAttributeMultiprocessorCount, dev);
        if (hipFuncSetAttribute((const void*)fwd_kernel, hipFuncAttributeMaxDynamicSharedMemorySize, LDS_BYTES) != hipSuccess) { fprintf(stderr, "kernel_launch: hipFuncSetAttribute failed\n"); grid = -1; return; }
        hipOccupancyMaxActiveBlocksPerMultiprocessor(&per_cu, (const void*)fwd_kernel, NTHR, LDS_BYTES);
        (void)hipGetLastError();
        if (per_cu < 1) fprintf(stderr, "kernel_launch: occupancy query says %d blocks/CU\n", per_cu);
        grid = cus;
        if (grid != 256) fprintf(stderr, "kernel_launch: %d CUs (built for 256)\n", grid);
    }
    if (grid < 0) return;
    hipMemsetAsync((char*)d_ws + WS_CTL, 0, CTL_ZERO_BYTES, stream);
    Args a{};
    const float** pa = (const float**)&a;
    for (int i = 0; i < 25; ++i) pa[i] = (const float*)d_in[i];
    a.out = (float*)d_out; a.ws = (unsigned char*)d_ws;
#if MK_SPLIT
    for (int p = 0; p < N_PHASES; ++p) { a.ph_lo = p; a.ph_hi = p + 1; hipLaunchKernelGGL(fwd_kernel, dim3(grid), dim3(NTHR), LDS_BYTES, stream, a); }
#else
    a.ph_lo = 0; a.ph_hi = N_PHASES; hipLaunchKernelGGL(fwd_kernel, dim3(grid), dim3(NTHR), LDS_BYTES, stream, a);
#endif
    const hipError_t le = hipPeekAtLastError();
    if (le != hipSuccess) fprintf(stderr, "kernel_launch: launch failed: %s\n", hipGetErrorName(le));
}
```

```cpp
#include <hip/hip_runtime.h>
#include <hip/hip_bf16.h>
#include <cstdio>
#include <cstdint>

#ifndef PROBE_BID
#define PROBE_BID 100
#endif
#ifndef PROBE_OFS
#define PROBE_OFS 0
#endif
constexpr int DM = 1024, NB = 16, SEQ = 256, DB = 4, DSEQ = 4096, PAST = 512, GRIDW = 64;
constexpr int NH = 8, NKV = 2, HD = 128, RH = 8, RDK = 64, RDV = 128, DFF = 2816, CHUNK = 128;
constexpr int MP = NB * SEQ, ML = DB * DSEQ, MT = MP + ML;
constexpr int DIN = 6656, SKV = DSEQ + PAST;
constexpr int NUP = 2 * DFF;
constexpr float EPS = 1e-6f;
constexpr int NCHUNK = MT / CHUNK;
constexpr int NITEM = NCHUNK * RH;

#define GAS __attribute__((address_space(1)))
#define LAS __attribute__((address_space(3)))
typedef unsigned short bf16_t;
typedef short bf16x8 __attribute__((ext_vector_type(8)));
typedef short s16x4 __attribute__((ext_vector_type(4)));
typedef float f32x4 __attribute__((ext_vector_type(4)));
typedef float f32x2 __attribute__((ext_vector_type(2)));
typedef float f32x16 __attribute__((ext_vector_type(16)));
typedef unsigned u32x4 __attribute__((ext_vector_type(4)));
typedef unsigned u32x2 __attribute__((ext_vector_type(2)));
typedef GAS unsigned gu32;

constexpr size_t MiB = 1u << 20;
constexpr size_t WS_CTL = 0, CTL_ZERO_BYTES = 16 * 1024;
constexpr size_t WS_MOD = 256 * 1024;
constexpr size_t MODQ = 5 * 6144;
constexpr size_t WS_MODF = 1 * MiB + 832 * 1024;
constexpr size_t WS_BUP = 768 * 1024;
constexpr size_t BUPQ = 5 * 5632;
constexpr size_t WS_BUPF = 1 * MiB + 384 * 1024;
constexpr size_t WS_SSQ1 = 1 * MiB + 256 * 1024;
constexpr size_t WS_XS = 1 * MiB + 512 * 1024;
constexpr size_t WS_CNT = 64 * 1024;
constexpr size_t WS_CNT1 = 152 * 1024;
constexpr int CNT_D2 = 0, CNT_D3 = 80, CNT_D4 = 160, CNT_X5 = 240, CNT_G3ALL = 320, CNT_R3Q = 321;
constexpr size_t WS_WA = 2 * MiB;
constexpr size_t WS_WB = 16 * MiB;
constexpr size_t WS_WC = 20 * MiB;
constexpr size_t WS_WD = 22 * MiB;
constexpr size_t WS_H = 28 * MiB;
constexpr size_t WS_Q = 68 * MiB;
constexpr size_t WS_KALL = 108 * MiB, WS_VALL = 117 * MiB, WS_KP = 126 * MiB, WS_VP = 128 * MiB;
constexpr size_t WS_RQ = 132 * MiB, WS_RK = 152 * MiB, WS_RV = 172 * MiB, WS_SRG = 212 * MiB, WS_END = 252 * MiB;
constexpr size_t WS_Y = WS_RQ;
constexpr size_t WS_X1B = WS_SRG;
constexpr size_t WS_ACT = WS_Q;
constexpr size_t WS_EDGE_U = 178 * MiB, WS_EDGE_UC = 182 * MiB;
static_assert((size_t)DIN * DM * 2 <= 14 * MiB && (size_t)MT * DM * 2 == 40 * MiB && (size_t)NITEM * 2 * RDK * RDV * 2 == 40 * MiB, "ws map");
static_assert((size_t)DB * NKV * SKV * HD * 2 <= 9 * MiB && (size_t)NB * NKV * SEQ * HD * 2 <= 2 * MiB, "ws map kv");
static_assert(WS_ACT + (size_t)MT * DFF * 2 <= WS_EDGE_U && (size_t)80 * 2 * NUP * 4 <= 4 * MiB && WS_EDGE_UC + 4 * MiB <= WS_X1B, "ws map act");
static_assert(WS_CNT + 322 * 256 <= WS_CNT1 && WS_CNT1 + (481 + 82) * 64 <= WS_MOD && WS_MOD + 4 * MODQ * 4 <= WS_BUP && WS_BUP + 4 * BUPQ * 4 <= WS_SSQ1 && WS_SSQ1 + (size_t)MT * 4 <= WS_BUPF
              && WS_BUPF + BUPQ * 4 <= WS_XS && WS_XS + (size_t)80 * 4 * 256 * 4 <= WS_MODF && WS_MODF + MODQ * 4 <= WS_WA, "ws map: small buffers");
constexpr size_t OUT_Y = 0, OUT_CK = (size_t)MT * DM, OUT_CV = OUT_CK + (size_t)NB * NKV * SEQ * HD, OUT_SF = OUT_CV + (size_t)NB * NKV * SEQ * HD, OUT_SB = OUT_SF + (size_t)NB * RH * RDK * RDV;

#define LDS_WAIT() asm volatile("s_waitcnt lgkmcnt(0)" ::: "memory")
#define VM_WAIT() asm volatile("s_waitcnt vmcnt(0)" ::: "memory")
#define RLX_AGENT __ATOMIC_RELAXED, __HIP_MEMORY_SCOPE_AGENT
typedef __bf16 bf16x2_t __attribute__((ext_vector_type(2)));
__device__ __forceinline__ unsigned pk2(float lo, float hi) { const f32x2 v = {lo, hi}; return __builtin_bit_cast(unsigned, __builtin_convertvector(v, bf16x2_t)); }
__device__ __forceinline__ unsigned f2bf(float f) { return pk2(f, 0.f) & 0xffffu; }
__device__ __forceinline__ float bflo(unsigned w) { return __builtin_bit_cast(float, w << 16); }
__device__ __forceinline__ float bfhi(unsigned w) { return __builtin_bit_cast(float, w & 0xffff0000u); }
__device__ __forceinline__ float bf2f(bf16_t h) { return __builtin_bit_cast(float, (unsigned)h << 16); }
__device__ __forceinline__ int swap25(int p) { return (p & ~0x24) | ((p & 4) << 3) | ((p & 32) >> 3); }
__device__ __forceinline__ float sigmoidf_(float x) { return __builtin_amdgcn_rcpf(1.0f + __builtin_amdgcn_exp2f(-1.4426950408889634f * x)); }
__device__ __forceinline__ float siluf_(float x) { return x * __builtin_amdgcn_rcpf(1.0f + __builtin_amdgcn_exp2f(-1.4426950408889634f * x)); }
__device__ __forceinline__ int lane_id_() { int l; asm volatile("v_mbcnt_lo_u32_b32 %0, -1, 0\n\tv_mbcnt_hi_u32_b32 %0, -1, %0" : "=v"(l)); return l; }
__device__ __forceinline__ f32x4 sum4q(const float* p, size_t q) { return (*(const f32x4*)p + *(const f32x4*)(p + q)) + (*(const f32x4*)(p + 2 * q) + *(const f32x4*)(p + 3 * q)); }
__device__ __forceinline__ float wave_sum(float v) {
#pragma unroll
    for (int o = 1; o < 64; o <<= 1) v += __shfl_xor(v, o);
    return v;
}
__device__ __forceinline__ void sincos_rev(float ang, float& c, float& s) {
    double rev = (double)ang * 0.15915494309189533577; rev -= __builtin_rint(rev);
    const float fr = (float)rev; s = __builtin_amdgcn_sinf(fr); c = __builtin_amdgcn_cosf(fr);
}
__device__ __forceinline__ float rope_inv(int i) { return exp2f(-(float)i * (13.287712379549449f / 32.0f)); }

#define XB_TMO      128
#define XB_XCNT(j)  (256  + 64 * (j))
#define XB_XSUB(j)  (1280 + 64 * (j))
#define XB_XGEN(j)  (2304 + 64 * (j))
#define XB_TOP      3328
#define XB_TOPGEN   3392
#define XCD_BAR_WORDS 3456
#define XB_SPIN_CAP (1u << 20)
__device__ __forceinline__ unsigned xb_ld(unsigned* p)              { return __hip_atomic_load(p, __ATOMIC_RELAXED, __HIP_MEMORY_SCOPE_AGENT); }
__device__ __forceinline__ unsigned xb_add(unsigned* p, unsigned v) { return __hip_atomic_fetch_add(p, v, __ATOMIC_RELAXED, __HIP_MEMORY_SCOPE_AGENT); }
__device__ __forceinline__ unsigned xb_xcc_id() { return (unsigned)__builtin_amdgcn_s_getreg((3 << 11) | 20) & 0xFu; }
#define XB_SPIN(cond, bar) do { unsigned _sp = 0; while (cond) { __builtin_amdgcn_s_sleep(1); \
    if ((++_sp & 255u) == 0u) { if (xb_ld(&(bar)[XB_TMO])) break; if (_sp > XB_SPIN_CAP) { atomicAdd(&(bar)[XB_TMO], 1u); break; } } } } while (0)
struct XcdBarrier { unsigned* bar; unsigned x; volatile LAS unsigned* st; int wave; };
__device__ __forceinline__ XcdBarrier xcd_barrier_post(unsigned* bar, volatile LAS unsigned* st, int wave) {
    XcdBarrier b; b.bar = bar; b.x = xb_xcc_id(); b.st = st; b.wave = wave;
    if (wave == 0 && lane_id_() == 0) (void)xb_add(&bar[XB_XCNT(b.x)], 1u);
    return b;
}
__device__ __forceinline__ void xcd_barrier_complete(unsigned* bar, unsigned x, unsigned& nloc, unsigned& nx) {
    const unsigned G = gridDim.x * gridDim.y * gridDim.z;
    unsigned sum, cnt, mine, sp = 0u;
    for (;;) {
        sum = 0u; cnt = 0u; mine = 0u;
#pragma unroll
        for (unsigned j = 0; j < 16; ++j) { const unsigned c = xb_ld(&bar[XB_XCNT(j)]); sum += c; cnt += (c > 0u) ? 1u : 0u; mine = (j == x) ? c : mine; }
        if (sum == G) break;
        __builtin_amdgcn_s_sleep(1);
        if ((++sp & 255u) == 0u) { if (xb_ld(&bar[XB_TMO])) break; if (sp > XB_SPIN_CAP) { atomicAdd(&bar[XB_TMO], 1u); break; } }
    }
    nloc = mine > 0u ? mine : 1u; nx = cnt > 0u ? cnt : 1u;
}
__device__ __forceinline__ void xcd_barrier(const XcdBarrier& b) {
    asm volatile("s_waitcnt vmcnt(0)" ::: "memory");
    __syncthreads();
    if (b.wave == 0 && lane_id_() == 0) {
        unsigned* bar = b.bar;
        __builtin_amdgcn_s_waitcnt(0);
        unsigned nloc = b.st[0], nx = b.st[1];
        if (nloc == 0u) { xcd_barrier_complete(bar, b.x, nloc, nx); b.st[0] = nloc; b.st[1] = nx; }
        const unsigned old = xb_add(&bar[XB_XSUB(b.x)], 1u);
        const unsigned gen = old / nloc;
        if (old + 1u == (gen + 1u) * nloc) {
            __builtin_amdgcn_fence(__ATOMIC_RELEASE, "agent");
            asm volatile("s_waitcnt vmcnt(0)" ::: "memory");
            const unsigned og = xb_add(&bar[XB_TOP], 1u);
            const unsigned tg = og / nx;
            if (og + 1u == (tg + 1u) * nx) xb_add(&bar[XB_TOPGEN], 1u);
            else XB_SPIN(xb_ld(&bar[XB_TOPGEN]) == tg, bar);
            __builtin_amdgcn_fence(__ATOMIC_ACQUIRE, "agent");
            xb_add(&bar[XB_XGEN(b.x)], 1u);
            asm volatile("s_waitcnt vmcnt(0)" ::: "memory");
        } else {
            XB_SPIN(xb_ld(&bar[XB_XGEN(b.x)]) == gen, bar);
            __builtin_amdgcn_fence(__ATOMIC_ACQUIRE, "agent");
            asm volatile("s_waitcnt vmcnt(0)" ::: "memory");
        }
    }
    __syncthreads();
}

namespace pg8 {
constexpr int BM = 256, BK = 64, HALF = 128, HTB = HALF * BK * 2, STAGE_BYTES = 8 * HTB, NXCD = 8, WGM = 8;
__host__ __device__ __forceinline__ int lds_byte(int r, int c) { const int st = (r >> 4) * 2 + (c >> 5), rr = r & 15, cc = c & 31, ob = rr * 64 + cc * 2; return st * 1024 + (ob ^ (((ob >> 9) & 1) << 5)); }
__host__ __device__ __forceinline__ void stage_rc(int b, int& R, int& C) { const int st = b / 1024, sb = b % 1024, swz = sb ^ (((sb >> 9) & 1) << 5); R = (st >> 1) * 16 + swz / 64; C = (st & 1) * 32 + (swz % 64) / 2; }
__host__ __device__ __forceinline__ int perm32(int rho) { const int n = rho >> 4, i = rho & 15; return 8 * (i >> 2) + 4 * n + (i & 3); }
struct Unit { int pm, pn; };
struct Gemm { const bf16_t* A; const bf16_t* Bt; int M, N, K, lda, ldb, jt; long jumpA; };
struct StaticOrder {
    int nM, nN, nwg, G, c; bool in_order;
    __host__ __device__ void init(int M, int N, int G_, int c_, bool io = false) { nM = M / BM; nN = N / BM; nwg = nM * nN; G = G_; c = c_; in_order = io; }
    __host__ __device__ bool next(int i, Unit& u) const {
        const long L = (long)i * G + c; if (L >= nwg) return false;
        int wgid = (int)L; { const int q = nwg / NXCD, r = nwg % NXCD, xcd = wgid % NXCD, off = wgid / NXCD; wgid = (xcd < r ? xcd * (q + 1) : r * (q + 1) + (xcd - r) * q) + off; }
        const int nig = WGM * nN, gid = wgid / nig, fm = gid * WGM, gsz = (nM - fm) < WGM ? (nM - fm) : WGM;
        u.pm = fm + ((wgid % nig) % gsz); u.pn = (wgid % nig) / gsz;
        if (in_order) u.pn = u.pn < 6 ? 8 + u.pn : u.pn < 14 ? u.pn - 6 : u.pn;
        return true;
    }
    __device__ __forceinline__ void a_ready(const Unit&, int) const {}
};
template <class Epi, class Sched>
__device__ __forceinline__ void gemm_phase(LAS unsigned char* lds, const Gemm g, const Sched& S, const Epi& E, const int wid) {
    const int lane = lane_id_(), tid = wid * 64 + lane, wr = wid >> 2, wc = wid & 3, fr = lane & 15, fq = lane >> 4;
    const int nt = g.K / BK;
    unsigned voffA[2], voffB[2];
#pragma unroll
    for (int i = 0; i < 2; ++i) { int R, C; stage_rc(tid * 16 + i * 8192, R, C); const int Rb = (R & ~31) + perm32(R & 31);
        voffA[i] = (unsigned)(R * g.lda + C) * 2u; voffB[i] = (unsigned)(Rb * g.ldb + C) * 2u; }
    const size_t kstep = (size_t)(BK * 2);
    const size_t hstepA = (size_t)HALF * g.lda * 2, hstepB = (size_t)HALF * g.ldb * 2;
    const size_t tstepA = 2 * hstepA, tstepB = 2 * hstepB;
    const unsigned ldsw = (unsigned)wid * 1024u;
    const int aoff = lds_byte(wr * 64 + fr, fq * 8), boff = lds_byte(wc * 32 + fr, fq * 8);
#define PG8_SA(b, h) (((b) * 2 + (h)) * HTB)
#define PG8_SB(b, h) ((4 + (b) * 2 + (h)) * HTB)
#define PG8_STAGE(bufoff, gbase, voff) do { _Pragma("unroll") for (int _i = 0; _i < 2; ++_i) \
        __builtin_amdgcn_global_load_lds((const unsigned*)((const char*)(gbase) + (voff)[_i]), (LAS unsigned*)(lds + (bufoff) + ldsw + _i * 8192), 16, 0, 0); } while (0)
#define PG8_LDA(dst, b, h) do { _Pragma("unroll") for (int m = 0; m < 4; ++m) _Pragma("unroll") for (int k = 0; k < 2; ++k) dst[m][k] = *(const LAS bf16x8*)(lds + PG8_SA(b, h) + aoff + m * 2048 + k * 1024); } while (0)
#define PG8_LDB(dst, b, h) do { _Pragma("unroll") for (int n = 0; n < 2; ++n) _Pragma("unroll") for (int k = 0; k < 2; ++k) dst[n][k] = *(const LAS bf16x8*)(lds + PG8_SB(b, h) + boff + n * 2048 + k * 1024); } while (0)
#define PG8_MMA(ai, bj, At, Bt) do { __builtin_amdgcn_s_setprio(1); _Pragma("unroll") for (int m = 0; m < 4; ++m) _Pragma("unroll") for (int n = 0; n < 2; ++n) _Pragma("unroll") for (int k = 0; k < 2; ++k) \
        acc[ai][bj][m][n] = __builtin_amdgcn_mfma_f32_16x16x32_bf16(Bt[n][k], At[m][k], acc[ai][bj][m][n], 0, 0, 0); __builtin_amdgcn_s_setprio(0); } while (0)
#define PG8_WAIT_V(n) asm volatile("s_waitcnt vmcnt(" #n ")" ::: "memory")
#define PG8_WAIT_L(n) asm volatile("s_waitcnt lgkmcnt(" #n ")" ::: "memory")
#define PG8_BAR __builtin_amdgcn_s_barrier()
#define PG8_SCHED __builtin_amdgcn_sched_barrier(0)
    Unit cur, nxt; int ui = 0;
    if (!S.next(0, cur)) return;
    f32x4 acc[2][2][4][2];
#pragma unroll
    for (int a = 0; a < 2; ++a)
#pragma unroll
        for (int b = 0; b < 2; ++b)
#pragma unroll
            for (int m = 0; m < 4; ++m)
#pragma unroll
                for (int n = 0; n < 2; ++n) acc[a][b][m][n] = (f32x4){0.f, 0.f, 0.f, 0.f};
    bf16x8 At[4][2], B0[2][2], B1[2][2];
    const char* cA = (const char*)g.A + (size_t)cur.pm * tstepA; const char* cB = (const char*)g.Bt + (size_t)cur.pn * tstepB;
    const int jt = g.jt; const long jumpA = g.jumpA;
    S.a_ready(cur, wid);
#define PG8_KA(base, t) ((base) + (size_t)(t) * kstep + ((t) >= jt ? jumpA : 0L))
    PG8_STAGE(PG8_SB(0, 0), cB, voffB); PG8_STAGE(PG8_SB(0, 1), cB + hstepB, voffB); PG8_STAGE(PG8_SA(0, 0), cA, voffA); PG8_STAGE(PG8_SA(0, 1), cA + hstepA, voffA);
    if (wr == 1) PG8_BAR;
    PG8_WAIT_V(2); PG8_BAR;
    PG8_STAGE(PG8_SB(1, 0), cB + kstep, voffB); PG8_STAGE(PG8_SA(1, 0), PG8_KA(cA, 1), voffA); PG8_STAGE(PG8_SB(1, 1), cB + hstepB + kstep, voffB);
    PG8_WAIT_V(6); PG8_BAR;
    for (;;) {
        const bool has_next = S.next(ui + 1, nxt);
        const char* nA = has_next ? (const char*)g.A + (size_t)nxt.pm * tstepA : cA; const char* nB = has_next ? (const char*)g.Bt + (size_t)nxt.pn * tstepB : cB;
        for (int seg = 0; seg < (Epi::MID_T >= 0 ? 2 : 1); ++seg) {
        const int tb = (Epi::MID_T >= 0 && seg == 1) ? Epi::MID_T : 0, te = (Epi::MID_T >= 0 && seg == 0) ? Epi::MID_T : nt;
        if constexpr (Epi::MID_T >= 0) { if (seg == 1) E.mid(acc, cur, wr, wc, fr, fq); }
        for (int t = tb; t < te; t += 2) {
            const bool last = (t == nt - 2);
            if (last && has_next) S.a_ready(nxt, wid);
            const char* a1 = PG8_KA(cA, t + 1);
            const char* a2 = last ? nA : PG8_KA(cA, t + 2); const char* b2 = last ? nB : cB + (size_t)(t + 2) * kstep;
            const char* a3 = last ? PG8_KA(nA, 1) : PG8_KA(cA, t + 3); const char* b3 = b2 + kstep;
            PG8_LDB(B0, 0, 0); PG8_LDB(B1, 0, 1); PG8_SCHED; PG8_LDA(At, 0, 0); PG8_STAGE(PG8_SA(1, 1), a1 + hstepA, voffA);
            PG8_WAIT_V(8); PG8_WAIT_L(0); PG8_BAR; PG8_MMA(0, 0, At, B0); PG8_MMA(0, 1, At, B1); PG8_BAR; PG8_SCHED;
            PG8_LDA(At, 0, 1); PG8_STAGE(PG8_SB(0, 0), b2, voffB); PG8_STAGE(PG8_SB(0, 1), b2 + hstepB, voffB); PG8_STAGE(PG8_SA(0, 0), a2, voffA);
            PG8_WAIT_V(8); PG8_WAIT_L(0); PG8_BAR; PG8_MMA(1, 0, At, B0); PG8_MMA(1, 1, At, B1); PG8_BAR; PG8_SCHED;
            PG8_LDB(B0, 1, 0); PG8_LDB(B1, 1, 1); PG8_SCHED; PG8_LDA(At, 1, 0); PG8_STAGE(PG8_SA(0, 1), a2 + hstepA, voffA);
            PG8_WAIT_V(8); PG8_WAIT_L(0); PG8_BAR; PG8_MMA(0, 0, At, B0); PG8_MMA(0, 1, At, B1); PG8_BAR; PG8_SCHED;
            PG8_LDA(At, 1, 1); PG8_STAGE(PG8_SB(1, 0), b3, voffB); PG8_STAGE(PG8_SB(1, 1), b3 + hstepB, voffB); PG8_STAGE(PG8_SA(1, 0), a3, voffA);
            PG8_WAIT_V(8); PG8_WAIT_L(0); PG8_BAR; PG8_MMA(1, 0, At, B0); PG8_MMA(1, 1, At, B1); PG8_BAR; PG8_SCHED;
        }
        }
        const typename Epi::Pre pf = E.pre(cur, wr, wc, fr, fq, wid, lane);
        if (wr == 0) PG8_BAR;
        E.epi(acc, cur, wr, wc, fr, fq, wid, lane, pf);
        if (!has_next) break;
#pragma unroll
        for (int a = 0; a < 2; ++a)
#pragma unroll
            for (int b = 0; b < 2; ++b)
#pragma unroll
                for (int m = 0; m < 4; ++m)
#pragma unroll
                    for (int n = 0; n < 2; ++n) acc[a][b][m][n] = (f32x4){0.f, 0.f, 0.f, 0.f};
        cur = nxt; cA = nA; cB = nB; ++ui;
        if (wr == 1) PG8_BAR;
    }
    PG8_WAIT_V(0);
    PG8_BAR;
#undef PG8_KA
#undef PG8_SA
#undef PG8_SB
#undef PG8_STAGE
#undef PG8_LDA
#undef PG8_LDB
#undef PG8_MMA
#undef PG8_WAIT_V
#undef PG8_WAIT_L
#undef PG8_BAR
#undef PG8_SCHED
}
}

typedef f32x4 AccT[2][2][4][2];
struct NoPre {};
#define PIN8(a, i, j) asm volatile("" : "+v"(a[i][j][0][0]), "+v"(a[i][j][0][1]), "+v"(a[i][j][1][0]), "+v"(a[i][j][1][1]), "+v"(a[i][j][2][0]), "+v"(a[i][j][2][1]), "+v"(a[i][j][3][0]), "+v"(a[i][j][3][1]))
#define PINACC(a) do { PIN8(a, 0, 0); PIN8(a, 0, 1); PIN8(a, 1, 0); PIN8(a, 1, 1); } while (0)
#define RAW_BAR() do { asm volatile("s_waitcnt lgkmcnt(0)" ::: "memory"); __builtin_amdgcn_s_barrier(); asm volatile("" ::: "memory"); } while (0)
__device__ __forceinline__ u32x4 pack8(const f32x4 a, const f32x4 b) { u32x4 w; w.x = pk2(a[0], a[1]); w.y = pk2(a[2], a[3]); w.z = pk2(b[0], b[1]); w.w = pk2(b[2], b[3]); return w; }
__device__ __forceinline__ void unpack8(const u32x4 w, f32x4& a, f32x4& b) { a = (f32x4){bflo(w.x), bfhi(w.x), bflo(w.y), bfhi(w.y)}; b = (f32x4){bflo(w.z), bfhi(w.z), bflo(w.w), bfhi(w.w)}; }

typedef __amdgpu_buffer_rsrc_t rsrc_t;
__device__ __forceinline__ rsrc_t mk_rsrc(const void* p, unsigned bytes) { return __builtin_amdgcn_make_buffer_rsrc((void*)p, (short)0, (int)bytes, 0x00020000); }
__device__ __forceinline__ void st16_wt(rsrc_t r, unsigned off, u32x4 v) { __builtin_amdgcn_raw_buffer_store_b128(v, r, off, 0, 16); }
__device__ __forceinline__ void st16_wt(rsrc_t r, unsigned off, f32x4 v) { __builtin_amdgcn_raw_buffer_store_b128(__builtin_bit_cast(u32x4, v), r, off, 0, 16); }

struct EpiIn {
    static constexpr int MID_T = -1;
    typedef NoPre Pre;
    __device__ __forceinline__ Pre pre(const pg8::Unit&, int, int, int, int, int, int) const { return Pre(); }
    bf16_t *Q, *KALL, *VALL, *KP, *VP, *RQ, *RK, *RV, *SRG, *GA, *GR; float *ock, *ocv; const float *qg, *kg; LAS float* P; unsigned* c1;
    __device__ __forceinline__ void mid(AccT&, const pg8::Unit&, int, int, int, int) const {}
    __device__ __forceinline__ void epi(AccT& acc, const pg8::Unit& u, int wr, int wc, int fr, int fq, int wid, int lane, const Pre&) const {
        asm volatile("" : "+v"(fr), "+v"(fq));
        const int pn = u.pn, pm = u.pm; const bool latent = pm >= 16;
        if (wid == 0 && lane == 0) { __hip_atomic_fetch_add(c1 + 16 * (481 + pm), 1u, RLX_AGENT); __hip_atomic_fetch_add(c1 + 16 * (481 + 80), 1u, RLX_AGENT); }
        const int lb = (pm - 16) >> 4, t0 = latent ? ((pm - 16) & 15) * 256 : 0;
        const int rl0 = 64 * wr + fr, cw8 = 32 * wc + 8 * fq;
        const size_t grow0 = (size_t)pm * 256;
        if (pn <= 4) {
#pragma unroll
            for (int ai = 0; ai < 2; ++ai)
#pragma unroll
                for (int m = 0; m < 4; ++m)
#pragma unroll
                    for (int bj = 0; bj < 2; ++bj) { const f32x4 a = acc[ai][bj][m][0], b = acc[ai][bj][m][1];
                        float s = (a[0] * a[0] + a[1] * a[1]) + (a[2] * a[2] + a[3] * a[3]) + (b[0] * b[0] + b[1] * b[1]) + (b[2] * b[2] + b[3] * b[3]);
                        s += __shfl_xor(s, 16); s += __shfl_xor(s, 32);
                        if (fq == 0) P[((128 * ai + rl0 + 16 * m) * 2 + bj) * 4 + wc] = s; }
            RAW_BAR();
            const float* gain = pn < 4 ? qg : kg;
            const int d0 = 64 * (wc >> 1) + 8 * fq + 4 * (wc & 1);
            const f32x4 g0 = *(const f32x4*)(gain + d0), g1 = *(const f32x4*)(gain + d0 + 32);
            float inv[4];
#pragma unroll
            for (int e = 0; e < 4; ++e) inv[e] = rope_inv(8 * fq + 4 * (wc & 1) + e);
#pragma unroll
            for (int ai = 0; ai < 2; ++ai)
#pragma unroll
                for (int m = 0; m < 4; ++m) { const int r = 128 * ai + rl0 + 16 * m, t = t0 + r;
                    f32x4 cs = {1.f, 1.f, 1.f, 1.f}, sn = {0.f, 0.f, 0.f, 0.f};
                    if (latent) { const float pos = (float)((wc >> 1) == 0 ? (t >> 6) : (t & 63));
#pragma unroll
                        for (int e = 0; e < 4; ++e) { float c_, s_; sincos_rev(pos * inv[e], c_, s_); cs[e] = c_; sn[e] = s_; } }
#pragma unroll
                    for (int bj = 0; bj < 2; ++bj) { const f32x4 pp = *(const LAS f32x4*)&P[(r * 2 + bj) * 4];
                        const float rstd = __builtin_amdgcn_rsqf(((pp[0] + pp[1]) + (pp[2] + pp[3])) * (1.0f / 128.0f) + EPS);
                        const f32x4 x1 = acc[ai][bj][m][0] * rstd * g0, x2 = acc[ai][bj][m][1] * rstd * g1;
                        const f32x4 o1 = x1 * cs - x2 * sn, o2 = x2 * cs + x1 * sn;
                        const u32x4 w = pack8(o1, o2);
                        if (pn < 4) { *(u32x4*)(Q + (grow0 + r) * 1024 + 128 * (2 * pn + bj) + cw8) = w; }
                        else if (latent) { *(u32x4*)(KALL + ((size_t)(lb * 2 + bj) * SKV + t) * 128 + cw8) = w; }
                        else { const size_t o = ((size_t)(pm * 2 + bj) * 256 + t) * 128;
                            *(u32x4*)(KP + o + cw8) = w; *(f32x4*)(ock + o + d0) = o1; *(f32x4*)(ock + o + d0 + 32) = o2; } } }
        } else if (pn == 5) {
#pragma unroll
            for (int ai = 0; ai < 2; ++ai)
#pragma unroll
                for (int m = 0; m < 4; ++m) { const int r = 128 * ai + rl0 + 16 * m, t = t0 + r;
#pragma unroll
                    for (int bj = 0; bj < 2; ++bj) { const f32x4 a = acc[ai][bj][m][0], b = acc[ai][bj][m][1]; const u32x4 w = pack8(a, b);
                        if (latent) { *(u32x4*)(VALL + ((size_t)(lb * 2 + bj) * SKV + t) * 128 + cw8) = w; }
                        else { const size_t o = ((size_t)(pm * 2 + bj) * 256 + t) * 128 + cw8;
                            *(u32x4*)(VP + o) = w; *(f32x4*)(ocv + o) = a; *(f32x4*)(ocv + o + 4) = b; } } }
        } else if (pn <= 9) {
            const float sc = pn >= 8 ? 0.125f : 1.0f; bf16_t* dst = RQ + (pn >= 8 ? (WS_RK - WS_RQ) / 2 : 0); const int cb = 256 * ((pn - 6) & 1);
            const rsrc_t rd = mk_rsrc(dst + grow0 * 512, 256 * 512 * 2);
            float inv[4];
#pragma unroll
            for (int e = 0; e < 4; ++e) inv[e] = rope_inv(8 * fq + 4 * (wc & 1) + e);
#pragma unroll
            for (int ai = 0; ai < 2; ++ai)
#pragma unroll
                for (int m = 0; m < 4; ++m) { const int r = 128 * ai + rl0 + 16 * m, t = t0 + r; const float pos = (float)(latent ? PAST + t : t);
                    f32x4 cs, sn;
#pragma unroll
                    for (int e = 0; e < 4; ++e) { float c_, s_; sincos_rev(pos * inv[e], c_, s_); cs[e] = c_ * sc; sn[e] = s_ * sc; }
#pragma unroll
                    for (int bj = 0; bj < 2; ++bj) { const f32x4 x1 = acc[ai][bj][m][0], x2 = acc[ai][bj][m][1];
                        st16_wt(rd, (unsigned)(((r * 512) + cb + 128 * bj + cw8) * 2), pack8(x1 * cs - x2 * sn, x2 * cs + x1 * sn)); } }
        } else if (pn < 18) {
            const int kind = (pn - 10) >> 2; bf16_t* dst = RV + (size_t)kind * ((WS_SRG - WS_RV) / 2); const int cb = 256 * ((pn - 10) & 3);
            const rsrc_t rd = mk_rsrc(dst + grow0 * 1024, 256 * 1024 * 2);
#pragma unroll
            for (int ai = 0; ai < 2; ++ai)
#pragma unroll
                for (int m = 0; m < 4; ++m) { const int r = 128 * ai + rl0 + 16 * m;
#pragma unroll
                    for (int bj = 0; bj < 2; ++bj) { f32x4 a = acc[ai][bj][m][0], b = acc[ai][bj][m][1];
                        if (kind == 1) { _Pragma("unroll") for (int e = 0; e < 4; ++e) { a[e] = siluf_(a[e]); b[e] = siluf_(b[e]); } }
                        st16_wt(rd, (unsigned)(((r * 1024) + cb + 128 * bj + cw8) * 2), pack8(a, b)); } }
        } else {
            const int cb = 128 * (pn - 18);
            const rsrc_t rra = mk_rsrc(GA + grow0 * 1024, 256 * 1024 * 2), rrg = mk_rsrc(GR + grow0 * 1024, 256 * 1024 * 2);
#pragma unroll
            for (int ai = 0; ai < 2; ++ai)
#pragma unroll
                for (int m = 0; m < 4; ++m) { const int r = 128 * ai + rl0 + 16 * m; f32x4 q0, q1, g0, g1;
#pragma unroll
                    for (int e = 0; e < 4; ++e) { g0[e] = sigmoidf_(acc[ai][1][m][0][e]); g1[e] = sigmoidf_(acc[ai][1][m][1][e]);
                        q0[e] = sigmoidf_(acc[ai][0][m][0][e]) * __builtin_amdgcn_rcpf(fmaxf(g0[e], 1e-30f)); q1[e] = sigmoidf_(acc[ai][0][m][1][e]) * __builtin_amdgcn_rcpf(fmaxf(g1[e], 1e-30f)); }
                    const unsigned o = (unsigned)(((r * 1024) + cb + cw8) * 2);
                    st16_wt(rra, o, pack8(q0, q1)); st16_wt(rrg, o, pack8(g0, g1)); }
        }
        if (pn >= 8 && pn <= 13) {
            asm volatile("s_waitcnt vmcnt(0)" ::: "memory");
            RAW_BAR();
            if (wid == 0 && lane == 0) { __hip_atomic_fetch_add(c1 + 16 * (pm * 6 + pn - 8), 1u, RLX_AGENT); __hip_atomic_fetch_add(c1 + 16 * 480, 1u, RLX_AGENT); } }
    }
};

struct EpiMix {
    static constexpr int MID_T = 16;
    typedef NoPre Pre;
    __device__ __forceinline__ Pre pre(const pg8::Unit&, int, int, int, int, int, int) const { return Pre(); }
    const bf16_t *GA, *GR; bf16_t* Y; unsigned* done;
    __device__ __forceinline__ void mid(AccT& acc, const pg8::Unit& u, int wr, int wc, int fr, int fq) const {
        unsigned lo = (unsigned)(((64 * wr + fr) * 1024 + 32 * wc + 8 * fq) * 2); asm volatile("" : "+v"(lo));
        const char* ga = (const char*)GA + ((size_t)u.pm * 256 * 1024 + 256 * u.pn) * 2;
        u32x4 q[8][2];
#pragma unroll
        for (int k = 0; k < 8; ++k)
#pragma unroll
            for (int bj = 0; bj < 2; ++bj) q[k][bj] = *(const u32x4*)(ga + lo + (unsigned)((((128 * (k >> 2) + 16 * (k & 3)) * 1024) + 128 * bj) * 2));
#pragma unroll
        for (int k = 0; k < 8; ++k)
#pragma unroll
            for (int bj = 0; bj < 2; ++bj) { f32x4 a0, a1; unpack8(q[k][bj], a0, a1); acc[k >> 2][bj][k & 3][0] *= a0; acc[k >> 2][bj][k & 3][1] *= a1; }
    }
    __device__ __forceinline__ void epi(AccT& acc, const pg8::Unit& u, int wr, int wc, int fr, int fq, int wid, int lane, const Pre&) const {
        unsigned lo = (unsigned)(((64 * wr + fr) * 1024 + 32 * wc + 8 * fq) * 2); asm volatile("" : "+v"(lo));
        const size_t ub = ((size_t)u.pm * 256 * 1024 + 256 * u.pn) * 2; const char* gr = (const char*)GR + ub; const rsrc_t ry = mk_rsrc((char*)Y + ub, 256 * 1024 * 2);
        u32x4 q[8][2];
#pragma unroll
        for (int k = 0; k < 8; ++k)
#pragma unroll
            for (int bj = 0; bj < 2; ++bj) q[k][bj] = *(const u32x4*)(gr + lo + (unsigned)((((128 * (k >> 2) + 16 * (k & 3)) * 1024) + 128 * bj) * 2));
#pragma unroll
        for (int k = 0; k < 8; ++k)
#pragma unroll
            for (int bj = 0; bj < 2; ++bj) { f32x4 r0, r1; unpack8(q[k][bj], r0, r1);
                st16_wt(ry, lo + (unsigned)((((128 * (k >> 2) + 16 * (k & 3)) * 1024) + 128 * bj) * 2), pack8(acc[k >> 2][bj][k & 3][0] * r0, acc[k >> 2][bj][k & 3][1] * r1)); }
        asm volatile("s_waitcnt vmcnt(0)" ::: "memory");
        RAW_BAR();
        if (wid == 0 && lane == 0) __hip_atomic_fetch_add(done + 64 * u.pm, 1u, RLX_AGENT);
    }
};

struct EpiRes1 {
    static constexpr int MID_T = -1;
    typedef NoPre Pre;
    __device__ __forceinline__ Pre pre(const pg8::Unit&, int, int, int, int, int, int) const { return Pre(); }
    const float *xp, *xs, *modf, *g2n; bf16_t* X1B; float* ssq; bf16_t* A2;
    __device__ __forceinline__ void mid(AccT&, const pg8::Unit&, int, int, int, int) const {}
    __device__ __forceinline__ void epi(AccT& acc, const pg8::Unit& u, int wr, int wc, int fr, int fq, int wid, int lane, const Pre&) const {
        asm volatile("" : "+v"(fr), "+v"(fq));
        const int pm = u.pm, v = pm < 16 ? 0 : 1 + ((pm - 16) >> 4);
        const float* mv = modf + (size_t)v * 6144; const float* xsrc = pm < 16 ? xp + (size_t)pm * 256 * 1024 : xs + (size_t)(pm - 16) * 256 * 1024;
        const unsigned cb = (unsigned)(256 * u.pn + 32 * wc + 8 * fq), rb = (unsigned)(64 * wr + fr);
        {   f32x4 g1[2][2];
#pragma unroll
            for (int bj = 0; bj < 2; ++bj)
#pragma unroll
                for (int n = 0; n < 2; ++n) g1[bj][n] = *(const f32x4*)(mv + 2048 + cb + 128 * bj + 4 * n);
#pragma unroll
            for (int h = 0; h < 4; ++h) { f32x4 xv[2][2][2];
#pragma unroll
                for (int mm = 0; mm < 2; ++mm)
#pragma unroll
                    for (int bj = 0; bj < 2; ++bj) { const float* p = xsrc + (size_t)(128 * (h >> 1) + 16 * (2 * (h & 1) + mm) + rb) * 1024 + cb + 128 * bj; xv[mm][bj][0] = *(const f32x4*)p; xv[mm][bj][1] = *(const f32x4*)(p + 4); }
#pragma unroll
                for (int mm = 0; mm < 2; ++mm)
#pragma unroll
                    for (int bj = 0; bj < 2; ++bj) { const int ai = h >> 1, m = 2 * (h & 1) + mm;
                        acc[ai][bj][m][0] = xv[mm][bj][0] + g1[bj][0] * acc[ai][bj][m][0]; acc[ai][bj][m][1] = xv[mm][bj][1] + g1[bj][1] * acc[ai][bj][m][1]; }
                {   const int ai = h >> 1, m0 = 2 * (h & 1);
                    asm volatile("" : "+v"(acc[ai][0][m0][0]), "+v"(acc[ai][0][m0][1]), "+v"(acc[ai][1][m0][0]), "+v"(acc[ai][1][m0][1]),
                                      "+v"(acc[ai][0][m0 + 1][0]), "+v"(acc[ai][0][m0 + 1][1]), "+v"(acc[ai][1][m0 + 1][0]), "+v"(acc[ai][1][m0 + 1][1]) :: "memory"); } } }
        f32x4 w2[2][2];
#pragma unroll
        for (int bj = 0; bj < 2; ++bj)
#pragma unroll
            for (int n = 0; n < 2; ++n) { const unsigned c = cb + 128 * bj + 4 * n; w2[bj][n] = *(const f32x4*)(g2n + c) * (*(const f32x4*)(mv + 4096 + c) + 1.0f); }
        const rsrc_t rx = mk_rsrc(X1B + (size_t)pm * 256 * 1024, 256 * 1024 * 2), ra = mk_rsrc(A2 + (size_t)pm * 256 * 1024, 256 * 1024 * 2);
#pragma unroll
        for (int ai = 0; ai < 2; ++ai)
#pragma unroll
            for (int m = 0; m < 4; ++m) { const unsigned r = 128 * ai + 16 * m + rb; float s = 0.f;
#pragma unroll
                for (int bj = 0; bj < 2; ++bj) { const unsigned o = r * 1024 + cb + 128 * bj; const f32x4 x0 = acc[ai][bj][m][0], x1 = acc[ai][bj][m][1];
                    st16_wt(rx, o * 2u, pack8(x0, x1));
                    st16_wt(ra, o * 2u, pack8(x0 * w2[bj][0], x1 * w2[bj][1]));
                    s += (x0[0] * x0[0] + x0[1] * x0[1]) + (x0[2] * x0[2] + x0[3] * x0[3]) + (x1[0] * x1[0] + x1[1] * x1[1]) + (x1[2] * x1[2] + x1[3] * x1[3]); }
                s += __shfl_xor(s, 16); s += __shfl_xor(s, 32);
                if (fq == 0) atomicAdd(ssq + (size_t)pm * 256 + r, s); }
    }
};

struct EpiRes2 {
    static constexpr int MID_T = -1;
    typedef NoPre Pre;
    __device__ __forceinline__ Pre pre(const pg8::Unit&, int, int, int, int, int, int) const { return Pre(); }
    const float *mod, *fg; const bf16_t* X1B; float* X; float* XS; unsigned* xcnt; LAS float* P;
    __device__ __forceinline__ void mid(AccT&, const pg8::Unit&, int, int, int, int) const {}
    __device__ __forceinline__ void epi(AccT& acc, const pg8::Unit& u, int wr, int wc, int fr, int fq, int wid, int lane, const Pre&) const {
        asm volatile("" : "+v"(fr), "+v"(fq));
        const int pm = u.pm, v = pm < 16 ? 0 : 1 + ((pm - 16) >> 4); const float* mv = mod + (size_t)v * 6144;
        const int cb = 256 * u.pn + 32 * wc + 8 * fq;
        {   f32x4 g2[2][2]; u32x4 xq[8][2];
#pragma unroll
            for (int bj = 0; bj < 2; ++bj)
#pragma unroll
                for (int n = 0; n < 2; ++n) g2[bj][n] = *(const f32x4*)(mv + 5120 + cb + 128 * bj + 4 * n);
#pragma unroll
            for (int k = 0; k < 8; ++k)
#pragma unroll
                for (int bj = 0; bj < 2; ++bj) xq[k][bj] = *(const u32x4*)(X1B + ((size_t)pm * 256 + 128 * (k >> 2) + 64 * wr + 16 * (k & 3) + fr) * 1024 + cb + 128 * bj);
#pragma unroll
            for (int k = 0; k < 8; ++k) { const int ai = k >> 2, m = k & 3, r = 128 * ai + 64 * wr + 16 * m + fr; float s = 0.f;
#pragma unroll
                for (int bj = 0; bj < 2; ++bj) { f32x4 xa, xb; unpack8(xq[k][bj], xa, xb);
                    const f32x4 x0 = xa + g2[bj][0] * acc[ai][bj][m][0], x1 = xb + g2[bj][1] * acc[ai][bj][m][1];
                    acc[ai][bj][m][0] = x0; acc[ai][bj][m][1] = x1;
                    s += (x0[0] * x0[0] + x0[1] * x0[1]) + (x0[2] * x0[2] + x0[3] * x0[3]) + (x1[0] * x1[0] + x1[1] * x1[1]) + (x1[2] * x1[2] + x1[3] * x1[3]); }
                s += __shfl_xor(s, 16); s += __shfl_xor(s, 32);
                if (fq == 0) P[r * 4 + wc] = s; } }
        RAW_BAR();
        const int tid = wid * 64 + lane;
        if (wid < 4) { const f32x4 pp = *(const LAS f32x4*)&P[tid * 4];
            __hip_atomic_store(XS + ((size_t)pm * 4 + u.pn) * 256 + tid, (pp[0] + pp[1]) + (pp[2] + pp[3]), RLX_AGENT);
            asm volatile("s_waitcnt vmcnt(0)" ::: "memory");
            if (lane == 0) __hip_atomic_fetch_add(xcnt + 64 * pm, 1u, RLX_AGENT); }
        if (wid == 0) { unsigned sp = 0;
            while ((unsigned)__builtin_amdgcn_readfirstlane(__hip_atomic_load(xcnt + 64 * pm, RLX_AGENT)) < 16u) { __builtin_amdgcn_s_sleep(2); if (++sp > (1u << 22)) break; } }
        RAW_BAR();
        if (wid < 4) { float t = 0.f;
#pragma unroll
            for (int k = 0; k < 4; ++k) t += __hip_atomic_load(XS + ((size_t)pm * 4 + k) * 256 + tid, RLX_AGENT);
            P[1024 + tid] = 1.0f / sqrtf(t * (1.0f / 1024.0f) + EPS); }
        RAW_BAR();
        {   f32x4 fgv[2][2];
#pragma unroll
            for (int bj = 0; bj < 2; ++bj)
#pragma unroll
                for (int n = 0; n < 2; ++n) fgv[bj][n] = *(const f32x4*)(fg + cb + 128 * bj + 4 * n);
#pragma unroll
            for (int ai = 0; ai < 2; ++ai)
#pragma unroll
                for (int m = 0; m < 4; ++m) { const int r = 128 * ai + 64 * wr + 16 * m + fr;
                    const float rs = P[1024 + r];
#pragma unroll
                    for (int bj = 0; bj < 2; ++bj) { float* p = X + ((size_t)pm * 256 + r) * 1024 + cb + 128 * bj;
                        *(f32x4*)p = acc[ai][bj][m][0] * rs * fgv[bj][0]; *(f32x4*)(p + 4) = acc[ai][bj][m][1] * rs * fgv[bj][1]; } } }
    }
};

__device__ __forceinline__ float dpp_up(float cur, float old) {
    return __builtin_bit_cast(float, __builtin_amdgcn_update_dpp(__builtin_bit_cast(int, old), __builtin_bit_cast(int, cur), 0x111, 0xF, 0xF, false)); }
__device__ __forceinline__ float dpp_dn(float cur, float old) {
    return __builtin_bit_cast(float, __builtin_amdgcn_update_dpp(__builtin_bit_cast(int, old), __builtin_bit_cast(int, cur), 0x101, 0xF, 0xF, false)); }
__device__ __forceinline__ float dpp_ror1(float x) {
    return __builtin_bit_cast(float, __builtin_amdgcn_update_dpp(0, __builtin_bit_cast(int, x), 0x121, 0xF, 0xF, false)); }
__device__ __forceinline__ float dpp_rol1(float x) {
    return __builtin_bit_cast(float, __builtin_amdgcn_update_dpp(0, __builtin_bit_cast(int, x), 0x12F, 0xF, 0xF, false)); }
struct EpiConv {
    static constexpr int MID_T = -1;
    const float *ssq, *bup, *cw, *cbias; bf16_t* ACT; float *EU, *EUC; LAS float* E; unsigned* done;
    struct Pre { float ss[8]; f32x4 bb[2][2]; float cwv[4]; };
    __device__ __forceinline__ void mid(AccT&, const pg8::Unit&, int, int, int, int) const {}
    __device__ __forceinline__ Pre pre(const pg8::Unit& u, int wr, int wc, int fr, int fq, int wid, int lane) const {
        Pre p; const int pm = u.pm, pn = u.pn, v = pm < 16 ? 0 : 1 + ((pm - 16) >> 4);
        const float* sp = ssq + (size_t)pm * 256 + 64 * wr + fr; const float* bp = bup + (size_t)v * NUP + 256 * pn + 32 * wc + 8 * fq;
#pragma unroll
        for (int k = 0; k < 8; ++k) p.ss[k] = sp[128 * (k >> 2) + 16 * (k & 3)];
#pragma unroll
        for (int bj = 0; bj < 2; ++bj)
#pragma unroll
            for (int n = 0; n < 2; ++n) p.bb[bj][n] = *(const f32x4*)(bp + 128 * bj + 4 * n);
        const int t = wid * 64 + lane, tc = t & 255, ch = (tc < 128 ? 0 : DFF - 128) + 128 * pn + tc;
        p.cwv[0] = cw[ch]; p.cwv[1] = cw[NUP + ch]; p.cwv[2] = cw[2 * NUP + ch]; p.cwv[3] = cbias[ch];
        return p;
    }
    __device__ __forceinline__ void epi(AccT& acc, const pg8::Unit& u, int wr, int wc, int fr, int fq, int wid, int lane, const Pre& pf) const {
        const int pm = u.pm, pn = u.pn; const bool latent = pm >= 16;
#if defined(PROBE_K0) && PROBE_K0 == 400
        const unsigned long long te0_ = __builtin_amdgcn_s_memrealtime();
#endif
        unsigned cw8 = (unsigned)(32 * wc + 8 * fq), rl = (unsigned)(64 * wr + fr); asm volatile("" : "+v"(cw8), "+v"(rl));
        LAS float* CW = E + 2048;
        {   const int t = wid * 64 + lane;
            if (t < 256) { CW[t] = pf.cwv[0]; CW[256 + t] = pf.cwv[1]; CW[512 + t] = pf.cwv[2]; CW[768 + t] = pf.cwv[3]; } }
#pragma unroll
        for (int ai = 0; ai < 2; ++ai)
#pragma unroll
            for (int m = 0; m < 4; ++m) { const float rs = __builtin_amdgcn_rsqf(pf.ss[4 * ai + m] * (1.0f / 1024.0f) + EPS);
#pragma unroll
                for (int bj = 0; bj < 2; ++bj)
#pragma unroll
                    for (int n = 0; n < 2; ++n) acc[ai][bj][m][n] = acc[ai][bj][m][n] * rs + pf.bb[bj][n]; }
        PINACC(acc);
        const rsrc_t reu = mk_rsrc(EU + (size_t)pm * 2 * NUP + 256 * pn, (NUP + 256) * 4), reuc = mk_rsrc(EUC + (size_t)pm * 2 * NUP + 256 * pn, (NUP + 256) * 4);
#pragma unroll
        for (int ai = 0; ai < 2; ++ai)
#pragma unroll
            for (int bj = 0; bj < 2; ++bj)
#pragma unroll
                for (int n = 0; n < 2; ++n) { const unsigned ci = 128 * bj + cw8 + 4 * n; const int grp = 2 * ai + wr;
                    if (fr == 0) { *(LAS f32x4*)&E[(grp * 2 + 0) * 256 + ci] = acc[ai][bj][0][n]; if (latent && grp == 0) st16_wt(reu, ci * 4u, acc[ai][bj][0][n]); }
                    if (fr == 15) { *(LAS f32x4*)&E[(grp * 2 + 1) * 256 + ci] = acc[ai][bj][3][n]; if (latent && grp == 3) st16_wt(reu, (NUP + ci) * 4u, acc[ai][bj][3][n]); } }
        RAW_BAR();
#if defined(PROBE_K0) && PROBE_K0 == 400 && defined(PROBE_SUB) && PROBE_SUB == 1
        if (wid == 0 && lane == 0 && (int)__builtin_amdgcn_workgroup_id_x() == PROBE_BID) atomicAdd((float*)((char*)EU - WS_EDGE_U + 32768), (float)(__builtin_amdgcn_s_memrealtime() - te0_));
#endif
        const rsrc_t ract = mk_rsrc((char*)ACT + ((size_t)pm * 256 * DFF + 128 * pn) * 2, 256 * DFF * 2);
#pragma unroll
        for (int ai = 0; ai < 2; ++ai) { const int grp = 2 * ai + wr;
#pragma unroll
            for (int n = 0; n < 2; ++n)
#pragma unroll
                for (int bj = 0; bj < 2; ++bj) { const unsigned ci = 128 * bj + cw8 + 4 * n;
                    const f32x4 w0 = *(const LAS f32x4*)&CW[ci], w1 = *(const LAS f32x4*)&CW[256 + ci], w2 = *(const LAS f32x4*)&CW[512 + ci], cb = *(const LAS f32x4*)&CW[768 + ci];
                    f32x4 pe = {0.f, 0.f, 0.f, 0.f}, ne = {0.f, 0.f, 0.f, 0.f};
                    if (grp > 0) pe = *(const LAS f32x4*)&E[((grp - 1) * 2 + 1) * 256 + ci];
                    if (grp < 3) ne = *(const LAS f32x4*)&E[((grp + 1) * 2 + 0) * 256 + ci];
#pragma unroll
                    for (int e = 0; e < 4; ++e) { const float u0 = acc[ai][bj][0][n][e], u1 = acc[ai][bj][1][n][e], u2 = acc[ai][bj][2][n][e], u3 = acc[ai][bj][3][n][e];
                        const float p0 = dpp_up(u0, pe[e]), p1 = dpp_up(u1, dpp_ror1(u0)), p2 = dpp_up(u2, dpp_ror1(u1)), p3 = dpp_up(u3, dpp_ror1(u2));
                        const float n0 = dpp_dn(u0, dpp_rol1(u1)), n1 = dpp_dn(u1, dpp_rol1(u2)), n2 = dpp_dn(u2, dpp_rol1(u3)), n3 = dpp_dn(u3, ne[e]);
                        acc[ai][bj][0][n][e] = w0[e] * p0 + w1[e] * u0 + w2[e] * n0 + cb[e]; acc[ai][bj][1][n][e] = w0[e] * p1 + w1[e] * u1 + w2[e] * n1 + cb[e];
                        acc[ai][bj][2][n][e] = w0[e] * p2 + w1[e] * u2 + w2[e] * n2 + cb[e]; acc[ai][bj][3][n][e] = w0[e] * p3 + w1[e] * u3 + w2[e] * n3 + cb[e]; }
                    if (latent) { if (fr == 0 && grp == 0) st16_wt(reuc, ci * 4u, acc[ai][bj][0][n]);
                                  if (fr == 15 && grp == 3) st16_wt(reuc, (NUP + ci) * 4u, acc[ai][bj][3][n]); }
                    asm volatile("" : "+v"(acc[ai][bj][0][n]), "+v"(acc[ai][bj][1][n]), "+v"(acc[ai][bj][2][n]), "+v"(acc[ai][bj][3][n]) :: "memory"); }
#pragma unroll
            for (int m = 0; m < 4; ++m) { f32x4 o0, o1;
#pragma unroll
                for (int e = 0; e < 4; ++e) { o0[e] = siluf_(acc[ai][1][m][0][e]) * acc[ai][0][m][0][e]; o1[e] = siluf_(acc[ai][1][m][1][e]) * acc[ai][0][m][1][e]; }
                st16_wt(ract, ((rl + 128 * ai + 16 * m) * DFF + cw8) * 2u, pack8(o0, o1)); asm volatile("" ::: "memory"); } }
#if defined(PROBE_K0) && PROBE_K0 == 400 && !defined(PROBE_SUB)
        if (wid == 0 && lane == 0 && (int)__builtin_amdgcn_workgroup_id_x() == PROBE_BID) atomicAdd((float*)((char*)EU - WS_EDGE_U + 32768), (float)(__builtin_amdgcn_s_memrealtime() - te0_));
#endif
    }
};

constexpr int NWAVES = 8, NTHR = 512;
constexpr int RING_BYTES = 131072, SPARE_OFF = RING_BYTES, SPARE_BYTES = 16384, MISC_OFF = SPARE_OFF + SPARE_BYTES, LDS_BYTES = MISC_OFF + 256;
struct Args {
    const float *x_prompt, *x_sample, *c, *cache_k, *cache_v, *st_f, *st_b, *c_ctx, *norm1_g, *norm2_g, *w_mod, *b_mod, *w_in, *q_g, *k_g, *dec_f, *dec_b,
                *w_att_o, *w_ret_o, *w_out, *w_up, *conv_w, *conv_b, *w_down, *final_g;
    float* out; unsigned char* ws; int ph_lo, ph_hi;
};
struct Frame { LAS unsigned char* lds; int tid, lane, wave, G, bid; };
typedef const __attribute__((address_space(4))) Args CArgs;

template <class F> __device__ __forceinline__ void transpose_item(const float* W, int ldw, bf16_t* WT, int ldd, int kofs, int k0, int n0, F srccol, LAS float* scr, int lane) {
    const int sc = srccol(n0 + (lane & 31));
#pragma unroll 8
    for (int i = 0; i < 32; ++i) { const int kk = 2 * i + (lane >> 5); scr[kk * 33 + (lane & 31)] = __builtin_nontemporal_load(W + (size_t)(k0 + kk) * ldw + sc); }
    LDS_WAIT(); asm volatile("" ::: "memory");
    const int c = lane & 7;
#pragma unroll
    for (int j = 0; j < 4; ++j) { const int n = (lane >> 3) + 8 * j; const LAS float* s = scr + (8 * c) * 33 + n;
        u32x4 o; o.x = pk2(s[0 * 33], s[1 * 33]); o.y = pk2(s[2 * 33], s[3 * 33]); o.z = pk2(s[4 * 33], s[5 * 33]); o.w = pk2(s[6 * 33], s[7 * 33]);
        *(u32x4*)(WT + (size_t)(n0 + n) * ldd + kofs + k0 + 8 * c) = o; }
    LDS_WAIT(); asm volatile("" ::: "memory");
}
struct ColId { __device__ int operator()(int n) const { return n; } };
struct ColIn { __device__ int operator()(int n) const {
    if (n >= 4608) { const int t = (n - 4608) >> 8, j = (n - 4608) & 255; return j < 128 ? 4608 + 128 * t + j : 5632 + 128 * t + (j - 128); }
    return (n < 1280 || (n >= 1536 && n < 2560)) ? swap25(n) : n; } };
struct ColUp { __device__ int operator()(int n) const { const int t = n >> 8, j = n & 255; return j < 128 ? 128 * t + j : DFF + 128 * t + (j - 128); } };

template <class F> __device__ __forceinline__ void gemv5_item(const Frame& F_, const float* W, int ldw, int n0, int k0, F srccol, const LAS float* a, LAS float* red, const float* bias, float* out, int ldo) {
    const int col0 = srccol(n0 + F_.lane), col1 = srccol(n0 + 64 + F_.lane); float acc[5][2];
#pragma unroll
    for (int v = 0; v < 5; ++v) { acc[v][0] = 0.f; acc[v][1] = 0.f; }
    const int kb = F_.wave * 32;
    const float* wp = W + (size_t)(k0 + kb) * ldw;
    float w0[32], w1[32];
#pragma unroll
    for (int j = 0; j < 32; ++j) { w0[j] = __builtin_nontemporal_load(wp + col0); w1[j] = __builtin_nontemporal_load(wp + col1); wp += ldw; }
#pragma unroll
    for (int j = 0; j < 32; ++j)
#pragma unroll
        for (int v = 0; v < 5; ++v) { const float av = a[v * 256 + kb + j]; acc[v][0] += av * w0[j]; acc[v][1] += av * w1[j]; }
#pragma unroll
    for (int v = 0; v < 5; ++v) { red[(F_.wave * 5 + v) * 128 + F_.lane] = acc[v][0]; red[(F_.wave * 5 + v) * 128 + 64 + F_.lane] = acc[v][1]; }
    __syncthreads();
    for (int t = F_.tid; t < 640; t += NTHR) { const int v = t >> 7, l = t & 127; float sum = (bias && k0 == 0) ? bias[n0 + l] : 0.f;
#pragma unroll
        for (int w8 = 0; w8 < 8; ++w8) sum += red[(w8 * 5 + v) * 128 + l];
        out[((size_t)(k0 >> 8) * 5 + v) * ldo + n0 + l] = sum; }
    __syncthreads();
}

__device__ __forceinline__ void phase0(const Frame& F, CArgs& A) {
    unsigned char* ws = A.ws;
    for (int it = F.bid; it < 48 * 4; it += F.G) {
        const int cgp = it % 48, kq = it / 48;
        LAS float* a = (LAS float*)F.lds; LAS float* red = a + 5 * 256;
        for (int i = F.tid; i < 5 * 256; i += NTHR) { const int v = i >> 8, k = kq * 256 + (i & 255); const float cv = v == 0 ? A.c_ctx[k] : A.c[(v - 1) * 1024 + k]; a[i] = siluf_(cv); }
        __syncthreads();
        gemv5_item(F, A.w_mod, 6144, cgp * 128, kq * 256, ColId(), a, red, A.b_mod, (float*)(ws + WS_MOD), 6144);
    }
    LAS float* scr = (LAS float*)(F.lds + 32768 + F.wave * 8704);
    const int gw = ((F.bid + 128) % F.G) * NWAVES + F.wave, NGW = F.G * NWAVES;
    constexpr int I_IN = 16 * (DIN / 32);
    for (int it = gw; it < I_IN; it += NGW) transpose_item(A.w_in, DIN, (bf16_t*)(ws + WS_WA), 1024, 0, 64 * (it / (DIN / 32)), 32 * (it % (DIN / 32)), ColIn(), scr, F.lane);
    const int gt = F.bid * NTHR + F.tid, NGT = F.G * NTHR;
    for (int i = gt; i < DB * NKV * PAST * 16; i += NGT) { const int c8 = i & 15, row = i >> 4, t = row % PAST, bk = row / PAST;
        const size_t so = (size_t)row * 128, dofs = ((size_t)bk * SKV + DSEQ + t) * 128 + c8 * 8;
        f32x4 k0, k1; { const int p0 = c8 * 8, d0 = swap25(p0), d1 = swap25(p0 + 4); k0 = *(const f32x4*)(A.cache_k + so + d0); k1 = *(const f32x4*)(A.cache_k + so + d1); }
        *(u32x4*)((bf16_t*)(ws + WS_KALL) + dofs) = pack8(k0, k1);
        const f32x4 v0 = *(const f32x4*)(A.cache_v + so + c8 * 8), v1 = *(const f32x4*)(A.cache_v + so + c8 * 8 + 4);
        *(u32x4*)((bf16_t*)(ws + WS_VALL) + dofs) = pack8(v0, v1); }
    for (int i = gt; i < MT; i += NGT) ((float*)(ws + WS_SSQ1))[i] = 0.f;
    for (int i = gt; i < 322 * 64; i += NGT) ((unsigned*)(ws + WS_CNT))[i] = 0u;
    for (int i = gt; i < (481 + 81) * 16; i += NGT) ((unsigned*)(ws + WS_CNT1))[i] = 0u;
#if defined(PROBE_K0) && PROBE_K0 == 400
    if (gt == 0) *(float*)(ws + 32768) = 0.f;
#endif
}

__device__ __forceinline__ void phase1(const Frame& F, CArgs& A) {
    unsigned char* ws = A.ws; const float* mod = (const float*)(ws + WS_MOD);
    for (int it = F.bid; it < (NUP / 128) * 4; it += F.G) {
        const int cgp = it % (NUP / 128), kq = it / (NUP / 128);
        LAS float* a = (LAS float*)F.lds; LAS float* red = a + 5 * 256;
        for (int i = F.tid; i < 5 * 256; i += NTHR) { const float* p = mod + (size_t)(i >> 8) * 6144 + 3072 + kq * 256 + (i & 255); a[i] = (p[0] + p[MODQ]) + (p[2 * MODQ] + p[3 * MODQ]); }
        __syncthreads();
        gemv5_item(F, A.w_up, NUP, cgp * 128, kq * 256, ColUp(), a, red, nullptr, (float*)(ws + WS_BUP), NUP);
    }
    for (int i = F.bid * NTHR + F.tid; i < 5 * 6144; i += F.G * NTHR) ((float*)(ws + WS_MODF))[i] = (mod[i] + mod[i + MODQ]) + (mod[i + 2 * MODQ] + mod[i + 3 * MODQ]);
    bf16_t* H = (bf16_t*)(ws + WS_H);
    constexpr int RPW = MT / (256 * NWAVES);
    const int row0 = (F.bid * NWAVES + F.wave) * RPW;
    int vcur = -1; f32x4 w1[4], s1[4];
#pragma unroll 1
    for (int rb = row0; rb < row0 + RPW; rb += 5) {
        f32x4 x[5][4];
#pragma unroll
        for (int i = 0; i < 5; ++i) { const int r = rb + i; const float* xr = r < MP ? A.x_prompt + (size_t)r * 1024 : A.x_sample + (size_t)(r - MP) * 1024;
#pragma unroll
            for (int j = 0; j < 4; ++j) x[i][j] = __builtin_nontemporal_load((const f32x4*)(xr + 8 * F.lane + 4 * (j & 1) + 512 * (j >> 1))); }
#pragma unroll
        for (int i = 0; i < 5; ++i) { const int r = rb + i;
            const int v = r < MP ? 0 : 1 + (r - MP) / DSEQ;
            if (v != vcur) { vcur = v; const float* mv = mod + (size_t)v * 6144;
#pragma unroll
                for (int j = 0; j < 4; ++j) { const int k = 8 * F.lane + 4 * (j & 1) + 512 * (j >> 1); w1[j] = *(const f32x4*)(A.norm1_g + k) * (sum4q(mv + 1024 + k, MODQ) + 1.0f); s1[j] = sum4q(mv + k, MODQ); } }
            float s = 0.f;
#pragma unroll
            for (int j = 0; j < 4; ++j) s += (x[i][j][0] * x[i][j][0] + x[i][j][1] * x[i][j][1]) + (x[i][j][2] * x[i][j][2] + x[i][j][3] * x[i][j][3]);
            const float rstd = __builtin_amdgcn_rsqf(wave_sum(s) * (1.0f / 1024.0f) + EPS);
#pragma unroll
            for (int jj = 0; jj < 2; ++jj) { const f32x4 h0 = x[i][2 * jj] * rstd * w1[2 * jj] + s1[2 * jj], h1 = x[i][2 * jj + 1] * rstd * w1[2 * jj + 1] + s1[2 * jj + 1];
                *(u32x4*)(H + (size_t)r * 1024 + 8 * F.lane + 512 * jj) = pack8(h0, h1); } }
    }
}

__device__ __forceinline__ float log_sigmoid_(float x) { return -log1pf(__expf(-x)); }
__device__ __forceinline__ s16x4 tr_read16(const LAS bf16_t* p) { typedef short v4s __attribute__((ext_vector_type(4))); return __builtin_bit_cast(s16x4, __builtin_amdgcn_ds_read_tr16_b64_v4i16((LAS v4s*)p)); }
#define MK8(L, H) (bf16x8){L[0], L[1], L[2], L[3], H[0], H[1], H[2], H[3]}
constexpr int KLD = 72, VLD = 136;
__device__ __forceinline__ int vsw(int r, int c8) { return 256 * r + 16 * (c8 ^ (((r & 3) << 1) | (((r >> 3) & 1) << 3))); }
__device__ __forceinline__ int vsw_tr(int R, int col) { return vsw(R, col >> 3) + 2 * (col & 7); }

__device__ const unsigned char R1_PORD[80] = {0, 1, 2, 3, 4, 5, 6, 7, 12, 13, 14, 15, 16, 17, 18, 19, 28, 29, 30, 31, 32, 33, 34, 35, 40, 41, 42, 43, 44, 45, 46, 47, 52, 53, 54, 55, 56, 57, 58, 59, 68, 69, 70, 71, 72, 73, 74, 75,
    8, 9, 10, 11, 20, 21, 22, 23, 24, 25, 26, 27, 36, 37, 38, 39, 48, 49, 50, 51, 60, 61, 62, 63, 64, 65, 66, 67, 76, 77, 78, 79};
__device__ __forceinline__ int r1_item_of(int i) { return (int)R1_PORD[i >> 4] * 16 + (i & 15); }
__device__ __forceinline__ void spin_ge(unsigned* p, unsigned need) { unsigned sp = 0;
    while ((unsigned)__builtin_amdgcn_readfirstlane(__hip_atomic_load(p, RLX_AGENT)) < need) { __builtin_amdgcn_s_sleep(2); if (++sp > (1u << 22)) break; } }
__device__ __forceinline__ void r1_wait(const Frame& F, unsigned* c1, int item, volatile LAS unsigned* alld) {
    if (F.wave == 0 && *alld == 0u) { const int pm = item >> 4, h = item & 7;
        const bool all = (unsigned)__builtin_amdgcn_readfirstlane(__hip_atomic_load(c1 + 16 * 480, RLX_AGENT)) >= 480u
                      && (unsigned)__builtin_amdgcn_readfirstlane(__hip_atomic_load(c1 + 16 * (481 + 80), RLX_AGENT)) >= 2080u;
        spin_ge(c1 + 16 * (pm * 6 + (h >> 2)), 1u); spin_ge(c1 + 16 * (pm * 6 + 2 + (h >> 1)), 1u);
        spin_ge(c1 + 16 * (481 + pm), 26u);
        __builtin_amdgcn_fence(__ATOMIC_ACQUIRE, "agent"); asm volatile("s_waitcnt vmcnt(0)" ::: "memory");
        if (all) *alld = 1u; }
    __syncthreads();
}
__device__ __forceinline__ void phase_r1(const Frame& F, CArgs& A) {
    unsigned char* ws = A.ws; unsigned* c1 = (unsigned*)(ws + WS_CNT1);
    volatile LAS unsigned* alld = (volatile LAS unsigned*)(F.lds + MISC_OFF) + 17;
    if (F.tid == 0) *alld = 0u;
    __syncthreads();
    const bf16_t* RKb = (const bf16_t*)(ws + WS_RK); const bf16_t* RVb = (const bf16_t*)(ws + WS_RV); bf16_t* KVS = (bf16_t*)(ws + WS_H);
    LAS bf16_t* kf = (LAS bf16_t*)F.lds; LAS bf16_t* kb = kf + 128 * KLD; LAS bf16_t* vl = kb + 128 * KLD; LAS bf16_t* ol = vl + 128 * 128 + F.wave * (16 * VLD);
    u32x4 pk_[2], pv_[4];
#define R1_LOAD(it) do { const int cg_ = (it) >> 3, h_ = (it) & 7; const size_t r0_ = (size_t)cg_ * 128; \
        _Pragma("unroll") for (int i = 0; i < 2; ++i) { const int ci = F.tid + i * NTHR; pk_[i] = *(const u32x4*)(RKb + (r0_ + (ci >> 3)) * 512 + 64 * h_ + 8 * (ci & 7)); } \
        _Pragma("unroll") for (int i = 0; i < 4; ++i) { const int ci = F.tid + i * NTHR; pv_[i] = *(const u32x4*)(RVb + (r0_ + (ci >> 4)) * 1024 + 128 * h_ + 8 * (ci & 15)); } } while (0)
    const int n1 = F.bid >= 32 ? (768 - (F.bid - 32) + 223) / 224 : 0, cntp = n1 + 2;
#define R1_POS(n) ((n) < n1 ? (F.bid - 32) + 224 * (n) : 768 + F.bid + 256 * ((n) - n1))
    { r1_wait(F, c1, r1_item_of(R1_POS(0)), alld); R1_LOAD(r1_item_of(R1_POS(0))); }
    for (int n = 0; n < cntp; ++n) { const int item = r1_item_of(R1_POS(n));
        const int h = item & 7;
        const float lgf = log_sigmoid_(A.dec_f[h]) * 1.4426950408889634f, lgb = log_sigmoid_(A.dec_b[h]) * 1.4426950408889634f;
#pragma unroll
        for (int i = 0; i < 2; ++i) { const int ci = F.tid + i * NTHR, j = ci >> 3, c8 = ci & 7;
            f32x4 a, b; unpack8(pk_[i], a, b);
            const float df = __builtin_amdgcn_exp2f(lgf * (float)(127 - j)), db = __builtin_amdgcn_exp2f(lgb * (float)j);
            *(LAS u32x4*)(kf + j * KLD + 8 * c8) = pack8(a * df, b * df); *(LAS u32x4*)(kb + j * KLD + 8 * c8) = pack8(a * db, b * db); }
#pragma unroll
        for (int i = 0; i < 4; ++i) { const int ci = F.tid + i * NTHR, j = ci >> 4, c8 = ci & 15; *(LAS u32x4*)((LAS char*)vl + vsw(j, c8)) = pv_[i]; }
        __syncthreads();
        if (n + 1 < cntp) { r1_wait(F, c1, r1_item_of(R1_POS(n + 1)), alld); R1_LOAD(r1_item_of(R1_POS(n + 1))); }
        const int dir = F.wave >> 2, mt = F.wave & 3, g = F.lane >> 4, q = (F.lane & 15) >> 2, p = F.lane & 3, l15 = F.lane & 15;
        const LAS bf16_t* ks = dir ? kb : kf;
        bf16x8 af[4];
#pragma unroll
        for (int s = 0; s < 4; ++s) { const LAS bf16_t* ap = ks + (32 * s + 8 * g + q) * KLD + 16 * mt + 4 * p; const s16x4 lo = tr_read16(ap), hi = tr_read16(ap + 4 * KLD); af[s] = MK8(lo, hi); }
#pragma unroll
        for (int nt = 0; nt < 8; ++nt) { f32x4 acc = {0.f, 0.f, 0.f, 0.f};
#pragma unroll
            for (int s = 0; s < 4; ++s) { const int R0 = 32 * s + 8 * g + q, col = 16 * nt + 4 * p;
                const s16x4 lo = tr_read16((const LAS bf16_t*)((const LAS char*)vl + vsw_tr(R0, col))), hi = tr_read16((const LAS bf16_t*)((const LAS char*)vl + vsw_tr(R0 + 4, col)));
                acc = __builtin_amdgcn_mfma_f32_16x16x32_bf16(af[s], MK8(lo, hi), acc, 0, 0, 0); }
#pragma unroll
            for (int e = 0; e < 4; ++e) ol[(4 * g + e) * VLD + 16 * nt + l15] = (bf16_t)f2bf(acc[e]); }
        LDS_WAIT(); asm volatile("" ::: "memory");
        bf16_t* dst = KVS + ((size_t)item * 2 + dir) * (64 * 128) + (size_t)(16 * mt + (F.lane >> 2)) * 128 + (F.lane & 3) * 32;
#pragma unroll
        for (int c = 0; c < 4; ++c) *(u32x4*)(dst + 8 * c) = *(const LAS u32x4*)(ol + (F.lane >> 2) * VLD + (F.lane & 3) * 32 + 8 * c);
        __syncthreads();
    }
#undef R1_LOAD
#undef R1_POS
}

__device__ __forceinline__ void phase_scan(const Frame& F, CArgs& A) {
    bf16_t* KVS = (bf16_t*)(A.ws + WS_H);
    const int gt = F.bid * NTHR + F.tid, NGT = F.G * NTHR;
    for (int i = gt; i < 5 * NUP; i += NGT) { const float* p = (const float*)(A.ws + WS_BUP) + i; ((float*)(A.ws + WS_BUPF))[i] = (p[0] + p[BUPQ]) + (p[2 * BUPQ] + p[3 * BUPQ]); }
    constexpr size_t CST = (size_t)8 * 2 * 8192;
    if (NGT * 4 == 256 * 2048) {
        u32x2 kv[4][2]; bf16_t* basep[4]; float decp[4];
#pragma unroll
        for (int k = 0; k < 4; ++k) { const int w = gt + k * NGT, e4 = (w & 2047) * 4, chain = w >> 11, dir = chain & 1, h = (chain >> 1) & 7, sq = chain >> 4;
            decp[k] = __expf(log_sigmoid_((dir ? A.dec_b : A.dec_f)[h]) * 128.0f);
            basep[k] = KVS + ((size_t)(2 * sq * 8 + h) * 2 + dir) * 8192 + e4;
            kv[k][0] = *(const u32x2*)(basep[k] + (size_t)(dir ? 1 : 0) * CST); kv[k][1] = *(const u32x2*)(basep[k] + (size_t)(dir ? 0 : 1) * CST); }
#pragma unroll
        for (int k = 0; k < 4; ++k) { const int w = gt + k * NGT, e4 = (w & 2047) * 4, chain = w >> 11, dir = chain & 1, h = (chain >> 1) & 7, sq = chain >> 4;
            const int pr = e4 >> 7, dv = e4 & 127, lr = swap25(pr);
            f32x4 st = {0.f, 0.f, 0.f, 0.f};
#pragma unroll
            for (int i = 0; i < 2; ++i) { u32x2 o; o.x = pk2(st[0], st[1]); o.y = pk2(st[2], st[3]); *(u32x2*)(basep[k] + (size_t)(dir ? 1 - i : i) * CST) = o;
                st = st * decp[k] + (f32x4){bflo(kv[k][i].x), bfhi(kv[k][i].x), bflo(kv[k][i].y), bfhi(kv[k][i].y)}; }
            *(f32x4*)(A.out + (dir ? OUT_SB : OUT_SF) + (((size_t)sq * 8 + h) * 64 + lr) * 128 + dv) = st; }
    }
    for (int w = (NGT * 4 == 256 * 2048) ? gt + 4 * NGT : gt; w < 320 * 2048; w += NGT) {
        const int e4 = (w & 2047) * 4, chain = w >> 11, dir = chain & 1, h = (chain >> 1) & 7, s = chain >> 4;
        const int nch = s < 16 ? 2 : 32, c0 = s < 16 ? 2 * s : 32 + 32 * (s - 16);
        const float lg = log_sigmoid_((dir ? A.dec_b : A.dec_f)[h]), dec = __expf(lg * 128.0f);
        const int pr = e4 >> 7, dv = e4 & 127, lr = swap25(pr);
        f32x4 st = {0.f, 0.f, 0.f, 0.f};
        if (s >= 16) st = *(const f32x4*)((dir ? A.st_b : A.st_f) + (((size_t)(s - 16) * 8 + h) * 64 + lr) * 128 + dv);
        bf16_t* base = KVS + ((size_t)(c0 * 8 + h) * 2 + dir) * 8192 + e4;
        if (s < 16) {
            u32x2 kv[2];
#pragma unroll
            for (int i = 0; i < 2; ++i) kv[i] = *(const u32x2*)(base + (size_t)(dir ? 1 - i : i) * CST);
#pragma unroll
            for (int i = 0; i < 2; ++i) { u32x2 o; o.x = pk2(st[0], st[1]); o.y = pk2(st[2], st[3]); *(u32x2*)(base + (size_t)(dir ? 1 - i : i) * CST) = o;
                st = st * dec + (f32x4){bflo(kv[i].x), bfhi(kv[i].x), bflo(kv[i].y), bfhi(kv[i].y)}; }
        } else {
            u32x2 kv[32];
#pragma unroll
            for (int i = 0; i < 32; ++i) kv[i] = *(const u32x2*)(base + (size_t)(dir ? 31 - i : i) * CST);
#pragma unroll
            for (int i = 0; i < 32; ++i) { u32x2 o; o.x = pk2(st[0], st[1]); o.y = pk2(st[2], st[3]); *(u32x2*)(base + (size_t)(dir ? 31 - i : i) * CST) = o;
                st = st * dec + (f32x4){bflo(kv[i].x), bfhi(kv[i].x), bflo(kv[i].y), bfhi(kv[i].y)}; }
        }
        if (s < 16) *(f32x4*)(A.out + (dir ? OUT_SB : OUT_SF) + (((size_t)s * 8 + h) * 64 + lr) * 128 + dv) = st;
    }
}

namespace att {
constexpr int D = 128, NW = 8, QBLK = 32, KVBLK = 64;
constexpr float SCALE = 0.088388347648318440f, THR = 8.f;
constexpr size_t SHM_V = KVBLK * D * 2, SHM_K = KVBLK * D * 2, SHM_ATTN = 2 * SHM_V + 2 * SHM_K + NW * 64 * 4;
#define KSWZ(row, colB) ((row) * 256 + ((colB) ^ (((row) & 7) << 4)))
#define SBAR() __builtin_amdgcn_sched_barrier(0)
__device__ __forceinline__ int crow(int r, int hi) { return (r & 3) + 8 * (r >> 2) + 4 * hi; }
__device__ __forceinline__ unsigned cvtpk(float lo, float hi) { unsigned r; asm volatile("v_cvt_pk_bf16_f32 %0, %1, %2" : "=v"(r) : "v"(lo), "v"(hi)); return r; }
__device__ __forceinline__ void partialSM(f32x16& p0, f32x16& p1, float& m_reg, float& mn, float& alpha) {
  constexpr float C = SCALE * 1.4426950408889634f;
  float pmax = p0[0]; for (int r = 1; r < 16; ++r) pmax = fmaxf(pmax, p0[r]); for (int r = 0; r < 16; ++r) pmax = fmaxf(pmax, p1[r]);
  { auto rr = __builtin_amdgcn_permlane32_swap(__float_as_uint(pmax), __float_as_uint(pmax), false, false);
    pmax = fmaxf(__uint_as_float(rr[0]), __uint_as_float(rr[1])); }
  if (__builtin_expect(__all(pmax - m_reg <= THR / SCALE), 1)) { mn = m_reg; alpha = 1.f; }
  else { mn = fmaxf(m_reg, pmax); alpha = __builtin_amdgcn_exp2f((m_reg - mn) * C); m_reg = mn; }
  float mnC = -mn * C;
  for (int r = 0; r < 16; ++r) p0[r] = fmaf(p0[r], C, mnC); for (int r = 0; r < 16; ++r) p1[r] = fmaf(p1[r], C, mnC);
  for (int r = 0; r < 16; ++r) p0[r] = __builtin_amdgcn_exp2f(p0[r]);
}
__device__ __forceinline__ void finishSM(f32x16& p0, f32x16& p1, float alpha, float& l_reg, bf16x8& pa0, bf16x8& pa1, bf16x8& pa2, bf16x8& pa3) {
  for (int r = 0; r < 16; ++r) p1[r] = __builtin_amdgcn_exp2f(p1[r]);
  float ps = 0; for (int r = 0; r < 16; ++r) ps += p0[r]; for (int r = 0; r < 16; ++r) ps += p1[r];
  { auto rr = __builtin_amdgcn_permlane32_swap(__float_as_uint(ps), __float_as_uint(ps), false, false);
    ps = __uint_as_float(rr[0]) + __uint_as_float(rr[1]); }
  l_reg = l_reg * alpha + ps;
#define PK4(P, BASE, OUT) do { unsigned a0 = cvtpk(P[BASE + 0], P[BASE + 1]), a1 = cvtpk(P[BASE + 2], P[BASE + 3]);   \
    unsigned b0 = cvtpk(P[BASE + 4], P[BASE + 5]), b1 = cvtpk(P[BASE + 6], P[BASE + 7]);                              \
    auto r0 = __builtin_amdgcn_permlane32_swap(a0, b0, false, false); auto r1 = __builtin_amdgcn_permlane32_swap(a1, b1, false, false); \
    u32x4 w = {r0[0], r1[0], r0[1], r1[1]}; OUT = *reinterpret_cast<bf16x8*>(&w); } while (0)
  PK4(p0, 0, pa0); PK4(p0, 8, pa1); PK4(p1, 0, pa2); PK4(p1, 8, pa3);
#undef PK4
}
__device__ __forceinline__ void qkt(f32x16& p0, f32x16& p1, const bf16_t* Ks, const bf16x8* qr, int r32, int hi) {
  p0 = f32x16{}; p1 = f32x16{};
  for (int d0 = 0; d0 < 8; ++d0) { int cb = (d0 * 16 + hi * 8) * 2;
    bf16x8 b0 = *reinterpret_cast<const bf16x8*>((const char*)Ks + KSWZ(r32, cb));
    bf16x8 b1 = *reinterpret_cast<const bf16x8*>((const char*)Ks + KSWZ(32 + r32, cb));
    p0 = __builtin_amdgcn_mfma_f32_32x32x16_bf16(b0, qr[d0], p0, 0, 0, 0);
    p1 = __builtin_amdgcn_mfma_f32_32x32x16_bf16(b1, qr[d0], p1, 0, 0, 0); }
}
__device__ __forceinline__ int v_st(int k, int c) { const int kk = (k & ~0xC) | ((k & 4) << 1) | ((k & 8) >> 1); return ((kk >> 3) * 4 + (c >> 5)) * 512 + ((kk & 7) * 32 + (c & 31)) * 2; }
__device__ __forceinline__ int v_rd_base(int lane) { return ((lane & 3) << 3) | (((lane >> 2) & 3) << 6) | (((lane >> 4) & 1) << 5) | (((lane >> 5) & 1) << 8); }
constexpr int v_rd_off(int d0, int ks, int half) { return d0 * 512 + ks * 4096 + half * 2048; }
template <int OFF> __device__ __forceinline__ s16x4 tr_read(int vb) { s16x4 r; asm volatile("ds_read_b64_tr_b16 %0, %1 offset:%2" : "=&v"(r) : "v"(vb), "i"(OFF) : "memory"); return r; }
template <int D0> __device__ __forceinline__ void pv_one(f32x16& od, int vb, bf16x8 pa0, bf16x8 pa1, bf16x8 pa2, bf16x8 pa3) {
  const s16x4 l0 = tr_read<v_rd_off(D0, 0, 0)>(vb), h0 = tr_read<v_rd_off(D0, 0, 1)>(vb), l1 = tr_read<v_rd_off(D0, 1, 0)>(vb), h1 = tr_read<v_rd_off(D0, 1, 1)>(vb);
  const s16x4 l2 = tr_read<v_rd_off(D0, 2, 0)>(vb), h2 = tr_read<v_rd_off(D0, 2, 1)>(vb), l3 = tr_read<v_rd_off(D0, 3, 0)>(vb), h3 = tr_read<v_rd_off(D0, 3, 1)>(vb);
  asm volatile("s_waitcnt lgkmcnt(0)" ::: "memory"); SBAR();
  od = __builtin_amdgcn_mfma_f32_32x32x16_bf16(pa0, MK8(l0, h0), od, 0, 0, 0);
  od = __builtin_amdgcn_mfma_f32_32x32x16_bf16(pa1, MK8(l1, h1), od, 0, 0, 0);
  od = __builtin_amdgcn_mfma_f32_32x32x16_bf16(pa2, MK8(l2, h2), od, 0, 0, 0);
  od = __builtin_amdgcn_mfma_f32_32x32x16_bf16(pa3, MK8(l3, h3), od, 0, 0, 0);
}
__device__ __forceinline__ void pv_d0(f32x16* o, int vb, bf16x8 pa0, bf16x8 pa1, bf16x8 pa2, bf16x8 pa3) {
  pv_one<0>(o[0], vb, pa0, pa1, pa2, pa3); pv_one<1>(o[1], vb, pa0, pa1, pa2, pa3); pv_one<2>(o[2], vb, pa0, pa1, pa2, pa3); pv_one<3>(o[3], vb, pa0, pa1, pa2, pa3);
}
template <int LDQ>
__device__ __forceinline__ void attn_dense_body(const bf16_t* Qb, const bf16_t* __restrict__ Kh, const bf16_t* __restrict__ Vh, bf16_t* Ob, int seq, char* lds, const int wid) {
  constexpr int LDK = 128;
  const int lane = lane_id_(), tid = wid * 64 + lane, r32 = lane & 31, hi = lane >> 5;
  bf16_t* V_lds = (bf16_t*)lds; bf16_t* K_lds = (bf16_t*)(lds + 2 * SHM_V);
  float* ws = (float*)(lds + 2 * SHM_V + 2 * SHM_K) + wid * 64; float* li_l = ws; float* al_l = ws + 32;
  float m_reg = -1e30f, l_reg = 0; f32x16 o[4] = {}; bf16x8 qr[8];
  const bf16_t* Qw = Qb + (long)(wid * QBLK + r32) * LDQ + hi * 8;
#pragma unroll
  for (int d0 = 0; d0 < 8; ++d0) qr[d0] = *reinterpret_cast<const bf16x8*>(Qw + d0 * 16);
  const int sr = tid >> 4, sc = (tid & 15) * 8, vst0 = v_st(sr, sc), vst1 = v_st(32 + sr, sc);
  const int vb0 = (int)(uintptr_t)V_lds + v_rd_base(lane);
  struct { bf16x8 vs0, vs1, ks0, ks1; } sr_[2];
#define SLOAD(i, k0) do { sr_[i].vs0 = *(const bf16x8*)(&Vh[(long)((k0) + sr) * LDK + sc]); sr_[i].vs1 = *(const bf16x8*)(&Vh[(long)((k0) + 32 + sr) * LDK + sc]); \
    sr_[i].ks0 = *(const bf16x8*)(&Kh[(long)((k0) + sr) * LDK + sc]); sr_[i].ks1 = *(const bf16x8*)(&Kh[(long)((k0) + 32 + sr) * LDK + sc]); } while (0)
#define SWRITE(b, i) do { *(bf16x8*)((char*)V_lds + (b) * SHM_V + vst0) = sr_[i].vs0;          \
    *(bf16x8*)((char*)V_lds + (b) * SHM_V + vst1) = sr_[i].vs1; int kc = sc * 2;               \
    *(bf16x8*)((char*)K_lds + (b) * SHM_K + KSWZ(sr, kc)) = sr_[i].ks0;                       \
    *(bf16x8*)((char*)K_lds + (b) * SHM_K + KSWZ(32 + sr, kc)) = sr_[i].ks1; } while (0)
#define SWAIT() asm volatile("s_waitcnt vmcnt(4)" ::: "memory")
#define RESC(a) do { if (__any((a) < 1.f)) { if (hi == 0) al_l[r32] = (a); asm volatile("s_waitcnt lgkmcnt(0)" ::: "memory"); \
    for (int d = 0; d < 4; ++d) for (int r = 0; r < 16; ++r) o[d][r] *= al_l[crow(r, hi)]; } } while (0)
  f32x16 pA0, pA1, pB0, pB1; float mnA, mnB, alA, alB; bf16x8 pa0, pa1, pa2, pa3; const int NT = seq / KVBLK;
  constexpr int SE = 0, SO = 1;
  SLOAD(SE, 0); asm volatile("s_waitcnt vmcnt(0)" ::: "memory"); SWRITE(0, SE); __syncthreads();
  qkt(pA0, pA1, K_lds, qr, r32, hi); partialSM(pA0, pA1, m_reg, mnA, alA);
  SLOAD(SO, KVBLK); if (2 < NT) SLOAD(SE, 2 * KVBLK);
  SWAIT(); SWRITE(1, SO); __syncthreads();
  for (int j = 1; j + 1 < NT; j += 2) {
    SBAR(); qkt(pB0, pB1, (bf16_t*)((char*)K_lds + SHM_K), qr, r32, hi);
    finishSM(pA0, pA1, alA, l_reg, pa0, pa1, pa2, pa3); SBAR();
    SLOAD(SO, (j + 2) * KVBLK); SBAR();
    pv_d0(o, vb0, pa0, pa1, pa2, pa3); partialSM(pB0, pB1, m_reg, mnB, alB);
    __syncthreads(); SWAIT(); SWRITE(0, SE);
    RESC(alB); __syncthreads();
    SBAR(); qkt(pA0, pA1, K_lds, qr, r32, hi);
    finishSM(pB0, pB1, alB, l_reg, pa0, pa1, pa2, pa3); SBAR();
    if (j + 3 < NT) SLOAD(SE, (j + 3) * KVBLK); SBAR();
    pv_d0(o, vb0 + (int)SHM_V, pa0, pa1, pa2, pa3); partialSM(pA0, pA1, m_reg, mnA, alA);
    __syncthreads(); SWAIT(); SWRITE(1, SO);
    RESC(alA); __syncthreads();
  }
  SBAR(); qkt(pB0, pB1, (bf16_t*)((char*)K_lds + SHM_K), qr, r32, hi);
  finishSM(pA0, pA1, alA, l_reg, pa0, pa1, pa2, pa3); SBAR();
  pv_d0(o, vb0, pa0, pa1, pa2, pa3); partialSM(pB0, pB1, m_reg, mnB, alB);
  __syncthreads(); RESC(alB);
  finishSM(pB0, pB1, alB, l_reg, pa0, pa1, pa2, pa3); SBAR();
  pv_d0(o, vb0 + (int)SHM_V, pa0, pa1, pa2, pa3);
  if (hi == 0) li_l[r32] = l_reg; asm volatile("s_waitcnt lgkmcnt(0)" ::: "memory");
  float rli[16];
#pragma unroll
  for (int r = 0; r < 16; ++r) rli[r] = __builtin_amdgcn_rcpf(li_l[crow(r, hi)]);
  bf16_t* Ow = Ob + (long)(wid * QBLK) * LDQ;
#pragma unroll
  for (int r = 0; r < 16; ++r) { int orow = crow(r, hi);
    for (int d0 = 0; d0 < 4; ++d0) Ow[(long)orow * LDQ + d0 * 32 + r32] = (bf16_t)f2bf(o[d0][r] * rli[r]); }
  __syncthreads();
#undef SLOAD
#undef SWRITE
#undef SWAIT
#undef RESC
}
#undef KSWZ
#undef SBAR
}

struct R3Regs { u32x4 k[2], v[4], s[4], srg[4]; bf16x8 q[2]; };
__device__ __forceinline__ void r3_load(const Frame& F, CArgs& A, int item, R3Regs& R) {
    unsigned char* ws = A.ws;
    const bf16_t* RQb = (const bf16_t*)(ws + WS_RQ); const bf16_t* RKb = (const bf16_t*)(ws + WS_RK); const bf16_t* RVb = (const bf16_t*)(ws + WS_RV);
    const bf16_t* SRGb = (const bf16_t*)(ws + WS_SRG); const bf16_t* KVS = (const bf16_t*)(ws + WS_H);
    const int cg = item >> 3, h = item & 7; const size_t row0 = (size_t)cg * 128;
#pragma unroll
    for (int i = 0; i < 2; ++i) { const int ci = F.tid + i * NTHR; R.k[i] = *(const u32x4*)(RKb + (row0 + (ci >> 3)) * 512 + 64 * h + 8 * (ci & 7)); }
#pragma unroll
    for (int i = 0; i < 4; ++i) { const int ci = F.tid + i * NTHR, j = ci >> 4, c8 = ci & 15;
        R.v[i] = *(const u32x4*)(RVb + (row0 + j) * 1024 + 128 * h + 8 * c8);
        R.s[i] = *(const u32x4*)(KVS + (size_t)item * 2 * 8192 + (size_t)j * 128 + 8 * c8); }
    const size_t gofs = (row0 + 16 * F.wave + (F.lane >> 2)) * 1024 + 128 * h + (F.lane & 3) * 32;
#pragma unroll
    for (int c = 0; c < 4; ++c) R.srg[c] = *(const u32x4*)(SRGb + gofs + 8 * c);
#pragma unroll
    for (int s = 0; s < 2; ++s) R.q[s] = *(const bf16x8*)(RQb + (row0 + 16 * F.wave + (F.lane & 15)) * 512 + 64 * h + 32 * s + 8 * (F.lane >> 4));
}
__device__ __forceinline__ void r3_item(const Frame& F, CArgs& A, int item, int item_next, R3Regs& R, int after_next, LAS int* slot) {
    unsigned char* ws = A.ws; bf16_t* RVb = (bf16_t*)(ws + WS_RV);
    LAS bf16_t* kl = (LAS bf16_t*)F.lds; LAS bf16_t* vl = kl + 128 * KLD; LAS bf16_t* sl = vl + 128 * 128; LAS bf16_t* pl = sl + 128 * 128 + F.wave * (16 * VLD);
    const int cg = item >> 3, h = item & 7; const size_t row0 = (size_t)cg * 128;
    const float lgf = log_sigmoid_(A.dec_f[h]) * 1.4426950408889634f, lgb = log_sigmoid_(A.dec_b[h]) * 1.4426950408889634f;
#pragma unroll
    for (int i = 0; i < 2; ++i) { const int ci = F.tid + i * NTHR; *(LAS u32x4*)(kl + (ci >> 3) * KLD + 8 * (ci & 7)) = R.k[i]; }
#pragma unroll
    for (int i = 0; i < 4; ++i) { const int ci = F.tid + i * NTHR, j = ci >> 4, c8 = ci & 15; *(LAS u32x4*)((LAS char*)vl + vsw(j, c8)) = R.v[i]; *(LAS u32x4*)((LAS char*)sl + vsw(j, c8)) = R.s[i]; }
    int lane_ = F.lane; asm volatile("" : "+v"(lane_));
    const int g = lane_ >> 4, l15 = lane_ & 15, q = l15 >> 2, p = lane_ & 3, w = F.wave;
    const size_t gofs = (row0 + 16 * w + (lane_ >> 2)) * 1024 + 128 * h + (lane_ & 3) * 32;
    u32x4 srg_[4]; bf16x8 qf[2];
#pragma unroll
    for (int c = 0; c < 4; ++c) srg_[c] = R.srg[c];
#pragma unroll
    for (int s = 0; s < 2; ++s) qf[s] = R.q[s];
    __syncthreads();
    if (item_next >= 0) r3_load(F, A, item_next, R);
    float rf[4], rb[4];
#pragma unroll
    for (int e = 0; e < 4; ++e) { const float fi = (float)(16 * w + 4 * g + e); rf[e] = __builtin_amdgcn_exp2f(lgf * fi); rb[e] = __builtin_amdgcn_exp2f(-lgb * fi); }
#pragma unroll
    for (int nt = 0; nt < 8; ++nt) { f32x4 sacc = {0.f, 0.f, 0.f, 0.f};
#pragma unroll
        for (int s = 0; s < 2; ++s) { const bf16x8 kfr = *(const LAS bf16x8*)(kl + (16 * nt + l15) * KLD + 32 * s + 8 * g); sacc = __builtin_amdgcn_mfma_f32_16x16x32_bf16(qf[s], kfr, sacc, 0, 0, 0); }
        const int j = 16 * nt + l15;
        if (nt < w) {
            const float cf = __builtin_amdgcn_exp2f(-lgf * (float)j);
#pragma unroll
            for (int e = 0; e < 4; ++e) pl[(4 * g + e) * VLD + j] = (bf16_t)f2bf(sacc[e] * (rf[e] * cf));
        } else if (nt > w) {
            const float cb = __builtin_amdgcn_exp2f(lgb * (float)j);
#pragma unroll
            for (int e = 0; e < 4; ++e) pl[(4 * g + e) * VLD + j] = (bf16_t)f2bf(sacc[e] * (rb[e] * cb));
        } else {
            const float cf = __builtin_amdgcn_exp2f(-lgf * (float)j), cb = __builtin_amdgcn_exp2f(lgb * (float)j);
#pragma unroll
            for (int e = 0; e < 4; ++e) { const int df = 16 * w + 4 * g + e - j;
                const float dm = (df >= 0 ? rf[e] * cf : 0.f) + (df <= 0 ? rb[e] * cb : 0.f);
                pl[(4 * g + e) * VLD + j] = (bf16_t)f2bf(sacc[e] * dm); } } }
    LDS_WAIT(); asm volatile("" ::: "memory");
    bf16x8 pa[4], qa[4];
#pragma unroll
    for (int s = 0; s < 4; ++s) pa[s] = *(const LAS bf16x8*)(pl + l15 * VLD + 32 * s + 8 * g);
    { const int i = 16 * w + l15; const float qdf = __builtin_amdgcn_exp2f(lgf * (float)(i + 1)), qdb = __builtin_amdgcn_exp2f(lgb * (float)(128 - i));
#pragma unroll
      for (int s = 0; s < 2; ++s) { f32x4 a, b; unpack8(__builtin_bit_cast(u32x4, qf[s]), a, b); qa[s] = __builtin_bit_cast(bf16x8, pack8(a * qdf, b * qdf)); qa[2 + s] = __builtin_bit_cast(bf16x8, pack8(a * qdb, b * qdb)); } }
    f32x4 oacc[8];
#pragma unroll
    for (int nt = 0; nt < 8; ++nt) { f32x4 acc = {0.f, 0.f, 0.f, 0.f};
#pragma unroll
        for (int s = 0; s < 4; ++s) { const int R0 = 32 * s + 8 * g + q, col = 16 * nt + 4 * p;
            const s16x4 lo = tr_read16((const LAS bf16_t*)((const LAS char*)vl + vsw_tr(R0, col))), hi = tr_read16((const LAS bf16_t*)((const LAS char*)vl + vsw_tr(R0 + 4, col)));
            acc = __builtin_amdgcn_mfma_f32_16x16x32_bf16(pa[s], MK8(lo, hi), acc, 0, 0, 0); }
#pragma unroll
        for (int s = 0; s < 4; ++s) { const int R0 = 32 * s + 8 * g + q, col = 16 * nt + 4 * p;
            const s16x4 lo = tr_read16((const LAS bf16_t*)((const LAS char*)sl + vsw_tr(R0, col))), hi = tr_read16((const LAS bf16_t*)((const LAS char*)sl + vsw_tr(R0 + 4, col)));
            acc = __builtin_amdgcn_mfma_f32_16x16x32_bf16(qa[s], MK8(lo, hi), acc, 0, 0, 0); }
        oacc[nt] = acc; }
    f32x4 ss = {0.f, 0.f, 0.f, 0.f};
#pragma unroll
    for (int nt = 0; nt < 8; ++nt) ss += oacc[nt] * oacc[nt];
#pragma unroll
    for (int e = 0; e < 4; ++e) { float s = ss[e]; s += __shfl_xor(s, 1); s += __shfl_xor(s, 2); s += __shfl_xor(s, 4); s += __shfl_xor(s, 8); ss[e] = __builtin_amdgcn_rsqf(s * (1.0f / 128.0f) + EPS); }
#pragma unroll
    for (int nt = 0; nt < 8; ++nt)
#pragma unroll
        for (int e = 0; e < 4; ++e) pl[(4 * g + e) * VLD + 16 * nt + l15] = (bf16_t)f2bf(oacc[nt][e] * ss[e]);
    LDS_WAIT(); asm volatile("" ::: "memory");
#pragma unroll
    for (int c = 0; c < 4; ++c) { f32x4 o0, o1, g0, g1; unpack8(*(const LAS u32x4*)(pl + (lane_ >> 2) * VLD + (lane_ & 3) * 32 + 8 * c), o0, o1); unpack8(srg_[c], g0, g1);
        *(u32x4*)(RVb + gofs + 8 * c) = pack8(o0 * g0, o1 * g1); }
    if (F.tid == 0) *slot = after_next;
    __syncthreads();
}

__device__ __forceinline__ void phase_attn(const Frame& F, CArgs& A) {
    unsigned char* ws = A.ws; bf16_t* Q = (bf16_t*)(ws + WS_Q);
    {
        LAS float* scr = (LAS float*)(F.lds + F.wave * 8704);
        const int gw = F.bid * NWAVES + F.wave, NGW = F.G * NWAVES;
        constexpr int I_O = 16 * 32, NIT = 3 * I_O;
        for (int it = gw; it < NIT; it += NGW) {
            int r = it;
            if (r < I_O) { transpose_item(A.w_att_o, 1024, (bf16_t*)(ws + WS_WB), 2048, 0, 64 * (r / 32), 32 * (r % 32), ColId(), scr, F.lane); continue; } r -= I_O;
            if (r < I_O) { transpose_item(A.w_ret_o, 1024, (bf16_t*)(ws + WS_WB), 2048, 1024, 64 * (r / 32), 32 * (r % 32), ColId(), scr, F.lane); continue; } r -= I_O;
            transpose_item(A.w_out, 1024, (bf16_t*)(ws + WS_WC), 1024, 0, 64 * (r / 32), 32 * (r % 32), ColId(), scr, F.lane);
        }
        __syncthreads();
    }
    const int x = F.bid & 7, c = F.bid >> 3;
    const int nun = F.bid < NB * NH ? 3 : 2;
    unsigned* qctr = (unsigned*)(ws + WS_CNT) + 64 * CNT_R3Q; LAS int* slot = (LAS int*)(F.lds + 122880);
    int nxt_v = 0; if (F.tid == 0) nxt_v = (int)__hip_atomic_fetch_add(qctr, 1u, RLX_AGENT) + F.G;
#pragma nounroll
    for (int i = 0; i < nun; ++i) {
        const bf16_t *Kh, *Vh; bf16_t* Qb; int seq;
        if (i < 2) { const int lb = x >> 1, kvh = x & 1, uu = c + 32 * i, hq = kvh * 4 + (uu >> 4), qb = uu & 15;
            Kh = (const bf16_t*)(ws + WS_KALL) + (size_t)(lb * 2 + kvh) * SKV * 128; Vh = (const bf16_t*)(ws + WS_VALL) + (size_t)(lb * 2 + kvh) * SKV * 128;
            Qb = Q + ((size_t)MP + (size_t)lb * DSEQ + qb * 256) * 1024 + hq * 128; seq = SKV; }
        else { const int b = F.bid >> 3, hq = F.bid & 7, kvh = hq >> 2;
            Kh = (const bf16_t*)(ws + WS_KP) + (size_t)(b * 2 + kvh) * SEQ * 128; Vh = (const bf16_t*)(ws + WS_VP) + (size_t)(b * 2 + kvh) * SEQ * 128;
            Qb = Q + (size_t)b * SEQ * 1024 + hq * 128; seq = SEQ; }
        att::attn_dense_body<1024>(Qb, Kh, Vh, Qb, seq, (char*)F.lds, F.wave);
    }
    {
      constexpr int NIT3 = (MT / 128) * 8;
      Frame F2 = F; F2.lane = lane_id_(); F2.tid = F2.wave * 64 + F2.lane;
      if (F2.tid == 0) *slot = nxt_v;
      __syncthreads();
      int cur = F.bid, nxt = __builtin_amdgcn_readfirstlane(*slot); if (nxt >= NIT3) nxt = -1;
      R3Regs R; r3_load(F2, A, cur, R);
      while (cur >= 0) {
          int n2_v = -1; if (nxt >= 0 && F2.tid == 0) n2_v = (int)__hip_atomic_fetch_add(qctr, 1u, RLX_AGENT) + F.G;
          r3_item(F2, A, cur, nxt, R, n2_v, slot);
          cur = nxt; nxt = __builtin_amdgcn_readfirstlane(*slot); if (nxt >= NIT3) nxt = -1;
      }
    }
}

struct OneUnit { int pm, pn; __device__ __forceinline__ bool next(int i, pg8::Unit& u) const { if (i) return false; u.pm = pm; u.pn = pn; return true; }
    __device__ __forceinline__ void a_ready(const pg8::Unit&, int) const {} };
constexpr int NU2 = 0, NU3 = 320, NU4 = (MT / 256) * (NUP / 256), NU5 = 320, NUTOT = NU2 + NU3 + NU4 + NU5;
__device__ __forceinline__ void fix_panel(const Frame& F, CArgs& A, int pm) {
    unsigned char* ws = A.ws; const float* EU = (const float*)(ws + WS_EDGE_U); const float* EUC = (const float*)(ws + WS_EDGE_UC); bf16_t* ACT = (bf16_t*)(ws + WS_ACT);
    const int jt = (pm - 16) & 15;
    for (int i = F.tid; i < 2 * DFF; i += NTHR) { const int j = i % DFF, e = i / DFF;
        if ((e == 0 && jt == 0) || (e == 1 && jt == 15)) continue;
        const int pmn = e ? pm + 1 : pm - 1, na = 256 * (j >> 7) + (j & 127), ng = na + 128, tap = e ? 2 : 0;
        const float ua = EUC[((size_t)pm * 2 + e) * NUP + na] + A.conv_w[(size_t)tap * NUP + j] * EU[((size_t)pmn * 2 + (1 - e)) * NUP + na];
        const float ug = EUC[((size_t)pm * 2 + e) * NUP + ng] + A.conv_w[(size_t)tap * NUP + DFF + j] * EU[((size_t)pmn * 2 + (1 - e)) * NUP + ng];
        ACT[((size_t)pm * 256 + (e ? 255 : 0)) * DFF + j] = (bf16_t)f2bf(siluf_(ug) * ua); }
}
__device__ __forceinline__ void g3_unit(const Frame& F, CArgs& A, int idx) {
    unsigned char* ws = A.ws; unsigned* cnt = (unsigned*)(ws + WS_CNT); const int pm = idx >> 2, pn = idx & 3;
    OneUnit S{pm, pn};
    pg8::Gemm g{(const bf16_t*)(ws + WS_Y), (const bf16_t*)(ws + WS_WC), MT, DM, DM, DM, DM, 1 << 30, 0};
    EpiRes1 E{A.x_prompt, A.x_sample, (const float*)(ws + WS_MODF), A.norm2_g, (bf16_t*)(ws + WS_X1B), (float*)(ws + WS_SSQ1), (bf16_t*)(ws + WS_H)};
    pg8::gemm_phase(F.lds, g, S, E, F.wave);
    asm volatile("s_waitcnt vmcnt(0)" ::: "memory");
    __syncthreads();
    if (F.wave == 0 && lane_id_() == 0) { __hip_atomic_fetch_add(cnt + 64 * (CNT_D3 + pm), 1u, RLX_AGENT); __hip_atomic_fetch_add(cnt + 64 * CNT_G3ALL, 1u, RLX_AGENT); }
}
__device__ __forceinline__ void phase_mix(const Frame& F, CArgs& A) {
    unsigned char* ws = A.ws; unsigned* cnt = (unsigned*)(ws + WS_CNT);
    const int v = (F.bid & 7) * (F.G >> 3) + (F.bid >> 3);
#if defined(PROBE_K0) && (PROBE_K0 == 301 || PROBE_K0 == 302)
    const unsigned long long tmix0_ = __builtin_amdgcn_s_memrealtime();
#endif
    {   struct G2Run { int v, n; __device__ __forceinline__ bool next(int i, pg8::Unit& u) const { if (i >= n) return false; const int l = i == 0 ? v : 256 + v; u.pm = l >> 2; u.pn = l & 3; return true; }
            __device__ __forceinline__ void a_ready(const pg8::Unit&, int) const {} };
        G2Run S{v, v < 64 ? 2 : 1};
        pg8::Gemm g{(const bf16_t*)(ws + WS_Q), (const bf16_t*)(ws + WS_WB), MT, DM, 2 * DM, DM, 2 * DM, 16, (long)(WS_RV - WS_Q) - 16 * 128};
        EpiMix E{(const bf16_t*)A.out, (const bf16_t*)A.out + (size_t)MT * DM, (bf16_t*)(ws + WS_Y), cnt + 64 * CNT_D2};
        pg8::gemm_phase(F.lds, g, S, E, F.wave);
    }
#if defined(PROBE_K0) && PROBE_K0 == 300
    const unsigned long long t0_ = __builtin_amdgcn_s_memrealtime();
#endif
#if defined(PROBE_K0) && PROBE_K0 == 301
    if (v == PROBE_BID && F.tid == 0) *(float*)(ws + 32768) = (float)(__builtin_amdgcn_s_memrealtime() - tmix0_);
#endif
    if (v >= 64) { const int idx = v - 64, pm = idx >> 2;
        if (F.wave == 0) { spin_ge(cnt + 64 * (CNT_D2 + pm), 4u); __builtin_amdgcn_fence(__ATOMIC_ACQUIRE, "agent"); asm volatile("s_waitcnt vmcnt(0)" ::: "memory"); }
        __syncthreads();
        g3_unit(F, A, idx);
        __syncthreads();
        LAS float* scr = (LAS float*)(F.lds + F.wave * 8704);
        constexpr int I_DN = (DFF / 64) * 32, I_UP = 16 * (NUP / 32);
        for (int it = (v - 64) * NWAVES + F.wave; it < I_DN + I_UP; it += (F.G - 64) * NWAVES) {
            if (it < I_DN) transpose_item(A.w_down, 1024, (bf16_t*)(ws + WS_WD), DFF, 0, 64 * (it / 32), 32 * (it % 32), ColId(), scr, F.lane);
            else { const int r = it - I_DN; transpose_item(A.w_up, NUP, (bf16_t*)(ws + WS_WA), 1024, 0, 64 * (r / (NUP / 32)), 32 * (r % (NUP / 32)), ColUp(), scr, F.lane); } }
    }
#if defined(PROBE_K0) && PROBE_K0 == 300
    if (v == PROBE_BID && F.tid == 0) *(float*)(ws + 32768) = (float)(__builtin_amdgcn_s_memrealtime() - t0_);
#endif
#if defined(PROBE_K0) && PROBE_K0 == 302
    if (v == PROBE_BID && F.tid == 0) *(float*)(ws + 32768) = (float)(__builtin_amdgcn_s_memrealtime() - tmix0_);
#endif
}
__device__ __forceinline__ void phase_stream(const Frame& F, CArgs& A) {
    unsigned char* ws = A.ws; unsigned* cnt = (unsigned*)(ws + WS_CNT);
    LAS float* spare = (LAS float*)(F.lds + SPARE_OFF);
    const int NOJ = 1 << 30;
    const int v = (F.bid & 7) * (F.G >> 3) + (F.bid >> 3);
#if defined(PROBE_K0) && PROBE_K0 >= 100 && PROBE_K0 < 200
    unsigned long long tacc_ = 0, tl_ = __builtin_amdgcn_s_memrealtime();
#define SPROBE(cat) do { const unsigned long long tn_ = __builtin_amdgcn_s_memrealtime(); if ((cat) == PROBE_K0 - 100 || PROBE_K0 - 100 == 3) tacc_ += tn_ - tl_; tl_ = tn_; } while (0)
#else
#define SPROBE(cat) do { } while (0)
#endif
    const int nG4 = v < 96 ? 8 : v < 224 ? 7 : 3, nG5 = v >= 224 ? 3 : 1;
    if (v >= 96 && v < 224) g3_unit(F, A, 192 + (v - 96));
    SPROBE(0);
    {   struct G4Run { int v, n; unsigned* d3; unsigned* g3all; volatile LAS unsigned* alld; unsigned* d4; mutable int p0, p1;
            __device__ __forceinline__ void publish(int pm) const {
                if (pm >= 0) { asm volatile("s_waitcnt vmcnt(0)" ::: "memory"); if (lane_id_() == 0) __hip_atomic_fetch_add(d4 + 64 * pm, 1u, RLX_AGENT); } }
            __device__ __forceinline__ bool next(int r, pg8::Unit& u) const { if (r >= n) return false;
                const int l = r < 3 ? 256 * r + v : r < 7 ? 768 + 224 * (r - 3) + v : 1664 + v;
                const int sr = l / 176, rem = l % 176, blk = rem < 160 ? rem >> 5 : 5, w = rem < 160 ? rem & 31 : rem - 160;
                u.pm = 8 * sr + (w & 7); u.pn = 4 * blk + (w >> 3); return true; }
            __device__ __forceinline__ void a_ready(const pg8::Unit& u, int wid) const {
                publish(p0); p0 = p1; p1 = u.pm;
                if (wid == 0 && *alld == 0u) {
                    const bool all = (unsigned)__builtin_amdgcn_readfirstlane(__hip_atomic_load(g3all, RLX_AGENT)) >= 320u;
                    spin_ge(d3 + 64 * u.pm, 4u);
                    if (u.pm >= 63) spin_ge(g3all, 320u);
                    __builtin_amdgcn_fence(__ATOMIC_ACQUIRE, "agent"); asm volatile("s_waitcnt vmcnt(0)" ::: "memory");
                    if (all) *alld = 1u; }
                asm volatile("" ::: "memory"); __builtin_amdgcn_s_barrier(); asm volatile("" ::: "memory"); } };
        volatile LAS unsigned* alld = (volatile LAS unsigned*)(F.lds + MISC_OFF) + 16;
        if (F.tid == 0) *alld = 0u;
        __syncthreads();
        G4Run S{v, nG4, cnt + 64 * CNT_D3, cnt + 64 * CNT_G3ALL, alld, cnt + 64 * CNT_D4, -1, -1};
        pg8::Gemm g{(const bf16_t*)(ws + WS_H), (const bf16_t*)(ws + WS_WA), MT, NUP, DM, DM, DM, NOJ, 0};
        EpiConv E{(const float*)(ws + WS_SSQ1), (const float*)(ws + WS_BUPF), A.conv_w, A.conv_b, (bf16_t*)(ws + WS_ACT), (float*)(ws + WS_EDGE_U), (float*)(ws + WS_EDGE_UC), spare, cnt + 64 * CNT_D4};
        pg8::gemm_phase(F.lds, g, S, E, F.wave);
        S.publish(S.p0); S.publish(S.p1);
    }
    SPROBE(1);
    for (int j = 0; j < nG5; ++j) { const int l = v >= 224 ? 32 * j + (v - 224) : 96 + v, pm = l >> 2, pn = l & 3;
        if (F.wave == 0) { spin_ge(cnt + 64 * (CNT_D4 + pm), 176u);
            if (pm >= 16) { const int jt = (pm - 16) & 15; if (jt > 0) spin_ge(cnt + 64 * (CNT_D4 + pm - 1), 176u); if (jt < 15) spin_ge(cnt + 64 * (CNT_D4 + pm + 1), 176u); }
            __builtin_amdgcn_fence(__ATOMIC_ACQUIRE, "agent"); asm volatile("s_waitcnt vmcnt(0)" ::: "memory"); }
        __syncthreads();
        if (pm >= 16) { fix_panel(F, A, pm); asm volatile("s_waitcnt vmcnt(0)" ::: "memory"); __syncthreads(); }
        SPROBE(0);
        OneUnit S{pm, pn};
        pg8::Gemm g{(const bf16_t*)(ws + WS_ACT), (const bf16_t*)(ws + WS_WD), MT, DM, DFF, DFF, DFF, NOJ, 0};
        EpiRes2 E{(const float*)(ws + WS_MODF), A.final_g, (const bf16_t*)(ws + WS_X1B), A.out, (float*)(ws + WS_XS), cnt + 64 * CNT_X5, spare};
        pg8::gemm_phase(F.lds, g, S, E, F.wave);
        SPROBE(2);
    }
#if defined(PROBE_K0) && PROBE_K0 >= 100 && PROBE_K0 < 200
    if (v == PROBE_BID && F.tid == 0) *(float*)(ws + 32768) = (float)tacc_;
#endif
}

constexpr int N_PHASES = 8;
__global__ void __launch_bounds__(NTHR, 2) fwd_kernel(Args A_) {
    CArgs& A = *(CArgs*)__builtin_amdgcn_kernarg_segment_ptr();
    extern __shared__ __attribute__((aligned(16))) unsigned char lds_raw[];
    Frame F; F.lds = (LAS unsigned char*)lds_raw; F.wave = __builtin_amdgcn_readfirstlane(threadIdx.x >> 6); F.lane = lane_id_(); F.tid = F.wave * 64 + F.lane; F.G = gridDim.x; F.bid = blockIdx.x;
    volatile LAS unsigned* MISC = (volatile LAS unsigned*)(F.lds + MISC_OFF);
    if (F.tid < 64) MISC[F.tid] = 0u;
    __syncthreads();
    unsigned char* ws = A.ws;
    XcdBarrier bar = xcd_barrier_post((unsigned*)(ws + WS_CTL), MISC + 8, F.wave);
    const int lo = A.ph_lo, hi = A.ph_hi;
#ifdef ONLY_PHASE
#define IN(k) ((k) == ONLY_PHASE)
#else
#define IN(k) (lo <= (k) && (k) < hi)
#endif
#ifdef PROBE_K0
    unsigned long long tA_ = __builtin_amdgcn_s_memrealtime();
#define PROBE_AT(k) do { if ((k) == PROBE_K0 - 1) tA_ = __builtin_amdgcn_s_memrealtime(); \
    if ((k) == PROBE_K1 && F.bid == 0 && F.tid == 0) { const unsigned long long tB_ = __builtin_amdgcn_s_memrealtime(); *(float*)(ws + 32768) = (float)(tB_ - tA_) - 100.0f * PROBE_OFS; } } while (0)
#else
#define PROBE_AT(k) do { } while (0)
#endif
#define SEAM(k) do { if (IN(k) && IN((k) + 1)) xcd_barrier(bar); F.lane = lane_id_(); F.tid = F.wave * 64 + F.lane; PROBE_AT(k); } while (0)
    LAS float* spare = (LAS float*)(F.lds + SPARE_OFF);
    const int NOJ = 1 << 30;
    if (IN(0)) { phase0(F, A); } SEAM(0);
    if (IN(1)) { phase1(F, A); } SEAM(1);
    if (IN(2)) {
        pg8::Gemm g{(const bf16_t*)(ws + WS_H), (const bf16_t*)(ws + WS_WA), MT, DIN, DM, DM, DM, NOJ, 0};
        pg8::StaticOrder S; S.init(MT, DIN, F.G, F.bid, true);
        EpiIn E{(bf16_t*)(ws + WS_Q), (bf16_t*)(ws + WS_KALL), (bf16_t*)(ws + WS_VALL), (bf16_t*)(ws + WS_KP), (bf16_t*)(ws + WS_VP), (bf16_t*)(ws + WS_RQ), (bf16_t*)(ws + WS_RK),
                (bf16_t*)(ws + WS_RV), (bf16_t*)(ws + WS_SRG), (bf16_t*)A.out, (bf16_t*)A.out + (size_t)MT * DM, A.out + OUT_CK, A.out + OUT_CV, A.q_g, A.k_g, spare, (unsigned*)(ws + WS_CNT1)};
        pg8::gemm_phase(F.lds, g, S, E, F.wave);
        phase_r1(F, A);
    } SEAM(2);
    if (IN(4)) { phase_scan(F, A); } SEAM(4);
    if (IN(5)) { phase_attn(F, A); } SEAM(5);
    if (IN(6)) { phase_mix(F, A); } SEAM(6);
    if (IN(7)) { phase_stream(F, A); }
#ifdef PROBE_K0
    {
        PROBE_AT(7);
        xcd_barrier(bar);
        const float sc_ = 1.0f + sqrtf(*(const float*)(ws + 32768) * 1e-7f);
        for (int i = F.bid * NTHR + F.tid; i < NB * NKV * SEQ * HD; i += F.G * NTHR) A.out[OUT_CV + i] *= sc_;
    }
#endif
#undef IN
#undef SEAM
}

#ifndef MK_SPLIT
#define MK_SPLIT 0
#endif
extern "C" void kernel_launch(void* const* d_in, const int* in_sizes, int n_in, void* d_out, int out_size, void* d_ws, size_t ws_size, hipStream_t stream) {
    static int grid = 0;
    if (grid == 0) {
        if (n_in != 25 || ws_size < WS_END) { fprintf(stderr, "kernel_launch: unexpected n_in %d / ws %zu\n", n_in, ws_size); grid = -1; return; }
        int dev = 0, cus = 0, per_cu = 0;
        hipGetDevice(&dev); hipDeviceGetAttribute(&cus, hipDeviceAttributeMultiprocessorCount, dev);
        if (hipFuncSetAttribute((const void*)fwd_kernel, hipFuncAttributeMaxDynamicSharedMemorySize, LDS_BYTES) != hipSuccess) { fprintf(stderr, "kernel_launch: hipFuncSetAttribute failed\n"); grid = -1; return; }
        hipOccupancyMaxActiveBlocksPerMultiprocessor(&per_cu, (const void*)fwd_kernel, NTHR, LDS_BYTES);
        (void)hipGetLastError();
        if (per_cu < 1) fprintf(stderr, "kernel_launch: occupancy query says %d blocks/CU\n", per_cu);
        grid = cus;
        if (grid != 256) fprintf(stderr, "kernel_launch: %d CUs (built for 256)\n", grid);
    }
    if (grid < 0) return;
    hipMemsetAsync((char*)d_ws + WS_CTL, 0, CTL_ZERO_BYTES, stream);
    Args a{};
    const float** pa = (const float**)&a;
    for (int i = 0; i < 25; ++i) pa[i] = (const float*)d_in[i];
    a.out = (float*)d_out; a.ws = (unsigned char*)d_ws;
#if MK_SPLIT
    for (int p = 0; p < N_PHASES; ++p) { a.ph_lo = p; a.ph_hi = p + 1; hipLaunchKernelGGL(fwd_kernel, dim3(grid), dim3(NTHR), LDS_BYTES, stream, a); }
#else
    a.ph_lo = 0; a.ph_hi = N_PHASES; hipLaunchKernelGGL(fwd_kernel, dim3(grid), dim3(NTHR), LDS_BYTES, stream, a);
#endif
    const hipError_t le = hipPeekAtLastError();
    if (le != hipSuccess) fprintf(stderr, "kernel_launch: launch failed: %s\n", hipGetErrorName(le));
}
```

```cpp
#include <hip/hip_runtime.h>
#include <hip/hip_bf16.h>
#include <cstdio>
#include <cstdint>

#ifndef PROBE_BID
#define PROBE_BID 100
#endif
#ifndef PROBE_OFS
#define PROBE_OFS 0
#endif
constexpr int DM = 1024, NB = 16, SEQ = 256, DB = 4, DSEQ = 4096, PAST = 512, GRIDW = 64;
constexpr int NH = 8, NKV = 2, HD = 128, RH = 8, RDK = 64, RDV = 128, DFF = 2816, CHUNK = 128;
constexpr int MP = NB * SEQ, ML = DB * DSEQ, MT = MP + ML;
constexpr int DIN = 6656, SKV = DSEQ + PAST;
constexpr int NUP = 2 * DFF;
constexpr float EPS = 1e-6f;
constexpr int NCHUNK = MT / CHUNK;
constexpr int NITEM = NCHUNK * RH;

#define GAS __attribute__((address_space(1)))
#define LAS __attribute__((address_space(3)))
typedef unsigned short bf16_t;
typedef short bf16x8 __attribute__((ext_vector_type(8)));
typedef short s16x4 __attribute__((ext_vector_type(4)));
typedef float f32x4 __attribute__((ext_vector_type(4)));
typedef float f32x2 __attribute__((ext_vector_type(2)));
typedef float f32x16 __attribute__((ext_vector_type(16)));
typedef unsigned u32x4 __attribute__((ext_vector_type(4)));
typedef unsigned u32x2 __attribute__((ext_vector_type(2)));
typedef GAS unsigned gu32;

constexpr size_t MiB = 1u << 20;
constexpr size_t WS_CTL = 0, CTL_ZERO_BYTES = 16 * 1024;
constexpr size_t WS_MOD = 256 * 1024;
constexpr size_t MODQ = 5 * 6144;
constexpr size_t WS_MODF = 1 * MiB + 832 * 1024;
constexpr size_t WS_BUP = 768 * 1024;
constexpr size_t BUPQ = 5 * 5632;
constexpr size_t WS_BUPF = 1 * MiB + 384 * 1024;
constexpr size_t WS_SSQ1 = 1 * MiB + 256 * 1024;
constexpr size_t WS_XS = 1 * MiB + 512 * 1024;
constexpr size_t WS_CNT = 64 * 1024;
constexpr size_t WS_CNT1 = 152 * 1024;
constexpr int CNT_D2 = 0, CNT_D3 = 80, CNT_D4 = 160, CNT_X5 = 240, CNT_G3ALL = 320, CNT_R3Q = 321;
constexpr size_t WS_WA = 2 * MiB;
constexpr size_t WS_WB = 16 * MiB;
constexpr size_t WS_WC = 20 * MiB;
constexpr size_t WS_WD = 22 * MiB;
constexpr size_t WS_H = 28 * MiB;
constexpr size_t WS_Q = 68 * MiB;
constexpr size_t WS_KALL = 108 * MiB, WS_VALL = 117 * MiB, WS_KP = 126 * MiB, WS_VP = 128 * MiB;
constexpr size_t WS_RQ = 132 * MiB, WS_RK = 152 * MiB, WS_RV = 172 * MiB, WS_SRG = 212 * MiB, WS_END = 252 * MiB;
constexpr size_t WS_Y = WS_RQ;
constexpr size_t WS_X1B = WS_SRG;
constexpr size_t WS_ACT = WS_Q;
constexpr size_t WS_EDGE_U = 178 * MiB, WS_EDGE_UC = 182 * MiB;
static_assert((size_t)DIN * DM * 2 <= 14 * MiB && (size_t)MT * DM * 2 == 40 * MiB && (size_t)NITEM * 2 * RDK * RDV * 2 == 40 * MiB, "ws map");
static_assert((size_t)DB * NKV * SKV * HD * 2 <= 9 * MiB && (size_t)NB * NKV * SEQ * HD * 2 <= 2 * MiB, "ws map kv");
static_assert(WS_ACT + (size_t)MT * DFF * 2 <= WS_EDGE_U && (size_t)80 * 2 * NUP * 4 <= 4 * MiB && WS_EDGE_UC + 4 * MiB <= WS_X1B, "ws map act");
static_assert(WS_CNT + 322 * 256 <= WS_CNT1 && WS_CNT1 + (481 + 82) * 64 <= WS_MOD && WS_MOD + 4 * MODQ * 4 <= WS_BUP && WS_BUP + 4 * BUPQ * 4 <= WS_SSQ1 && WS_SSQ1 + (size_t)MT * 4 <= WS_BUPF
              && WS_BUPF + BUPQ * 4 <= WS_XS && WS_XS + (size_t)80 * 4 * 256 * 4 <= WS_MODF && WS_MODF + MODQ * 4 <= WS_WA, "ws map: small buffers");
constexpr size_t OUT_Y = 0, OUT_CK = (size_t)MT * DM, OUT_CV = OUT_CK + (size_t)NB * NKV * SEQ * HD, OUT_SF = OUT_CV + (size_t)NB * NKV * SEQ * HD, OUT_SB = OUT_SF + (size_t)NB * RH * RDK * RDV;

#define LDS_WAIT() asm volatile("s_waitcnt lgkmcnt(0)" ::: "memory")
#define VM_WAIT() asm volatile("s_waitcnt vmcnt(0)" ::: "memory")
#define RLX_AGENT __ATOMIC_RELAXED, __HIP_MEMORY_SCOPE_AGENT
typedef __bf16 bf16x2_t __attribute__((ext_vector_type(2)));
__device__ __forceinline__ unsigned pk2(float lo, float hi) { const f32x2 v = {lo, hi}; return __builtin_bit_cast(unsigned, __builtin_convertvector(v, bf16x2_t)); }
__device__ __forceinline__ unsigned f2bf(float f) { return pk2(f, 0.f) & 0xffffu; }
__device__ __forceinline__ float bflo(unsigned w) { return __builtin_bit_cast(float, w << 16); }
__device__ __forceinline__ float bfhi(unsigned w) { return __builtin_bit_cast(float, w & 0xffff0000u); }
__device__ __forceinline__ float bf2f(bf16_t h) { return __builtin_bit_cast(float, (unsigned)h << 16); }
__device__ __forceinline__ int swap25(int p) { return (p & ~0x24) | ((p & 4) << 3) | ((p & 32) >> 3); }
__device__ __forceinline__ float sigmoidf_(float x) { return __builtin_amdgcn_rcpf(1.0f + __builtin_amdgcn_exp2f(-1.4426950408889634f * x)); }
__device__ __forceinline__ float siluf_(float x) { return x * __builtin_amdgcn_rcpf(1.0f + __builtin_amdgcn_exp2f(-1.4426950408889634f * x)); }
__device__ __forceinline__ int lane_id_() { int l; asm volatile("v_mbcnt_lo_u32_b32 %0, -1, 0\n\tv_mbcnt_hi_u32_b32 %0, -1, %0" : "=v"(l)); return l; }
__device__ __forceinline__ f32x4 sum4q(const float* p, size_t q) { return (*(const f32x4*)p + *(const f32x4*)(p + q)) + (*(const f32x4*)(p + 2 * q) + *(const f32x4*)(p + 3 * q)); }
__device__ __forceinline__ float wave_sum(float v) {
#pragma unroll
    for (int o = 1; o < 64; o <<= 1) v += __shfl_xor(v, o);
    return v;
}
__device__ __forceinline__ void sincos_rev(float ang, float& c, float& s) {
    double rev = (double)ang * 0.15915494309189533577; rev -= __builtin_rint(rev);
    const float fr = (float)rev; s = __builtin_amdgcn_sinf(fr); c = __builtin_amdgcn_cosf(fr);
}
__device__ __forceinline__ float rope_inv(int i) { return exp2f(-(float)i * (13.287712379549449f / 32.0f)); }

#define XB_TMO      128
#define XB_XCNT(j)  (256  + 64 * (j))
#define XB_XSUB(j)  (1280 + 64 * (j))
#define XB_XGEN(j)  (2304 + 64 * (j))
#define XB_TOP      3328
#define XB_TOPGEN   3392
#define XCD_BAR_WORDS 3456
#define XB_SPIN_CAP (1u << 20)
__device__ __forceinline__ unsigned xb_ld(unsigned* p)              { return __hip_atomic_load(p, __ATOMIC_RELAXED, __HIP_MEMORY_SCOPE_AGENT); }
__device__ __forceinline__ unsigned xb_add(unsigned* p, unsigned v) { return __hip_atomic_fetch_add(p, v, __ATOMIC_RELAXED, __HIP_MEMORY_SCOPE_AGENT); }
__device__ __forceinline__ unsigned xb_xcc_id() { return (unsigned)__builtin_amdgcn_s_getreg((3 << 11) | 20) & 0xFu; }
#define XB_SPIN(cond, bar) do { unsigned _sp = 0; while (cond) { __builtin_amdgcn_s_sleep(1); \
    if ((++_sp & 255u) == 0u) { if (xb_ld(&(bar)[XB_TMO])) break; if (_sp > XB_SPIN_CAP) { atomicAdd(&(bar)[XB_TMO], 1u); break; } } } } while (0)
struct XcdBarrier { unsigned* bar; unsigned x; volatile LAS unsigned* st; int wave; };
__device__ __forceinline__ XcdBarrier xcd_barrier_post(unsigned* bar, volatile LAS unsigned* st, int wave) {
    XcdBarrier b; b.bar = bar; b.x = xb_xcc_id(); b.st = st; b.wave = wave;
    if (wave == 0 && lane_id_() == 0) (void)xb_add(&bar[XB_XCNT(b.x)], 1u);
    return b;
}
__device__ __forceinline__ void xcd_barrier_complete(unsigned* bar, unsigned x, unsigned& nloc, unsigned& nx) {
    const unsigned G = gridDim.x * gridDim.y * gridDim.z;
    unsigned sum, cnt, mine, sp = 0u;
    for (;;) {
        sum = 0u; cnt = 0u; mine = 0u;
#pragma unroll
        for (unsigned j = 0; j < 16; ++j) { const unsigned c = xb_ld(&bar[XB_XCNT(j)]); sum += c; cnt += (c > 0u) ? 1u : 0u; mine = (j == x) ? c : mine; }
        if (sum == G) break;
        __builtin_amdgcn_s_sleep(1);
        if ((++sp & 255u) == 0u) { if (xb_ld(&bar[XB_TMO])) break; if (sp > XB_SPIN_CAP) { atomicAdd(&bar[XB_TMO], 1u); break; } }
    }
    nloc = mine > 0u ? mine : 1u; nx = cnt > 0u ? cnt : 1u;
}
__device__ __forceinline__ void xcd_barrier(const XcdBarrier& b) {
    asm volatile("s_waitcnt vmcnt(0)" ::: "memory");
    __syncthreads();
    if (b.wave == 0 && lane_id_() == 0) {
        unsigned* bar = b.bar;
        __builtin_amdgcn_s_waitcnt(0);
        unsigned nloc = b.st[0], nx = b.st[1];
        if (nloc == 0u) { xcd_barrier_complete(bar, b.x, nloc, nx); b.st[0] = nloc; b.st[1] = nx; }
        const unsigned old = xb_add(&bar[XB_XSUB(b.x)], 1u);
        const unsigned gen = old / nloc;
        if (old + 1u == (gen + 1u) * nloc) {
            __builtin_amdgcn_fence(__ATOMIC_RELEASE, "agent");
            asm volatile("s_waitcnt vmcnt(0)" ::: "memory");
            const unsigned og = xb_add(&bar[XB_TOP], 1u);
            const unsigned tg = og / nx;
            if (og + 1u == (tg + 1u) * nx) xb_add(&bar[XB_TOPGEN], 1u);
            else XB_SPIN(xb_ld(&bar[XB_TOPGEN]) == tg, bar);
            __builtin_amdgcn_fence(__ATOMIC_ACQUIRE, "agent");
            xb_add(&bar[XB_XGEN(b.x)], 1u);
            asm volatile("s_waitcnt vmcnt(0)" ::: "memory");
        } else {
            XB_SPIN(xb_ld(&bar[XB_XGEN(b.x)]) == gen, bar);
            __builtin_amdgcn_fence(__ATOMIC_ACQUIRE, "agent");
            asm volatile("s_waitcnt vmcnt(0)" ::: "memory");
        }
    }
    __syncthreads();
}

namespace pg8 {
constexpr int BM = 256, BK = 64, HALF = 128, HTB = HALF * BK * 2, STAGE_BYTES = 8 * HTB, NXCD = 8, WGM = 8;
__host__ __device__ __forceinline__ int lds_byte(int r, int c) { const int st = (r >> 4) * 2 + (c >> 5), rr = r & 15, cc = c & 31, ob = rr * 64 + cc * 2; return st * 1024 + (ob ^ (((ob >> 9) & 1) << 5)); }
__host__ __device__ __forceinline__ void stage_rc(int b, int& R, int& C) { const int st = b / 1024, sb = b % 1024, swz = sb ^ (((sb >> 9) & 1) << 5); R = (st >> 1) * 16 + swz / 64; C = (st & 1) * 32 + (swz % 64) / 2; }
__host__ __device__ __forceinline__ int perm32(int rho) { const int n = rho >> 4, i = rho & 15; return 8 * (i >> 2) + 4 * n + (i & 3); }
struct Unit { int pm, pn; };
struct Gemm { const bf16_t* A; const bf16_t* Bt; int M, N, K, lda, ldb, jt; long jumpA; };
struct StaticOrder {
    int nM, nN, nwg, G, c; bool in_order;
    __host__ __device__ void init(int M, int N, int G_, int c_, bool io = false) { nM = M / BM; nN = N / BM; nwg = nM * nN; G = G_; c = c_; in_order = io; }
    __host__ __device__ bool next(int i, Unit& u) const {
        const long L = (long)i * G + c; if (L >= nwg) return false;
        int wgid = (int)L; { const int q = nwg / NXCD, r = nwg % NXCD, xcd = wgid % NXCD, off = wgid / NXCD; wgid = (xcd < r ? xcd * (q + 1) : r * (q + 1) + (xcd - r) * q) + off; }
        const int nig = WGM * nN, gid = wgid / nig, fm = gid * WGM, gsz = (nM - fm) < WGM ? (nM - fm) : WGM;
        u.pm = fm + ((wgid % nig) % gsz); u.pn = (wgid % nig) / gsz;
        if (in_order) u.pn = u.pn < 6 ? 8 + u.pn : u.pn < 14 ? u.pn - 6 : u.pn;
        return true;
    }
    __device__ __forceinline__ void a_ready(const Unit&, int) const {}
};
template <class Epi, class Sched>
__device__ __forceinline__ void gemm_phase(LAS unsigned char* lds, const Gemm g, const Sched& S, const Epi& E, const int wid) {
    const int lane = lane_id_(), tid = wid * 64 + lane, wr = wid >> 2, wc = wid & 3, fr = lane & 15, fq = lane >> 4;
    const int nt = g.K / BK;
    unsigned voffA[2], voffB[2];
#pragma unroll
    for (int i = 0; i < 2; ++i) { int R, C; stage_rc(tid * 16 + i * 8192, R, C); const int Rb = (R & ~31) + perm32(R & 31);
        voffA[i] = (unsigned)(R * g.lda + C) * 2u; voffB[i] = (unsigned)(Rb * g.ldb + C) * 2u; }
    const size_t kstep = (size_t)(BK * 2);
    const size_t hstepA = (size_t)HALF * g.lda * 2, hstepB = (size_t)HALF * g.ldb * 2;
    const size_t tstepA = 2 * hstepA, tstepB = 2 * hstepB;
    const unsigned ldsw = (unsigned)wid * 1024u;
    const int aoff = lds_byte(wr * 64 + fr, fq * 8), boff = lds_byte(wc * 32 + fr, fq * 8);
#define PG8_SA(b, h) (((b) * 2 + (h)) * HTB)
#define PG8_SB(b, h) ((4 + (b) * 2 + (h)) * HTB)
#define PG8_STAGE(bufoff, gbase, voff) do { _Pragma("unroll") for (int _i = 0; _i < 2; ++_i) \
        __builtin_amdgcn_global_load_lds((const unsigned*)((const char*)(gbase) + (voff)[_i]), (LAS unsigned*)(lds + (bufoff) + ldsw + _i * 8192), 16, 0, 0); } while (0)
#define PG8_LDA(dst, b, h) do { _Pragma("unroll") for (int m = 0; m < 4; ++m) _Pragma("unroll") for (int k = 0; k < 2; ++k) dst[m][k] = *(const LAS bf16x8*)(lds + PG8_SA(b, h) + aoff + m * 2048 + k * 1024); } while (0)
#define PG8_LDB(dst, b, h) do { _Pragma("unroll") for (int n = 0; n < 2; ++n) _Pragma("unroll") for (int k = 0; k < 2; ++k) dst[n][k] = *(const LAS bf16x8*)(lds + PG8_SB(b, h) + boff + n * 2048 + k * 1024); } while (0)
#define PG8_MMA(ai, bj, At, Bt) do { __builtin_amdgcn_s_setprio(1); _Pragma("unroll") for (int m = 0; m < 4; ++m) _Pragma("unroll") for (int n = 0; n < 2; ++n) _Pragma("unroll") for (int k = 0; k < 2; ++k) \
        acc[ai][bj][m][n] = __builtin_amdgcn_mfma_f32_16x16x32_bf16(Bt[n][k], At[m][k], acc[ai][bj][m][n], 0, 0, 0); __builtin_amdgcn_s_setprio(0); } while (0)
#define PG8_WAIT_V(n) asm volatile("s_waitcnt vmcnt(" #n ")" ::: "memory")
#define PG8_WAIT_L(n) asm volatile("s_waitcnt lgkmcnt(" #n ")" ::: "memory")
#define PG8_BAR __builtin_amdgcn_s_barrier()
#define PG8_SCHED __builtin_amdgcn_sched_barrier(0)
    Unit cur, nxt; int ui = 0;
    if (!S.next(0, cur)) return;
    f32x4 acc[2][2][4][2];
#pragma unroll
    for (int a = 0; a < 2; ++a)
#pragma unroll
        for (int b = 0; b < 2; ++b)
#pragma unroll
            for (int m = 0; m < 4; ++m)
#pragma unroll
                for (int n = 0; n < 2; ++n) acc[a][b][m][n] = (f32x4){0.f, 0.f, 0.f, 0.f};
    bf16x8 At[4][2], B0[2][2], B1[2][2];
    const char* cA = (const char*)g.A + (size_t)cur.pm * tstepA; const char* cB = (const char*)g.Bt + (size_t)cur.pn * tstepB;
    const int jt = g.jt; const long jumpA = g.jumpA;
    S.a_ready(cur, wid);
#define PG8_KA(base, t) ((base) + (size_t)(t) * kstep + ((t) >= jt ? jumpA : 0L))
    PG8_STAGE(PG8_SB(0, 0), cB, voffB); PG8_STAGE(PG8_SB(0, 1), cB + hstepB, voffB); PG8_STAGE(PG8_SA(0, 0), cA, voffA); PG8_STAGE(PG8_SA(0, 1), cA + hstepA, voffA);
    if (wr == 1) PG8_BAR;
    PG8_WAIT_V(2); PG8_BAR;
    PG8_STAGE(PG8_SB(1, 0), cB + kstep, voffB); PG8_STAGE(PG8_SA(1, 0), PG8_KA(cA, 1), voffA); PG8_STAGE(PG8_SB(1, 1), cB + hstepB + kstep, voffB);
    PG8_WAIT_V(6); PG8_BAR;
    for (;;) {
        const bool has_next = S.next(ui + 1, nxt);
        const char* nA = has_next ? (const char*)g.A + (size_t)nxt.pm * tstepA : cA; const char* nB = has_next ? (const char*)g.Bt + (size_t)nxt.pn * tstepB : cB;
        for (int seg = 0; seg < (Epi::MID_T >= 0 ? 2 : 1); ++seg) {
        const int tb = (Epi::MID_T >= 0 && seg == 1) ? Epi::MID_T : 0, te = (Epi::MID_T >= 0 && seg == 0) ? Epi::MID_T : nt;
        if constexpr (Epi::MID_T >= 0) { if (seg == 1) E.mid(acc, cur, wr, wc, fr, fq); }
        for (int t = tb; t < te; t += 2) {
            const bool last = (t == nt - 2);
            if (last && has_next) S.a_ready(nxt, wid);
            const char* a1 = PG8_KA(cA, t + 1);
            const char* a2 = last ? nA : PG8_KA(cA, t + 2); const char* b2 = last ? nB : cB + (size_t)(t + 2) * kstep;
            const char* a3 = last ? PG8_KA(nA, 1) : PG8_KA(cA, t + 3); const char* b3 = b2 + kstep;
            PG8_LDB(B0, 0, 0); PG8_LDB(B1, 0, 1); PG8_SCHED; PG8_LDA(At, 0, 0); PG8_STAGE(PG8_SA(1, 1), a1 + hstepA, voffA);
            PG8_WAIT_V(8); PG8_WAIT_L(0); PG8_BAR; PG8_MMA(0, 0, At, B0); PG8_MMA(0, 1, At, B1); PG8_BAR; PG8_SCHED;
            PG8_LDA(At, 0, 1); PG8_STAGE(PG8_SB(0, 0), b2, voffB); PG8_STAGE(PG8_SB(0, 1), b2 + hstepB, voffB); PG8_STAGE(PG8_SA(0, 0), a2, voffA);
            PG8_WAIT_V(8); PG8_WAIT_L(0); PG8_BAR; PG8_MMA(1, 0, At, B0); PG8_MMA(1, 1, At, B1); PG8_BAR; PG8_SCHED;
            PG8_LDB(B0, 1, 0); PG8_LDB(B1, 1, 1); PG8_SCHED; PG8_LDA(At, 1, 0); PG8_STAGE(PG8_SA(0, 1), a2 + hstepA, voffA);
            PG8_WAIT_V(8); PG8_WAIT_L(0); PG8_BAR; PG8_MMA(0, 0, At, B0); PG8_MMA(0, 1, At, B1); PG8_BAR; PG8_SCHED;
            PG8_LDA(At, 1, 1); PG8_STAGE(PG8_SB(1, 0), b3, voffB); PG8_STAGE(PG8_SB(1, 1), b3 + hstepB, voffB); PG8_STAGE(PG8_SA(1, 0), a3, voffA);
            PG8_WAIT_V(8); PG8_WAIT_L(0); PG8_BAR; PG8_MMA(1, 0, At, B0); PG8_MMA(1, 1, At, B1); PG8_BAR; PG8_SCHED;
        }
        }
        const typename Epi::Pre pf = E.pre(cur, wr, wc, fr, fq, wid, lane);
        if (wr == 0) PG8_BAR;
        E.epi(acc, cur, wr, wc, fr, fq, wid, lane, pf);
        if (!has_next) break;
#pragma unroll
        for (int a = 0; a < 2; ++a)
#pragma unroll
            for (int b = 0; b < 2; ++b)
#pragma unroll
                for (int m = 0; m < 4; ++m)
#pragma unroll
                    for (int n = 0; n < 2; ++n) acc[a][b][m][n] = (f32x4){0.f, 0.f, 0.f, 0.f};
        cur = nxt; cA = nA; cB = nB; ++ui;
        if (wr == 1) PG8_BAR;
    }
    PG8_WAIT_V(0);
    PG8_BAR;
#undef PG8_KA
#undef PG8_SA
#undef PG8_SB
#undef PG8_STAGE
#undef PG8_LDA
#undef PG8_LDB
#undef PG8_MMA
#undef PG8_WAIT_V
#undef PG8_WAIT_L
#undef PG8_BAR
#undef PG8_SCHED
}
}

typedef f32x4 AccT[2][2][4][2];
struct NoPre {};
#define PIN8(a, i, j) asm volatile("" : "+v"(a[i][j][0][0]), "+v"(a[i][j][0][1]), "+v"(a[i][j][1][0]), "+v"(a[i][j][1][1]), "+v"(a[i][j][2][0]), "+v"(a[i][j][2][1]), "+v"(a[i][j][3][0]), "+v"(a[i][j][3][1]))
#define PINACC(a) do { PIN8(a, 0, 0); PIN8(a, 0, 1); PIN8(a, 1, 0); PIN8(a, 1, 1); } while (0)
#define RAW_BAR() do { asm volatile("s_waitcnt lgkmcnt(0)" ::: "memory"); __builtin_amdgcn_s_barrier(); asm volatile("" ::: "memory"); } while (0)
__device__ __forceinline__ u32x4 pack8(const f32x4 a, const f32x4 b) { u32x4 w; w.x = pk2(a[0], a[1]); w.y = pk2(a[2], a[3]); w.z = pk2(b[0], b[1]); w.w = pk2(b[2], b[3]); return w; }
__device__ __forceinline__ void unpack8(const u32x4 w, f32x4& a, f32x4& b) { a = (f32x4){bflo(w.x), bfhi(w.x), bflo(w.y), bfhi(w.y)}; b = (f32x4){bflo(w.z), bfhi(w.z), bflo(w.w), bfhi(w.w)}; }

typedef __amdgpu_buffer_rsrc_t rsrc_t;
__device__ __forceinline__ rsrc_t mk_rsrc(const void* p, unsigned bytes) { return __builtin_amdgcn_make_buffer_rsrc((void*)p, (short)0, (int)bytes, 0x00020000); }
__device__ __forceinline__ void st16_wt(rsrc_t r, unsigned off, u32x4 v) { __builtin_amdgcn_raw_buffer_store_b128(v, r, off, 0, 16); }
__device__ __forceinline__ void st16_wt(rsrc_t r, unsigned off, f32x4 v) { __builtin_amdgcn_raw_buffer_store_b128(__builtin_bit_cast(u32x4, v), r, off, 0, 16); }

struct EpiIn {
    static constexpr int MID_T = -1;
    typedef NoPre Pre;
    __device__ __forceinline__ Pre pre(const pg8::Unit&, int, int, int, int, int, int) const { return Pre(); }
    bf16_t *Q, *KALL, *VALL, *KP, *VP, *RQ, *RK, *RV, *SRG, *GA, *GR; float *ock, *ocv; const float *qg, *kg; LAS float* P; unsigned* c1;
    __device__ __forceinline__ void mid(AccT&, const pg8::Unit&, int, int, int, int) const {}
    __device__ __forceinline__ void epi(AccT& acc, const pg8::Unit& u, int wr, int wc, int fr, int fq, int wid, int lane, const Pre&) const {
        asm volatile("" : "+v"(fr), "+v"(fq));
        const int pn = u.pn, pm = u.pm; const bool latent = pm >= 16;
        if (wid == 0 && lane == 0) { __hip_atomic_fetch_add(c1 + 16 * (481 + pm), 1u, RLX_AGENT); __hip_atomic_fetch_add(c1 + 16 * (481 + 80), 1u, RLX_AGENT); }
        const int lb = (pm - 16) >> 4, t0 = latent ? ((pm - 16) & 15) * 256 : 0;
        const int rl0 = 64 * wr + fr, cw8 = 32 * wc + 8 * fq;
        const size_t grow0 = (size_t)pm * 256;
        if (pn <= 4) {
#pragma unroll
            for (int ai = 0; ai < 2; ++ai)
#pragma unroll
                for (int m = 0; m < 4; ++m)
#pragma unroll
                    for (int bj = 0; bj < 2; ++bj) { const f32x4 a = acc[ai][bj][m][0], b = acc[ai][bj][m][1];
                        float s = (a[0] * a[0] + a[1] * a[1]) + (a[2] * a[2] + a[3] * a[3]) + (b[0] * b[0] + b[1] * b[1]) + (b[2] * b[2] + b[3] * b[3]);
                        s += __shfl_xor(s, 16); s += __shfl_xor(s, 32);
                        if (fq == 0) P[((128 * ai + rl0 + 16 * m) * 2 + bj) * 4 + wc] = s; }
            RAW_BAR();
            const float* gain = pn < 4 ? qg : kg;
            const int d0 = 64 * (wc >> 1) + 8 * fq + 4 * (wc & 1);
            const f32x4 g0 = *(const f32x4*)(gain + d0), g1 = *(const f32x4*)(gain + d0 + 32);
            float inv[4];
#pragma unroll
            for (int e = 0; e < 4; ++e) inv[e] = rope_inv(8 * fq + 4 * (wc & 1) + e);
#pragma unroll
            for (int ai = 0; ai < 2; ++ai)
#pragma unroll
                for (int m = 0; m < 4; ++m) { const int r = 128 * ai + rl0 + 16 * m, t = t0 + r;
                    f32x4 cs = {1.f, 1.f, 1.f, 1.f}, sn = {0.f, 0.f, 0.f, 0.f};
                    if (latent) { const float pos = (float)((wc >> 1) == 0 ? (t >> 6) : (t & 63));
#pragma unroll
                        for (int e = 0; e < 4; ++e) { float c_, s_; sincos_rev(pos * inv[e], c_, s_); cs[e] = c_; sn[e] = s_; } }
#pragma unroll
                    for (int bj = 0; bj < 2; ++bj) { const f32x4 pp = *(const LAS f32x4*)&P[(r * 2 + bj) * 4];
                        const float rstd = __builtin_amdgcn_rsqf(((pp[0] + pp[1]) + (pp[2] + pp[3])) * (1.0f / 128.0f) + EPS);
                        const f32x4 x1 = acc[ai][bj][m][0] * rstd * g0, x2 = acc[ai][bj][m][1] * rstd * g1;
                        const f32x4 o1 = x1 * cs - x2 * sn, o2 = x2 * cs + x1 * sn;
                        const u32x4 w = pack8(o1, o2);
                        if (pn < 4) { *(u32x4*)(Q + (grow0 + r) * 1024 + 128 * (2 * pn + bj) + cw8) = w; }
                        else if (latent) { *(u32x4*)(KALL + ((size_t)(lb * 2 + bj) * SKV + t) * 128 + cw8) = w; }
                        else { const size_t o = ((size_t)(pm * 2 + bj) * 256 + t) * 128;
                            *(u32x4*)(KP + o + cw8) = w; *(f32x4*)(ock + o + d0) = o1; *(f32x4*)(ock + o + d0 + 32) = o2; } } }
        } else if (pn == 5) {
#pragma unroll
            for (int ai = 0; ai < 2; ++ai)
#pragma unroll
                for (int m = 0; m < 4; ++m) { const int r = 128 * ai + rl0 + 16 * m, t = t0 + r;
#pragma unroll
                    for (int bj = 0; bj < 2; ++bj) { const f32x4 a = acc[ai][bj][m][0], b = acc[ai][bj][m][1]; const u32x4 w = pack8(a, b);
                        if (latent) { *(u32x4*)(VALL + ((size_t)(lb * 2 + bj) * SKV + t) * 128 + cw8) = w; }
                        else { const size_t o = ((size_t)(pm * 2 + bj) * 256 + t) * 128 + cw8;
                            *(u32x4*)(VP + o) = w; *(f32x4*)(ocv + o) = a; *(f32x4*)(ocv + o + 4) = b; } } }
        } else if (pn <= 9) {
            const float sc = pn >= 8 ? 0.125f : 1.0f; bf16_t* dst = RQ + (pn >= 8 ? (WS_RK - WS_RQ) / 2 : 0); const int cb = 256 * ((pn - 6) & 1);
            const rsrc_t rd = mk_rsrc(dst + grow0 * 512, 256 * 512 * 2);
            float inv[4];
#pragma unroll
            for (int e = 0; e < 4; ++e) inv[e] = rope_inv(8 * fq + 4 * (wc & 1) + e);
#pragma unroll
            for (int ai = 0; ai < 2; ++ai)
#pragma unroll
                for (int m = 0; m < 4; ++m) { const int r = 128 * ai + rl0 + 16 * m, t = t0 + r; const float pos = (float)(latent ? PAST + t : t);
                    f32x4 cs, sn;
#pragma unroll
                    for (int e = 0; e < 4; ++e) { float c_, s_; sincos_rev(pos * inv[e], c_, s_); cs[e] = c_ * sc; sn[e] = s_ * sc; }
#pragma unroll
                    for (int bj = 0; bj < 2; ++bj) { const f32x4 x1 = acc[ai][bj][m][0], x2 = acc[ai][bj][m][1];
                        st16_wt(rd, (unsigned)(((r * 512) + cb + 128 * bj + cw8) * 2), pack8(x1 * cs - x2 * sn, x2 * cs + x1 * sn)); } }
        } else if (pn < 18) {
            const int kind = (pn - 10) >> 2; bf16_t* dst = RV + (size_t)kind * ((WS_SRG - WS_RV) / 2); const int cb = 256 * ((pn - 10) & 3);
            const rsrc_t rd = mk_rsrc(dst + grow0 * 1024, 256 * 1024 * 2);
#pragma unroll
            for (int ai = 0; ai < 2; ++ai)
#pragma unroll
                for (int m = 0; m < 4; ++m) { const int r = 128 * ai + rl0 + 16 * m;
#pragma unroll
                    for (int bj = 0; bj < 2; ++bj) { f32x4 a = acc[ai][bj][m][0], b = acc[ai][bj][m][1];
                        if (kind == 1) { _Pragma("unroll") for (int e = 0; e < 4; ++e) { a[e] = siluf_(a[e]); b[e] = siluf_(b[e]); } }
                        st16_wt(rd, (unsigned)(((r * 1024) + cb + 128 * bj + cw8) * 2), pack8(a, b)); } }
        } else {
            const int cb = 128 * (pn - 18);
            const rsrc_t rra = mk_rsrc(GA + grow0 * 1024, 256 * 1024 * 2), rrg = mk_rsrc(GR + grow0 * 1024, 256 * 1024 * 2);
#pragma unroll
            for (int ai = 0; ai < 2; ++ai)
#pragma unroll
                for (int m = 0; m < 4; ++m) { const int r = 128 * ai + rl0 + 16 * m; f32x4 q0, q1, g0, g1;
#pragma unroll
                    for (int e = 0; e < 4; ++e) { g0[e] = sigmoidf_(acc[ai][1][m][0][e]); g1[e] = sigmoidf_(acc[ai][1][m][1][e]);
                        q0[e] = sigmoidf_(acc[ai][0][m][0][e]) * __builtin_amdgcn_rcpf(fmaxf(g0[e], 1e-30f)); q1[e] = sigmoidf_(acc[ai][0][m][1][e]) * __builtin_amdgcn_rcpf(fmaxf(g1[e], 1e-30f)); }
                    const unsigned o = (unsigned)(((r * 1024) + cb + cw8) * 2);
                    st16_wt(rra, o, pack8(q0, q1)); st16_wt(rrg, o, pack8(g0, g1)); }
        }
        if (pn >= 8 && pn <= 13) {
            asm volatile("s_waitcnt vmcnt(0)" ::: "memory");
            RAW_BAR();
            if (wid == 0 && lane == 0) { __hip_atomic_fetch_add(c1 + 16 * (pm * 6 + pn - 8), 1u, RLX_AGENT); __hip_atomic_fetch_add(c1 + 16 * 480, 1u, RLX_AGENT); } }
    }
};

struct EpiMix {
    static constexpr int MID_T = 16;
    typedef NoPre Pre;
    __device__ __forceinline__ Pre pre(const pg8::Unit&, int, int, int, int, int, int) const { return Pre(); }
    const bf16_t *GA, *GR; bf16_t* Y; unsigned* done;
    __device__ __forceinline__ void mid(AccT& acc, const pg8::Unit& u, int wr, int wc, int fr, int fq) const {
        unsigned lo = (unsigned)(((64 * wr + fr) * 1024 + 32 * wc + 8 * fq) * 2); asm volatile("" : "+v"(lo));
        const char* ga = (const char*)GA + ((size_t)u.pm * 256 * 1024 + 256 * u.pn) * 2;
        u32x4 q[8][2];
#pragma unroll
        for (int k = 0; k < 8; ++k)
#pragma unroll
            for (int bj = 0; bj < 2; ++bj) q[k][bj] = *(const u32x4*)(ga + lo + (unsigned)((((128 * (k >> 2) + 16 * (k & 3)) * 1024) + 128 * bj) * 2));
#pragma unroll
        for (int k = 0; k < 8; ++k)
#pragma unroll
            for (int bj = 0; bj < 2; ++bj) { f32x4 a0, a1; unpack8(q[k][bj], a0, a1); acc[k >> 2][bj][k & 3][0] *= a0; acc[k >> 2][bj][k & 3][1] *= a1; }
    }
    __device__ __forceinline__ void epi(AccT& acc, const pg8::Unit& u, int wr, int wc, int fr, int fq, int wid, int lane, const Pre&) const {
        unsigned lo = (unsigned)(((64 * wr + fr) * 1024 + 32 * wc + 8 * fq) * 2); asm volatile("" : "+v"(lo));
        const size_t ub = ((size_t)u.pm * 256 * 1024 + 256 * u.pn) * 2; const char* gr = (const char*)GR + ub; const rsrc_t ry = mk_rsrc((char*)Y + ub, 256 * 1024 * 2);
        u32x4 q[8][2];
#pragma unroll
        for (int k = 0; k < 8; ++k)
#pragma unroll
            for (int bj = 0; bj < 2; ++bj) q[k][bj] = *(const u32x4*)(gr + lo + (unsigned)((((128 * (k >> 2) + 16 * (k & 3)) * 1024) + 128 * bj) * 2));
#pragma unroll
        for (int k = 0; k < 8; ++k)
#pragma unroll
            for (int bj = 0; bj < 2; ++bj) { f32x4 r0, r1; unpack8(q[k][bj], r0, r1);
                st16_wt(ry, lo + (unsigned)((((128 * (k >> 2) + 16 * (k & 3)) * 1024) + 128 * bj) * 2), pack8(acc[k >> 2][bj][k & 3][0] * r0, acc[k >> 2][bj][k & 3][1] * r1)); }
        asm volatile("s_waitcnt vmcnt(0)" ::: "memory");
        RAW_BAR();
        if (wid == 0 && lane == 0) __hip_atomic_fetch_add(done + 64 * u.pm, 1u, RLX_AGENT);
    }
};

struct EpiRes1 {
    static constexpr int MID_T = -1;
    typedef NoPre Pre;
    __device__ __forceinline__ Pre pre(const pg8::Unit&, int, int, int, int, int, int) const { return Pre(); }
    const float *xp, *xs, *modf, *g2n; bf16_t* X1B; float* ssq; bf16_t* A2;
    __device__ __forceinline__ void mid(AccT&, const pg8::Unit&, int, int, int, int) const {}
    __device__ __forceinline__ void epi(AccT& acc, const pg8::Unit& u, int wr, int wc, int fr, int fq, int wid, int lane, const Pre&) const {
        asm volatile("" : "+v"(fr), "+v"(fq));
        const int pm = u.pm, v = pm < 16 ? 0 : 1 + ((pm - 16) >> 4);
        const float* mv = modf + (size_t)v * 6144; const float* xsrc = pm < 16 ? xp + (size_t)pm * 256 * 1024 : xs + (size_t)(pm - 16) * 256 * 1024;
        const unsigned cb = (unsigned)(256 * u.pn + 32 * wc + 8 * fq), rb = (unsigned)(64 * wr + fr);
        {   f32x4 g1[2][2];
#pragma unroll
            for (int bj = 0; bj < 2; ++bj)
#pragma unroll
                for (int n = 0; n < 2; ++n) g1[bj][n] = *(const f32x4*)(mv + 2048 + cb + 128 * bj + 4 * n);
#pragma unroll
            for (int h = 0; h < 4; ++h) { f32x4 xv[2][2][2];
#pragma unroll
                for (int mm = 0; mm < 2; ++mm)
#pragma unroll
                    for (int bj = 0; bj < 2; ++bj) { const float* p = xsrc + (size_t)(128 * (h >> 1) + 16 * (2 * (h & 1) + mm) + rb) * 1024 + cb + 128 * bj; xv[mm][bj][0] = *(const f32x4*)p; xv[mm][bj][1] = *(const f32x4*)(p + 4); }
#pragma unroll
                for (int mm = 0; mm < 2; ++mm)
#pragma unroll
                    for (int bj = 0; bj < 2; ++bj) { const int ai = h >> 1, m = 2 * (h & 1) + mm;
                        acc[ai][bj][m][0] = xv[mm][bj][0] + g1[bj][0] * acc[ai][bj][m][0]; acc[ai][bj][m][1] = xv[mm][bj][1] + g1[bj][1] * acc[ai][bj][m][1]; }
                {   const int ai = h >> 1, m0 = 2 * (h & 1);
                    asm volatile("" : "+v"(acc[ai][0][m0][0]), "+v"(acc[ai][0][m0][1]), "+v"(acc[ai][1][m0][0]), "+v"(acc[ai][1][m0][1]),
                                      "+v"(acc[ai][0][m0 + 1][0]), "+v"(acc[ai][0][m0 + 1][1]), "+v"(acc[ai][1][m0 + 1][0]), "+v"(acc[ai][1][m0 + 1][1]) :: "memory"); } } }
        f32x4 w2[2][2];
#pragma unroll
        for (int bj = 0; bj < 2; ++bj)
#pragma unroll
            for (int n = 0; n < 2; ++n) { const unsigned c = cb + 128 * bj + 4 * n; w2[bj][n] = *(const f32x4*)(g2n + c) * (*(const f32x4*)(mv + 4096 + c) + 1.0f); }
        const rsrc_t rx = mk_rsrc(X1B + (size_t)pm * 256 * 1024, 256 * 1024 * 2), ra = mk_rsrc(A2 + (size_t)pm * 256 * 1024, 256 * 1024 * 2);
#pragma unroll
        for (int ai = 0; ai < 2; ++ai)
#pragma unroll
            for (int m = 0; m < 4; ++m) { const unsigned r = 128 * ai + 16 * m + rb; float s = 0.f;
#pragma unroll
                for (int bj = 0; bj < 2; ++bj) { const unsigned o = r * 1024 + cb + 128 * bj; const f32x4 x0 = acc[ai][bj][m][0], x1 = acc[ai][bj][m][1];
                    st16_wt(rx, o * 2u, pack8(x0, x1));
                    st16_wt(ra, o * 2u, pack8(x0 * w2[bj][0], x1 * w2[bj][1]));
                    s += (x0[0] * x0[0] + x0[1] * x0[1]) + (x0[2] * x0[2] + x0[3] * x0[3]) + (x1[0] * x1[0] + x1[1] * x1[1]) + (x1[2] * x1[2] + x1[3] * x1[3]); }
                s += __shfl_xor(s, 16); s += __shfl_xor(s, 32);
                if (fq == 0) atomicAdd(ssq + (size_t)pm * 256 + r, s); }
    }
};

struct EpiRes2 {
    static constexpr int MID_T = -1;
    typedef NoPre Pre;
    __device__ __forceinline__ Pre pre(const pg8::Unit&, int, int, int, int, int, int) const { return Pre(); }
    const float *mod, *fg; const bf16_t* X1B; float* X; float* XS; unsigned* xcnt; LAS float* P;
    __device__ __forceinline__ void mid(AccT&, const pg8::Unit&, int, int, int, int) const {}
    __device__ __forceinline__ void epi(AccT& acc, const pg8::Unit& u, int wr, int wc, int fr, int fq, int wid, int lane, const Pre&) const {
        asm volatile("" : "+v"(fr), "+v"(fq));
        const int pm = u.pm, v = pm < 16 ? 0 : 1 + ((pm - 16) >> 4); const float* mv = mod + (size_t)v * 6144;
        const int cb = 256 * u.pn + 32 * wc + 8 * fq;
        {   f32x4 g2[2][2]; u32x4 xq[8][2];
#pragma unroll
            for (int bj = 0; bj < 2; ++bj)
#pragma unroll
                for (int n = 0; n < 2; ++n) g2[bj][n] = *(const f32x4*)(mv + 5120 + cb + 128 * bj + 4 * n);
#pragma unroll
            for (int k = 0; k < 8; ++k)
#pragma unroll
                for (int bj = 0; bj < 2; ++bj) xq[k][bj] = *(const u32x4*)(X1B + ((size_t)pm * 256 + 128 * (k >> 2) + 64 * wr + 16 * (k & 3) + fr) * 1024 + cb + 128 * bj);
#pragma unroll
            for (int k = 0; k < 8; ++k) { const int ai = k >> 2, m = k & 3, r = 128 * ai + 64 * wr + 16 * m + fr; float s = 0.f;
#pragma unroll
                for (int bj = 0; bj < 2; ++bj) { f32x4 xa, xb; unpack8(xq[k][bj], xa, xb);
                    const f32x4 x0 = xa + g2[bj][0] * acc[ai][bj][m][0], x1 = xb + g2[bj][1] * acc[ai][bj][m][1];
                    acc[ai][bj][m][0] = x0; acc[ai][bj][m][1] = x1;
                    s += (x0[0] * x0[0] + x0[1] * x0[1]) + (x0[2] * x0[2] + x0[3] * x0[3]) + (x1[0] * x1[0] + x1[1] * x1[1]) + (x1[2] * x1[2] + x1[3] * x1[3]); }
                s += __shfl_xor(s, 16); s += __shfl_xor(s, 32);
                if (fq == 0) P[r * 4 + wc] = s; } }
        RAW_BAR();
        const int tid = wid * 64 + lane;
        if (wid < 4) { const f32x4 pp = *(const LAS f32x4*)&P[tid * 4];
            __hip_atomic_store(XS + ((size_t)pm * 4 + u.pn) * 256 + tid, (pp[0] + pp[1]) + (pp[2] + pp[3]), RLX_AGENT);
            asm volatile("s_waitcnt vmcnt(0)" ::: "memory");
            if (lane == 0) __hip_atomic_fetch_add(xcnt + 64 * pm, 1u, RLX_AGENT); }
        if (wid == 0) { unsigned sp = 0;
            while ((unsigned)__builtin_amdgcn_readfirstlane(__hip_atomic_load(xcnt + 64 * pm, RLX_AGENT)) < 16u) { __builtin_amdgcn_s_sleep(2); if (++sp > (1u << 22)) break; } }
        RAW_BAR();
        if (wid < 4) { float t = 0.f;
#pragma unroll
            for (int k = 0; k < 4; ++k) t += __hip_atomic_load(XS + ((size_t)pm * 4 + k) * 256 + tid, RLX_AGENT);
            P[1024 + tid] = 1.0f / sqrtf(t * (1.0f / 1024.0f) + EPS); }
        RAW_BAR();
        {   f32x4 fgv[2][2];
#pragma unroll
            for (int bj = 0; bj < 2; ++bj)
#pragma unroll
                for (int n = 0; n < 2; ++n) fgv[bj][n] = *(const f32x4*)(fg + cb + 128 * bj + 4 * n);
#pragma unroll
            for (int ai = 0; ai < 2; ++ai)
#pragma unroll
                for (int m = 0; m < 4; ++m) { const int r = 128 * ai + 64 * wr + 16 * m + fr;
                    const float rs = P[1024 + r];
#pragma unroll
                    for (int bj = 0; bj < 2; ++bj) { float* p = X + ((size_t)pm * 256 + r) * 1024 + cb + 128 * bj;
                        *(f32x4*)p = acc[ai][bj][m][0] * rs * fgv[bj][0]; *(f32x4*)(p + 4) = acc[ai][bj][m][1] * rs * fgv[bj][1]; } } }
    }
};

__device__ __forceinline__ float dpp_up(float cur, float old) {
    return __builtin_bit_cast(float, __builtin_amdgcn_update_dpp(__builtin_bit_cast(int, old), __builtin_bit_cast(int, cur), 0x111, 0xF, 0xF, false)); }
__device__ __forceinline__ float dpp_dn(float cur, float old) {
    return __builtin_bit_cast(float, __builtin_amdgcn_update_dpp(__builtin_bit_cast(int, old), __builtin_bit_cast(int, cur), 0x101, 0xF, 0xF, false)); }
__device__ __forceinline__ float dpp_ror1(float x) {
    return __builtin_bit_cast(float, __builtin_amdgcn_update_dpp(0, __builtin_bit_cast(int, x), 0x121, 0xF, 0xF, false)); }
__device__ __forceinline__ float dpp_rol1(float x) {
    return __builtin_bit_cast(float, __builtin_amdgcn_update_dpp(0, __builtin_bit_cast(int, x), 0x12F, 0xF, 0xF, false)); }
struct EpiConv {
    static constexpr int MID_T = -1;
    const float *ssq, *bup, *cw, *cbias; bf16_t* ACT; float *EU, *EUC; LAS float* E; unsigned* done;
    struct Pre { float ss[8]; f32x4 bb[2][2]; float cwv[4]; };
    __device__ __forceinline__ void mid(AccT&, const pg8::Unit&, int, int, int, int) const {}
    __device__ __forceinline__ Pre pre(const pg8::Unit& u, int wr, int wc, int fr, int fq, int wid, int lane) const {
        Pre p; const int pm = u.pm, pn = u.pn, v = pm < 16 ? 0 : 1 + ((pm - 16) >> 4);
        const float* sp = ssq + (size_t)pm * 256 + 64 * wr + fr; const float* bp = bup + (size_t)v * NUP + 256 * pn + 32 * wc + 8 * fq;
#pragma unroll
        for (int k = 0; k < 8; ++k) p.ss[k] = sp[128 * (k >> 2) + 16 * (k & 3)];
#pragma unroll
        for (int bj = 0; bj < 2; ++bj)
#pragma unroll
            for (int n = 0; n < 2; ++n) p.bb[bj][n] = *(const f32x4*)(bp + 128 * bj + 4 * n);
        const int t = wid * 64 + lane, tc = t & 255, ch = (tc < 128 ? 0 : DFF - 128) + 128 * pn + tc;
        p.cwv[0] = cw[ch]; p.cwv[1] = cw[NUP + ch]; p.cwv[2] = cw[2 * NUP + ch]; p.cwv[3] = cbias[ch];
        return p;
    }
    __device__ __forceinline__ void epi(AccT& acc, const pg8::Unit& u, int wr, int wc, int fr, int fq, int wid, int lane, const Pre& pf) const {
        const int pm = u.pm, pn = u.pn; const bool latent = pm >= 16;
#if defined(PROBE_K0) && PROBE_K0 == 400
        const unsigned long long te0_ = __builtin_amdgcn_s_memrealtime();
#endif
        unsigned cw8 = (unsigned)(32 * wc + 8 * fq), rl = (unsigned)(64 * wr + fr); asm volatile("" : "+v"(cw8), "+v"(rl));
        LAS float* CW = E + 2048;
        {   const int t = wid * 64 + lane;
            if (t < 256) { CW[t] = pf.cwv[0]; CW[256 + t] = pf.cwv[1]; CW[512 + t] = pf.cwv[2]; CW[768 + t] = pf.cwv[3]; } }
#pragma unroll
        for (int ai = 0; ai < 2; ++ai)
#pragma unroll
            for (int m = 0; m < 4; ++m) { const float rs = __builtin_amdgcn_rsqf(pf.ss[4 * ai + m] * (1.0f / 1024.0f) + EPS);
#pragma unroll
                for (int bj = 0; bj < 2; ++bj)
#pragma unroll
                    for (int n = 0; n < 2; ++n) acc[ai][bj][m][n] = acc[ai][bj][m][n] * rs + pf.bb[bj][n]; }
        PINACC(acc);
        const rsrc_t reu = mk_rsrc(EU + (size_t)pm * 2 * NUP + 256 * pn, (NUP + 256) * 4), reuc = mk_rsrc(EUC + (size_t)pm * 2 * NUP + 256 * pn, (NUP + 256) * 4);
#pragma unroll
        for (int ai = 0; ai < 2; ++ai)
#pragma unroll
            for (int bj = 0; bj < 2; ++bj)
#pragma unroll
                for (int n = 0; n < 2; ++n) { const unsigned ci = 128 * bj + cw8 + 4 * n; const int grp = 2 * ai + wr;
                    if (fr == 0) { *(LAS f32x4*)&E[(grp * 2 + 0) * 256 + ci] = acc[ai][bj][0][n]; if (latent && grp == 0) st16_wt(reu, ci * 4u, acc[ai][bj][0][n]); }
                    if (fr == 15) { *(LAS f32x4*)&E[(grp * 2 + 1) * 256 + ci] = acc[ai][bj][3][n]; if (latent && grp == 3) st16_wt(reu, (NUP + ci) * 4u, acc[ai][bj][3][n]); } }
        RAW_BAR();
#if defined(PROBE_K0) && PROBE_K0 == 400 && defined(PROBE_SUB) && PROBE_SUB == 1
        if (wid == 0 && lane == 0 && (int)__builtin_amdgcn_workgroup_id_x() == PROBE_BID) atomicAdd((float*)((char*)EU - WS_EDGE_U + 32768), (float)(__builtin_amdgcn_s_memrealtime() - te0_));
#endif
        const rsrc_t ract = mk_rsrc((char*)ACT + ((size_t)pm * 256 * DFF + 128 * pn) * 2, 256 * DFF * 2);
#pragma unroll
        for (int ai = 0; ai < 2; ++ai) { const int grp = 2 * ai + wr;
#pragma unroll
            for (int n = 0; n < 2; ++n)
#pragma unroll
                for (int bj = 0; bj < 2; ++bj) { const unsigned ci = 128 * bj + cw8 + 4 * n;
                    const f32x4 w0 = *(const LAS f32x4*)&CW[ci], w1 = *(const LAS f32x4*)&CW[256 + ci], w2 = *(const LAS f32x4*)&CW[512 + ci], cb = *(const LAS f32x4*)&CW[768 + ci];
                    f32x4 pe = {0.f, 0.f, 0.f, 0.f}, ne = {0.f, 0.f, 0.f, 0.f};
                    if (grp > 0) pe = *(const LAS f32x4*)&E[((grp - 1) * 2 + 1) * 256 + ci];
                    if (grp < 3) ne = *(const LAS f32x4*)&E[((grp + 1) * 2 + 0) * 256 + ci];
#pragma unroll
                    for (int e = 0; e < 4; ++e) { const float u0 = acc[ai][bj][0][n][e], u1 = acc[ai][bj][1][n][e], u2 = acc[ai][bj][2][n][e], u3 = acc[ai][bj][3][n][e];
                        const float p0 = dpp_up(u0, pe[e]), p1 = dpp_up(u1, dpp_ror1(u0)), p2 = dpp_up(u2, dpp_ror1(u1)), p3 = dpp_up(u3, dpp_ror1(u2));
                        const float n0 = dpp_dn(u0, dpp_rol1(u1)), n1 = dpp_dn(u1, dpp_rol1(u2)), n2 = dpp_dn(u2, dpp_rol1(u3)), n3 = dpp_dn(u3, ne[e]);
                        acc[ai][bj][0][n][e] = w0[e] * p0 + w1[e] * u0 + w2[e] * n0 + cb[e]; acc[ai][bj][1][n][e] = w0[e] * p1 + w1[e] * u1 + w2[e] * n1 + cb[e];
                        acc[ai][bj][2][n][e] = w0[e] * p2 + w1[e] * u2 + w2[e] * n2 + cb[e]; acc[ai][bj][3][n][e] = w0[e] * p3 + w1[e] * u3 + w2[e] * n3 + cb[e]; }
                    if (latent) { if (fr == 0 && grp == 0) st16_wt(reuc, ci * 4u, acc[ai][bj][0][n]);
                                  if (fr == 15 && grp == 3) st16_wt(reuc, (NUP + ci) * 4u, acc[ai][bj][3][n]); }
                    asm volatile("" : "+v"(acc[ai][bj][0][n]), "+v"(acc[ai][bj][1][n]), "+v"(acc[ai][bj][2][n]), "+v"(acc[ai][bj][3][n]) :: "memory"); }
#pragma unroll
            for (int m = 0; m < 4; ++m) { f32x4 o0, o1;
#pragma unroll
                for (int e = 0; e < 4; ++e) { o0[e] = siluf_(acc[ai][1][m][0][e]) * acc[ai][0][m][0][e]; o1[e] = siluf_(acc[ai][1][m][1][e]) * acc[ai][0][m][1][e]; }
                st16_wt(ract, ((rl + 128 * ai + 16 * m) * DFF + cw8) * 2u, pack8(o0, o1)); asm volatile("" ::: "memory"); } }
#if defined(PROBE_K0) && PROBE_K0 == 400 && !defined(PROBE_SUB)
        if (wid == 0 && lane == 0 && (int)__builtin_amdgcn_workgroup_id_x() == PROBE_BID) atomicAdd((float*)((char*)EU - WS_EDGE_U + 32768), (float)(__builtin_amdgcn_s_memrealtime() - te0_));
#endif
    }
};

constexpr int NWAVES = 8, NTHR = 512;
constexpr int RING_BYTES = 131072, SPARE_OFF = RING_BYTES, SPARE_BYTES = 16384, MISC_OFF = SPARE_OFF + SPARE_BYTES, LDS_BYTES = MISC_OFF + 256;
struct Args {
    const float *x_prompt, *x_sample, *c, *cache_k, *cache_v, *st_f, *st_b, *c_ctx, *norm1_g, *norm2_g, *w_mod, *b_mod, *w_in, *q_g, *k_g, *dec_f, *dec_b,
                *w_att_o, *w_ret_o, *w_out, *w_up, *conv_w, *conv_b, *w_down, *final_g;
    float* out; unsigned char* ws; int ph_lo, ph_hi;
};
struct Frame { LAS unsigned char* lds; int tid, lane, wave, G, bid; };
typedef const __attribute__((address_space(4))) Args CArgs;

template <class F> __device__ __forceinline__ void transpose_item(const float* W, int ldw, bf16_t* WT, int ldd, int kofs, int k0, int n0, F srccol, LAS float* scr, int lane) {
    const int sc = srccol(n0 + (lane & 31));
#pragma unroll 8
    for (int i = 0; i < 32; ++i) { const int kk = 2 * i + (lane >> 5); scr[kk * 33 + (lane & 31)] = __builtin_nontemporal_load(W + (size_t)(k0 + kk) * ldw + sc); }
    LDS_WAIT(); asm volatile("" ::: "memory");
    const int c = lane & 7;
#pragma unroll
    for (int j = 0; j < 4; ++j) { const int n = (lane >> 3) + 8 * j; const LAS float* s = scr + (8 * c) * 33 + n;
        u32x4 o; o.x = pk2(s[0 * 33], s[1 * 33]); o.y = pk2(s[2 * 33], s[3 * 33]); o.z = pk2(s[4 * 33], s[5 * 33]); o.w = pk2(s[6 * 33], s[7 * 33]);
        *(u32x4*)(WT + (size_t)(n0 + n) * ldd + kofs + k0 + 8 * c) = o; }
    LDS_WAIT(); asm volatile("" ::: "memory");
}
struct ColId { __device__ int operator()(int n) const { return n; } };
struct ColIn { __device__ int operator()(int n) const {
    if (n >= 4608) { const int t = (n - 4608) >> 8, j = (n - 4608) & 255; return j < 128 ? 4608 + 128 * t + j : 5632 + 128 * t + (j - 128); }
    return (n < 1280 || (n >= 1536 && n < 2560)) ? swap25(n) : n; } };
struct ColUp { __device__ int operator()(int n) const { const int t = n >> 8, j = n & 255; return j < 128 ? 128 * t + j : DFF + 128 * t + (j - 128); } };

template <class F> __device__ __forceinline__ void gemv5_item(const Frame& F_, const float* W, int ldw, int n0, int k0, F srccol, const LAS float* a, LAS float* red, const float* bias, float* out, int ldo) {
    const int col0 = srccol(n0 + F_.lane), col1 = srccol(n0 + 64 + F_.lane); float acc[5][2];
#pragma unroll
    for (int v = 0; v < 5; ++v) { acc[v][0] = 0.f; acc[v][1] = 0.f; }
    const int kb = F_.wave * 32;
    const float* wp = W + (size_t)(k0 + kb) * ldw;
    float w0[32], w1[32];
#pragma unroll
    for (int j = 0; j < 32; ++j) { w0[j] = __builtin_nontemporal_load(wp + col0); w1[j] = __builtin_nontemporal_load(wp + col1); wp += ldw; }
#pragma unroll
    for (int j = 0; j < 32; ++j)
#pragma unroll
        for (int v = 0; v < 5; ++v) { const float av = a[v * 256 + kb + j]; acc[v][0] += av * w0[j]; acc[v][1] += av * w1[j]; }
#pragma unroll
    for (int v = 0; v < 5; ++v) { red[(F_.wave * 5 + v) * 128 + F_.lane] = acc[v][0]; red[(F_.wave * 5 + v) * 128 + 64 + F_.lane] = acc[v][1]; }
    __syncthreads();
    for (int t = F_.tid; t < 640; t += NTHR) { const int v = t >> 7, l = t & 127; float sum = (bias && k0 == 0) ? bias[n0 + l] : 0.f;
#pragma unroll
        for (int w8 = 0; w8 < 8; ++w8) sum += red[(w8 * 5 + v) * 128 + l];
        out[((size_t)(k0 >> 8) * 5 + v) * ldo + n0 + l] = sum; }
    __syncthreads();
}

__device__ __forceinline__ void phase0(const Frame& F, CArgs& A) {
    unsigned char* ws = A.ws;
    for (int it = F.bid; it < 48 * 4; it += F.G) {
        const int cgp = it % 48, kq = it / 48;
        LAS float* a = (LAS float*)F.lds; LAS float* red = a + 5 * 256;
        for (int i = F.tid; i < 5 * 256; i += NTHR) { const int v = i >> 8, k = kq * 256 + (i & 255); const float cv = v == 0 ? A.c_ctx[k] : A.c[(v - 1) * 1024 + k]; a[i] = siluf_(cv); }
        __syncthreads();
        gemv5_item(F, A.w_mod, 6144, cgp * 128, kq * 256, ColId(), a, red, A.b_mod, (float*)(ws + WS_MOD), 6144);
    }
    LAS float* scr = (LAS float*)(F.lds + 32768 + F.wave * 8704);
    const int gw = ((F.bid + 128) % F.G) * NWAVES + F.wave, NGW = F.G * NWAVES;
    constexpr int I_IN = 16 * (DIN / 32);
    for (int it = gw; it < I_IN; it += NGW) transpose_item(A.w_in, DIN, (bf16_t*)(ws + WS_WA), 1024, 0, 64 * (it / (DIN / 32)), 32 * (it % (DIN / 32)), ColIn(), scr, F.lane);
    const int gt = F.bid * NTHR + F.tid, NGT = F.G * NTHR;
    for (int i = gt; i < DB * NKV * PAST * 16; i += NGT) { const int c8 = i & 15, row = i >> 4, t = row % PAST, bk = row / PAST;
        const size_t so = (size_t)row * 128, dofs = ((size_t)bk * SKV + DSEQ + t) * 128 + c8 * 8;
        f32x4 k0, k1; { const int p0 = c8 * 8, d0 = swap25(p0), d1 = swap25(p0 + 4); k0 = *(const f32x4*)(A.cache_k + so + d0); k1 = *(const f32x4*)(A.cache_k + so + d1); }
        *(u32x4*)((bf16_t*)(ws + WS_KALL) + dofs) = pack8(k0, k1);
        const f32x4 v0 = *(const f32x4*)(A.cache_v + so + c8 * 8), v1 = *(const f32x4*)(A.cache_v + so + c8 * 8 + 4);
        *(u32x4*)((bf16_t*)(ws + WS_VALL) + dofs) = pack8(v0, v1); }
    for (int i = gt; i < MT; i += NGT) ((float*)(ws + WS_SSQ1))[i] = 0.f;
    for (int i = gt; i < 322 * 64; i += NGT) ((unsigned*)(ws + WS_CNT))[i] = 0u;
    for (int i = gt; i < (481 + 81) * 16; i += NGT) ((unsigned*)(ws + WS_CNT1))[i] = 0u;
#if defined(PROBE_K0) && PROBE_K0 == 400
    if (gt == 0) *(float*)(ws + 32768) = 0.f;
#endif
}

__device__ __forceinline__ void phase1(const Frame& F, CArgs& A) {
    unsigned char* ws = A.ws; const float* mod = (const float*)(ws + WS_MOD);
    for (int it = F.bid; it < (NUP / 128) * 4; it += F.G) {
        const int cgp = it % (NUP / 128), kq = it / (NUP / 128);
        LAS float* a = (LAS float*)F.lds; LAS float* red = a + 5 * 256;
        for (int i = F.tid; i < 5 * 256; i += NTHR) { const float* p = mod + (size_t)(i >> 8) * 6144 + 3072 + kq * 256 + (i & 255); a[i] = (p[0] + p[MODQ]) + (p[2 * MODQ] + p[3 * MODQ]); }
        __syncthreads();
        gemv5_item(F, A.w_up, NUP, cgp * 128, kq * 256, ColUp(), a, red, nullptr, (float*)(ws + WS_BUP), NUP);
    }
    for (int i = F.bid * NTHR + F.tid; i < 5 * 6144; i += F.G * NTHR) ((float*)(ws + WS_MODF))[i] = (mod[i] + mod[i + MODQ]) + (mod[i + 2 * MODQ] + mod[i + 3 * MODQ]);
    bf16_t* H = (bf16_t*)(ws + WS_H);
    constexpr int RPW = MT / (256 * NWAVES);
    const int row0 = (F.bid * NWAVES + F.wave) * RPW;
    int vcur = -1; f32x4 w1[4], s1[4];
#pragma unroll 1
    for (int rb = row0; rb < row0 + RPW; rb += 5) {
        f32x4 x[5][4];
#pragma unroll
        for (int i = 0; i < 5; ++i) { const int r = rb + i; const float* xr = r < MP ? A.x_prompt + (size_t)r * 1024 : A.x_sample + (size_t)(r - MP) * 1024;
#pragma unroll
            for (int j = 0; j < 4; ++j) x[i][j] = __builtin_nontemporal_load((const f32x4*)(xr + 8 * F.lane + 4 * (j & 1) + 512 * (j >> 1))); }
#pragma unroll
        for (int i = 0; i < 5; ++i) { const int r = rb + i;
            const int v = r < MP ? 0 : 1 + (r - MP) / DSEQ;
            if (v != vcur) { vcur = v; const float* mv = mod + (size_t)v * 6144;
#pragma unroll
                for (int j = 0; j < 4; ++j) { const int k = 8 * F.lane + 4 * (j & 1) + 512 * (j >> 1); w1[j] = *(const f32x4*)(A.norm1_g + k) * (sum4q(mv + 1024 + k, MODQ) + 1.0f); s1[j] = sum4q(mv + k, MODQ); } }
            float s = 0.f;
#pragma unroll
            for (int j = 0; j < 4; ++j) s += (x[i][j][0] * x[i][j][0] + x[i][j][1] * x[i][j][1]) + (x[i][j][2] * x[i][j][2] + x[i][j][3] * x[i][j][3]);
            const float rstd = __builtin_amdgcn_rsqf(wave_sum(s) * (1.0f / 1024.0f) + EPS);
#pragma unroll
            for (int jj = 0; jj < 2; ++jj) { const f32x4 h0 = x[i][2 * jj] * rstd * w1[2 * jj] + s1[2 * jj], h1 = x[i][2 * jj + 1] * rstd * w1[2 * jj + 1] + s1[2 * jj + 1];
                *(u32x4*)(H + (size_t)r * 1024 + 8 * F.lane + 512 * jj) = pack8(h0, h1); } }
    }
}

__device__ __forceinline__ float log_sigmoid_(float x) { return -log1pf(__expf(-x)); }
__device__ __forceinline__ s16x4 tr_read16(const LAS bf16_t* p) { typedef short v4s __attribute__((ext_vector_type(4))); return __builtin_bit_cast(s16x4, __builtin_amdgcn_ds_read_tr16_b64_v4i16((LAS v4s*)p)); }
#define MK8(L, H) (bf16x8){L[0], L[1], L[2], L[3], H[0], H[1], H[2], H[3]}
constexpr int KLD = 72, VLD = 136;
__device__ __forceinline__ int vsw(int r, int c8) { return 256 * r + 16 * (c8 ^ (((r & 3) << 1) | (((r >> 3) & 1) << 3))); }
__device__ __forceinline__ int vsw_tr(int R, int col) { return vsw(R, col >> 3) + 2 * (col & 7); }

__device__ const unsigned char R1_PORD[80] = {0, 1, 2, 3, 4, 5, 6, 7, 12, 13, 14, 15, 16, 17, 18, 19, 28, 29, 30, 31, 32, 33, 34, 35, 40, 41, 42, 43, 44, 45, 46, 47, 52, 53, 54, 55, 56, 57, 58, 59, 68, 69, 70, 71, 72, 73, 74, 75,
    8, 9, 10, 11, 20, 21, 22, 23, 24, 25, 26, 27, 36, 37, 38, 39, 48, 49, 50, 51, 60, 61, 62, 63, 64, 65, 66, 67, 76, 77, 78, 79};
__device__ __forceinline__ int r1_item_of(int i) { return (int)R1_PORD[i >> 4] * 16 + (i & 15); }
__device__ __forceinline__ void spin_ge(unsigned* p, unsigned need) { unsigned sp = 0;
    while ((unsigned)__builtin_amdgcn_readfirstlane(__hip_atomic_load(p, RLX_AGENT)) < need) { __builtin_amdgcn_s_sleep(2); if (++sp > (1u << 22)) break; } }
__device__ __forceinline__ void r1_wait(const Frame& F, unsigned* c1, int item, volatile LAS unsigned* alld) {
    if (F.wave == 0 && *alld == 0u) { const int pm = item >> 4, h = item & 7;
        const bool all = (unsigned)__builtin_amdgcn_readfirstlane(__hip_atomic_load(c1 + 16 * 480, RLX_AGENT)) >= 480u
                      && (unsigned)__builtin_amdgcn_readfirstlane(__hip_atomic_load(c1 + 16 * (481 + 80), RLX_AGENT)) >= 2080u;
        spin_ge(c1 + 16 * (pm * 6 + (h >> 2)), 1u); spin_ge(c1 + 16 * (pm * 6 + 2 + (h >> 1)), 1u);
        spin_ge(c1 + 16 * (481 + pm), 26u);
        __builtin_amdgcn_fence(__ATOMIC_ACQUIRE, "agent"); asm volatile("s_waitcnt vmcnt(0)" ::: "memory");
        if (all) *alld = 1u; }
    __syncthreads();
}
__device__ __forceinline__ void phase_r1(const Frame& F, CArgs& A) {
    unsigned char* ws = A.ws; unsigned* c1 = (unsigned*)(ws + WS_CNT1);
    volatile LAS unsigned* alld = (volatile LAS unsigned*)(F.lds + MISC_OFF) + 17;
    if (F.tid == 0) *alld = 0u;
    __syncthreads();
    const bf16_t* RKb = (const bf16_t*)(ws + WS_RK); const bf16_t* RVb = (const bf16_t*)(ws + WS_RV); bf16_t* KVS = (bf16_t*)(ws + WS_H);
    LAS bf16_t* kf = (LAS bf16_t*)F.lds; LAS bf16_t* kb = kf + 128 * KLD; LAS bf16_t* vl = kb + 128 * KLD; LAS bf16_t* ol = vl + 128 * 128 + F.wave * (16 * VLD);
    u32x4 pk_[2], pv_[4];
#define R1_LOAD(it) do { const int cg_ = (it) >> 3, h_ = (it) & 7; const size_t r0_ = (size_t)cg_ * 128; \
        _Pragma("unroll") for (int i = 0; i < 2; ++i) { const int ci = F.tid + i * NTHR; pk_[i] = *(const u32x4*)(RKb + (r0_ + (ci >> 3)) * 512 + 64 * h_ + 8 * (ci & 7)); } \
        _Pragma("unroll") for (int i = 0; i < 4; ++i) { const int ci = F.tid + i * NTHR; pv_[i] = *(const u32x4*)(RVb + (r0_ + (ci >> 4)) * 1024 + 128 * h_ + 8 * (ci & 15)); } } while (0)
    const int n1 = F.bid >= 32 ? (768 - (F.bid - 32) + 223) / 224 : 0, cntp = n1 + 2;
#define R1_POS(n) ((n) < n1 ? (F.bid - 32) + 224 * (n) : 768 + F.bid + 256 * ((n) - n1))
    { r1_wait(F, c1, r1_item_of(R1_POS(0)), alld); R1_LOAD(r1_item_of(R1_POS(0))); }
    for (int n = 0; n < cntp; ++n) { const int item = r1_item_of(R1_POS(n));
        const int h = item & 7;
        const float lgf = log_sigmoid_(A.dec_f[h]) * 1.4426950408889634f, lgb = log_sigmoid_(A.dec_b[h]) * 1.4426950408889634f;
#pragma unroll
        for (int i = 0; i < 2; ++i) { const int ci = F.tid + i * NTHR, j = ci >> 3, c8 = ci & 7;
            f32x4 a, b; unpack8(pk_[i], a, b);
            const float df = __builtin_amdgcn_exp2f(lgf * (float)(127 - j)), db = __builtin_amdgcn_exp2f(lgb * (float)j);
            *(LAS u32x4*)(kf + j * KLD + 8 * c8) = pack8(a * df, b * df); *(LAS u32x4*)(kb + j * KLD + 8 * c8) = pack8(a * db, b * db); }
#pragma unroll
        for (int i = 0; i < 4; ++i) { const int ci = F.tid + i * NTHR, j = ci >> 4, c8 = ci & 15; *(LAS u32x4*)((LAS char*)vl + vsw(j, c8)) = pv_[i]; }
        __syncthreads();
        if (n + 1 < cntp) { r1_wait(F, c1, r1_item_of(R1_POS(n + 1)), alld); R1_LOAD(r1_item_of(R1_POS(n + 1))); }
        const int dir = F.wave >> 2, mt = F.wave & 3, g = F.lane >> 4, q = (F.lane & 15) >> 2, p = F.lane & 3, l15 = F.lane & 15;
        const LAS bf16_t* ks = dir ? kb : kf;
        bf16x8 af[4];
#pragma unroll
        for (int s = 0; s < 4; ++s) { const LAS bf16_t* ap = ks + (32 * s + 8 * g + q) * KLD + 16 * mt + 4 * p; const s16x4 lo = tr_read16(ap), hi = tr_read16(ap + 4 * KLD); af[s] = MK8(lo, hi); }
#pragma unroll
        for (int nt = 0; nt < 8; ++nt) { f32x4 acc = {0.f, 0.f, 0.f, 0.f};
#pragma unroll
            for (int s = 0; s < 4; ++s) { const int R0 = 32 * s + 8 * g + q, col = 16 * nt + 4 * p;
                const s16x4 lo = tr_read16((const LAS bf16_t*)((const LAS char*)vl + vsw_tr(R0, col))), hi = tr_read16((const LAS bf16_t*)((const LAS char*)vl + vsw_tr(R0 + 4, col)));
                acc = __builtin_amdgcn_mfma_f32_16x16x32_bf16(af[s], MK8(lo, hi), acc, 0, 0, 0); }
#pragma unroll
            for (int e = 0; e < 4; ++e) ol[(4 * g + e) * VLD + 16 * nt + l15] = (bf16_t)f2bf(acc[e]); }
        LDS_WAIT(); asm volatile("" ::: "memory");
        bf16_t* dst = KVS + ((size_t)item * 2 + dir) * (64 * 128) + (size_t)(16 * mt + (F.lane >> 2)) * 128 + (F.lane & 3) * 32;
#pragma unroll
        for (int c = 0; c < 4; ++c) *(u32x4*)(dst + 8 * c) = *(const LAS u32x4*)(ol + (F.lane >> 2) * VLD + (F.lane & 3) * 32 + 8 * c);
        __syncthreads();
    }
#undef R1_LOAD
#undef R1_POS
}

__device__ __forceinline__ void phase_scan(const Frame& F, CArgs& A) {
    bf16_t* KVS = (bf16_t*)(A.ws + WS_H);
    const int gt = F.bid * NTHR + F.tid, NGT = F.G * NTHR;
    for (int i = gt; i < 5 * NUP; i += NGT) { const float* p = (const float*)(A.ws + WS_BUP) + i; ((float*)(A.ws + WS_BUPF))[i] = (p[0] + p[BUPQ]) + (p[2 * BUPQ] + p[3 * BUPQ]); }
    constexpr size_t CST = (size_t)8 * 2 * 8192;
    if (NGT * 4 == 256 * 2048) {
        u32x2 kv[4][2]; bf16_t* basep[4]; float decp[4];
#pragma unroll
        for (int k = 0; k < 4; ++k) { const int w = gt + k * NGT, e4 = (w & 2047) * 4, chain = w >> 11, dir = chain & 1, h = (chain >> 1) & 7, sq = chain >> 4;
            decp[k] = __expf(log_sigmoid_((dir ? A.dec_b : A.dec_f)[h]) * 128.0f);
            basep[k] = KVS + ((size_t)(2 * sq * 8 + h) * 2 + dir) * 8192 + e4;
            kv[k][0] = *(const u32x2*)(basep[k] + (size_t)(dir ? 1 : 0) * CST); kv[k][1] = *(const u32x2*)(basep[k] + (size_t)(dir ? 0 : 1) * CST); }
#pragma unroll
        for (int k = 0; k < 4; ++k) { const int w = gt + k * NGT, e4 = (w & 2047) * 4, chain = w >> 11, dir = chain & 1, h = (chain >> 1) & 7, sq = chain >> 4;
            const int pr = e4 >> 7, dv = e4 & 127, lr = swap25(pr);
            f32x4 st = {0.f, 0.f, 0.f, 0.f};
#pragma unroll
            for (int i = 0; i < 2; ++i) { u32x2 o; o.x = pk2(st[0], st[1]); o.y = pk2(st[2], st[3]); *(u32x2*)(basep[k] + (size_t)(dir ? 1 - i : i) * CST) = o;
                st = st * decp[k] + (f32x4){bflo(kv[k][i].x), bfhi(kv[k][i].x), bflo(kv[k][i].y), bfhi(kv[k][i].y)}; }
            *(f32x4*)(A.out + (dir ? OUT_SB : OUT_SF) + (((size_t)sq * 8 + h) * 64 + lr) * 128 + dv) = st; }
    }
    for (int w = (NGT * 4 == 256 * 2048) ? gt + 4 * NGT : gt; w < 320 * 2048; w += NGT) {
        const int e4 = (w & 2047) * 4, chain = w >> 11, dir = chain & 1, h = (chain >> 1) & 7, s = chain >> 4;
        const int nch = s < 16 ? 2 : 32, c0 = s < 16 ? 2 * s : 32 + 32 * (s - 16);
        const float lg = log_sigmoid_((dir ? A.dec_b : A.dec_f)[h]), dec = __expf(lg * 128.0f);
        const int pr = e4 >> 7, dv = e4 & 127, lr = swap25(pr);
        f32x4 st = {0.f, 0.f, 0.f, 0.f};
        if (s >= 16) st = *(const f32x4*)((dir ? A.st_b : A.st_f) + (((size_t)(s - 16) * 8 + h) * 64 + lr) * 128 + dv);
        bf16_t* base = KVS + ((size_t)(c0 * 8 + h) * 2 + dir) * 8192 + e4;
        if (s < 16) {
            u32x2 kv[2];
#pragma unroll
            for (int i = 0; i < 2; ++i) kv[i] = *(const u32x2*)(base + (size_t)(dir ? 1 - i : i) * CST);
#pragma unroll
            for (int i = 0; i < 2; ++i) { u32x2 o; o.x = pk2(st[0], st[1]); o.y = pk2(st[2], st[3]); *(u32x2*)(base + (size_t)(dir ? 1 - i : i) * CST) = o;
                st = st * dec + (f32x4){bflo(kv[i].x), bfhi(kv[i].x), bflo(kv[i].y), bfhi(kv[i].y)}; }
        } else {
            u32x2 kv[32];
#pragma unroll
            for (int i = 0; i < 32; ++i) kv[i] = *(const u32x2*)(base + (size_t)(dir ? 31 - i : i) * CST);
#pragma unroll
            for (int i = 0; i < 32; ++i) { u32x2 o; o.x = pk2(st[0], st[1]); o.y = pk2(st[2], st[3]); *(u32x2*)(base + (size_t)(dir ? 31 - i : i) * CST) = o;
                st = st * dec + (f32x4){bflo(kv[i].x), bfhi(kv[i].x), bflo(kv[i].y), bfhi(kv[i].y)}; }
        }
        if (s < 16) *(f32x4*)(A.out + (dir ? OUT_SB : OUT_SF) + (((size_t)s * 8 + h) * 64 + lr) * 128 + dv) = st;
    }
}

namespace att {
constexpr int D = 128, NW = 8, QBLK = 32, KVBLK = 64;
constexpr float SCALE = 0.088388347648318440f, THR = 8.f;
constexpr size_t SHM_V = KVBLK * D * 2, SHM_K = KVBLK * D * 2, SHM_ATTN = 2 * SHM_V + 2 * SHM_K + NW * 64 * 4;
#define KSWZ(row, colB) ((row) * 256 + ((colB) ^ (((row) & 7) << 4)))
#define SBAR() __builtin_amdgcn_sched_barrier(0)
__device__ __forceinline__ int crow(int r, int hi) { return (r & 3) + 8 * (r >> 2) + 4 * hi; }
__device__ __forceinline__ unsigned cvtpk(float lo, float hi) { unsigned r; asm volatile("v_cvt_pk_bf16_f32 %0, %1, %2" : "=v"(r) : "v"(lo), "v"(hi)); return r; }
__device__ __forceinline__ void partialSM(f32x16& p0, f32x16& p1, float& m_reg, float& mn, float& alpha) {
  constexpr float C = SCALE * 1.4426950408889634f;
  float pmax = p0[0]; for (int r = 1; r < 16; ++r) pmax = fmaxf(pmax, p0[r]); for (int r = 0; r < 16; ++r) pmax = fmaxf(pmax, p1[r]);
  { auto rr = __builtin_amdgcn_permlane32_swap(__float_as_uint(pmax), __float_as_uint(pmax), false, false);
    pmax = fmaxf(__uint_as_float(rr[0]), __uint_as_float(rr[1])); }
  if (__builtin_expect(__all(pmax - m_reg <= THR / SCALE), 1)) { mn = m_reg; alpha = 1.f; }
  else { mn = fmaxf(m_reg, pmax); alpha = __builtin_amdgcn_exp2f((m_reg - mn) * C); m_reg = mn; }
  float mnC = -mn * C;
  for (int r = 0; r < 16; ++r) p0[r] = fmaf(p0[r], C, mnC); for (int r = 0; r < 16; ++r) p1[r] = fmaf(p1[r], C, mnC);
  for (int r = 0; r < 16; ++r) p0[r] = __builtin_amdgcn_exp2f(p0[r]);
}
__device__ __forceinline__ void finishSM(f32x16& p0, f32x16& p1, float alpha, float& l_reg, bf16x8& pa0, bf16x8& pa1, bf16x8& pa2, bf16x8& pa3) {
  for (int r = 0; r < 16; ++r) p1[r] = __builtin_amdgcn_exp2f(p1[r]);
  float ps = 0; for (int r = 0; r < 16; ++r) ps += p0[r]; for (int r = 0; r < 16; ++r) ps += p1[r];
  { auto rr = __builtin_amdgcn_permlane32_swap(__float_as_uint(ps), __float_as_uint(ps), false, false);
    ps = __uint_as_float(rr[0]) + __uint_as_float(rr[1]); }
  l_reg = l_reg * alpha + ps;
#define PK4(P, BASE, OUT) do { unsigned a0 = cvtpk(P[BASE + 0], P[BASE + 1]), a1 = cvtpk(P[BASE + 2], P[BASE + 3]);   \
    unsigned b0 = cvtpk(P[BASE + 4], P[BASE + 5]), b1 = cvtpk(P[BASE + 6], P[BASE + 7]);                              \
    auto r0 = __builtin_amdgcn_permlane32_swap(a0, b0, false, false); auto r1 = __builtin_amdgcn_permlane32_swap(a1, b1, false, false); \
    u32x4 w = {r0[0], r1[0], r0[1], r1[1]}; OUT = *reinterpret_cast<bf16x8*>(&w); } while (0)
  PK4(p0, 0, pa0); PK4(p0, 8, pa1); PK4(p1, 0, pa2); PK4(p1, 8, pa3);
#undef PK4
}
__device__ __forceinline__ void qkt(f32x16& p0, f32x16& p1, const bf16_t* Ks, const bf16x8* qr, int r32, int hi) {
  p0 = f32x16{}; p1 = f32x16{};
  for (int d0 = 0; d0 < 8; ++d0) { int cb = (d0 * 16 + hi * 8) * 2;
    bf16x8 b0 = *reinterpret_cast<const bf16x8*>((const char*)Ks + KSWZ(r32, cb));
    bf16x8 b1 = *reinterpret_cast<const bf16x8*>((const char*)Ks + KSWZ(32 + r32, cb));
    p0 = __builtin_amdgcn_mfma_f32_32x32x16_bf16(b0, qr[d0], p0, 0, 0, 0);
    p1 = __builtin_amdgcn_mfma_f32_32x32x16_bf16(b1, qr[d0], p1, 0, 0, 0); }
}
__device__ __forceinline__ int v_st(int k, int c) { const int kk = (k & ~0xC) | ((k & 4) << 1) | ((k & 8) >> 1); return ((kk >> 3) * 4 + (c >> 5)) * 512 + ((kk & 7) * 32 + (c & 31)) * 2; }
__device__ __forceinline__ int v_rd_base(int lane) { return ((lane & 3) << 3) | (((lane >> 2) & 3) << 6) | (((lane >> 4) & 1) << 5) | (((lane >> 5) & 1) << 8); }
constexpr int v_rd_off(int d0, int ks, int half) { return d0 * 512 + ks * 4096 + half * 2048; }
template <int OFF> __device__ __forceinline__ s16x4 tr_read(int vb) { s16x4 r; asm volatile("ds_read_b64_tr_b16 %0, %1 offset:%2" : "=&v"(r) : "v"(vb), "i"(OFF) : "memory"); return r; }
template <int D0> __device__ __forceinline__ void pv_one(f32x16& od, int vb, bf16x8 pa0, bf16x8 pa1, bf16x8 pa2, bf16x8 pa3) {
  const s16x4 l0 = tr_read<v_rd_off(D0, 0, 0)>(vb), h0 = tr_read<v_rd_off(D0, 0, 1)>(vb), l1 = tr_read<v_rd_off(D0, 1, 0)>(vb), h1 = tr_read<v_rd_off(D0, 1, 1)>(vb);
  const s16x4 l2 = tr_read<v_rd_off(D0, 2, 0)>(vb), h2 = tr_read<v_rd_off(D0, 2, 1)>(vb), l3 = tr_read<v_rd_off(D0, 3, 0)>(vb), h3 = tr_read<v_rd_off(D0, 3, 1)>(vb);
  asm volatile("s_waitcnt lgkmcnt(0)" ::: "memory"); SBAR();
  od = __builtin_amdgcn_mfma_f32_32x32x16_bf16(pa0, MK8(l0, h0), od, 0, 0, 0);
  od = __builtin_amdgcn_mfma_f32_32x32x16_bf16(pa1, MK8(l1, h1), od, 0, 0, 0);
  od = __builtin_amdgcn_mfma_f32_32x32x16_bf16(pa2, MK8(l2, h2), od, 0, 0, 0);
  od = __builtin_amdgcn_mfma_f32_32x32x16_bf16(pa3, MK8(l3, h3), od, 0, 0, 0);
}
__device__ __forceinline__ void pv_d0(f32x16* o, int vb, bf16x8 pa0, bf16x8 pa1, bf16x8 pa2, bf16x8 pa3) {
  pv_one<0>(o[0], vb, pa0, pa1, pa2, pa3); pv_one<1>(o[1], vb, pa0, pa1, pa2, pa3); pv_one<2>(o[2], vb, pa0, pa1, pa2, pa3); pv_one<3>(o[3], vb, pa0, pa1, pa2, pa3);
}
__device__ __forceinline__ void pv_partial(f32x16* o, int vb, bf16x8 pa0, bf16x8 pa1, bf16x8 pa2, bf16x8 pa3, f32x16& p0, f32x16& p1, float& m_reg, float& mn, float& alpha) {
  constexpr float C = SCALE * 1.4426950408889634f;
  pv_one<0>(o[0], vb, pa0, pa1, pa2, pa3);
  float pmax = p0[0]; for (int r = 1; r < 16; ++r) pmax = fmaxf(pmax, p0[r]); for (int r = 0; r < 16; ++r) pmax = fmaxf(pmax, p1[r]);
  { auto rr = __builtin_amdgcn_permlane32_swap(__float_as_uint(pmax), __float_as_uint(pmax), false, false);
    pmax = fmaxf(__uint_as_float(rr[0]), __uint_as_float(rr[1])); }
  asm volatile("" : "+v"(pmax));
  pv_one<1>(o[1], vb, pa0, pa1, pa2, pa3);
  { const bool keep = __all(pmax - m_reg <= THR / SCALE);
    mn = keep ? m_reg : fmaxf(m_reg, pmax); alpha = __builtin_amdgcn_exp2f((m_reg - mn) * C); m_reg = mn; }
  const float mnC = -mn * C;
  for (int r = 0; r < 16; ++r) p0[r] = fmaf(p0[r], C, mnC); for (int r = 0; r < 16; ++r) p1[r] = fmaf(p1[r], C, mnC);
  asm volatile("" : "+v"(p0), "+v"(p1), "+v"(alpha));
  pv_one<2>(o[2], vb, pa0, pa1, pa2, pa3);
  for (int r = 0; r < 8; ++r) p0[r] = __builtin_amdgcn_exp2f(p0[r]);
  asm volatile("" : "+v"(p0));
  pv_one<3>(o[3], vb, pa0, pa1, pa2, pa3);
  for (int r = 8; r < 16; ++r) p0[r] = __builtin_amdgcn_exp2f(p0[r]);
  asm volatile("" : "+v"(p0)); SBAR();
}
template <int LDQ>
__device__ __forceinline__ void attn_dense_body(const bf16_t* Qb, const bf16_t* __restrict__ Kh, const bf16_t* __restrict__ Vh, bf16_t* Ob, int seq, char* lds, const int wid) {
  constexpr int LDK = 128;
  const int lane = lane_id_(), tid = wid * 64 + lane, r32 = lane & 31, hi = lane >> 5;
  bf16_t* V_lds = (bf16_t*)lds; bf16_t* K_lds = (bf16_t*)(lds + 2 * SHM_V);
  float* ws = (float*)(lds + 2 * SHM_V + 2 * SHM_K) + wid * 64; float* li_l = ws; float* al_l = ws + 32;
  float m_reg = -1e30f, l_reg = 0; f32x16 o[4] = {}; bf16x8 qr[8];
  const bf16_t* Qw = Qb + (long)(wid * QBLK + r32) * LDQ + hi * 8;
#pragma unroll
  for (int d0 = 0; d0 < 8; ++d0) qr[d0] = *reinterpret_cast<const bf16x8*>(Qw + d0 * 16);
  const int sr = tid >> 4, sc = (tid & 15) * 8, vst0 = v_st(sr, sc), vst1 = v_st(32 + sr, sc);
  const int vb0 = (int)(uintptr_t)V_lds + v_rd_base(lane);
  struct { bf16x8 vs0, vs1, ks0, ks1; } sr_[2];
#define SLOAD(i, k0) do { sr_[i].vs0 = *(const bf16x8*)(&Vh[(long)((k0) + sr) * LDK + sc]); sr_[i].vs1 = *(const bf16x8*)(&Vh[(long)((k0) + 32 + sr) * LDK + sc]); \
    sr_[i].ks0 = *(const bf16x8*)(&Kh[(long)((k0) + sr) * LDK + sc]); sr_[i].ks1 = *(const bf16x8*)(&Kh[(long)((k0) + 32 + sr) * LDK + sc]); } while (0)
#define SWRITE(b, i) do { *(bf16x8*)((char*)V_lds + (b) * SHM_V + vst0) = sr_[i].vs0;          \
    *(bf16x8*)((char*)V_lds + (b) * SHM_V + vst1) = sr_[i].vs1; int kc = sc * 2;               \
    *(bf16x8*)((char*)K_lds + (b) * SHM_K + KSWZ(sr, kc)) = sr_[i].ks0;                       \
    *(bf16x8*)((char*)K_lds + (b) * SHM_K + KSWZ(32 + sr, kc)) = sr_[i].ks1; } while (0)
#define SWAIT() asm volatile("s_waitcnt vmcnt(4)" ::: "memory")
#define RESC(a) do { if (__any((a) < 1.f)) { if (hi == 0) al_l[r32] = (a); asm volatile("s_waitcnt lgkmcnt(0)" ::: "memory"); \
    for (int d = 0; d < 4; ++d) for (int r = 0; r < 16; ++r) o[d][r] *= al_l[crow(r, hi)]; } } while (0)
  f32x16 pA0, pA1, pB0, pB1; float mnA, mnB, alA, alB; bf16x8 pa0, pa1, pa2, pa3; const int NT = seq / KVBLK;
  constexpr int SE = 0, SO = 1;
  SLOAD(SE, 0); asm volatile("s_waitcnt vmcnt(0)" ::: "memory"); SWRITE(0, SE); __syncthreads();
  qkt(pA0, pA1, K_lds, qr, r32, hi); partialSM(pA0, pA1, m_reg, mnA, alA);
  SLOAD(SO, KVBLK); if (2 < NT) SLOAD(SE, 2 * KVBLK);
  SWAIT(); SWRITE(1, SO); __syncthreads();
  for (int j = 1; j + 1 < NT; j += 2) {
    SBAR(); qkt(pB0, pB1, (bf16_t*)((char*)K_lds + SHM_K), qr, r32, hi);
    finishSM(pA0, pA1, alA, l_reg, pa0, pa1, pa2, pa3); SBAR();
    SLOAD(SO, (j + 2) * KVBLK); SBAR();
    pv_partial(o, vb0, pa0, pa1, pa2, pa3, pB0, pB1, m_reg, mnB, alB);
    __syncthreads(); SWAIT(); SWRITE(0, SE);
    RESC(alB); __syncthreads();
    SBAR(); qkt(pA0, pA1, K_lds, qr, r32, hi);
    finishSM(pB0, pB1, alB, l_reg, pa0, pa1, pa2, pa3); SBAR();
    if (j + 3 < NT) SLOAD(SE, (j + 3) * KVBLK); SBAR();
    pv_partial(o, vb0 + (int)SHM_V, pa0, pa1, pa2, pa3, pA0, pA1, m_reg, mnA, alA);
    __syncthreads(); SWAIT(); SWRITE(1, SO);
    RESC(alA); __syncthreads();
  }
  SBAR(); qkt(pB0, pB1, (bf16_t*)((char*)K_lds + SHM_K), qr, r32, hi);
  finishSM(pA0, pA1, alA, l_reg, pa0, pa1, pa2, pa3); SBAR();
  pv_partial(o, vb0, pa0, pa1, pa2, pa3, pB0, pB1, m_reg, mnB, alB);
  __syncthreads(); RESC(alB);
  finishSM(pB0, pB1, alB, l_reg, pa0, pa1, pa2, pa3); SBAR();
  pv_d0(o, vb0 + (int)SHM_V, pa0, pa1, pa2, pa3);
  if (hi == 0) li_l[r32] = l_reg; asm volatile("s_waitcnt lgkmcnt(0)" ::: "memory");
  float rli[16];
#pragma unroll
  for (int r = 0; r < 16; ++r) rli[r] = __builtin_amdgcn_rcpf(li_l[crow(r, hi)]);
  bf16_t* Ow = Ob + (long)(wid * QBLK) * LDQ;
#pragma unroll
  for (int r = 0; r < 16; ++r) { int orow = crow(r, hi);
    for (int d0 = 0; d0 < 4; ++d0) Ow[(long)orow * LDQ + d0 * 32 + r32] = (bf16_t)f2bf(o[d0][r] * rli[r]); }
  __syncthreads();
#undef SLOAD
#undef SWRITE
#undef SWAIT
#undef RESC
}
#undef KSWZ
#undef SBAR
}

struct R3Regs { u32x4 k[2], v[4], s[4], srg[4]; bf16x8 q[2]; };
__device__ __forceinline__ void r3_load(const Frame& F, CArgs& A, int item, R3Regs& R) {
    unsigned char* ws = A.ws;
    const bf16_t* RQb = (const bf16_t*)(ws + WS_RQ); const bf16_t* RKb = (const bf16_t*)(ws + WS_RK); const bf16_t* RVb = (const bf16_t*)(ws + WS_RV);
    const bf16_t* SRGb = (const bf16_t*)(ws + WS_SRG); const bf16_t* KVS = (const bf16_t*)(ws + WS_H);
    const int cg = item >> 3, h = item & 7; const size_t row0 = (size_t)cg * 128;
#pragma unroll
    for (int i = 0; i < 2; ++i) { const int ci = F.tid + i * NTHR; R.k[i] = *(const u32x4*)(RKb + (row0 + (ci >> 3)) * 512 + 64 * h + 8 * (ci & 7)); }
#pragma unroll
    for (int i = 0; i < 4; ++i) { const int ci = F.tid + i * NTHR, j = ci >> 4, c8 = ci & 15;
        R.v[i] = *(const u32x4*)(RVb + (row0 + j) * 1024 + 128 * h + 8 * c8);
        R.s[i] = *(const u32x4*)(KVS + (size_t)item * 2 * 8192 + (size_t)j * 128 + 8 * c8); }
    const size_t gofs = (row0 + 16 * F.wave + (F.lane >> 2)) * 1024 + 128 * h + (F.lane & 3) * 32;
#pragma unroll
    for (int c = 0; c < 4; ++c) R.srg[c] = *(const u32x4*)(SRGb + gofs + 8 * c);
#pragma unroll
    for (int s = 0; s < 2; ++s) R.q[s] = *(const bf16x8*)(RQb + (row0 + 16 * F.wave + (F.lane & 15)) * 512 + 64 * h + 32 * s + 8 * (F.lane >> 4));
}
__device__ __forceinline__ void r3_item(const Frame& F, CArgs& A, int item, int item_next, R3Regs& R, int after_next, LAS int* slot) {
    unsigned char* ws = A.ws; bf16_t* RVb = (bf16_t*)(ws + WS_RV);
    LAS bf16_t* kl = (LAS bf16_t*)F.lds; LAS bf16_t* vl = kl + 128 * KLD; LAS bf16_t* sl = vl + 128 * 128; LAS bf16_t* pl = sl + 128 * 128 + F.wave * (16 * VLD);
    const int cg = item >> 3, h = item & 7; const size_t row0 = (size_t)cg * 128;
    const float lgf = log_sigmoid_(A.dec_f[h]) * 1.4426950408889634f, lgb = log_sigmoid_(A.dec_b[h]) * 1.4426950408889634f;
#pragma unroll
    for (int i = 0; i < 2; ++i) { const int ci = F.tid + i * NTHR; *(LAS u32x4*)(kl + (ci >> 3) * KLD + 8 * (ci & 7)) = R.k[i]; }
#pragma unroll
    for (int i = 0; i < 4; ++i) { const int ci = F.tid + i * NTHR, j = ci >> 4, c8 = ci & 15; *(LAS u32x4*)((LAS char*)vl + vsw(j, c8)) = R.v[i]; *(LAS u32x4*)((LAS char*)sl + vsw(j, c8)) = R.s[i]; }
    int lane_ = F.lane; asm volatile("" : "+v"(lane_));
    const int g = lane_ >> 4, l15 = lane_ & 15, q = l15 >> 2, p = lane_ & 3, w = F.wave;
    const size_t gofs = (row0 + 16 * w + (lane_ >> 2)) * 1024 + 128 * h + (lane_ & 3) * 32;
    u32x4 srg_[4]; bf16x8 qf[2];
#pragma unroll
    for (int c = 0; c < 4; ++c) srg_[c] = R.srg[c];
#pragma unroll
    for (int s = 0; s < 2; ++s) qf[s] = R.q[s];
    __syncthreads();
    if (item_next >= 0) r3_load(F, A, item_next, R);
    float rf[4], rb[4];
#pragma unroll
    for (int e = 0; e < 4; ++e) { const float fi = (float)(16 * w + 4 * g + e); rf[e] = __builtin_amdgcn_exp2f(lgf * fi); rb[e] = __builtin_amdgcn_exp2f(-lgb * fi); }
#pragma unroll
    for (int nt = 0; nt < 8; ++nt) { f32x4 sacc = {0.f, 0.f, 0.f, 0.f};
#pragma unroll
        for (int s = 0; s < 2; ++s) { const bf16x8 kfr = *(const LAS bf16x8*)(kl + (16 * nt + l15) * KLD + 32 * s + 8 * g); sacc = __builtin_amdgcn_mfma_f32_16x16x32_bf16(qf[s], kfr, sacc, 0, 0, 0); }
        const int j = 16 * nt + l15;
        if (nt < w) {
            const float cf = __builtin_amdgcn_exp2f(-lgf * (float)j);
#pragma unroll
            for (int e = 0; e < 4; ++e) pl[(4 * g + e) * VLD + j] = (bf16_t)f2bf(sacc[e] * (rf[e] * cf));
        } else if (nt > w) {
            const float cb = __builtin_amdgcn_exp2f(lgb * (float)j);
#pragma unroll
            for (int e = 0; e < 4; ++e) pl[(4 * g + e) * VLD + j] = (bf16_t)f2bf(sacc[e] * (rb[e] * cb));
        } else {
            const float cf = __builtin_amdgcn_exp2f(-lgf * (float)j), cb = __builtin_amdgcn_exp2f(lgb * (float)j);
#pragma unroll
            for (int e = 0; e < 4; ++e) { const int df = 16 * w + 4 * g + e - j;
                const float dm = (df >= 0 ? rf[e] * cf : 0.f) + (df <= 0 ? rb[e] * cb : 0.f);
                pl[(4 * g + e) * VLD + j] = (bf16_t)f2bf(sacc[e] * dm); } } }
    LDS_WAIT(); asm volatile("" ::: "memory");
    bf16x8 pa[4], qa[4];
#pragma unroll
    for (int s = 0; s < 4; ++s) pa[s] = *(const LAS bf16x8*)(pl + l15 * VLD + 32 * s + 8 * g);
    { const int i = 16 * w + l15; const float qdf = __builtin_amdgcn_exp2f(lgf * (float)(i + 1)), qdb = __builtin_amdgcn_exp2f(lgb * (float)(128 - i));
#pragma unroll
      for (int s = 0; s < 2; ++s) { f32x4 a, b; unpack8(__builtin_bit_cast(u32x4, qf[s]), a, b); qa[s] = __builtin_bit_cast(bf16x8, pack8(a * qdf, b * qdf)); qa[2 + s] = __builtin_bit_cast(bf16x8, pack8(a * qdb, b * qdb)); } }
    f32x4 oacc[8];
#pragma unroll
    for (int nt = 0; nt < 8; ++nt) { f32x4 acc = {0.f, 0.f, 0.f, 0.f};
#pragma unroll
        for (int s = 0; s < 4; ++s) { const int R0 = 32 * s + 8 * g + q, col = 16 * nt + 4 * p;
            const s16x4 lo = tr_read16((const LAS bf16_t*)((const LAS char*)vl + vsw_tr(R0, col))), hi = tr_read16((const LAS bf16_t*)((const LAS char*)vl + vsw_tr(R0 + 4, col)));
            acc = __builtin_amdgcn_mfma_f32_16x16x32_bf16(pa[s], MK8(lo, hi), acc, 0, 0, 0); }
#pragma unroll
        for (int s = 0; s < 4; ++s) { const int R0 = 32 * s + 8 * g + q, col = 16 * nt + 4 * p;
            const s16x4 lo = tr_read16((const LAS bf16_t*)((const LAS char*)sl + vsw_tr(R0, col))), hi = tr_read16((const LAS bf16_t*)((const LAS char*)sl + vsw_tr(R0 + 4, col)));
            acc = __builtin_amdgcn_mfma_f32_16x16x32_bf16(qa[s], MK8(lo, hi), acc, 0, 0, 0); }
        oacc[nt] = acc; }
    f32x4 ss = {0.f, 0.f, 0.f, 0.f};
#pragma unroll
    for (int nt = 0; nt < 8; ++nt) ss += oacc[nt] * oacc[nt];
#pragma unroll
    for (int e = 0; e < 4; ++e) { float s = ss[e]; s += __shfl_xor(s, 1); s += __shfl_xor(s, 2); s += __shfl_xor(s, 4); s += __shfl_xor(s, 8); ss[e] = __builtin_amdgcn_rsqf(s * (1.0f / 128.0f) + EPS); }
#pragma unroll
    for (int nt = 0; nt < 8; ++nt)
#pragma unroll
        for (int e = 0; e < 4; ++e) pl[(4 * g + e) * VLD + 16 * nt + l15] = (bf16_t)f2bf(oacc[nt][e] * ss[e]);
    LDS_WAIT(); asm volatile("" ::: "memory");
#pragma unroll
    for (int c = 0; c < 4; ++c) { f32x4 o0, o1, g0, g1; unpack8(*(const LAS u32x4*)(pl + (lane_ >> 2) * VLD + (lane_ & 3) * 32 + 8 * c), o0, o1); unpack8(srg_[c], g0, g1);
        *(u32x4*)(RVb + gofs + 8 * c) = pack8(o0 * g0, o1 * g1); }
    if (F.tid == 0) *slot = after_next;
    __syncthreads();
}

__device__ __forceinline__ void phase_attn(const Frame& F, CArgs& A) {
    unsigned char* ws = A.ws; bf16_t* Q = (bf16_t*)(ws + WS_Q);
    {
        LAS float* scr = (LAS float*)(F.lds + F.wave * 8704);
        const int gw = F.bid * NWAVES + F.wave, NGW = F.G * NWAVES;
        constexpr int I_O = 16 * 32, NIT = 3 * I_O;
        for (int it = gw; it < NIT; it += NGW) {
            int r = it;
            if (r < I_O) { transpose_item(A.w_att_o, 1024, (bf16_t*)(ws + WS_WB), 2048, 0, 64 * (r / 32), 32 * (r % 32), ColId(), scr, F.lane); continue; } r -= I_O;
            if (r < I_O) { transpose_item(A.w_ret_o, 1024, (bf16_t*)(ws + WS_WB), 2048, 1024, 64 * (r / 32), 32 * (r % 32), ColId(), scr, F.lane); continue; } r -= I_O;
            transpose_item(A.w_out, 1024, (bf16_t*)(ws + WS_WC), 1024, 0, 64 * (r / 32), 32 * (r % 32), ColId(), scr, F.lane);
        }
        __syncthreads();
    }
    const int x = F.bid & 7, c = F.bid >> 3;
    const int nun = F.bid < NB * NH ? 3 : 2;
    unsigned* qctr = (unsigned*)(ws + WS_CNT) + 64 * CNT_R3Q; LAS int* slot = (LAS int*)(F.lds + 122880);
    int nxt_v = 0; if (F.tid == 0) nxt_v = (int)__hip_atomic_fetch_add(qctr, 1u, RLX_AGENT) + F.G;
#pragma nounroll
    for (int i = 0; i < nun; ++i) {
        const bf16_t *Kh, *Vh; bf16_t* Qb; int seq;
        if (i < 2) { const int lb = x >> 1, kvh = x & 1, uu = c + 32 * i, hq = kvh * 4 + (uu >> 4), qb = uu & 15;
            Kh = (const bf16_t*)(ws + WS_KALL) + (size_t)(lb * 2 + kvh) * SKV * 128; Vh = (const bf16_t*)(ws + WS_VALL) + (size_t)(lb * 2 + kvh) * SKV * 128;
            Qb = Q + ((size_t)MP + (size_t)lb * DSEQ + qb * 256) * 1024 + hq * 128; seq = SKV; }
        else { const int b = F.bid >> 3, hq = F.bid & 7, kvh = hq >> 2;
            Kh = (const bf16_t*)(ws + WS_KP) + (size_t)(b * 2 + kvh) * SEQ * 128; Vh = (const bf16_t*)(ws + WS_VP) + (size_t)(b * 2 + kvh) * SEQ * 128;
            Qb = Q + (size_t)b * SEQ * 1024 + hq * 128; seq = SEQ; }
        att::attn_dense_body<1024>(Qb, Kh, Vh, Qb, seq, (char*)F.lds, F.wave);
    }
    {
      constexpr int NIT3 = (MT / 128) * 8;
      Frame F2 = F; F2.lane = lane_id_(); F2.tid = F2.wave * 64 + F2.lane;
      if (F2.tid == 0) *slot = nxt_v;
      __syncthreads();
      int cur = F.bid, nxt = __builtin_amdgcn_readfirstlane(*slot); if (nxt >= NIT3) nxt = -1;
      R3Regs R; r3_load(F2, A, cur, R);
      while (cur >= 0) {
          int n2_v = -1; if (nxt >= 0 && F2.tid == 0) n2_v = (int)__hip_atomic_fetch_add(qctr, 1u, RLX_AGENT) + F.G;
          r3_item(F2, A, cur, nxt, R, n2_v, slot);
          cur = nxt; nxt = __builtin_amdgcn_readfirstlane(*slot); if (nxt >= NIT3) nxt = -1;
      }
    }
}

struct OneUnit { int pm, pn; __device__ __forceinline__ bool next(int i, pg8::Unit& u) const { if (i) return false; u.pm = pm; u.pn = pn; return true; }
    __device__ __forceinline__ void a_ready(const pg8::Unit&, int) const {} };
constexpr int NU2 = 0, NU3 = 320, NU4 = (MT / 256) * (NUP / 256), NU5 = 320, NUTOT = NU2 + NU3 + NU4 + NU5;
__device__ __forceinline__ void fix_panel(const Frame& F, CArgs& A, int pm) {
    unsigned char* ws = A.ws; const float* EU = (const float*)(ws + WS_EDGE_U); const float* EUC = (const float*)(ws + WS_EDGE_UC); bf16_t* ACT = (bf16_t*)(ws + WS_ACT);
    const int jt = (pm - 16) & 15;
    for (int i = F.tid; i < 2 * DFF; i += NTHR) { const int j = i % DFF, e = i / DFF;
        if ((e == 0 && jt == 0) || (e == 1 && jt == 15)) continue;
        const int pmn = e ? pm + 1 : pm - 1, na = 256 * (j >> 7) + (j & 127), ng = na + 128, tap = e ? 2 : 0;
        const float ua = EUC[((size_t)pm * 2 + e) * NUP + na] + A.conv_w[(size_t)tap * NUP + j] * EU[((size_t)pmn * 2 + (1 - e)) * NUP + na];
        const float ug = EUC[((size_t)pm * 2 + e) * NUP + ng] + A.conv_w[(size_t)tap * NUP + DFF + j] * EU[((size_t)pmn * 2 + (1 - e)) * NUP + ng];
        ACT[((size_t)pm * 256 + (e ? 255 : 0)) * DFF + j] = (bf16_t)f2bf(siluf_(ug) * ua); }
}
__device__ __forceinline__ void g3_unit(const Frame& F, CArgs& A, int idx) {
    unsigned char* ws = A.ws; unsigned* cnt = (unsigned*)(ws + WS_CNT); const int pm = idx >> 2, pn = idx & 3;
    OneUnit S{pm, pn};
    pg8::Gemm g{(const bf16_t*)(ws + WS_Y), (const bf16_t*)(ws + WS_WC), MT, DM, DM, DM, DM, 1 << 30, 0};
    EpiRes1 E{A.x_prompt, A.x_sample, (const float*)(ws + WS_MODF), A.norm2_g, (bf16_t*)(ws + WS_X1B), (float*)(ws + WS_SSQ1), (bf16_t*)(ws + WS_H)};
    pg8::gemm_phase(F.lds, g, S, E, F.wave);
    asm volatile("s_waitcnt vmcnt(0)" ::: "memory");
    __syncthreads();
    if (F.wave == 0 && lane_id_() == 0) { __hip_atomic_fetch_add(cnt + 64 * (CNT_D3 + pm), 1u, RLX_AGENT); __hip_atomic_fetch_add(cnt + 64 * CNT_G3ALL, 1u, RLX_AGENT); }
}
__device__ __forceinline__ void phase_mix(const Frame& F, CArgs& A) {
    unsigned char* ws = A.ws; unsigned* cnt = (unsigned*)(ws + WS_CNT);
    const int v = (F.bid & 7) * (F.G >> 3) + (F.bid >> 3);
#if defined(PROBE_K0) && (PROBE_K0 == 301 || PROBE_K0 == 302)
    const unsigned long long tmix0_ = __builtin_amdgcn_s_memrealtime();
#endif
    {   struct G2Run { int v, n; __device__ __forceinline__ bool next(int i, pg8::Unit& u) const { if (i >= n) return false; const int l = i == 0 ? v : 256 + v; u.pm = l >> 2; u.pn = l & 3; return true; }
            __device__ __forceinline__ void a_ready(const pg8::Unit&, int) const {} };
        G2Run S{v, v < 64 ? 2 : 1};
        pg8::Gemm g{(const bf16_t*)(ws + WS_Q), (const bf16_t*)(ws + WS_WB), MT, DM, 2 * DM, DM, 2 * DM, 16, (long)(WS_RV - WS_Q) - 16 * 128};
        EpiMix E{(const bf16_t*)A.out, (const bf16_t*)A.out + (size_t)MT * DM, (bf16_t*)(ws + WS_Y), cnt + 64 * CNT_D2};
        pg8::gemm_phase(F.lds, g, S, E, F.wave);
    }
#if defined(PROBE_K0) && PROBE_K0 == 300
    const unsigned long long t0_ = __builtin_amdgcn_s_memrealtime();
#endif
#if defined(PROBE_K0) && PROBE_K0 == 301
    if (v == PROBE_BID && F.tid == 0) *(float*)(ws + 32768) = (float)(__builtin_amdgcn_s_memrealtime() - tmix0_);
#endif
    if (v >= 64) { const int idx = v - 64, pm = idx >> 2;
        if (F.wave == 0) { spin_ge(cnt + 64 * (CNT_D2 + pm), 4u); __builtin_amdgcn_fence(__ATOMIC_ACQUIRE, "agent"); asm volatile("s_waitcnt vmcnt(0)" ::: "memory"); }
        __syncthreads();
        g3_unit(F, A, idx);
        __syncthreads();
        LAS float* scr = (LAS float*)(F.lds + F.wave * 8704);
        constexpr int I_DN = (DFF / 64) * 32, I_UP = 16 * (NUP / 32);
        for (int it = (v - 64) * NWAVES + F.wave; it < I_DN + I_UP; it += (F.G - 64) * NWAVES) {
            if (it < I_DN) transpose_item(A.w_down, 1024, (bf16_t*)(ws + WS_WD), DFF, 0, 64 * (it / 32), 32 * (it % 32), ColId(), scr, F.lane);
            else { const int r = it - I_DN; transpose_item(A.w_up, NUP, (bf16_t*)(ws + WS_WA), 1024, 0, 64 * (r / (NUP / 32)), 32 * (r % (NUP / 32)), ColUp(), scr, F.lane); } }
    }
#if defined(PROBE_K0) && PROBE_K0 == 300
    if (v == PROBE_BID && F.tid == 0) *(float*)(ws + 32768) = (float)(__builtin_amdgcn_s_memrealtime() - t0_);
#endif
#if defined(PROBE_K0) && PROBE_K0 == 302
    if (v == PROBE_BID && F.tid == 0) *(float*)(ws + 32768) = (float)(__builtin_amdgcn_s_memrealtime() - tmix0_);
#endif
}
__device__ __forceinline__ void phase_stream(const Frame& F, CArgs& A) {
    unsigned char* ws = A.ws; unsigned* cnt = (unsigned*)(ws + WS_CNT);
    LAS float* spare = (LAS float*)(F.lds + SPARE_OFF);
    const int NOJ = 1 << 30;
    const int v = (F.bid & 7) * (F.G >> 3) + (F.bid >> 3);
#if defined(PROBE_K0) && PROBE_K0 >= 100 && PROBE_K0 < 200
    unsigned long long tacc_ = 0, tl_ = __builtin_amdgcn_s_memrealtime();
#define SPROBE(cat) do { const unsigned long long tn_ = __builtin_amdgcn_s_memrealtime(); if ((cat) == PROBE_K0 - 100 || PROBE_K0 - 100 == 3) tacc_ += tn_ - tl_; tl_ = tn_; } while (0)
#else
#define SPROBE(cat) do { } while (0)
#endif
    const int nG4 = v < 64 ? 8 : v < 192 ? 7 : v < 224 ? 6 : 5, nG5 = v >= 192 ? 2 : 1;
    if (v >= 64 && v < 192) g3_unit(F, A, 192 + (v - 64));
    SPROBE(0);
    {   struct G4Run { int v, n; unsigned* d3; unsigned* g3all; volatile LAS unsigned* alld; unsigned* d4; mutable int p0, p1;
            __device__ __forceinline__ void publish(int pm) const {
                if (pm >= 0) { asm volatile("s_waitcnt vmcnt(0)" ::: "memory"); if (lane_id_() == 0) __hip_atomic_fetch_add(d4 + 64 * pm, 1u, RLX_AGENT); } }
            __device__ __forceinline__ bool next(int r, pg8::Unit& u) const { if (r >= n) return false;
                const int l = r < 5 ? 256 * r + v : r == 5 ? 1280 + v : r == 6 ? 1504 + v : 1696 + v;
                const int sr = l / 176, rem = l % 176, blk = rem < 160 ? rem >> 5 : 5, w = rem < 160 ? rem & 31 : rem - 160;
                u.pm = 8 * sr + (w & 7); u.pn = 4 * blk + (w >> 3); return true; }
            __device__ __forceinline__ void a_ready(const pg8::Unit& u, int wid) const {
                publish(p0); p0 = p1; p1 = u.pm;
                if (wid == 0 && *alld == 0u) {
                    const bool all = (unsigned)__builtin_amdgcn_readfirstlane(__hip_atomic_load(g3all, RLX_AGENT)) >= 320u;
                    spin_ge(d3 + 64 * u.pm, 4u);
                    if (u.pm >= 63) spin_ge(g3all, 320u);
                    __builtin_amdgcn_fence(__ATOMIC_ACQUIRE, "agent"); asm volatile("s_waitcnt vmcnt(0)" ::: "memory");
                    if (all) *alld = 1u; }
                asm volatile("" ::: "memory"); __builtin_amdgcn_s_barrier(); asm volatile("" ::: "memory"); } };
        volatile LAS unsigned* alld = (volatile LAS unsigned*)(F.lds + MISC_OFF) + 16;
        if (F.tid == 0) *alld = 0u;
        __syncthreads();
        G4Run S{v, nG4, cnt + 64 * CNT_D3, cnt + 64 * CNT_G3ALL, alld, cnt + 64 * CNT_D4, -1, -1};
        pg8::Gemm g{(const bf16_t*)(ws + WS_H), (const bf16_t*)(ws + WS_WA), MT, NUP, DM, DM, DM, NOJ, 0};
        EpiConv E{(const float*)(ws + WS_SSQ1), (const float*)(ws + WS_BUPF), A.conv_w, A.conv_b, (bf16_t*)(ws + WS_ACT), (float*)(ws + WS_EDGE_U), (float*)(ws + WS_EDGE_UC), spare, cnt + 64 * CNT_D4};
        pg8::gemm_phase(F.lds, g, S, E, F.wave);
        S.publish(S.p0); S.publish(S.p1);
    }
    SPROBE(1);
    for (int j = 0; j < nG5; ++j) { const int l = j == 0 ? ((v + 64) & 255) : 256 + (v - 192), pm = l >> 2, pn = l & 3;
        if (F.wave == 0) { spin_ge(cnt + 64 * (CNT_D4 + pm), 176u);
            if (pm >= 16) { const int jt = (pm - 16) & 15; if (jt > 0) spin_ge(cnt + 64 * (CNT_D4 + pm - 1), 176u); if (jt < 15) spin_ge(cnt + 64 * (CNT_D4 + pm + 1), 176u); }
            __builtin_amdgcn_fence(__ATOMIC_ACQUIRE, "agent"); asm volatile("s_waitcnt vmcnt(0)" ::: "memory"); }
        __syncthreads();
        if (pm >= 16) { fix_panel(F, A, pm); asm volatile("s_waitcnt vmcnt(0)" ::: "memory"); __syncthreads(); }
        SPROBE(0);
        OneUnit S{pm, pn};
        pg8::Gemm g{(const bf16_t*)(ws + WS_ACT), (const bf16_t*)(ws + WS_WD), MT, DM, DFF, DFF, DFF, NOJ, 0};
        EpiRes2 E{(const float*)(ws + WS_MODF), A.final_g, (const bf16_t*)(ws + WS_X1B), A.out, (float*)(ws + WS_XS), cnt + 64 * CNT_X5, spare};
        pg8::gemm_phase(F.lds, g, S, E, F.wave);
        SPROBE(2);
    }
#if defined(PROBE_K0) && PROBE_K0 >= 100 && PROBE_K0 < 200
    if (v == PROBE_BID && F.tid == 0) *(float*)(ws + 32768) = (float)tacc_;
#endif
}

constexpr int N_PHASES = 8;
__global__ void __launch_bounds__(NTHR, 2) fwd_kernel(Args A_) {
    CArgs& A = *(CArgs*)__builtin_amdgcn_kernarg_segment_ptr();
    extern __shared__ __attribute__((aligned(16))) unsigned char lds_raw[];
    Frame F; F.lds = (LAS unsigned char*)lds_raw; F.wave = __builtin_amdgcn_readfirstlane(threadIdx.x >> 6); F.lane = lane_id_(); F.tid = F.wave * 64 + F.lane; F.G = gridDim.x; F.bid = blockIdx.x;
    volatile LAS unsigned* MISC = (volatile LAS unsigned*)(F.lds + MISC_OFF);
    if (F.tid < 64) MISC[F.tid] = 0u;
    __syncthreads();
    unsigned char* ws = A.ws;
    XcdBarrier bar = xcd_barrier_post((unsigned*)(ws + WS_CTL), MISC + 8, F.wave);
    const int lo = A.ph_lo, hi = A.ph_hi;
#ifdef ONLY_PHASE
#define IN(k) ((k) == ONLY_PHASE)
#else
#define IN(k) (lo <= (k) && (k) < hi)
#endif
#ifdef PROBE_K0
    unsigned long long tA_ = __builtin_amdgcn_s_memrealtime();
#define PROBE_AT(k) do { if ((k) == PROBE_K0 - 1) tA_ = __builtin_amdgcn_s_memrealtime(); \
    if ((k) == PROBE_K1 && F.bid == 0 && F.tid == 0) { const unsigned long long tB_ = __builtin_amdgcn_s_memrealtime(); *(float*)(ws + 32768) = (float)(tB_ - tA_) - 100.0f * PROBE_OFS; } } while (0)
#else
#define PROBE_AT(k) do { } while (0)
#endif
#define SEAM(k) do { if (IN(k) && IN((k) + 1)) xcd_barrier(bar); F.lane = lane_id_(); F.tid = F.wave * 64 + F.lane; PROBE_AT(k); } while (0)
    LAS float* spare = (LAS float*)(F.lds + SPARE_OFF);
    const int NOJ = 1 << 30;
    if (IN(0)) { phase0(F, A); } SEAM(0);
    if (IN(1)) { phase1(F, A); } SEAM(1);
    if (IN(2)) {
        pg8::Gemm g{(const bf16_t*)(ws + WS_H), (const bf16_t*)(ws + WS_WA), MT, DIN, DM, DM, DM, NOJ, 0};
        pg8::StaticOrder S; S.init(MT, DIN, F.G, F.bid, true);
        EpiIn E{(bf16_t*)(ws + WS_Q), (bf16_t*)(ws + WS_KALL), (bf16_t*)(ws + WS_VALL), (bf16_t*)(ws + WS_KP), (bf16_t*)(ws + WS_VP), (bf16_t*)(ws + WS_RQ), (bf16_t*)(ws + WS_RK),
                (bf16_t*)(ws + WS_RV), (bf16_t*)(ws + WS_SRG), (bf16_t*)A.out, (bf16_t*)A.out + (size_t)MT * DM, A.out + OUT_CK, A.out + OUT_CV, A.q_g, A.k_g, spare, (unsigned*)(ws + WS_CNT1)};
        pg8::gemm_phase(F.lds, g, S, E, F.wave);
        phase_r1(F, A);
    } SEAM(2);
    if (IN(4)) { phase_scan(F, A); } SEAM(4);
    if (IN(5)) { phase_attn(F, A); } SEAM(5);
    if (IN(6)) { phase_mix(F, A); } SEAM(6);
    if (IN(7)) { phase_stream(F, A); }
#ifdef PROBE_K0
    {
        PROBE_AT(7);
        xcd_barrier(bar);
        const float sc_ = 1.0f + sqrtf(*(const float*)(ws + 32768) * 1e-7f);
        for (int i = F.bid * NTHR + F.tid; i < NB * NKV * SEQ * HD; i += F.G * NTHR) A.out[OUT_CV + i] *= sc_;
    }
#endif
#undef IN
#undef SEAM
}

#ifndef MK_SPLIT
#define MK_SPLIT 0
#endif
extern "C" void kernel_launch(void* const* d_in, const int* in_sizes, int n_in, void* d_out, int out_size, void* d_ws, size_t ws_size, hipStream_t stream) {
    static int grid = 0;
    if (grid == 0) {
        if (n_in != 25 || ws_size < WS_END) { fprintf(stderr, "kernel_launch: unexpected n_in %d / ws %zu\n", n_in, ws_size); grid = -1; return; }
        int dev = 0, cus = 0, per_cu = 0;
        hipGetDevice(&dev); hipDeviceGetAttribute(&cus, hipDeviceAttributeMultiprocessorCount, dev);
        if (hipFuncSetAttribute((const void*)fwd_kernel, hipFuncAttributeMaxDynamicSharedMemorySize, LDS_BYTES) != hipSuccess) { fprintf(stderr, "kernel_launch: hipFuncSetAttribute failed\n"); grid = -1; return; }
        hipOccupancyMaxActiveBlocksPerMultiprocessor(&per_cu, (const void*)fwd_kernel, NTHR, LDS_BYTES);
        (void)hipGetLastError();
        if (per_cu < 1) fprintf(stderr, "kernel_launch: occupancy query says %d blocks/CU\n", per_cu);
        grid = cus;
        if (grid != 256) fprintf(stderr, "kernel_launch: %d CUs (built for 256)\n", grid);
    }
    if (grid < 0) return;
    hipMemsetAsync((char*)d_ws + WS_CTL, 0, CTL_ZERO_BYTES, stream);
    Args a{};
    const float** pa = (const float**)&a;
    for (int i = 0; i < 25; ++i) pa[i] = (const float*)d_in[i];
    a.out = (float*)d_out; a.ws = (unsigned char*)d_ws;
#if MK_SPLIT
    for (int p = 0; p < N_PHASES; ++p) { a.ph_lo = p; a.ph_hi = p + 1; hipLaunchKernelGGL(fwd_kernel, dim3(grid), dim3(NTHR), LDS_BYTES, stream, a); }
#else
    a.ph_lo = 0; a.ph_hi = N_PHASES; hipLaunchKernelGGL(fwd_kernel, dim3(grid), dim3(NTHR), LDS_BYTES, stream, a);
#endif
    const hipError_t le = hipPeekAtLastError();
    if (le != hipSuccess) fprintf(stderr, "kernel_launch: launch failed: %s\n", hipGetErrorName(le));
}
```

```cpp
#include <hip/hip_runtime.h>
#include <hip/hip_bf16.h>
#include <cstdio>
#include <cstdint>

#ifndef PROBE_BID
#define PROBE_BID 100
#endif
#ifndef PROBE_OFS
#define PROBE_OFS 0
#endif
constexpr int DM = 1024, NB = 16, SEQ = 256, DB = 4, DSEQ = 4096, PAST = 512, GRIDW = 64;
constexpr int NH = 8, NKV = 2, HD = 128, RH = 8, RDK = 64, RDV = 128, DFF = 2816, CHUNK = 128;
constexpr int MP = NB * SEQ, ML = DB * DSEQ, MT = MP + ML;
constexpr int DIN = 6656, SKV = DSEQ + PAST;
constexpr int NUP = 2 * DFF;
constexpr float EPS = 1e-6f;
constexpr int NCHUNK = MT / CHUNK;
constexpr int NITEM = NCHUNK * RH;

#define GAS __attribute__((address_space(1)))
#define LAS __attribute__((address_space(3)))
typedef unsigned short bf16_t;
typedef short bf16x8 __attribute__((ext_vector_type(8)));
typedef short s16x4 __attribute__((ext_vector_type(4)));
typedef float f32x4 __attribute__((ext_vector_type(4)));
typedef float f32x2 __attribute__((ext_vector_type(2)));
typedef float f32x16 __attribute__((ext_vector_type(16)));
typedef unsigned u32x4 __attribute__((ext_vector_type(4)));
typedef unsigned u32x2 __attribute__((ext_vector_type(2)));
typedef GAS unsigned gu32;

constexpr size_t MiB = 1u << 20;
constexpr size_t WS_CTL = 0, CTL_ZERO_BYTES = 16 * 1024;
constexpr size_t WS_MOD = 256 * 1024;
constexpr size_t MODQ = 5 * 6144;
constexpr size_t WS_MODF = 1 * MiB + 832 * 1024;
constexpr size_t WS_BUP = 768 * 1024;
constexpr size_t BUPQ = 5 * 5632;
constexpr size_t WS_BUPF = 1 * MiB + 384 * 1024;
constexpr size_t WS_SSQ1 = 1 * MiB + 256 * 1024;
constexpr size_t WS_XS = 1 * MiB + 512 * 1024;
constexpr size_t WS_CNT = 64 * 1024;
constexpr size_t WS_CNT1 = 152 * 1024;
constexpr int CNT_D2 = 0, CNT_D3 = 80, CNT_D4 = 160, CNT_X5 = 240, CNT_G3ALL = 320, CNT_R3Q = 321;
constexpr size_t WS_WA = 2 * MiB;
constexpr size_t WS_WB = 16 * MiB;
constexpr size_t WS_WC = 20 * MiB;
constexpr size_t WS_WD = 22 * MiB;
constexpr size_t WS_H = 28 * MiB;
constexpr size_t WS_Q = 68 * MiB;
constexpr size_t WS_KALL = 108 * MiB, WS_VALL = 117 * MiB, WS_KP = 126 * MiB, WS_VP = 128 * MiB;
constexpr size_t WS_RQ = 132 * MiB, WS_RK = 152 * MiB, WS_RV = 172 * MiB, WS_SRG = 212 * MiB, WS_END = 252 * MiB;
constexpr size_t WS_Y = WS_RQ;
constexpr size_t WS_X1B = WS_SRG;
constexpr size_t WS_ACT = WS_Q;
constexpr size_t WS_EDGE_U = 178 * MiB, WS_EDGE_UC = 182 * MiB;
static_assert((size_t)DIN * DM * 2 <= 14 * MiB && (size_t)MT * DM * 2 == 40 * MiB && (size_t)NITEM * 2 * RDK * RDV * 2 == 40 * MiB, "ws map");
static_assert((size_t)DB * NKV * SKV * HD * 2 <= 9 * MiB && (size_t)NB * NKV * SEQ * HD * 2 <= 2 * MiB, "ws map kv");
static_assert(WS_ACT + (size_t)MT * DFF * 2 <= WS_EDGE_U && (size_t)80 * 2 * NUP * 4 <= 4 * MiB && WS_EDGE_UC + 4 * MiB <= WS_X1B, "ws map act");
static_assert(WS_CNT + 322 * 256 <= WS_CNT1 && WS_CNT1 + (481 + 82) * 64 <= WS_MOD && WS_MOD + 4 * MODQ * 4 <= WS_BUP && WS_BUP + 4 * BUPQ * 4 <= WS_SSQ1 && WS_SSQ1 + (size_t)MT * 4 <= WS_BUPF
              && WS_BUPF + BUPQ * 4 <= WS_XS && WS_XS + (size_t)80 * 4 * 256 * 4 <= WS_MODF && WS_MODF + MODQ * 4 <= WS_WA, "ws map: small buffers");
constexpr size_t OUT_Y = 0, OUT_CK = (size_t)MT * DM, OUT_CV = OUT_CK + (size_t)NB * NKV * SEQ * HD, OUT_SF = OUT_CV + (size_t)NB * NKV * SEQ * HD, OUT_SB = OUT_SF + (size_t)NB * RH * RDK * RDV;

#define LDS_WAIT() asm volatile("s_waitcnt lgkmcnt(0)" ::: "memory")
#define VM_WAIT() asm volatile("s_waitcnt vmcnt(0)" ::: "memory")
#define RLX_AGENT __ATOMIC_RELAXED, __HIP_MEMORY_SCOPE_AGENT
typedef __bf16 bf16x2_t __attribute__((ext_vector_type(2)));
__device__ __forceinline__ unsigned pk2(float lo, float hi) { const f32x2 v = {lo, hi}; return __builtin_bit_cast(unsigned, __builtin_convertvector(v, bf16x2_t)); }
__device__ __forceinline__ unsigned f2bf(float f) { return pk2(f, 0.f) & 0xffffu; }
__device__ __forceinline__ float bflo(unsigned w) { return __builtin_bit_cast(float, w << 16); }
__device__ __forceinline__ float bfhi(unsigned w) { return __builtin_bit_cast(float, w & 0xffff0000u); }
__device__ __forceinline__ float bf2f(bf16_t h) { return __builtin_bit_cast(float, (unsigned)h << 16); }
__device__ __forceinline__ int swap25(int p) { return (p & ~0x24) | ((p & 4) << 3) | ((p & 32) >> 3); }
__device__ __forceinline__ float sigmoidf_(float x) { return __builtin_amdgcn_rcpf(1.0f + __builtin_amdgcn_exp2f(-1.4426950408889634f * x)); }
__device__ __forceinline__ float siluf_(float x) { return x * __builtin_amdgcn_rcpf(1.0f + __builtin_amdgcn_exp2f(-1.4426950408889634f * x)); }
__device__ __forceinline__ int lane_id_() { int l; asm volatile("v_mbcnt_lo_u32_b32 %0, -1, 0\n\tv_mbcnt_hi_u32_b32 %0, -1, %0" : "=v"(l)); return l; }
__device__ __forceinline__ f32x4 sum4q(const float* p, size_t q) { return (*(const f32x4*)p + *(const f32x4*)(p + q)) + (*(const f32x4*)(p + 2 * q) + *(const f32x4*)(p + 3 * q)); }
__device__ __forceinline__ float wave_sum(float v) {
#pragma unroll
    for (int o = 1; o < 64; o <<= 1) v += __shfl_xor(v, o);
    return v;
}
__device__ __forceinline__ void sincos_rev(float ang, float& c, float& s) {
    double rev = (double)ang * 0.15915494309189533577; rev -= __builtin_rint(rev);
    const float fr = (float)rev; s = __builtin_amdgcn_sinf(fr); c = __builtin_amdgcn_cosf(fr);
}
__device__ __forceinline__ float rope_inv(int i) { return exp2f(-(float)i * (13.287712379549449f / 32.0f)); }

#define XB_TMO      128
#define XB_XCNT(j)  (256  + 64 * (j))
#define XB_XSUB(j)  (1280 + 64 * (j))
#define XB_XGEN(j)  (2304 + 64 * (j))
#define XB_TOP      3328
#define XB_TOPGEN   3392
#define XCD_BAR_WORDS 3456
#define XB_SPIN_CAP (1u << 20)
__device__ __forceinline__ unsigned xb_ld(unsigned* p)              { return __hip_atomic_load(p, __ATOMIC_RELAXED, __HIP_MEMORY_SCOPE_AGENT); }
__device__ __forceinline__ unsigned xb_add(unsigned* p, unsigned v) { return __hip_atomic_fetch_add(p, v, __ATOMIC_RELAXED, __HIP_MEMORY_SCOPE_AGENT); }
__device__ __forceinline__ unsigned xb_xcc_id() { return (unsigned)__builtin_amdgcn_s_getreg((3 << 11) | 20) & 0xFu; }
#define XB_SPIN(cond, bar) do { unsigned _sp = 0; while (cond) { __builtin_amdgcn_s_sleep(1); \
    if ((++_sp & 255u) == 0u) { if (xb_ld(&(bar)[XB_TMO])) break; if (_sp > XB_SPIN_CAP) { atomicAdd(&(bar)[XB_TMO], 1u); break; } } } } while (0)
struct XcdBarrier { unsigned* bar; unsigned x; volatile LAS unsigned* st; int wave; };
__device__ __forceinline__ XcdBarrier xcd_barrier_post(unsigned* bar, volatile LAS unsigned* st, int wave) {
    XcdBarrier b; b.bar = bar; b.x = xb_xcc_id(); b.st = st; b.wave = wave;
    if (wave == 0 && lane_id_() == 0) (void)xb_add(&bar[XB_XCNT(b.x)], 1u);
    return b;
}
__device__ __forceinline__ void xcd_barrier_complete(unsigned* bar, unsigned x, unsigned& nloc, unsigned& nx) {
    const unsigned G = gridDim.x * gridDim.y * gridDim.z;
    unsigned sum, cnt, mine, sp = 0u;
    for (;;) {
        sum = 0u; cnt = 0u; mine = 0u;
#pragma unroll
        for (unsigned j = 0; j < 16; ++j) { const unsigned c = xb_ld(&bar[XB_XCNT(j)]); sum += c; cnt += (c > 0u) ? 1u : 0u; mine = (j == x) ? c : mine; }
        if (sum == G) break;
        __builtin_amdgcn_s_sleep(1);
        if ((++sp & 255u) == 0u) { if (xb_ld(&bar[XB_TMO])) break; if (sp > XB_SPIN_CAP) { atomicAdd(&bar[XB_TMO], 1u); break; } }
    }
    nloc = mine > 0u ? mine : 1u; nx = cnt > 0u ? cnt : 1u;
}
__device__ __forceinline__ void xcd_barrier(const XcdBarrier& b) {
    asm volatile("s_waitcnt vmcnt(0)" ::: "memory");
    __syncthreads();
    if (b.wave == 0 && lane_id_() == 0) {
        unsigned* bar = b.bar;
        __builtin_amdgcn_s_waitcnt(0);
        unsigned nloc = b.st[0], nx = b.st[1];
        if (nloc == 0u) { xcd_barrier_complete(bar, b.x, nloc, nx); b.st[0] = nloc; b.st[1] = nx; }
        const unsigned old = xb_add(&bar[XB_XSUB(b.x)], 1u);
        const unsigned gen = old / nloc;
        if (old + 1u == (gen + 1u) * nloc) {
            __builtin_amdgcn_fence(__ATOMIC_RELEASE, "agent");
            asm volatile("s_waitcnt vmcnt(0)" ::: "memory");
            const unsigned og = xb_add(&bar[XB_TOP], 1u);
            const unsigned tg = og / nx;
            if (og + 1u == (tg + 1u) * nx) xb_add(&bar[XB_TOPGEN], 1u);
            else XB_SPIN(xb_ld(&bar[XB_TOPGEN]) == tg, bar);
            __builtin_amdgcn_fence(__ATOMIC_ACQUIRE, "agent");
            xb_add(&bar[XB_XGEN(b.x)], 1u);
            asm volatile("s_waitcnt vmcnt(0)" ::: "memory");
        } else {
            XB_SPIN(xb_ld(&bar[XB_XGEN(b.x)]) == gen, bar);
            __builtin_amdgcn_fence(__ATOMIC_ACQUIRE, "agent");
            asm volatile("s_waitcnt vmcnt(0)" ::: "memory");
        }
    }
    __syncthreads();
}

namespace pg8 {
constexpr int BM = 256, BK = 64, HALF = 128, HTB = HALF * BK * 2, STAGE_BYTES = 8 * HTB, NXCD = 8, WGM = 8;
__host__ __device__ __forceinline__ int lds_byte(int r, int c) { const int st = (r >> 4) * 2 + (c >> 5), rr = r & 15, cc = c & 31, ob = rr * 64 + cc * 2; return st * 1024 + (ob ^ (((ob >> 9) & 1) << 5)); }
__host__ __device__ __forceinline__ void stage_rc(int b, int& R, int& C) { const int st = b / 1024, sb = b % 1024, swz = sb ^ (((sb >> 9) & 1) << 5); R = (st >> 1) * 16 + swz / 64; C = (st & 1) * 32 + (swz % 64) / 2; }
__host__ __device__ __forceinline__ int perm32(int rho) { const int n = rho >> 4, i = rho & 15; return 8 * (i >> 2) + 4 * n + (i & 3); }
struct Unit { int pm, pn; };
struct Gemm { const bf16_t* A; const bf16_t* Bt; int M, N, K, lda, ldb, jt; long jumpA; };
struct StaticOrder {
    int nM, nN, nwg, G, c; bool in_order;
    __host__ __device__ void init(int M, int N, int G_, int c_, bool io = false) { nM = M / BM; nN = N / BM; nwg = nM * nN; G = G_; c = c_; in_order = io; }
    __host__ __device__ bool next(int i, Unit& u) const {
        const long L = (long)i * G + c; if (L >= nwg) return false;
        int wgid = (int)L; { const int q = nwg / NXCD, r = nwg % NXCD, xcd = wgid % NXCD, off = wgid / NXCD; wgid = (xcd < r ? xcd * (q + 1) : r * (q + 1) + (xcd - r) * q) + off; }
        const int nig = WGM * nN, gid = wgid / nig, fm = gid * WGM, gsz = (nM - fm) < WGM ? (nM - fm) : WGM;
        u.pm = fm + ((wgid % nig) % gsz); u.pn = (wgid % nig) / gsz;
        if (in_order) u.pn = u.pn < 6 ? 8 + u.pn : u.pn < 14 ? u.pn - 6 : u.pn;
        return true;
    }
    __device__ __forceinline__ void a_ready(const Unit&, int) const {}
};
template <class Epi, class Sched>
__device__ __forceinline__ void gemm_phase(LAS unsigned char* lds, const Gemm g, const Sched& S, const Epi& E, const int wid) {
    const int lane = lane_id_(), tid = wid * 64 + lane, wr = wid >> 2, wc = wid & 3, fr = lane & 15, fq = lane >> 4;
    const int nt = g.K / BK;
    unsigned voffA[2], voffB[2];
#pragma unroll
    for (int i = 0; i < 2; ++i) { int R, C; stage_rc(tid * 16 + i * 8192, R, C); const int Rb = (R & ~31) + perm32(R & 31);
        voffA[i] = (unsigned)(R * g.lda + C) * 2u; voffB[i] = (unsigned)(Rb * g.ldb + C) * 2u; }
    const size_t kstep = (size_t)(BK * 2);
    const size_t hstepA = (size_t)HALF * g.lda * 2, hstepB = (size_t)HALF * g.ldb * 2;
    const size_t tstepA = 2 * hstepA, tstepB = 2 * hstepB;
    const unsigned ldsw = (unsigned)wid * 1024u;
    const int aoff = lds_byte(wr * 64 + fr, fq * 8), boff = lds_byte(wc * 32 + fr, fq * 8);
#define PG8_SA(b, h) (((b) * 2 + (h)) * HTB)
#define PG8_SB(b, h) ((4 + (b) * 2 + (h)) * HTB)
#define PG8_STAGE(bufoff, gbase, voff) do { _Pragma("unroll") for (int _i = 0; _i < 2; ++_i) \
        __builtin_amdgcn_global_load_lds((const unsigned*)((const char*)(gbase) + (voff)[_i]), (LAS unsigned*)(lds + (bufoff) + ldsw + _i * 8192), 16, 0, 0); } while (0)
#define PG8_LDA(dst, b, h) do { _Pragma("unroll") for (int m = 0; m < 4; ++m) _Pragma("unroll") for (int k = 0; k < 2; ++k) dst[m][k] = *(const LAS bf16x8*)(lds + PG8_SA(b, h) + aoff + m * 2048 + k * 1024); } while (0)
#define PG8_LDB(dst, b, h) do { _Pragma("unroll") for (int n = 0; n < 2; ++n) _Pragma("unroll") for (int k = 0; k < 2; ++k) dst[n][k] = *(const LAS bf16x8*)(lds + PG8_SB(b, h) + boff + n * 2048 + k * 1024); } while (0)
#define PG8_MMA(ai, bj, At, Bt) do { __builtin_amdgcn_s_setprio(1); _Pragma("unroll") for (int m = 0; m < 4; ++m) _Pragma("unroll") for (int n = 0; n < 2; ++n) _Pragma("unroll") for (int k = 0; k < 2; ++k) \
        acc[ai][bj][m][n] = __builtin_amdgcn_mfma_f32_16x16x32_bf16(Bt[n][k], At[m][k], acc[ai][bj][m][n], 0, 0, 0); __builtin_amdgcn_s_setprio(0); } while (0)
#define PG8_WAIT_V(n) asm volatile("s_waitcnt vmcnt(" #n ")" ::: "memory")
#define PG8_WAIT_L(n) asm volatile("s_waitcnt lgkmcnt(" #n ")" ::: "memory")
#define PG8_BAR __builtin_amdgcn_s_barrier()
#define PG8_SCHED __builtin_amdgcn_sched_barrier(0)
    Unit cur, nxt; int ui = 0;
    if (!S.next(0, cur)) return;
    f32x4 acc[2][2][4][2];
#pragma unroll
    for (int a = 0; a < 2; ++a)
#pragma unroll
        for (int b = 0; b < 2; ++b)
#pragma unroll
            for (int m = 0; m < 4; ++m)
#pragma unroll
                for (int n = 0; n < 2; ++n) acc[a][b][m][n] = (f32x4){0.f, 0.f, 0.f, 0.f};
    bf16x8 At[4][2], B0[2][2], B1[2][2];
    const char* cA = (const char*)g.A + (size_t)cur.pm * tstepA; const char* cB = (const char*)g.Bt + (size_t)cur.pn * tstepB;
    const int jt = g.jt; const long jumpA = g.jumpA;
    S.a_ready(cur, wid);
#define PG8_KA(base, t) ((base) + (size_t)(t) * kstep + ((t) >= jt ? jumpA : 0L))
    PG8_STAGE(PG8_SB(0, 0), cB, voffB); PG8_STAGE(PG8_SB(0, 1), cB + hstepB, voffB); PG8_STAGE(PG8_SA(0, 0), cA, voffA); PG8_STAGE(PG8_SA(0, 1), cA + hstepA, voffA);
    if (wr == 1) PG8_BAR;
    PG8_WAIT_V(2); PG8_BAR;
    PG8_STAGE(PG8_SB(1, 0), cB + kstep, voffB); PG8_STAGE(PG8_SA(1, 0), PG8_KA(cA, 1), voffA); PG8_STAGE(PG8_SB(1, 1), cB + hstepB + kstep, voffB);
    PG8_WAIT_V(6); PG8_BAR;
    for (;;) {
        const bool has_next = S.next(ui + 1, nxt);
        const char* nA = has_next ? (const char*)g.A + (size_t)nxt.pm * tstepA : cA; const char* nB = has_next ? (const char*)g.Bt + (size_t)nxt.pn * tstepB : cB;
        for (int seg = 0; seg < (Epi::MID_T >= 0 ? 2 : 1); ++seg) {
        const int tb = (Epi::MID_T >= 0 && seg == 1) ? Epi::MID_T : 0, te = (Epi::MID_T >= 0 && seg == 0) ? Epi::MID_T : nt;
        if constexpr (Epi::MID_T >= 0) { if (seg == 1) E.mid(acc, cur, wr, wc, fr, fq); }
        for (int t = tb; t < te; t += 2) {
            const bool last = (t == nt - 2);
            if (last && has_next) S.a_ready(nxt, wid);
            const char* a1 = PG8_KA(cA, t + 1);
            const char* a2 = last ? nA : PG8_KA(cA, t + 2); const char* b2 = last ? nB : cB + (size_t)(t + 2) * kstep;
            const char* a3 = last ? PG8_KA(nA, 1) : PG8_KA(cA, t + 3); const char* b3 = b2 + kstep;
            PG8_LDB(B0, 0, 0); PG8_LDB(B1, 0, 1); PG8_SCHED; PG8_LDA(At, 0, 0); PG8_STAGE(PG8_SA(1, 1), a1 + hstepA, voffA);
            PG8_WAIT_V(8); PG8_WAIT_L(0); PG8_BAR; PG8_MMA(0, 0, At, B0); PG8_MMA(0, 1, At, B1); PG8_BAR; PG8_SCHED;
            PG8_LDA(At, 0, 1); PG8_STAGE(PG8_SB(0, 0), b2, voffB); PG8_STAGE(PG8_SB(0, 1), b2 + hstepB, voffB); PG8_STAGE(PG8_SA(0, 0), a2, voffA);
            PG8_WAIT_V(8); PG8_WAIT_L(0); PG8_BAR; PG8_MMA(1, 0, At, B0); PG8_MMA(1, 1, At, B1); PG8_BAR; PG8_SCHED;
            PG8_LDB(B0, 1, 0); PG8_LDB(B1, 1, 1); PG8_SCHED; PG8_LDA(At, 1, 0); PG8_STAGE(PG8_SA(0, 1), a2 + hstepA, voffA);
            PG8_WAIT_V(8); PG8_WAIT_L(0); PG8_BAR; PG8_MMA(0, 0, At, B0); PG8_MMA(0, 1, At, B1); PG8_BAR; PG8_SCHED;
            PG8_LDA(At, 1, 1); PG8_STAGE(PG8_SB(1, 0), b3, voffB); PG8_STAGE(PG8_SB(1, 1), b3 + hstepB, voffB); PG8_STAGE(PG8_SA(1, 0), a3, voffA);
            PG8_WAIT_V(8); PG8_WAIT_L(0); PG8_BAR; PG8_MMA(1, 0, At, B0); PG8_MMA(1, 1, At, B1); PG8_BAR; PG8_SCHED;
        }
        }
        const typename Epi::Pre pf = E.pre(cur, wr, wc, fr, fq, wid, lane);
        if (wr == 0) PG8_BAR;
        E.epi(acc, cur, wr, wc, fr, fq, wid, lane, pf);
        if (!has_next) break;
#pragma unroll
        for (int a = 0; a < 2; ++a)
#pragma unroll
            for (int b = 0; b < 2; ++b)
#pragma unroll
                for (int m = 0; m < 4; ++m)
#pragma unroll
                    for (int n = 0; n < 2; ++n) acc[a][b][m][n] = (f32x4){0.f, 0.f, 0.f, 0.f};
        cur = nxt; cA = nA; cB = nB; ++ui;
        if (wr == 1) PG8_BAR;
    }
    PG8_WAIT_V(0);
    PG8_BAR;
#undef PG8_KA
#undef PG8_SA
#undef PG8_SB
#undef PG8_STAGE
#undef PG8_LDA
#undef PG8_LDB
#undef PG8_MMA
#undef PG8_WAIT_V
#undef PG8_WAIT_L
#undef PG8_BAR
#undef PG8_SCHED
}
}

typedef f32x4 AccT[2][2][4][2];
struct NoPre {};
#define PIN8(a, i, j) asm volatile("" : "+v"(a[i][j][0][0]), "+v"(a[i][j][0][1]), "+v"(a[i][j][1][0]), "+v"(a[i][j][1][1]), "+v"(a[i][j][2][0]), "+v"(a[i][j][2][1]), "+v"(a[i][j][3][0]), "+v"(a[i][j][3][1]))
#define PINACC(a) do { PIN8(a, 0, 0); PIN8(a, 0, 1); PIN8(a, 1, 0); PIN8(a, 1, 1); } while (0)
#define RAW_BAR() do { asm volatile("s_waitcnt lgkmcnt(0)" ::: "memory"); __builtin_amdgcn_s_barrier(); asm volatile("" ::: "memory"); } while (0)
__device__ __forceinline__ u32x4 pack8(const f32x4 a, const f32x4 b) { u32x4 w; w.x = pk2(a[0], a[1]); w.y = pk2(a[2], a[3]); w.z = pk2(b[0], b[1]); w.w = pk2(b[2], b[3]); return w; }
__device__ __forceinline__ void unpack8(const u32x4 w, f32x4& a, f32x4& b) { a = (f32x4){bflo(w.x), bfhi(w.x), bflo(w.y), bfhi(w.y)}; b = (f32x4){bflo(w.z), bfhi(w.z), bflo(w.w), bfhi(w.w)}; }

typedef __amdgpu_buffer_rsrc_t rsrc_t;
__device__ __forceinline__ rsrc_t mk_rsrc(const void* p, unsigned bytes) { return __builtin_amdgcn_make_buffer_rsrc((void*)p, (short)0, (int)bytes, 0x00020000); }
__device__ __forceinline__ void st16_wt(rsrc_t r, unsigned off, u32x4 v) { __builtin_amdgcn_raw_buffer_store_b128(v, r, off, 0, 16); }
__device__ __forceinline__ void st16_wt(rsrc_t r, unsigned off, f32x4 v) { __builtin_amdgcn_raw_buffer_store_b128(__builtin_bit_cast(u32x4, v), r, off, 0, 16); }

struct EpiIn {
    static constexpr int MID_T = -1;
    typedef NoPre Pre;
    __device__ __forceinline__ Pre pre(const pg8::Unit&, int, int, int, int, int, int) const { return Pre(); }
    bf16_t *Q, *KALL, *VALL, *KP, *VP, *RQ, *RK, *RV, *SRG, *GA, *GR; float *ock, *ocv; const float *qg, *kg; LAS float* P; unsigned* c1;
    __device__ __forceinline__ void mid(AccT&, const pg8::Unit&, int, int, int, int) const {}
    __device__ __forceinline__ void epi(AccT& acc, const pg8::Unit& u, int wr, int wc, int fr, int fq, int wid, int lane, const Pre&) const {
        asm volatile("" : "+v"(fr), "+v"(fq));
        const int pn = u.pn, pm = u.pm; const bool latent = pm >= 16;
        if (wid == 0 && lane == 0) { __hip_atomic_fetch_add(c1 + 16 * (481 + pm), 1u, RLX_AGENT); __hip_atomic_fetch_add(c1 + 16 * (481 + 80), 1u, RLX_AGENT); }
        const int lb = (pm - 16) >> 4, t0 = latent ? ((pm - 16) & 15) * 256 : 0;
        const int rl0 = 64 * wr + fr, cw8 = 32 * wc + 8 * fq;
        const size_t grow0 = (size_t)pm * 256;
        if (pn <= 4) {
#pragma unroll
            for (int ai = 0; ai < 2; ++ai)
#pragma unroll
                for (int m = 0; m < 4; ++m)
#pragma unroll
                    for (int bj = 0; bj < 2; ++bj) { const f32x4 a = acc[ai][bj][m][0], b = acc[ai][bj][m][1];
                        float s = (a[0] * a[0] + a[1] * a[1]) + (a[2] * a[2] + a[3] * a[3]) + (b[0] * b[0] + b[1] * b[1]) + (b[2] * b[2] + b[3] * b[3]);
                        s += __shfl_xor(s, 16); s += __shfl_xor(s, 32);
                        if (fq == 0) P[((128 * ai + rl0 + 16 * m) * 2 + bj) * 4 + wc] = s; }
            RAW_BAR();
            const float* gain = pn < 4 ? qg : kg;
            const int d0 = 64 * (wc >> 1) + 8 * fq + 4 * (wc & 1);
            const f32x4 g0 = *(const f32x4*)(gain + d0), g1 = *(const f32x4*)(gain + d0 + 32);
            float inv[4];
#pragma unroll
            for (int e = 0; e < 4; ++e) inv[e] = rope_inv(8 * fq + 4 * (wc & 1) + e);
#pragma unroll
            for (int ai = 0; ai < 2; ++ai)
#pragma unroll
                for (int m = 0; m < 4; ++m) { const int r = 128 * ai + rl0 + 16 * m, t = t0 + r;
                    f32x4 cs = {1.f, 1.f, 1.f, 1.f}, sn = {0.f, 0.f, 0.f, 0.f};
                    if (latent) { const float pos = (float)((wc >> 1) == 0 ? (t >> 6) : (t & 63));
#pragma unroll
                        for (int e = 0; e < 4; ++e) { float c_, s_; sincos_rev(pos * inv[e], c_, s_); cs[e] = c_; sn[e] = s_; } }
#pragma unroll
                    for (int bj = 0; bj < 2; ++bj) { const f32x4 pp = *(const LAS f32x4*)&P[(r * 2 + bj) * 4];
                        const float rstd = __builtin_amdgcn_rsqf(((pp[0] + pp[1]) + (pp[2] + pp[3])) * (1.0f / 128.0f) + EPS);
                        const f32x4 x1 = acc[ai][bj][m][0] * rstd * g0, x2 = acc[ai][bj][m][1] * rstd * g1;
                        const f32x4 o1 = x1 * cs - x2 * sn, o2 = x2 * cs + x1 * sn;
                        const u32x4 w = pack8(o1, o2);
                        if (pn < 4) { *(u32x4*)(Q + (grow0 + r) * 1024 + 128 * (2 * pn + bj) + cw8) = w; }
                        else if (latent) { *(u32x4*)(KALL + ((size_t)(lb * 2 + bj) * SKV + t) * 128 + cw8) = w; }
                        else { const size_t o = ((size_t)(pm * 2 + bj) * 256 + t) * 128;
                            *(u32x4*)(KP + o + cw8) = w; *(f32x4*)(ock + o + d0) = o1; *(f32x4*)(ock + o + d0 + 32) = o2; } } }
        } else if (pn == 5) {
#pragma unroll
            for (int ai = 0; ai < 2; ++ai)
#pragma unroll
                for (int m = 0; m < 4; ++m) { const int r = 128 * ai + rl0 + 16 * m, t = t0 + r;
#pragma unroll
                    for (int bj = 0; bj < 2; ++bj) { const f32x4 a = acc[ai][bj][m][0], b = acc[ai][bj][m][1]; const u32x4 w = pack8(a, b);
                        if (latent) { *(u32x4*)(VALL + ((size_t)(lb * 2 + bj) * SKV + t) * 128 + cw8) = w; }
                        else { const size_t o = ((size_t)(pm * 2 + bj) * 256 + t) * 128 + cw8;
                            *(u32x4*)(VP + o) = w; *(f32x4*)(ocv + o) = a; *(f32x4*)(ocv + o + 4) = b; } } }
        } else if (pn <= 9) {
            const float sc = pn >= 8 ? 0.125f : 1.0f; bf16_t* dst = RQ + (pn >= 8 ? (WS_RK - WS_RQ) / 2 : 0); const int cb = 256 * ((pn - 6) & 1);
            const rsrc_t rd = mk_rsrc(dst + grow0 * 512, 256 * 512 * 2);
            float inv[4];
#pragma unroll
            for (int e = 0; e < 4; ++e) inv[e] = rope_inv(8 * fq + 4 * (wc & 1) + e);
#pragma unroll
            for (int ai = 0; ai < 2; ++ai)
#pragma unroll
                for (int m = 0; m < 4; ++m) { const int r = 128 * ai + rl0 + 16 * m, t = t0 + r; const float pos = (float)(latent ? PAST + t : t);
                    f32x4 cs, sn;
#pragma unroll
                    for (int e = 0; e < 4; ++e) { float c_, s_; sincos_rev(pos * inv[e], c_, s_); cs[e] = c_ * sc; sn[e] = s_ * sc; }
#pragma unroll
                    for (int bj = 0; bj < 2; ++bj) { const f32x4 x1 = acc[ai][bj][m][0], x2 = acc[ai][bj][m][1];
                        st16_wt(rd, (unsigned)(((r * 512) + cb + 128 * bj + cw8) * 2), pack8(x1 * cs - x2 * sn, x2 * cs + x1 * sn)); } }
        } else if (pn < 18) {
            const int kind = (pn - 10) >> 2; bf16_t* dst = RV + (size_t)kind * ((WS_SRG - WS_RV) / 2); const int cb = 256 * ((pn - 10) & 3);
            const rsrc_t rd = mk_rsrc(dst + grow0 * 1024, 256 * 1024 * 2);
#pragma unroll
            for (int ai = 0; ai < 2; ++ai)
#pragma unroll
                for (int m = 0; m < 4; ++m) { const int r = 128 * ai + rl0 + 16 * m;
#pragma unroll
                    for (int bj = 0; bj < 2; ++bj) { f32x4 a = acc[ai][bj][m][0], b = acc[ai][bj][m][1];
                        if (kind == 1) { _Pragma("unroll") for (int e = 0; e < 4; ++e) { a[e] = siluf_(a[e]); b[e] = siluf_(b[e]); } }
                        st16_wt(rd, (unsigned)(((r * 1024) + cb + 128 * bj + cw8) * 2), pack8(a, b)); } }
        } else {
            const int cb = 128 * (pn - 18);
            const rsrc_t rra = mk_rsrc(GA + grow0 * 1024, 256 * 1024 * 2), rrg = mk_rsrc(GR + grow0 * 1024, 256 * 1024 * 2);
#pragma unroll
            for (int ai = 0; ai < 2; ++ai)
#pragma unroll
                for (int m = 0; m < 4; ++m) { const int r = 128 * ai + rl0 + 16 * m; f32x4 q0, q1, g0, g1;
#pragma unroll
                    for (int e = 0; e < 4; ++e) { g0[e] = sigmoidf_(acc[ai][1][m][0][e]); g1[e] = sigmoidf_(acc[ai][1][m][1][e]);
                        q0[e] = sigmoidf_(acc[ai][0][m][0][e]) * __builtin_amdgcn_rcpf(fmaxf(g0[e], 1e-30f)); q1[e] = sigmoidf_(acc[ai][0][m][1][e]) * __builtin_amdgcn_rcpf(fmaxf(g1[e], 1e-30f)); }
                    const unsigned o = (unsigned)(((r * 1024) + cb + cw8) * 2);
                    st16_wt(rra, o, pack8(q0, q1)); st16_wt(rrg, o, pack8(g0, g1)); }
        }
        if (pn >= 8 && pn <= 13) {
            asm volatile("s_waitcnt vmcnt(0)" ::: "memory");
            RAW_BAR();
            if (wid == 0 && lane == 0) { __hip_atomic_fetch_add(c1 + 16 * (pm * 6 + pn - 8), 1u, RLX_AGENT); __hip_atomic_fetch_add(c1 + 16 * 480, 1u, RLX_AGENT); } }
    }
};

struct EpiMix {
    static constexpr int MID_T = 16;
    typedef NoPre Pre;
    __device__ __forceinline__ Pre pre(const pg8::Unit&, int, int, int, int, int, int) const { return Pre(); }
    const bf16_t *GA, *GR; bf16_t* Y; unsigned* done;
    __device__ __forceinline__ void mid(AccT& acc, const pg8::Unit& u, int wr, int wc, int fr, int fq) const {
        unsigned lo = (unsigned)(((64 * wr + fr) * 1024 + 32 * wc + 8 * fq) * 2); asm volatile("" : "+v"(lo));
        const char* ga = (const char*)GA + ((size_t)u.pm * 256 * 1024 + 256 * u.pn) * 2;
        u32x4 q[8][2];
#pragma unroll
        for (int k = 0; k < 8; ++k)
#pragma unroll
            for (int bj = 0; bj < 2; ++bj) q[k][bj] = *(const u32x4*)(ga + lo + (unsigned)((((128 * (k >> 2) + 16 * (k & 3)) * 1024) + 128 * bj) * 2));
#pragma unroll
        for (int k = 0; k < 8; ++k)
#pragma unroll
            for (int bj = 0; bj < 2; ++bj) { f32x4 a0, a1; unpack8(q[k][bj], a0, a1); acc[k >> 2][bj][k & 3][0] *= a0; acc[k >> 2][bj][k & 3][1] *= a1; }
    }
    __device__ __forceinline__ void epi(AccT& acc, const pg8::Unit& u, int wr, int wc, int fr, int fq, int wid, int lane, const Pre&) const {
        unsigned lo = (unsigned)(((64 * wr + fr) * 1024 + 32 * wc + 8 * fq) * 2); asm volatile("" : "+v"(lo));
        const size_t ub = ((size_t)u.pm * 256 * 1024 + 256 * u.pn) * 2; const char* gr = (const char*)GR + ub; const rsrc_t ry = mk_rsrc((char*)Y + ub, 256 * 1024 * 2);
        u32x4 q[8][2];
#pragma unroll
        for (int k = 0; k < 8; ++k)
#pragma unroll
            for (int bj = 0; bj < 2; ++bj) q[k][bj] = *(const u32x4*)(gr + lo + (unsigned)((((128 * (k >> 2) + 16 * (k & 3)) * 1024) + 128 * bj) * 2));
#pragma unroll
        for (int k = 0; k < 8; ++k)
#pragma unroll
            for (int bj = 0; bj < 2; ++bj) { f32x4 r0, r1; unpack8(q[k][bj], r0, r1);
                st16_wt(ry, lo + (unsigned)((((128 * (k >> 2) + 16 * (k & 3)) * 1024) + 128 * bj) * 2), pack8(acc[k >> 2][bj][k & 3][0] * r0, acc[k >> 2][bj][k & 3][1] * r1)); }
        asm volatile("s_waitcnt vmcnt(0)" ::: "memory");
        RAW_BAR();
        if (wid == 0 && lane == 0) __hip_atomic_fetch_add(done + 64 * u.pm, 1u, RLX_AGENT);
    }
};

struct EpiRes1 {
    static constexpr int MID_T = -1;
    typedef NoPre Pre;
    __device__ __forceinline__ Pre pre(const pg8::Unit&, int, int, int, int, int, int) const { return Pre(); }
    const float *xp, *xs, *modf, *g2n; bf16_t* X1B; float* ssq; bf16_t* A2;
    __device__ __forceinline__ void mid(AccT&, const pg8::Unit&, int, int, int, int) const {}
    __device__ __forceinline__ void epi(AccT& acc, const pg8::Unit& u, int wr, int wc, int fr, int fq, int wid, int lane, const Pre&) const {
        asm volatile("" : "+v"(fr), "+v"(fq));
        const int pm = u.pm, v = pm < 16 ? 0 : 1 + ((pm - 16) >> 4);
        const float* mv = modf + (size_t)v * 6144; const float* xsrc = pm < 16 ? xp + (size_t)pm * 256 * 1024 : xs + (size_t)(pm - 16) * 256 * 1024;
        const unsigned cb = (unsigned)(256 * u.pn + 32 * wc + 8 * fq), rb = (unsigned)(64 * wr + fr);
        {   f32x4 g1[2][2];
#pragma unroll
            for (int bj = 0; bj < 2; ++bj)
#pragma unroll
                for (int n = 0; n < 2; ++n) g1[bj][n] = *(const f32x4*)(mv + 2048 + cb + 128 * bj + 4 * n);
#pragma unroll
            for (int h = 0; h < 4; ++h) { f32x4 xv[2][2][2];
#pragma unroll
                for (int mm = 0; mm < 2; ++mm)
#pragma unroll
                    for (int bj = 0; bj < 2; ++bj) { const float* p = xsrc + (size_t)(128 * (h >> 1) + 16 * (2 * (h & 1) + mm) + rb) * 1024 + cb + 128 * bj; xv[mm][bj][0] = *(const f32x4*)p; xv[mm][bj][1] = *(const f32x4*)(p + 4); }
#pragma unroll
                for (int mm = 0; mm < 2; ++mm)
#pragma unroll
                    for (int bj = 0; bj < 2; ++bj) { const int ai = h >> 1, m = 2 * (h & 1) + mm;
                        acc[ai][bj][m][0] = xv[mm][bj][0] + g1[bj][0] * acc[ai][bj][m][0]; acc[ai][bj][m][1] = xv[mm][bj][1] + g1[bj][1] * acc[ai][bj][m][1]; }
                {   const int ai = h >> 1, m0 = 2 * (h & 1);
                    asm volatile("" : "+v"(acc[ai][0][m0][0]), "+v"(acc[ai][0][m0][1]), "+v"(acc[ai][1][m0][0]), "+v"(acc[ai][1][m0][1]),
                                      "+v"(acc[ai][0][m0 + 1][0]), "+v"(acc[ai][0][m0 + 1][1]), "+v"(acc[ai][1][m0 + 1][0]), "+v"(acc[ai][1][m0 + 1][1]) :: "memory"); } } }
        f32x4 w2[2][2];
#pragma unroll
        for (int bj = 0; bj < 2; ++bj)
#pragma unroll
            for (int n = 0; n < 2; ++n) { const unsigned c = cb + 128 * bj + 4 * n; w2[bj][n] = *(const f32x4*)(g2n + c) * (*(const f32x4*)(mv + 4096 + c) + 1.0f); }
        const rsrc_t rx = mk_rsrc(X1B + (size_t)pm * 256 * 1024, 256 * 1024 * 2), ra = mk_rsrc(A2 + (size_t)pm * 256 * 1024, 256 * 1024 * 2);
#pragma unroll
        for (int ai = 0; ai < 2; ++ai)
#pragma unroll
            for (int m = 0; m < 4; ++m) { const unsigned r = 128 * ai + 16 * m + rb; float s = 0.f;
#pragma unroll
                for (int bj = 0; bj < 2; ++bj) { const unsigned o = r * 1024 + cb + 128 * bj; const f32x4 x0 = acc[ai][bj][m][0], x1 = acc[ai][bj][m][1];
                    st16_wt(rx, o * 2u, pack8(x0, x1));
                    st16_wt(ra, o * 2u, pack8(x0 * w2[bj][0], x1 * w2[bj][1]));
                    s += (x0[0] * x0[0] + x0[1] * x0[1]) + (x0[2] * x0[2] + x0[3] * x0[3]) + (x1[0] * x1[0] + x1[1] * x1[1]) + (x1[2] * x1[2] + x1[3] * x1[3]); }
                s += __shfl_xor(s, 16); s += __shfl_xor(s, 32);
                if (fq == 0) atomicAdd(ssq + (size_t)pm * 256 + r, s); }
    }
};

struct EpiRes2 {
    static constexpr int MID_T = -1;
    typedef NoPre Pre;
    __device__ __forceinline__ Pre pre(const pg8::Unit&, int, int, int, int, int, int) const { return Pre(); }
    const float *mod, *fg; const bf16_t* X1B; float* X; float* XS; unsigned* xcnt; LAS float* P;
    __device__ __forceinline__ void mid(AccT&, const pg8::Unit&, int, int, int, int) const {}
    __device__ __forceinline__ void epi(AccT& acc, const pg8::Unit& u, int wr, int wc, int fr, int fq, int wid, int lane, const Pre&) const {
        asm volatile("" : "+v"(fr), "+v"(fq));
        const int pm = u.pm, v = pm < 16 ? 0 : 1 + ((pm - 16) >> 4); const float* mv = mod + (size_t)v * 6144;
        const int cb = 256 * u.pn + 32 * wc + 8 * fq;
        {   f32x4 g2[2][2]; u32x4 xq[8][2];
#pragma unroll
            for (int bj = 0; bj < 2; ++bj)
#pragma unroll
                for (int n = 0; n < 2; ++n) g2[bj][n] = *(const f32x4*)(mv + 5120 + cb + 128 * bj + 4 * n);
#pragma unroll
            for (int k = 0; k < 8; ++k)
#pragma unroll
                for (int bj = 0; bj < 2; ++bj) xq[k][bj] = *(const u32x4*)(X1B + ((size_t)pm * 256 + 128 * (k >> 2) + 64 * wr + 16 * (k & 3) + fr) * 1024 + cb + 128 * bj);
#pragma unroll
            for (int k = 0; k < 8; ++k) { const int ai = k >> 2, m = k & 3, r = 128 * ai + 64 * wr + 16 * m + fr; float s = 0.f;
#pragma unroll
                for (int bj = 0; bj < 2; ++bj) { f32x4 xa, xb; unpack8(xq[k][bj], xa, xb);
                    const f32x4 x0 = xa + g2[bj][0] * acc[ai][bj][m][0], x1 = xb + g2[bj][1] * acc[ai][bj][m][1];
                    acc[ai][bj][m][0] = x0; acc[ai][bj][m][1] = x1;
                    s += (x0[0] * x0[0] + x0[1] * x0[1]) + (x0[2] * x0[2] + x0[3] * x0[3]) + (x1[0] * x1[0] + x1[1] * x1[1]) + (x1[2] * x1[2] + x1[3] * x1[3]); }
                s += __shfl_xor(s, 16); s += __shfl_xor(s, 32);
                if (fq == 0) P[r * 4 + wc] = s; } }
        RAW_BAR();
        const int tid = wid * 64 + lane;
        if (wid < 4) { const f32x4 pp = *(const LAS f32x4*)&P[tid * 4];
            __hip_atomic_store(XS + ((size_t)pm * 4 + u.pn) * 256 + tid, (pp[0] + pp[1]) + (pp[2] + pp[3]), RLX_AGENT);
            asm volatile("s_waitcnt vmcnt(0)" ::: "memory");
            if (lane == 0) __hip_atomic_fetch_add(xcnt + 64 * pm, 1u, RLX_AGENT); }
        if (wid == 0) { unsigned sp = 0;
            while ((unsigned)__builtin_amdgcn_readfirstlane(__hip_atomic_load(xcnt + 64 * pm, RLX_AGENT)) < 16u) { __builtin_amdgcn_s_sleep(2); if (++sp > (1u << 22)) break; } }
        RAW_BAR();
        if (wid < 4) { float t = 0.f;
#pragma unroll
            for (int k = 0; k < 4; ++k) t += __hip_atomic_load(XS + ((size_t)pm * 4 + k) * 256 + tid, RLX_AGENT);
            P[1024 + tid] = 1.0f / sqrtf(t * (1.0f / 1024.0f) + EPS); }
        RAW_BAR();
        {   f32x4 fgv[2][2];
#pragma unroll
            for (int bj = 0; bj < 2; ++bj)
#pragma unroll
                for (int n = 0; n < 2; ++n) fgv[bj][n] = *(const f32x4*)(fg + cb + 128 * bj + 4 * n);
#pragma unroll
            for (int ai = 0; ai < 2; ++ai)
#pragma unroll
                for (int m = 0; m < 4; ++m) { const int r = 128 * ai + 64 * wr + 16 * m + fr;
                    const float rs = P[1024 + r];
#pragma unroll
                    for (int bj = 0; bj < 2; ++bj) { float* p = X + ((size_t)pm * 256 + r) * 1024 + cb + 128 * bj;
                        *(f32x4*)p = acc[ai][bj][m][0] * rs * fgv[bj][0]; *(f32x4*)(p + 4) = acc[ai][bj][m][1] * rs * fgv[bj][1]; } } }
    }
};

__device__ __forceinline__ float dpp_up(float cur, float old) {
    return __builtin_bit_cast(float, __builtin_amdgcn_update_dpp(__builtin_bit_cast(int, old), __builtin_bit_cast(int, cur), 0x111, 0xF, 0xF, false)); }
__device__ __forceinline__ float dpp_dn(float cur, float old) {
    return __builtin_bit_cast(float, __builtin_amdgcn_update_dpp(__builtin_bit_cast(int, old), __builtin_bit_cast(int, cur), 0x101, 0xF, 0xF, false)); }
__device__ __forceinline__ float dpp_ror1(float x) {
    return __builtin_bit_cast(float, __builtin_amdgcn_update_dpp(0, __builtin_bit_cast(int, x), 0x121, 0xF, 0xF, false)); }
__device__ __forceinline__ float dpp_rol1(float x) {
    return __builtin_bit_cast(float, __builtin_amdgcn_update_dpp(0, __builtin_bit_cast(int, x), 0x12F, 0xF, 0xF, false)); }
struct EpiConv {
    static constexpr int MID_T = -1;
    const float *ssq, *bup, *cw, *cbias; bf16_t* ACT; float *EU, *EUC; LAS float* E; unsigned* done;
    struct Pre { float ss[8]; f32x4 bb[2][2]; float cwv[4]; };
    __device__ __forceinline__ void mid(AccT&, const pg8::Unit&, int, int, int, int) const {}
    __device__ __forceinline__ Pre pre(const pg8::Unit& u, int wr, int wc, int fr, int fq, int wid, int lane) const {
        Pre p; const int pm = u.pm, pn = u.pn, v = pm < 16 ? 0 : 1 + ((pm - 16) >> 4);
        const float* sp = ssq + (size_t)pm * 256 + 64 * wr + fr; const float* bp = bup + (size_t)v * NUP + 256 * pn + 32 * wc + 8 * fq;
#pragma unroll
        for (int k = 0; k < 8; ++k) p.ss[k] = sp[128 * (k >> 2) + 16 * (k & 3)];
#pragma unroll
        for (int bj = 0; bj < 2; ++bj)
#pragma unroll
            for (int n = 0; n < 2; ++n) p.bb[bj][n] = *(const f32x4*)(bp + 128 * bj + 4 * n);
        const int t = wid * 64 + lane, tc = t & 255, ch = (tc < 128 ? 0 : DFF - 128) + 128 * pn + tc;
        p.cwv[0] = cw[ch]; p.cwv[1] = cw[NUP + ch]; p.cwv[2] = cw[2 * NUP + ch]; p.cwv[3] = cbias[ch];
        return p;
    }
    __device__ __forceinline__ void epi(AccT& acc, const pg8::Unit& u, int wr, int wc, int fr, int fq, int wid, int lane, const Pre& pf) const {
        const int pm = u.pm, pn = u.pn; const bool latent = pm >= 16;
#if defined(PROBE_K0) && PROBE_K0 == 400
        const unsigned long long te0_ = __builtin_amdgcn_s_memrealtime();
#endif
        unsigned cw8 = (unsigned)(32 * wc + 8 * fq), rl = (unsigned)(64 * wr + fr); asm volatile("" : "+v"(cw8), "+v"(rl));
        LAS float* CW = E + 2048;
        {   const int t = wid * 64 + lane;
            if (t < 256) { CW[t] = pf.cwv[0]; CW[256 + t] = pf.cwv[1]; CW[512 + t] = pf.cwv[2]; CW[768 + t] = pf.cwv[3]; } }
#pragma unroll
        for (int ai = 0; ai < 2; ++ai)
#pragma unroll
            for (int m = 0; m < 4; ++m) { const float rs = __builtin_amdgcn_rsqf(pf.ss[4 * ai + m] * (1.0f / 1024.0f) + EPS);
#pragma unroll
                for (int bj = 0; bj < 2; ++bj)
#pragma unroll
                    for (int n = 0; n < 2; ++n) acc[ai][bj][m][n] = acc[ai][bj][m][n] * rs + pf.bb[bj][n]; }
        PINACC(acc);
        const rsrc_t reu = mk_rsrc(EU + (size_t)pm * 2 * NUP + 256 * pn, (NUP + 256) * 4), reuc = mk_rsrc(EUC + (size_t)pm * 2 * NUP + 256 * pn, (NUP + 256) * 4);
#pragma unroll
        for (int ai = 0; ai < 2; ++ai)
#pragma unroll
            for (int bj = 0; bj < 2; ++bj)
#pragma unroll
                for (int n = 0; n < 2; ++n) { const unsigned ci = 128 * bj + cw8 + 4 * n; const int grp = 2 * ai + wr;
                    if (fr == 0) { *(LAS f32x4*)&E[(grp * 2 + 0) * 256 + ci] = acc[ai][bj][0][n]; if (latent && grp == 0) st16_wt(reu, ci * 4u, acc[ai][bj][0][n]); }
                    if (fr == 15) { *(LAS f32x4*)&E[(grp * 2 + 1) * 256 + ci] = acc[ai][bj][3][n]; if (latent && grp == 3) st16_wt(reu, (NUP + ci) * 4u, acc[ai][bj][3][n]); } }
        RAW_BAR();
#if defined(PROBE_K0) && PROBE_K0 == 400 && defined(PROBE_SUB) && PROBE_SUB == 1
        if (wid == 0 && lane == 0 && (int)__builtin_amdgcn_workgroup_id_x() == PROBE_BID) atomicAdd((float*)((char*)EU - WS_EDGE_U + 32768), (float)(__builtin_amdgcn_s_memrealtime() - te0_));
#endif
        const rsrc_t ract = mk_rsrc((char*)ACT + ((size_t)pm * 256 * DFF + 128 * pn) * 2, 256 * DFF * 2);
#pragma unroll
        for (int ai = 0; ai < 2; ++ai) { const int grp = 2 * ai + wr;
#pragma unroll
            for (int n = 0; n < 2; ++n)
#pragma unroll
                for (int bj = 0; bj < 2; ++bj) { const unsigned ci = 128 * bj + cw8 + 4 * n;
                    const f32x4 w0 = *(const LAS f32x4*)&CW[ci], w1 = *(const LAS f32x4*)&CW[256 + ci], w2 = *(const LAS f32x4*)&CW[512 + ci], cb = *(const LAS f32x4*)&CW[768 + ci];
                    f32x4 pe = {0.f, 0.f, 0.f, 0.f}, ne = {0.f, 0.f, 0.f, 0.f};
                    if (grp > 0) pe = *(const LAS f32x4*)&E[((grp - 1) * 2 + 1) * 256 + ci];
                    if (grp < 3) ne = *(const LAS f32x4*)&E[((grp + 1) * 2 + 0) * 256 + ci];
#pragma unroll
                    for (int e = 0; e < 4; ++e) { const float u0 = acc[ai][bj][0][n][e], u1 = acc[ai][bj][1][n][e], u2 = acc[ai][bj][2][n][e], u3 = acc[ai][bj][3][n][e];
                        const float p0 = dpp_up(u0, pe[e]), p1 = dpp_up(u1, dpp_ror1(u0)), p2 = dpp_up(u2, dpp_ror1(u1)), p3 = dpp_up(u3, dpp_ror1(u2));
                        const float n0 = dpp_dn(u0, dpp_rol1(u1)), n1 = dpp_dn(u1, dpp_rol1(u2)), n2 = dpp_dn(u2, dpp_rol1(u3)), n3 = dpp_dn(u3, ne[e]);
                        acc[ai][bj][0][n][e] = w0[e] * p0 + w1[e] * u0 + w2[e] * n0 + cb[e]; acc[ai][bj][1][n][e] = w0[e] * p1 + w1[e] * u1 + w2[e] * n1 + cb[e];
                        acc[ai][bj][2][n][e] = w0[e] * p2 + w1[e] * u2 + w2[e] * n2 + cb[e]; acc[ai][bj][3][n][e] = w0[e] * p3 + w1[e] * u3 + w2[e] * n3 + cb[e]; }
                    if (latent) { if (fr == 0 && grp == 0) st16_wt(reuc, ci * 4u, acc[ai][bj][0][n]);
                                  if (fr == 15 && grp == 3) st16_wt(reuc, (NUP + ci) * 4u, acc[ai][bj][3][n]); }
                    asm volatile("" : "+v"(acc[ai][bj][0][n]), "+v"(acc[ai][bj][1][n]), "+v"(acc[ai][bj][2][n]), "+v"(acc[ai][bj][3][n]) :: "memory"); }
#pragma unroll
            for (int m = 0; m < 4; ++m) { f32x4 o0, o1;
#pragma unroll
                for (int e = 0; e < 4; ++e) { o0[e] = siluf_(acc[ai][1][m][0][e]) * acc[ai][0][m][0][e]; o1[e] = siluf_(acc[ai][1][m][1][e]) * acc[ai][0][m][1][e]; }
                st16_wt(ract, ((rl + 128 * ai + 16 * m) * DFF + cw8) * 2u, pack8(o0, o1)); asm volatile("" ::: "memory"); } }
#if defined(PROBE_K0) && PROBE_K0 == 400 && !defined(PROBE_SUB)
        if (wid == 0 && lane == 0 && (int)__builtin_amdgcn_workgroup_id_x() == PROBE_BID) atomicAdd((float*)((char*)EU - WS_EDGE_U + 32768), (float)(__builtin_amdgcn_s_memrealtime() - te0_));
#endif
    }
};

constexpr int NWAVES = 8, NTHR = 512;
constexpr int RING_BYTES = 131072, SPARE_OFF = RING_BYTES, SPARE_BYTES = 16384, MISC_OFF = SPARE_OFF + SPARE_BYTES, LDS_BYTES = MISC_OFF + 256;
struct Args {
    const float *x_prompt, *x_sample, *c, *cache_k, *cache_v, *st_f, *st_b, *c_ctx, *norm1_g, *norm2_g, *w_mod, *b_mod, *w_in, *q_g, *k_g, *dec_f, *dec_b,
                *w_att_o, *w_ret_o, *w_out, *w_up, *conv_w, *conv_b, *w_down, *final_g;
    float* out; unsigned char* ws; int ph_lo, ph_hi;
};
struct Frame { LAS unsigned char* lds; int tid, lane, wave, G, bid; };
typedef const __attribute__((address_space(4))) Args CArgs;

template <class F> __device__ __forceinline__ void transpose_item(const float* W, int ldw, bf16_t* WT, int ldd, int kofs, int k0, int n0, F srccol, LAS float* scr, int lane) {
    const int sc = srccol(n0 + (lane & 31));
#pragma unroll 8
    for (int i = 0; i < 32; ++i) { const int kk = 2 * i + (lane >> 5); scr[kk * 33 + (lane & 31)] = __builtin_nontemporal_load(W + (size_t)(k0 + kk) * ldw + sc); }
    LDS_WAIT(); asm volatile("" ::: "memory");
    const int c = lane & 7;
#pragma unroll
    for (int j = 0; j < 4; ++j) { const int n = (lane >> 3) + 8 * j; const LAS float* s = scr + (8 * c) * 33 + n;
        u32x4 o; o.x = pk2(s[0 * 33], s[1 * 33]); o.y = pk2(s[2 * 33], s[3 * 33]); o.z = pk2(s[4 * 33], s[5 * 33]); o.w = pk2(s[6 * 33], s[7 * 33]);
        *(u32x4*)(WT + (size_t)(n0 + n) * ldd + kofs + k0 + 8 * c) = o; }
    LDS_WAIT(); asm volatile("" ::: "memory");
}
struct ColId { __device__ int operator()(int n) const { return n; } };
struct ColIn { __device__ int operator()(int n) const {
    if (n >= 4608) { const int t = (n - 4608) >> 8, j = (n - 4608) & 255; return j < 128 ? 4608 + 128 * t + j : 5632 + 128 * t + (j - 128); }
    return (n < 1280 || (n >= 1536 && n < 2560)) ? swap25(n) : n; } };
struct ColUp { __device__ int operator()(int n) const { const int t = n >> 8, j = n & 255; return j < 128 ? 128 * t + j : DFF + 128 * t + (j - 128); } };

template <class F> __device__ __forceinline__ void gemv5_item(const Frame& F_, const float* W, int ldw, int n0, int k0, F srccol, const LAS float* a, LAS float* red, const float* bias, float* out, int ldo) {
    const int col0 = srccol(n0 + F_.lane), col1 = srccol(n0 + 64 + F_.lane); float acc[5][2];
#pragma unroll
    for (int v = 0; v < 5; ++v) { acc[v][0] = 0.f; acc[v][1] = 0.f; }
    const int kb = F_.wave * 32;
    const float* wp = W + (size_t)(k0 + kb) * ldw;
    float w0[32], w1[32];
#pragma unroll
    for (int j = 0; j < 32; ++j) { w0[j] = __builtin_nontemporal_load(wp + col0); w1[j] = __builtin_nontemporal_load(wp + col1); wp += ldw; }
#pragma unroll
    for (int j = 0; j < 32; ++j)
#pragma unroll
        for (int v = 0; v < 5; ++v) { const float av = a[v * 256 + kb + j]; acc[v][0] += av * w0[j]; acc[v][1] += av * w1[j]; }
#pragma unroll
    for (int v = 0; v < 5; ++v) { red[(F_.wave * 5 + v) * 128 + F_.lane] = acc[v][0]; red[(F_.wave * 5 + v) * 128 + 64 + F_.lane] = acc[v][1]; }
    __syncthreads();
    for (int t = F_.tid; t < 640; t += NTHR) { const int v = t >> 7, l = t & 127; float sum = (bias && k0 == 0) ? bias[n0 + l] : 0.f;
#pragma unroll
        for (int w8 = 0; w8 < 8; ++w8) sum += red[(w8 * 5 + v) * 128 + l];
        out[((size_t)(k0 >> 8) * 5 + v) * ldo + n0 + l] = sum; }
    __syncthreads();
}

__device__ __forceinline__ void phase0(const Frame& F, CArgs& A) {
    unsigned char* ws = A.ws;
    for (int it = F.bid; it < 48 * 4; it += F.G) {
        const int cgp = it % 48, kq = it / 48;
        LAS float* a = (LAS float*)F.lds; LAS float* red = a + 5 * 256;
        for (int i = F.tid; i < 5 * 256; i += NTHR) { const int v = i >> 8, k = kq * 256 + (i & 255); const float cv = v == 0 ? A.c_ctx[k] : A.c[(v - 1) * 1024 + k]; a[i] = siluf_(cv); }
        __syncthreads();
        gemv5_item(F, A.w_mod, 6144, cgp * 128, kq * 256, ColId(), a, red, A.b_mod, (float*)(ws + WS_MOD), 6144);
    }
    LAS float* scr = (LAS float*)(F.lds + 32768 + F.wave * 8704);
    const int gw = ((F.bid + 128) % F.G) * NWAVES + F.wave, NGW = F.G * NWAVES;
    constexpr int I_IN = 16 * (DIN / 32);
    for (int it = gw; it < I_IN; it += NGW) transpose_item(A.w_in, DIN, (bf16_t*)(ws + WS_WA), 1024, 0, 64 * (it / (DIN / 32)), 32 * (it % (DIN / 32)), ColIn(), scr, F.lane);
    const int gt = F.bid * NTHR + F.tid, NGT = F.G * NTHR;
    for (int i = gt; i < DB * NKV * PAST * 16; i += NGT) { const int c8 = i & 15, row = i >> 4, t = row % PAST, bk = row / PAST;
        const size_t so = (size_t)row * 128, dofs = ((size_t)bk * SKV + DSEQ + t) * 128 + c8 * 8;
        f32x4 k0, k1; { const int p0 = c8 * 8, d0 = swap25(p0), d1 = swap25(p0 + 4); k0 = *(const f32x4*)(A.cache_k + so + d0); k1 = *(const f32x4*)(A.cache_k + so + d1); }
        *(u32x4*)((bf16_t*)(ws + WS_KALL) + dofs) = pack8(k0, k1);
        const f32x4 v0 = *(const f32x4*)(A.cache_v + so + c8 * 8), v1 = *(const f32x4*)(A.cache_v + so + c8 * 8 + 4);
        *(u32x4*)((bf16_t*)(ws + WS_VALL) + dofs) = pack8(v0, v1); }
    for (int i = gt; i < MT; i += NGT) ((float*)(ws + WS_SSQ1))[i] = 0.f;
    for (int i = gt; i < 322 * 64; i += NGT) ((unsigned*)(ws + WS_CNT))[i] = 0u;
    for (int i = gt; i < (481 + 81) * 16; i += NGT) ((unsigned*)(ws + WS_CNT1))[i] = 0u;
#if defined(PROBE_K0) && PROBE_K0 == 400
    if (gt == 0) *(float*)(ws + 32768) = 0.f;
#endif
}

__device__ __forceinline__ void phase1(const Frame& F, CArgs& A) {
    unsigned char* ws = A.ws; const float* mod = (const float*)(ws + WS_MOD);
    for (int it = F.bid; it < (NUP / 128) * 4; it += F.G) {
        const int cgp = it % (NUP / 128), kq = it / (NUP / 128);
        LAS float* a = (LAS float*)F.lds; LAS float* red = a + 5 * 256;
        for (int i = F.tid; i < 5 * 256; i += NTHR) { const float* p = mod + (size_t)(i >> 8) * 6144 + 3072 + kq * 256 + (i & 255); a[i] = (p[0] + p[MODQ]) + (p[2 * MODQ] + p[3 * MODQ]); }
        __syncthreads();
        gemv5_item(F, A.w_up, NUP, cgp * 128, kq * 256, ColUp(), a, red, nullptr, (float*)(ws + WS_BUP), NUP);
    }
    for (int i = F.bid * NTHR + F.tid; i < 5 * 6144; i += F.G * NTHR) ((float*)(ws + WS_MODF))[i] = (mod[i] + mod[i + MODQ]) + (mod[i + 2 * MODQ] + mod[i + 3 * MODQ]);
    bf16_t* H = (bf16_t*)(ws + WS_H);
    constexpr int RPW = MT / (256 * NWAVES);
    const int row0 = (F.bid * NWAVES + F.wave) * RPW;
    int vcur = -1; f32x4 w1[4], s1[4];
#pragma unroll 1
    for (int rb = row0; rb < row0 + RPW; rb += 5) {
        f32x4 x[5][4];
#pragma unroll
        for (int i = 0; i < 5; ++i) { const int r = rb + i; const float* xr = r < MP ? A.x_prompt + (size_t)r * 1024 : A.x_sample + (size_t)(r - MP) * 1024;
#pragma unroll
            for (int j = 0; j < 4; ++j) x[i][j] = __builtin_nontemporal_load((const f32x4*)(xr + 8 * F.lane + 4 * (j & 1) + 512 * (j >> 1))); }
#pragma unroll
        for (int i = 0; i < 5; ++i) { const int r = rb + i;
            const int v = r < MP ? 0 : 1 + (r - MP) / DSEQ;
            if (v != vcur) { vcur = v; const float* mv = mod + (size_t)v * 6144;
#pragma unroll
                for (int j = 0; j < 4; ++j) { const int k = 8 * F.lane + 4 * (j & 1) + 512 * (j >> 1); w1[j] = *(const f32x4*)(A.norm1_g + k) * (sum4q(mv + 1024 + k, MODQ) + 1.0f); s1[j] = sum4q(mv + k, MODQ); } }
            float s = 0.f;
#pragma unroll
            for (int j = 0; j < 4; ++j) s += (x[i][j][0] * x[i][j][0] + x[i][j][1] * x[i][j][1]) + (x[i][j][2] * x[i][j][2] + x[i][j][3] * x[i][j][3]);
            const float rstd = __builtin_amdgcn_rsqf(wave_sum(s) * (1.0f / 1024.0f) + EPS);
#pragma unroll
            for (int jj = 0; jj < 2; ++jj) { const f32x4 h0 = x[i][2 * jj] * rstd * w1[2 * jj] + s1[2 * jj], h1 = x[i][2 * jj + 1] * rstd * w1[2 * jj + 1] + s1[2 * jj + 1];
                *(u32x4*)(H + (size_t)r * 1024 + 8 * F.lane + 512 * jj) = pack8(h0, h1); } }
    }
}

__device__ __forceinline__ float log_sigmoid_(float x) { return -log1pf(__expf(-x)); }
__device__ __forceinline__ s16x4 tr_read16(const LAS bf16_t* p) { typedef short v4s __attribute__((ext_vector_type(4))); return __builtin_bit_cast(s16x4, __builtin_amdgcn_ds_read_tr16_b64_v4i16((LAS v4s*)p)); }
#define MK8(L, H) (bf16x8){L[0], L[1], L[2], L[3], H[0], H[1], H[2], H[3]}
constexpr int KLD = 72, VLD = 136;
__device__ __forceinline__ int vsw(int r, int c8) { return 256 * r + 16 * (c8 ^ (((r & 3) << 1) | (((r >> 3) & 1) << 3))); }
__device__ __forceinline__ int vsw_tr(int R, int col) { return vsw(R, col >> 3) + 2 * (col & 7); }

__device__ const unsigned char R1_PORD[80] = {0, 1, 2, 3, 4, 5, 6, 7, 12, 13, 14, 15, 16, 17, 18, 19, 28, 29, 30, 31, 32, 33, 34, 35, 40, 41, 42, 43, 44, 45, 46, 47, 52, 53, 54, 55, 56, 57, 58, 59, 68, 69, 70, 71, 72, 73, 74, 75,
    8, 9, 10, 11, 20, 21, 22, 23, 24, 25, 26, 27, 36, 37, 38, 39, 48, 49, 50, 51, 60, 61, 62, 63, 64, 65, 66, 67, 76, 77, 78, 79};
__device__ __forceinline__ int r1_item_of(int i) { return (int)R1_PORD[i >> 4] * 16 + (i & 15); }
__device__ __forceinline__ void spin_ge(unsigned* p, unsigned need) { unsigned sp = 0;
    while ((unsigned)__builtin_amdgcn_readfirstlane(__hip_atomic_load(p, RLX_AGENT)) < need) { __builtin_amdgcn_s_sleep(2); if (++sp > (1u << 22)) break; } }
__device__ __forceinline__ void r1_wait(const Frame& F, unsigned* c1, int item, volatile LAS unsigned* alld) {
    if (F.wave == 0 && *alld == 0u) { const int pm = item >> 4, h = item & 7;
        const bool all = (unsigned)__builtin_amdgcn_readfirstlane(__hip_atomic_load(c1 + 16 * 480, RLX_AGENT)) >= 480u
                      && (unsigned)__builtin_amdgcn_readfirstlane(__hip_atomic_load(c1 + 16 * (481 + 80), RLX_AGENT)) >= 2080u;
        spin_ge(c1 + 16 * (pm * 6 + (h >> 2)), 1u); spin_ge(c1 + 16 * (pm * 6 + 2 + (h >> 1)), 1u);
        spin_ge(c1 + 16 * (481 + pm), 26u);
        __builtin_amdgcn_fence(__ATOMIC_ACQUIRE, "agent"); asm volatile("s_waitcnt vmcnt(0)" ::: "memory");
        if (all) *alld = 1u; }
    __syncthreads();
}
__device__ __forceinline__ void phase_r1(const Frame& F, CArgs& A) {
    unsigned char* ws = A.ws; unsigned* c1 = (unsigned*)(ws + WS_CNT1);
    volatile LAS unsigned* alld = (volatile LAS unsigned*)(F.lds + MISC_OFF) + 17;
    if (F.tid == 0) *alld = 0u;
    __syncthreads();
    const bf16_t* RKb = (const bf16_t*)(ws + WS_RK); const bf16_t* RVb = (const bf16_t*)(ws + WS_RV); bf16_t* KVS = (bf16_t*)(ws + WS_H);
    LAS bf16_t* kf = (LAS bf16_t*)F.lds; LAS bf16_t* kb = kf + 128 * KLD; LAS bf16_t* vl = kb + 128 * KLD; LAS bf16_t* ol = vl + 128 * 128 + F.wave * (16 * VLD);
    u32x4 pk_[2], pv_[4];
#define R1_LOAD(it) do { const int cg_ = (it) >> 3, h_ = (it) & 7; const size_t r0_ = (size_t)cg_ * 128; \
        _Pragma("unroll") for (int i = 0; i < 2; ++i) { const int ci = F.tid + i * NTHR; pk_[i] = *(const u32x4*)(RKb + (r0_ + (ci >> 3)) * 512 + 64 * h_ + 8 * (ci & 7)); } \
        _Pragma("unroll") for (int i = 0; i < 4; ++i) { const int ci = F.tid + i * NTHR; pv_[i] = *(const u32x4*)(RVb + (r0_ + (ci >> 4)) * 1024 + 128 * h_ + 8 * (ci & 15)); } } while (0)
    const int n1 = F.bid >= 32 ? (768 - (F.bid - 32) + 223) / 224 : 0, cntp = n1 + 2;
#define R1_POS(n) ((n) < n1 ? (F.bid - 32) + 224 * (n) : 768 + F.bid + 256 * ((n) - n1))
    { r1_wait(F, c1, r1_item_of(R1_POS(0)), alld); R1_LOAD(r1_item_of(R1_POS(0))); }
    for (int n = 0; n < cntp; ++n) { const int item = r1_item_of(R1_POS(n));
        const int h = item & 7;
        const float lgf = log_sigmoid_(A.dec_f[h]) * 1.4426950408889634f, lgb = log_sigmoid_(A.dec_b[h]) * 1.4426950408889634f;
#pragma unroll
        for (int i = 0; i < 2; ++i) { const int ci = F.tid + i * NTHR, j = ci >> 3, c8 = ci & 7;
            f32x4 a, b; unpack8(pk_[i], a, b);
            const float df = __builtin_amdgcn_exp2f(lgf * (float)(127 - j)), db = __builtin_amdgcn_exp2f(lgb * (float)j);
            *(LAS u32x4*)(kf + j * KLD + 8 * c8) = pack8(a * df, b * df); *(LAS u32x4*)(kb + j * KLD + 8 * c8) = pack8(a * db, b * db); }
#pragma unroll
        for (int i = 0; i < 4; ++i) { const int ci = F.tid + i * NTHR, j = ci >> 4, c8 = ci & 15; *(LAS u32x4*)((LAS char*)vl + vsw(j, c8)) = pv_[i]; }
        __syncthreads();
        if (n + 1 < cntp) { r1_wait(F, c1, r1_item_of(R1_POS(n + 1)), alld); R1_LOAD(r1_item_of(R1_POS(n + 1))); }
        const int dir = F.wave >> 2, mt = F.wave & 3, g = F.lane >> 4, q = (F.lane & 15) >> 2, p = F.lane & 3, l15 = F.lane & 15;
        const LAS bf16_t* ks = dir ? kb : kf;
        bf16x8 af[4];
#pragma unroll
        for (int s = 0; s < 4; ++s) { const LAS bf16_t* ap = ks + (32 * s + 8 * g + q) * KLD + 16 * mt + 4 * p; const s16x4 lo = tr_read16(ap), hi = tr_read16(ap + 4 * KLD); af[s] = MK8(lo, hi); }
#pragma unroll
        for (int nt = 0; nt < 8; ++nt) { f32x4 acc = {0.f, 0.f, 0.f, 0.f};
#pragma unroll
            for (int s = 0; s < 4; ++s) { const int R0 = 32 * s + 8 * g + q, col = 16 * nt + 4 * p;
                const s16x4 lo = tr_read16((const LAS bf16_t*)((const LAS char*)vl + vsw_tr(R0, col))), hi = tr_read16((const LAS bf16_t*)((const LAS char*)vl + vsw_tr(R0 + 4, col)));
                acc = __builtin_amdgcn_mfma_f32_16x16x32_bf16(af[s], MK8(lo, hi), acc, 0, 0, 0); }
#pragma unroll
            for (int e = 0; e < 4; ++e) ol[(4 * g + e) * VLD + 16 * nt + l15] = (bf16_t)f2bf(acc[e]); }
        LDS_WAIT(); asm volatile("" ::: "memory");
        bf16_t* dst = KVS + ((size_t)item * 2 + dir) * (64 * 128) + (size_t)(16 * mt + (F.lane >> 2)) * 128 + (F.lane & 3) * 32;
#pragma unroll
        for (int c = 0; c < 4; ++c) *(u32x4*)(dst + 8 * c) = *(const LAS u32x4*)(ol + (F.lane >> 2) * VLD + (F.lane & 3) * 32 + 8 * c);
        __syncthreads();
    }
#undef R1_LOAD
#undef R1_POS
}

__device__ __forceinline__ void phase_scan(const Frame& F, CArgs& A) {
    bf16_t* KVS = (bf16_t*)(A.ws + WS_H);
    const int gt = F.bid * NTHR + F.tid, NGT = F.G * NTHR;
    for (int i = gt; i < 5 * NUP; i += NGT) { const float* p = (const float*)(A.ws + WS_BUP) + i; ((float*)(A.ws + WS_BUPF))[i] = (p[0] + p[BUPQ]) + (p[2 * BUPQ] + p[3 * BUPQ]); }
    constexpr size_t CST = (size_t)8 * 2 * 8192;
    if (NGT * 4 == 256 * 2048) {
        u32x2 kv[4][2]; bf16_t* basep[4]; float decp[4];
#pragma unroll
        for (int k = 0; k < 4; ++k) { const int w = gt + k * NGT, e4 = (w & 2047) * 4, chain = w >> 11, dir = chain & 1, h = (chain >> 1) & 7, sq = chain >> 4;
            decp[k] = __expf(log_sigmoid_((dir ? A.dec_b : A.dec_f)[h]) * 128.0f);
            basep[k] = KVS + ((size_t)(2 * sq * 8 + h) * 2 + dir) * 8192 + e4;
            kv[k][0] = *(const u32x2*)(basep[k] + (size_t)(dir ? 1 : 0) * CST); kv[k][1] = *(const u32x2*)(basep[k] + (size_t)(dir ? 0 : 1) * CST); }
#pragma unroll
        for (int k = 0; k < 4; ++k) { const int w = gt + k * NGT, e4 = (w & 2047) * 4, chain = w >> 11, dir = chain & 1, h = (chain >> 1) & 7, sq = chain >> 4;
            const int pr = e4 >> 7, dv = e4 & 127, lr = swap25(pr);
            f32x4 st = {0.f, 0.f, 0.f, 0.f};
#pragma unroll
            for (int i = 0; i < 2; ++i) { u32x2 o; o.x = pk2(st[0], st[1]); o.y = pk2(st[2], st[3]); *(u32x2*)(basep[k] + (size_t)(dir ? 1 - i : i) * CST) = o;
                st = st * decp[k] + (f32x4){bflo(kv[k][i].x), bfhi(kv[k][i].x), bflo(kv[k][i].y), bfhi(kv[k][i].y)}; }
            *(f32x4*)(A.out + (dir ? OUT_SB : OUT_SF) + (((size_t)sq * 8 + h) * 64 + lr) * 128 + dv) = st; }
    }
    for (int w = (NGT * 4 == 256 * 2048) ? gt + 4 * NGT : gt; w < 320 * 2048; w += NGT) {
        const int e4 = (w & 2047) * 4, chain = w >> 11, dir = chain & 1, h = (chain >> 1) & 7, s = chain >> 4;
        const int nch = s < 16 ? 2 : 32, c0 = s < 16 ? 2 * s : 32 + 32 * (s - 16);
        const float lg = log_sigmoid_((dir ? A.dec_b : A.dec_f)[h]), dec = __expf(lg * 128.0f);
        const int pr = e4 >> 7, dv = e4 & 127, lr = swap25(pr);
        f32x4 st = {0.f, 0.f, 0.f, 0.f};
        if (s >= 16) st = *(const f32x4*)((dir ? A.st_b : A.st_f) + (((size_t)(s - 16) * 8 + h) * 64 + lr) * 128 + dv);
        bf16_t* base = KVS + ((size_t)(c0 * 8 + h) * 2 + dir) * 8192 + e4;
        if (s < 16) {
            u32x2 kv[2];
#pragma unroll
            for (int i = 0; i < 2; ++i) kv[i] = *(const u32x2*)(base + (size_t)(dir ? 1 - i : i) * CST);
#pragma unroll
            for (int i = 0; i < 2; ++i) { u32x2 o; o.x = pk2(st[0], st[1]); o.y = pk2(st[2], st[3]); *(u32x2*)(base + (size_t)(dir ? 1 - i : i) * CST) = o;
                st = st * dec + (f32x4){bflo(kv[i].x), bfhi(kv[i].x), bflo(kv[i].y), bfhi(kv[i].y)}; }
        } else {
            u32x2 kv[32];
#pragma unroll
            for (int i = 0; i < 32; ++i) kv[i] = *(const u32x2*)(base + (size_t)(dir ? 31 - i : i) * CST);
#pragma unroll
            for (int i = 0; i < 32; ++i) { u32x2 o; o.x = pk2(st[0], st[1]); o.y = pk2(st[2], st[3]); *(u32x2*)(base + (size_t)(dir ? 31 - i : i) * CST) = o;
                st = st * dec + (f32x4){bflo(kv[i].x), bfhi(kv[i].x), bflo(kv[i].y), bfhi(kv[i].y)}; }
        }
        if (s < 16) *(f32x4*)(A.out + (dir ? OUT_SB : OUT_SF) + (((size_t)s * 8 + h) * 64 + lr) * 128 + dv) = st;
    }
}

namespace att {
constexpr int D = 128, NW = 8, QBLK = 32, KVBLK = 64;
constexpr float SCALE = 0.088388347648318440f, THR = 8.f;
constexpr size_t SHM_V = KVBLK * D * 2, SHM_K = KVBLK * D * 2, SHM_ATTN = 2 * SHM_V + 2 * SHM_K + NW * 64 * 4;
#define KSWZ(row, colB) ((row) * 256 + ((colB) ^ (((row) & 7) << 4)))
#define SBAR() __builtin_amdgcn_sched_barrier(0)
__device__ __forceinline__ int crow(int r, int hi) { return (r & 3) + 8 * (r >> 2) + 4 * hi; }
__device__ __forceinline__ unsigned cvtpk(float lo, float hi) { unsigned r; asm volatile("v_cvt_pk_bf16_f32 %0, %1, %2" : "=v"(r) : "v"(lo), "v"(hi)); return r; }
__device__ __forceinline__ void partialSM(f32x16& p0, f32x16& p1, float& m_reg, float& mn, float& alpha) {
  constexpr float C = SCALE * 1.4426950408889634f;
  float pmax = p0[0]; for (int r = 1; r < 16; ++r) pmax = fmaxf(pmax, p0[r]); for (int r = 0; r < 16; ++r) pmax = fmaxf(pmax, p1[r]);
  { auto rr = __builtin_amdgcn_permlane32_swap(__float_as_uint(pmax), __float_as_uint(pmax), false, false);
    pmax = fmaxf(__uint_as_float(rr[0]), __uint_as_float(rr[1])); }
  if (__builtin_expect(__all(pmax - m_reg <= THR / SCALE), 1)) { mn = m_reg; alpha = 1.f; }
  else { mn = fmaxf(m_reg, pmax); alpha = __builtin_amdgcn_exp2f((m_reg - mn) * C); m_reg = mn; }
  float mnC = -mn * C;
  for (int r = 0; r < 16; ++r) p0[r] = fmaf(p0[r], C, mnC); for (int r = 0; r < 16; ++r) p1[r] = fmaf(p1[r], C, mnC);
  for (int r = 0; r < 16; ++r) p0[r] = __builtin_amdgcn_exp2f(p0[r]);
}
__device__ __forceinline__ void finishSM(f32x16& p0, f32x16& p1, float alpha, float& l_reg, bf16x8& pa0, bf16x8& pa1, bf16x8& pa2, bf16x8& pa3) {
  for (int r = 0; r < 16; ++r) p1[r] = __builtin_amdgcn_exp2f(p1[r]);
  float ps = 0; for (int r = 0; r < 16; ++r) ps += p0[r]; for (int r = 0; r < 16; ++r) ps += p1[r];
  { auto rr = __builtin_amdgcn_permlane32_swap(__float_as_uint(ps), __float_as_uint(ps), false, false);
    ps = __uint_as_float(rr[0]) + __uint_as_float(rr[1]); }
  l_reg = l_reg * alpha + ps;
#define PK4(P, BASE, OUT) do { unsigned a0 = cvtpk(P[BASE + 0], P[BASE + 1]), a1 = cvtpk(P[BASE + 2], P[BASE + 3]);   \
    unsigned b0 = cvtpk(P[BASE + 4], P[BASE + 5]), b1 = cvtpk(P[BASE + 6], P[BASE + 7]);                              \
    auto r0 = __builtin_amdgcn_permlane32_swap(a0, b0, false, false); auto r1 = __builtin_amdgcn_permlane32_swap(a1, b1, false, false); \
    u32x4 w = {r0[0], r1[0], r0[1], r1[1]}; OUT = *reinterpret_cast<bf16x8*>(&w); } while (0)
  PK4(p0, 0, pa0); PK4(p0, 8, pa1); PK4(p1, 0, pa2); PK4(p1, 8, pa3);
#undef PK4
}
__device__ __forceinline__ void qkt(f32x16& p0, f32x16& p1, const bf16_t* Ks, const bf16x8* qr, int r32, int hi) {
  p0 = f32x16{}; p1 = f32x16{};
  for (int d0 = 0; d0 < 8; ++d0) { int cb = (d0 * 16 + hi * 8) * 2;
    bf16x8 b0 = *reinterpret_cast<const bf16x8*>((const char*)Ks + KSWZ(r32, cb));
    bf16x8 b1 = *reinterpret_cast<const bf16x8*>((const char*)Ks + KSWZ(32 + r32, cb));
    p0 = __builtin_amdgcn_mfma_f32_32x32x16_bf16(b0, qr[d0], p0, 0, 0, 0);
    p1 = __builtin_amdgcn_mfma_f32_32x32x16_bf16(b1, qr[d0], p1, 0, 0, 0); }
}
__device__ __forceinline__ int v_st(int k, int c) { const int kk = (k & ~0xC) | ((k & 4) << 1) | ((k & 8) >> 1); return ((kk >> 3) * 4 + (c >> 5)) * 512 + ((kk & 7) * 32 + (c & 31)) * 2; }
__device__ __forceinline__ int v_rd_base(int lane) { return ((lane & 3) << 3) | (((lane >> 2) & 3) << 6) | (((lane >> 4) & 1) << 5) | (((lane >> 5) & 1) << 8); }
constexpr int v_rd_off(int d0, int ks, int half) { return d0 * 512 + ks * 4096 + half * 2048; }
template <int OFF> __device__ __forceinline__ s16x4 tr_read(int vb) { s16x4 r; asm volatile("ds_read_b64_tr_b16 %0, %1 offset:%2" : "=&v"(r) : "v"(vb), "i"(OFF) : "memory"); return r; }
template <int D0> __device__ __forceinline__ void pv_one(f32x16& od, int vb, bf16x8 pa0, bf16x8 pa1, bf16x8 pa2, bf16x8 pa3) {
  const s16x4 l0 = tr_read<v_rd_off(D0, 0, 0)>(vb), h0 = tr_read<v_rd_off(D0, 0, 1)>(vb), l1 = tr_read<v_rd_off(D0, 1, 0)>(vb), h1 = tr_read<v_rd_off(D0, 1, 1)>(vb);
  const s16x4 l2 = tr_read<v_rd_off(D0, 2, 0)>(vb), h2 = tr_read<v_rd_off(D0, 2, 1)>(vb), l3 = tr_read<v_rd_off(D0, 3, 0)>(vb), h3 = tr_read<v_rd_off(D0, 3, 1)>(vb);
  asm volatile("s_waitcnt lgkmcnt(0)" ::: "memory"); SBAR();
  od = __builtin_amdgcn_mfma_f32_32x32x16_bf16(pa0, MK8(l0, h0), od, 0, 0, 0);
  od = __builtin_amdgcn_mfma_f32_32x32x16_bf16(pa1, MK8(l1, h1), od, 0, 0, 0);
  od = __builtin_amdgcn_mfma_f32_32x32x16_bf16(pa2, MK8(l2, h2), od, 0, 0, 0);
  od = __builtin_amdgcn_mfma_f32_32x32x16_bf16(pa3, MK8(l3, h3), od, 0, 0, 0);
}
__device__ __forceinline__ void pv_d0(f32x16* o, int vb, bf16x8 pa0, bf16x8 pa1, bf16x8 pa2, bf16x8 pa3) {
  pv_one<0>(o[0], vb, pa0, pa1, pa2, pa3); pv_one<1>(o[1], vb, pa0, pa1, pa2, pa3); pv_one<2>(o[2], vb, pa0, pa1, pa2, pa3); pv_one<3>(o[3], vb, pa0, pa1, pa2, pa3);
}
__device__ __forceinline__ void pv_partial(f32x16* o, int vb, bf16x8 pa0, bf16x8 pa1, bf16x8 pa2, bf16x8 pa3, f32x16& p0, f32x16& p1, float& m_reg, float& mn, float& alpha) {
  constexpr float C = SCALE * 1.4426950408889634f;
  pv_one<0>(o[0], vb, pa0, pa1, pa2, pa3);
  float pmax = p0[0]; for (int r = 1; r < 16; ++r) pmax = fmaxf(pmax, p0[r]); for (int r = 0; r < 16; ++r) pmax = fmaxf(pmax, p1[r]);
  { auto rr = __builtin_amdgcn_permlane32_swap(__float_as_uint(pmax), __float_as_uint(pmax), false, false);
    pmax = fmaxf(__uint_as_float(rr[0]), __uint_as_float(rr[1])); }
  asm volatile("" : "+v"(pmax));
  pv_one<1>(o[1], vb, pa0, pa1, pa2, pa3);
  { const bool keep = __all(pmax - m_reg <= THR / SCALE);
    mn = keep ? m_reg : fmaxf(m_reg, pmax); alpha = __builtin_amdgcn_exp2f((m_reg - mn) * C); m_reg = mn; }
  const float mnC = -mn * C;
  for (int r = 0; r < 16; ++r) p0[r] = fmaf(p0[r], C, mnC); for (int r = 0; r < 16; ++r) p1[r] = fmaf(p1[r], C, mnC);
  asm volatile("" : "+v"(p0), "+v"(p1), "+v"(alpha));
  pv_one<2>(o[2], vb, pa0, pa1, pa2, pa3);
  for (int r = 0; r < 8; ++r) p0[r] = __builtin_amdgcn_exp2f(p0[r]);
  asm volatile("" : "+v"(p0));
  pv_one<3>(o[3], vb, pa0, pa1, pa2, pa3);
  for (int r = 8; r < 16; ++r) p0[r] = __builtin_amdgcn_exp2f(p0[r]);
  asm volatile("" : "+v"(p0)); SBAR();
}
template <int LDQ>
__device__ __forceinline__ void attn_dense_body(const bf16_t* Qb, const bf16_t* __restrict__ Kh, const bf16_t* __restrict__ Vh, bf16_t* Ob, int seq, char* lds, const int wid) {
  constexpr int LDK = 128;
  const int lane = lane_id_(), tid = wid * 64 + lane, r32 = lane & 31, hi = lane >> 5;
  bf16_t* V_lds = (bf16_t*)lds; bf16_t* K_lds = (bf16_t*)(lds + 2 * SHM_V);
  float* ws = (float*)(lds + 2 * SHM_V + 2 * SHM_K) + wid * 64; float* li_l = ws; float* al_l = ws + 32;
  float m_reg = -1e30f, l_reg = 0; f32x16 o[4] = {}; bf16x8 qr[8];
  const bf16_t* Qw = Qb + (long)(wid * QBLK + r32) * LDQ + hi * 8;
#pragma unroll
  for (int d0 = 0; d0 < 8; ++d0) qr[d0] = *reinterpret_cast<const bf16x8*>(Qw + d0 * 16);
  const int sr = tid >> 4, sc = (tid & 15) * 8, vst0 = v_st(sr, sc), vst1 = v_st(32 + sr, sc);
  const int vb0 = (int)(uintptr_t)V_lds + v_rd_base(lane);
  struct { bf16x8 vs0, vs1, ks0, ks1; } sr_[2];
#define SLOAD(i, k0) do { sr_[i].vs0 = *(const bf16x8*)(&Vh[(long)((k0) + sr) * LDK + sc]); sr_[i].vs1 = *(const bf16x8*)(&Vh[(long)((k0) + 32 + sr) * LDK + sc]); \
    sr_[i].ks0 = *(const bf16x8*)(&Kh[(long)((k0) + sr) * LDK + sc]); sr_[i].ks1 = *(const bf16x8*)(&Kh[(long)((k0) + 32 + sr) * LDK + sc]); } while (0)
#define SWRITE(b, i) do { *(bf16x8*)((char*)V_lds + (b) * SHM_V + vst0) = sr_[i].vs0;          \
    *(bf16x8*)((char*)V_lds + (b) * SHM_V + vst1) = sr_[i].vs1; int kc = sc * 2;               \
    *(bf16x8*)((char*)K_lds + (b) * SHM_K + KSWZ(sr, kc)) = sr_[i].ks0;                       \
    *(bf16x8*)((char*)K_lds + (b) * SHM_K + KSWZ(32 + sr, kc)) = sr_[i].ks1; } while (0)
#define SWAIT() asm volatile("s_waitcnt vmcnt(4)" ::: "memory")
#define RESC(a) do { if (__any((a) < 1.f)) { if (hi == 0) al_l[r32] = (a); asm volatile("s_waitcnt lgkmcnt(0)" ::: "memory"); \
    for (int d = 0; d < 4; ++d) for (int r = 0; r < 16; ++r) o[d][r] *= al_l[crow(r, hi)]; } } while (0)
  f32x16 pA0, pA1, pB0, pB1; float mnA, mnB, alA, alB; bf16x8 pa0, pa1, pa2, pa3; const int NT = seq / KVBLK;
  constexpr int SE = 0, SO = 1;
  if (wid >= 4) __builtin_amdgcn_s_setprio(1);
  SLOAD(SE, 0); asm volatile("s_waitcnt vmcnt(0)" ::: "memory"); SWRITE(0, SE); __syncthreads();
  qkt(pA0, pA1, K_lds, qr, r32, hi); partialSM(pA0, pA1, m_reg, mnA, alA);
  SLOAD(SO, KVBLK); if (2 < NT) SLOAD(SE, 2 * KVBLK);
  SWAIT(); SWRITE(1, SO); __syncthreads();
  for (int j = 1; j + 1 < NT; j += 2) {
    SBAR(); qkt(pB0, pB1, (bf16_t*)((char*)K_lds + SHM_K), qr, r32, hi);
    finishSM(pA0, pA1, alA, l_reg, pa0, pa1, pa2, pa3); SBAR();
    SLOAD(SO, (j + 2) * KVBLK); SBAR();
    pv_partial(o, vb0, pa0, pa1, pa2, pa3, pB0, pB1, m_reg, mnB, alB);
    __syncthreads(); SWAIT(); SWRITE(0, SE);
    RESC(alB); __syncthreads();
    SBAR(); qkt(pA0, pA1, K_lds, qr, r32, hi);
    finishSM(pB0, pB1, alB, l_reg, pa0, pa1, pa2, pa3); SBAR();
    if (j + 3 < NT) SLOAD(SE, (j + 3) * KVBLK); SBAR();
    pv_partial(o, vb0 + (int)SHM_V, pa0, pa1, pa2, pa3, pA0, pA1, m_reg, mnA, alA);
    __syncthreads(); SWAIT(); SWRITE(1, SO);
    RESC(alA); __syncthreads();
  }
  SBAR(); qkt(pB0, pB1, (bf16_t*)((char*)K_lds + SHM_K), qr, r32, hi);
  finishSM(pA0, pA1, alA, l_reg, pa0, pa1, pa2, pa3); SBAR();
  pv_partial(o, vb0, pa0, pa1, pa2, pa3, pB0, pB1, m_reg, mnB, alB);
  __syncthreads(); RESC(alB);
  finishSM(pB0, pB1, alB, l_reg, pa0, pa1, pa2, pa3); SBAR();
  pv_d0(o, vb0 + (int)SHM_V, pa0, pa1, pa2, pa3);
  __builtin_amdgcn_s_setprio(0);
  if (hi == 0) li_l[r32] = l_reg; asm volatile("s_waitcnt lgkmcnt(0)" ::: "memory");
  float rli[16];
#pragma unroll
  for (int r = 0; r < 16; ++r) rli[r] = __builtin_amdgcn_rcpf(li_l[crow(r, hi)]);
  bf16_t* Ow = Ob + (long)(wid * QBLK) * LDQ;
#pragma unroll
  for (int r = 0; r < 16; ++r) { int orow = crow(r, hi);
    for (int d0 = 0; d0 < 4; ++d0) Ow[(long)orow * LDQ + d0 * 32 + r32] = (bf16_t)f2bf(o[d0][r] * rli[r]); }
  __syncthreads();
#undef SLOAD
#undef SWRITE
#undef SWAIT
#undef RESC
}
#undef KSWZ
#undef SBAR
}

struct R3Regs { u32x4 k[2], v[4], s[4], srg[4]; bf16x8 q[2]; };
__device__ __forceinline__ void r3_load(const Frame& F, CArgs& A, int item, R3Regs& R) {
    unsigned char* ws = A.ws;
    const bf16_t* RQb = (const bf16_t*)(ws + WS_RQ); const bf16_t* RKb = (const bf16_t*)(ws + WS_RK); const bf16_t* RVb = (const bf16_t*)(ws + WS_RV);
    const bf16_t* SRGb = (const bf16_t*)(ws + WS_SRG); const bf16_t* KVS = (const bf16_t*)(ws + WS_H);
    const int cg = item >> 3, h = item & 7; const size_t row0 = (size_t)cg * 128;
#pragma unroll
    for (int i = 0; i < 2; ++i) { const int ci = F.tid + i * NTHR; R.k[i] = *(const u32x4*)(RKb + (row0 + (ci >> 3)) * 512 + 64 * h + 8 * (ci & 7)); }
#pragma unroll
    for (int i = 0; i < 4; ++i) { const int ci = F.tid + i * NTHR, j = ci >> 4, c8 = ci & 15;
        R.v[i] = *(const u32x4*)(RVb + (row0 + j) * 1024 + 128 * h + 8 * c8);
        R.s[i] = *(const u32x4*)(KVS + (size_t)item * 2 * 8192 + (size_t)j * 128 + 8 * c8); }
    const size_t gofs = (row0 + 16 * F.wave + (F.lane >> 2)) * 1024 + 128 * h + (F.lane & 3) * 32;
#pragma unroll
    for (int c = 0; c < 4; ++c) R.srg[c] = *(const u32x4*)(SRGb + gofs + 8 * c);
#pragma unroll
    for (int s = 0; s < 2; ++s) R.q[s] = *(const bf16x8*)(RQb + (row0 + 16 * F.wave + (F.lane & 15)) * 512 + 64 * h + 32 * s + 8 * (F.lane >> 4));
}
__device__ __forceinline__ void r3_item(const Frame& F, CArgs& A, int item, int item_next, R3Regs& R, int after_next, LAS int* slot) {
    unsigned char* ws = A.ws; bf16_t* RVb = (bf16_t*)(ws + WS_RV);
    LAS bf16_t* kl = (LAS bf16_t*)F.lds; LAS bf16_t* vl = kl + 128 * KLD; LAS bf16_t* sl = vl + 128 * 128; LAS bf16_t* pl = sl + 128 * 128 + F.wave * (16 * VLD);
    const int cg = item >> 3, h = item & 7; const size_t row0 = (size_t)cg * 128;
    const float lgf = log_sigmoid_(A.dec_f[h]) * 1.4426950408889634f, lgb = log_sigmoid_(A.dec_b[h]) * 1.4426950408889634f;
#pragma unroll
    for (int i = 0; i < 2; ++i) { const int ci = F.tid + i * NTHR; *(LAS u32x4*)(kl + (ci >> 3) * KLD + 8 * (ci & 7)) = R.k[i]; }
#pragma unroll
    for (int i = 0; i < 4; ++i) { const int ci = F.tid + i * NTHR, j = ci >> 4, c8 = ci & 15; *(LAS u32x4*)((LAS char*)vl + vsw(j, c8)) = R.v[i]; *(LAS u32x4*)((LAS char*)sl + vsw(j, c8)) = R.s[i]; }
    int lane_ = F.lane; asm volatile("" : "+v"(lane_));
    const int g = lane_ >> 4, l15 = lane_ & 15, q = l15 >> 2, p = lane_ & 3, w = F.wave;
    const size_t gofs = (row0 + 16 * w + (lane_ >> 2)) * 1024 + 128 * h + (lane_ & 3) * 32;
    u32x4 srg_[4]; bf16x8 qf[2];
#pragma unroll
    for (int c = 0; c < 4; ++c) srg_[c] = R.srg[c];
#pragma unroll
    for (int s = 0; s < 2; ++s) qf[s] = R.q[s];
    __syncthreads();
    if (item_next >= 0) r3_load(F, A, item_next, R);
    float rf[4], rb[4];
#pragma unroll
    for (int e = 0; e < 4; ++e) { const float fi = (float)(16 * w + 4 * g + e); rf[e] = __builtin_amdgcn_exp2f(lgf * fi); rb[e] = __builtin_amdgcn_exp2f(-lgb * fi); }
#pragma unroll
    for (int nt = 0; nt < 8; ++nt) { f32x4 sacc = {0.f, 0.f, 0.f, 0.f};
#pragma unroll
        for (int s = 0; s < 2; ++s) { const bf16x8 kfr = *(const LAS bf16x8*)(kl + (16 * nt + l15) * KLD + 32 * s + 8 * g); sacc = __builtin_amdgcn_mfma_f32_16x16x32_bf16(qf[s], kfr, sacc, 0, 0, 0); }
        const int j = 16 * nt + l15;
        if (nt < w) {
            const float cf = __builtin_amdgcn_exp2f(-lgf * (float)j);
#pragma unroll
            for (int e = 0; e < 4; ++e) pl[(4 * g + e) * VLD + j] = (bf16_t)f2bf(sacc[e] * (rf[e] * cf));
        } else if (nt > w) {
            const float cb = __builtin_amdgcn_exp2f(lgb * (float)j);
#pragma unroll
            for (int e = 0; e < 4; ++e) pl[(4 * g + e) * VLD + j] = (bf16_t)f2bf(sacc[e] * (rb[e] * cb));
        } else {
            const float cf = __builtin_amdgcn_exp2f(-lgf * (float)j), cb = __builtin_amdgcn_exp2f(lgb * (float)j);
#pragma unroll
            for (int e = 0; e < 4; ++e) { const int df = 16 * w + 4 * g + e - j;
                const float dm = (df >= 0 ? rf[e] * cf : 0.f) + (df <= 0 ? rb[e] * cb : 0.f);
                pl[(4 * g + e) * VLD + j] = (bf16_t)f2bf(sacc[e] * dm); } } }
    LDS_WAIT(); asm volatile("" ::: "memory");
    bf16x8 pa[4], qa[4];
#pragma unroll
    for (int s = 0; s < 4; ++s) pa[s] = *(const LAS bf16x8*)(pl + l15 * VLD + 32 * s + 8 * g);
    { const int i = 16 * w + l15; const float qdf = __builtin_amdgcn_exp2f(lgf * (float)(i + 1)), qdb = __builtin_amdgcn_exp2f(lgb * (float)(128 - i));
#pragma unroll
      for (int s = 0; s < 2; ++s) { f32x4 a, b; unpack8(__builtin_bit_cast(u32x4, qf[s]), a, b); qa[s] = __builtin_bit_cast(bf16x8, pack8(a * qdf, b * qdf)); qa[2 + s] = __builtin_bit_cast(bf16x8, pack8(a * qdb, b * qdb)); } }
    f32x4 oacc[8];
#pragma unroll
    for (int nt = 0; nt < 8; ++nt) { f32x4 acc = {0.f, 0.f, 0.f, 0.f};
#pragma unroll
        for (int s = 0; s < 4; ++s) { const int R0 = 32 * s + 8 * g + q, col = 16 * nt + 4 * p;
            const s16x4 lo = tr_read16((const LAS bf16_t*)((const LAS char*)vl + vsw_tr(R0, col))), hi = tr_read16((const LAS bf16_t*)((const LAS char*)vl + vsw_tr(R0 + 4, col)));
            acc = __builtin_amdgcn_mfma_f32_16x16x32_bf16(pa[s], MK8(lo, hi), acc, 0, 0, 0); }
#pragma unroll
        for (int s = 0; s < 4; ++s) { const int R0 = 32 * s + 8 * g + q, col = 16 * nt + 4 * p;
            const s16x4 lo = tr_read16((const LAS bf16_t*)((const LAS char*)sl + vsw_tr(R0, col))), hi = tr_read16((const LAS bf16_t*)((const LAS char*)sl + vsw_tr(R0 + 4, col)));
            acc = __builtin_amdgcn_mfma_f32_16x16x32_bf16(qa[s], MK8(lo, hi), acc, 0, 0, 0); }
        oacc[nt] = acc; }
    f32x4 ss = {0.f, 0.f, 0.f, 0.f};
#pragma unroll
    for (int nt = 0; nt < 8; ++nt) ss += oacc[nt] * oacc[nt];
#pragma unroll
    for (int e = 0; e < 4; ++e) { float s = ss[e]; s += __shfl_xor(s, 1); s += __shfl_xor(s, 2); s += __shfl_xor(s, 4); s += __shfl_xor(s, 8); ss[e] = __builtin_amdgcn_rsqf(s * (1.0f / 128.0f) + EPS); }
#pragma unroll
    for (int nt = 0; nt < 8; ++nt)
#pragma unroll
        for (int e = 0; e < 4; ++e) pl[(4 * g + e) * VLD + 16 * nt + l15] = (bf16_t)f2bf(oacc[nt][e] * ss[e]);
    LDS_WAIT(); asm volatile("" ::: "memory");
#pragma unroll
    for (int c = 0; c < 4; ++c) { f32x4 o0, o1, g0, g1; unpack8(*(const LAS u32x4*)(pl + (lane_ >> 2) * VLD + (lane_ & 3) * 32 + 8 * c), o0, o1); unpack8(srg_[c], g0, g1);
        *(u32x4*)(RVb + gofs + 8 * c) = pack8(o0 * g0, o1 * g1); }
    if (F.tid == 0) *slot = after_next;
    __syncthreads();
}

__device__ __forceinline__ void phase_attn(const Frame& F, CArgs& A) {
    unsigned char* ws = A.ws; bf16_t* Q = (bf16_t*)(ws + WS_Q);
    {
        LAS float* scr = (LAS float*)(F.lds + F.wave * 8704);
        const int gw = F.bid * NWAVES + F.wave, NGW = F.G * NWAVES;
        constexpr int I_O = 16 * 32, NIT = 3 * I_O;
        for (int it = gw; it < NIT; it += NGW) {
            int r = it;
            if (r < I_O) { transpose_item(A.w_att_o, 1024, (bf16_t*)(ws + WS_WB), 2048, 0, 64 * (r / 32), 32 * (r % 32), ColId(), scr, F.lane); continue; } r -= I_O;
            if (r < I_O) { transpose_item(A.w_ret_o, 1024, (bf16_t*)(ws + WS_WB), 2048, 1024, 64 * (r / 32), 32 * (r % 32), ColId(), scr, F.lane); continue; } r -= I_O;
            transpose_item(A.w_out, 1024, (bf16_t*)(ws + WS_WC), 1024, 0, 64 * (r / 32), 32 * (r % 32), ColId(), scr, F.lane);
        }
        __syncthreads();
    }
    const int x = F.bid & 7, c = F.bid >> 3;
    const int nun = F.bid < NB * NH ? 3 : 2;
    unsigned* qctr = (unsigned*)(ws + WS_CNT) + 64 * CNT_R3Q; LAS int* slot = (LAS int*)(F.lds + 122880);
    int nxt_v = 0; if (F.tid == 0) nxt_v = (int)__hip_atomic_fetch_add(qctr, 1u, RLX_AGENT) + F.G;
#pragma nounroll
    for (int i = 0; i < nun; ++i) {
        const bf16_t *Kh, *Vh; bf16_t* Qb; int seq;
        if (i < 2) { const int lb = x >> 1, kvh = x & 1, uu = c + 32 * i, hq = kvh * 4 + (uu >> 4), qb = uu & 15;
            Kh = (const bf16_t*)(ws + WS_KALL) + (size_t)(lb * 2 + kvh) * SKV * 128; Vh = (const bf16_t*)(ws + WS_VALL) + (size_t)(lb * 2 + kvh) * SKV * 128;
            Qb = Q + ((size_t)MP + (size_t)lb * DSEQ + qb * 256) * 1024 + hq * 128; seq = SKV; }
        else { const int b = F.bid >> 3, hq = F.bid & 7, kvh = hq >> 2;
            Kh = (const bf16_t*)(ws + WS_KP) + (size_t)(b * 2 + kvh) * SEQ * 128; Vh = (const bf16_t*)(ws + WS_VP) + (size_t)(b * 2 + kvh) * SEQ * 128;
            Qb = Q + (size_t)b * SEQ * 1024 + hq * 128; seq = SEQ; }
        att::attn_dense_body<1024>(Qb, Kh, Vh, Qb, seq, (char*)F.lds, F.wave);
    }
    {
      constexpr int NIT3 = (MT / 128) * 8;
      Frame F2 = F; F2.lane = lane_id_(); F2.tid = F2.wave * 64 + F2.lane;
      if (F2.tid == 0) *slot = nxt_v;
      __syncthreads();
      int cur = F.bid, nxt = __builtin_amdgcn_readfirstlane(*slot); if (nxt >= NIT3) nxt = -1;
      R3Regs R; r3_load(F2, A, cur, R);
      while (cur >= 0) {
          int n2_v = -1; if (nxt >= 0 && F2.tid == 0) n2_v = (int)__hip_atomic_fetch_add(qctr, 1u, RLX_AGENT) + F.G;
          r3_item(F2, A, cur, nxt, R, n2_v, slot);
          cur = nxt; nxt = __builtin_amdgcn_readfirstlane(*slot); if (nxt >= NIT3) nxt = -1;
      }
    }
}

struct OneUnit { int pm, pn; __device__ __forceinline__ bool next(int i, pg8::Unit& u) const { if (i) return false; u.pm = pm; u.pn = pn; return true; }
    __device__ __forceinline__ void a_ready(const pg8::Unit&, int) const {} };
constexpr int NU2 = 0, NU3 = 320, NU4 = (MT / 256) * (NUP / 256), NU5 = 320, NUTOT = NU2 + NU3 + NU4 + NU5;
__device__ __forceinline__ void fix_panel(const Frame& F, CArgs& A, int pm) {
    unsigned char* ws = A.ws; const float* EU = (const float*)(ws + WS_EDGE_U); const float* EUC = (const float*)(ws + WS_EDGE_UC); bf16_t* ACT = (bf16_t*)(ws + WS_ACT);
    const int jt = (pm - 16) & 15;
    for (int i = F.tid; i < 2 * DFF; i += NTHR) { const int j = i % DFF, e = i / DFF;
        if ((e == 0 && jt == 0) || (e == 1 && jt == 15)) continue;
        const int pmn = e ? pm + 1 : pm - 1, na = 256 * (j >> 7) + (j & 127), ng = na + 128, tap = e ? 2 : 0;
        const float ua = EUC[((size_t)pm * 2 + e) * NUP + na] + A.conv_w[(size_t)tap * NUP + j] * EU[((size_t)pmn * 2 + (1 - e)) * NUP + na];
        const float ug = EUC[((size_t)pm * 2 + e) * NUP + ng] + A.conv_w[(size_t)tap * NUP + DFF + j] * EU[((size_t)pmn * 2 + (1 - e)) * NUP + ng];
        ACT[((size_t)pm * 256 + (e ? 255 : 0)) * DFF + j] = (bf16_t)f2bf(siluf_(ug) * ua); }
}
__device__ __forceinline__ void g3_unit(const Frame& F, CArgs& A, int idx) {
    unsigned char* ws = A.ws; unsigned* cnt = (unsigned*)(ws + WS_CNT); const int pm = idx >> 2, pn = idx & 3;
    OneUnit S{pm, pn};
    pg8::Gemm g{(const bf16_t*)(ws + WS_Y), (const bf16_t*)(ws + WS_WC), MT, DM, DM, DM, DM, 1 << 30, 0};
    EpiRes1 E{A.x_prompt, A.x_sample, (const float*)(ws + WS_MODF), A.norm2_g, (bf16_t*)(ws + WS_X1B), (float*)(ws + WS_SSQ1), (bf16_t*)(ws + WS_H)};
    pg8::gemm_phase(F.lds, g, S, E, F.wave);
    asm volatile("s_waitcnt vmcnt(0)" ::: "memory");
    __syncthreads();
    if (F.wave == 0 && lane_id_() == 0) { __hip_atomic_fetch_add(cnt + 64 * (CNT_D3 + pm), 1u, RLX_AGENT); __hip_atomic_fetch_add(cnt + 64 * CNT_G3ALL, 1u, RLX_AGENT); }
}
__device__ __forceinline__ void phase_mix(const Frame& F, CArgs& A) {
    unsigned char* ws = A.ws; unsigned* cnt = (unsigned*)(ws + WS_CNT);
    const int v = (F.bid & 7) * (F.G >> 3) + (F.bid >> 3);
#if defined(PROBE_K0) && (PROBE_K0 == 301 || PROBE_K0 == 302)
    const unsigned long long tmix0_ = __builtin_amdgcn_s_memrealtime();
#endif
    {   struct G2Run { int v, n; __device__ __forceinline__ bool next(int i, pg8::Unit& u) const { if (i >= n) return false; const int l = i == 0 ? v : 256 + v; u.pm = l >> 2; u.pn = l & 3; return true; }
            __device__ __forceinline__ void a_ready(const pg8::Unit&, int) const {} };
        G2Run S{v, v < 64 ? 2 : 1};
        pg8::Gemm g{(const bf16_t*)(ws + WS_Q), (const bf16_t*)(ws + WS_WB), MT, DM, 2 * DM, DM, 2 * DM, 16, (long)(WS_RV - WS_Q) - 16 * 128};
        EpiMix E{(const bf16_t*)A.out, (const bf16_t*)A.out + (size_t)MT * DM, (bf16_t*)(ws + WS_Y), cnt + 64 * CNT_D2};
        pg8::gemm_phase(F.lds, g, S, E, F.wave);
    }
#if defined(PROBE_K0) && PROBE_K0 == 300
    const unsigned long long t0_ = __builtin_amdgcn_s_memrealtime();
#endif
#if defined(PROBE_K0) && PROBE_K0 == 301
    if (v == PROBE_BID && F.tid == 0) *(float*)(ws + 32768) = (float)(__builtin_amdgcn_s_memrealtime() - tmix0_);
#endif
    if (v >= 64) { const int idx = v - 64, pm = idx >> 2;
        if (F.wave == 0) { spin_ge(cnt + 64 * (CNT_D2 + pm), 4u); __builtin_amdgcn_fence(__ATOMIC_ACQUIRE, "agent"); asm volatile("s_waitcnt vmcnt(0)" ::: "memory"); }
        __syncthreads();
        g3_unit(F, A, idx);
        __syncthreads();
        LAS float* scr = (LAS float*)(F.lds + F.wave * 8704);
        constexpr int I_DN = (DFF / 64) * 32, I_UP = 16 * (NUP / 32);
        for (int it = (v - 64) * NWAVES + F.wave; it < I_DN + I_UP; it += (F.G - 64) * NWAVES) {
            if (it < I_DN) transpose_item(A.w_down, 1024, (bf16_t*)(ws + WS_WD), DFF, 0, 64 * (it / 32), 32 * (it % 32), ColId(), scr, F.lane);
            else { const int r = it - I_DN; transpose_item(A.w_up, NUP, (bf16_t*)(ws + WS_WA), 1024, 0, 64 * (r / (NUP / 32)), 32 * (r % (NUP / 32)), ColUp(), scr, F.lane); } }
    }
#if defined(PROBE_K0) && PROBE_K0 == 300
    if (v == PROBE_BID && F.tid == 0) *(float*)(ws + 32768) = (float)(__builtin_amdgcn_s_memrealtime() - t0_);
#endif
#if defined(PROBE_K0) && PROBE_K0 == 302
    if (v == PROBE_BID && F.tid == 0) *(float*)(ws + 32768) = (float)(__builtin_amdgcn_s_memrealtime() - tmix0_);
#endif
}
__device__ __forceinline__ void phase_stream(const Frame& F, CArgs& A) {
    unsigned char* ws = A.ws; unsigned* cnt = (unsigned*)(ws + WS_CNT);
    LAS float* spare = (LAS float*)(F.lds + SPARE_OFF);
    const int NOJ = 1 << 30;
    const int v = (F.bid & 7) * (F.G >> 3) + (F.bid >> 3);
#if defined(PROBE_K0) && PROBE_K0 >= 100 && PROBE_K0 < 200
    unsigned long long tacc_ = 0, tl_ = __builtin_amdgcn_s_memrealtime();
#define SPROBE(cat) do { const unsigned long long tn_ = __builtin_amdgcn_s_memrealtime(); if ((cat) == PROBE_K0 - 100 || PROBE_K0 - 100 == 3) tacc_ += tn_ - tl_; tl_ = tn_; } while (0)
#else
#define SPROBE(cat) do { } while (0)
#endif
    const int nG4 = v < 64 ? 8 : v < 192 ? 7 : v < 224 ? 6 : 5, nG5 = v >= 192 ? 2 : 1;
    if (v >= 64 && v < 192) g3_unit(F, A, 192 + (v - 64));
    SPROBE(0);
    {   struct G4Run { int v, n; unsigned* d3; unsigned* g3all; volatile LAS unsigned* alld; unsigned* d4; mutable int p0, p1;
            __device__ __forceinline__ void publish(int pm) const {
                if (pm >= 0) { asm volatile("s_waitcnt vmcnt(0)" ::: "memory"); if (lane_id_() == 0) __hip_atomic_fetch_add(d4 + 64 * pm, 1u, RLX_AGENT); } }
            __device__ __forceinline__ bool next(int r, pg8::Unit& u) const { if (r >= n) return false;
                const int l = r < 5 ? 256 * r + v : r == 5 ? 1280 + v : r == 6 ? 1504 + v : 1696 + v;
                const int sr = l / 176, rem = l % 176, blk = rem < 160 ? rem >> 5 : 5, w = rem < 160 ? rem & 31 : rem - 160;
                u.pm = 8 * sr + (w & 7); u.pn = 4 * blk + (w >> 3); return true; }
            __device__ __forceinline__ void a_ready(const pg8::Unit& u, int wid) const {
                publish(p0); p0 = p1; p1 = u.pm;
                if (wid == 0 && *alld == 0u) {
                    const bool all = (unsigned)__builtin_amdgcn_readfirstlane(__hip_atomic_load(g3all, RLX_AGENT)) >= 320u;
                    spin_ge(d3 + 64 * u.pm, 4u);
                    if (u.pm >= 63) spin_ge(g3all, 320u);
                    __builtin_amdgcn_fence(__ATOMIC_ACQUIRE, "agent"); asm volatile("s_waitcnt vmcnt(0)" ::: "memory");
                    if (all) *alld = 1u; }
                asm volatile("" ::: "memory"); __builtin_amdgcn_s_barrier(); asm volatile("" ::: "memory"); } };
        volatile LAS unsigned* alld = (volatile LAS unsigned*)(F.lds + MISC_OFF) + 16;
        if (F.tid == 0) *alld = 0u;
        __syncthreads();
        G4Run S{v, nG4, cnt + 64 * CNT_D3, cnt + 64 * CNT_G3ALL, alld, cnt + 64 * CNT_D4, -1, -1};
        pg8::Gemm g{(const bf16_t*)(ws + WS_H), (const bf16_t*)(ws + WS_WA), MT, NUP, DM, DM, DM, NOJ, 0};
        EpiConv E{(const float*)(ws + WS_SSQ1), (const float*)(ws + WS_BUPF), A.conv_w, A.conv_b, (bf16_t*)(ws + WS_ACT), (float*)(ws + WS_EDGE_U), (float*)(ws + WS_EDGE_UC), spare, cnt + 64 * CNT_D4};
        pg8::gemm_phase(F.lds, g, S, E, F.wave);
        S.publish(S.p0); S.publish(S.p1);
    }
    SPROBE(1);
    for (int j = 0; j < nG5; ++j) { const int l = j == 0 ? ((v + 64) & 255) : 256 + (v - 192), pm = l >> 2, pn = l & 3;
        if (F.wave == 0) { spin_ge(cnt + 64 * (CNT_D4 + pm), 176u);
            if (pm >= 16) { const int jt = (pm - 16) & 15; if (jt > 0) spin_ge(cnt + 64 * (CNT_D4 + pm - 1), 176u); if (jt < 15) spin_ge(cnt + 64 * (CNT_D4 + pm + 1), 176u); }
            __builtin_amdgcn_fence(__ATOMIC_ACQUIRE, "agent"); asm volatile("s_waitcnt vmcnt(0)" ::: "memory"); }
        __syncthreads();
        if (pm >= 16) { fix_panel(F, A, pm); asm volatile("s_waitcnt vmcnt(0)" ::: "memory"); __syncthreads(); }
        SPROBE(0);
        OneUnit S{pm, pn};
        pg8::Gemm g{(const bf16_t*)(ws + WS_ACT), (const bf16_t*)(ws + WS_WD), MT, DM, DFF, DFF, DFF, NOJ, 0};
        EpiRes2 E{(const float*)(ws + WS_MODF), A.final_g, (const bf16_t*)(ws + WS_X1B), A.out, (float*)(ws + WS_XS), cnt + 64 * CNT_X5, spare};
        pg8::gemm_phase(F.lds, g, S, E, F.wave);
        SPROBE(2);
    }
#if defined(PROBE_K0) && PROBE_K0 >= 100 && PROBE_K0 < 200
    if (v == PROBE_BID && F.tid == 0) *(float*)(ws + 32768) = (float)tacc_;
#endif
}

constexpr int N_PHASES = 8;
__global__ void __launch_bounds__(NTHR, 2) fwd_kernel(Args A_) {
    CArgs& A = *(CArgs*)__builtin_amdgcn_kernarg_segment_ptr();
    extern __shared__ __attribute__((aligned(16))) unsigned char lds_raw[];
    Frame F; F.lds = (LAS unsigned char*)lds_raw; F.wave = __builtin_amdgcn_readfirstlane(threadIdx.x >> 6); F.lane = lane_id_(); F.tid = F.wave * 64 + F.lane; F.G = gridDim.x; F.bid = blockIdx.x;
    volatile LAS unsigned* MISC = (volatile LAS unsigned*)(F.lds + MISC_OFF);
    if (F.tid < 64) MISC[F.tid] = 0u;
    __syncthreads();
    unsigned char* ws = A.ws;
    XcdBarrier bar = xcd_barrier_post((unsigned*)(ws + WS_CTL), MISC + 8, F.wave);
    const int lo = A.ph_lo, hi = A.ph_hi;
#ifdef ONLY_PHASE
#define IN(k) ((k) == ONLY_PHASE)
#else
#define IN(k) (lo <= (k) && (k) < hi)
#endif
#ifdef PROBE_K0
    unsigned long long tA_ = __builtin_amdgcn_s_memrealtime();
#define PROBE_AT(k) do { if ((k) == PROBE_K0 - 1) tA_ = __builtin_amdgcn_s_memrealtime(); \
    if ((k) == PROBE_K1 && F.bid == 0 && F.tid == 0) { const unsigned long long tB_ = __builtin_amdgcn_s_memrealtime(); *(float*)(ws + 32768) = (float)(tB_ - tA_) - 100.0f * PROBE_OFS; } } while (0)
#else
#define PROBE_AT(k) do { } while (0)
#endif
#define SEAM(k) do { if (IN(k) && IN((k) + 1)) xcd_barrier(bar); F.lane = lane_id_(); F.tid = F.wave * 64 + F.lane; PROBE_AT(k); } while (0)
    LAS float* spare = (LAS float*)(F.lds + SPARE_OFF);
    const int NOJ = 1 << 30;
    if (IN(0)) { phase0(F, A); } SEAM(0);
    if (IN(1)) { phase1(F, A); } SEAM(1);
    if (IN(2)) {
        pg8::Gemm g{(const bf16_t*)(ws + WS_H), (const bf16_t*)(ws + WS_WA), MT, DIN, DM, DM, DM, NOJ, 0};
        pg8::StaticOrder S; S.init(MT, DIN, F.G, F.bid, true);
        EpiIn E{(bf16_t*)(ws + WS_Q), (bf16_t*)(ws + WS_KALL), (bf16_t*)(ws + WS_VALL), (bf16_t*)(ws + WS_KP), (bf16_t*)(ws + WS_VP), (bf16_t*)(ws + WS_RQ), (bf16_t*)(ws + WS_RK),
                (bf16_t*)(ws + WS_RV), (bf16_t*)(ws + WS_SRG), (bf16_t*)A.out, (bf16_t*)A.out + (size_t)MT * DM, A.out + OUT_CK, A.out + OUT_CV, A.q_g, A.k_g, spare, (unsigned*)(ws + WS_CNT1)};
        pg8::gemm_phase(F.lds, g, S, E, F.wave);
        phase_r1(F, A);
    } SEAM(2);
    if (IN(4)) { phase_scan(F, A); } SEAM(4);
    if (IN(5)) { phase_attn(F, A); } SEAM(5);
    if (IN(6)) { phase_mix(F, A); } SEAM(6);
    if (IN(7)) { phase_stream(F, A); }
#ifdef PROBE_K0
    {
        PROBE_AT(7);
        xcd_barrier(bar);
        const float sc_ = 1.0f + sqrtf(*(const float*)(ws + 32768) * 1e-7f);
        for (int i = F.bid * NTHR + F.tid; i < NB * NKV * SEQ * HD; i += F.G * NTHR) A.out[OUT_CV + i] *= sc_;
    }
#endif
#undef IN
#undef SEAM
}

#ifndef MK_SPLIT
#define MK_SPLIT 0
#endif
extern "C" void kernel_launch(void* const* d_in, const int* in_sizes, int n_in, void* d_out, int out_size, void* d_ws, size_t ws_size, hipStream_t stream) {
    static int grid = 0;
    if (grid == 0) {
        if (n_in != 25 || ws_size < WS_END) { fprintf(stderr, "kernel_launch: unexpected n_in %d / ws %zu\n", n_in, ws_size); grid = -1; return; }
        int dev = 0, cus = 0, per_cu = 0;
        hipGetDevice(&dev); hipDeviceGetAttribute(&cus, hipDeviceAttributeMultiprocessorCount, dev);
        if (hipFuncSetAttribute((const void*)fwd_kernel, hipFuncAttributeMaxDynamicSharedMemorySize, LDS_BYTES) != hipSuccess) { fprintf(stderr, "kernel_launch: hipFuncSetAttribute failed\n"); grid = -1; return; }
        hipOccupancyMaxActiveBlocksPerMultiprocessor(&per_cu, (const void*)fwd_kernel, NTHR, LDS_BYTES);
        (void)hipGetLastError();
        if (per_cu < 1) fprintf(stderr, "kernel_launch: occupancy query says %d blocks/CU\n", per_cu);
        grid = cus;
        if (grid != 256) fprintf(stderr, "kernel_launch: %d CUs (built for 256)\n", grid);
    }
    if (grid < 0) return;
    hipMemsetAsync((char*)d_ws + WS_CTL, 0, CTL_ZERO_BYTES, stream);
    Args a{};
    const float** pa = (const float**)&a;
    for (int i = 0; i < 25; ++i) pa[i] = (const float*)d_in[i];
    a.out = (float*)d_out; a.ws = (unsigned char*)d_ws;
#if MK_SPLIT
    for (int p = 0; p < N_PHASES; ++p) { a.ph_lo = p; a.ph_hi = p + 1; hipLaunchKernelGGL(fwd_kernel, dim3(grid), dim3(NTHR), LDS_BYTES, stream, a); }
#else
    a.ph_lo = 0; a.ph_hi = N_PHASES; hipLaunchKernelGGL(fwd_kernel, dim3(grid), dim3(NTHR), LDS_BYTES, stream, a);
#endif
    const hipError_t le = hipPeekAtLastError();
    if (le != hipSuccess) fprintf(stderr, "kernel_launch: launch failed: %s\n", hipGetErrorName(le));
}
```

```cpp
#include <hip/hip_runtime.h>
#include <hip/hip_bf16.h>
#include <cstdio>
#include <cstdint>

#ifndef PROBE_BID
#define PROBE_BID 100
#endif
#ifndef PROBE_OFS
#define PROBE_OFS 0
#endif
constexpr int DM = 1024, NB = 16, SEQ = 256, DB = 4, DSEQ = 4096, PAST = 512, GRIDW = 64;
constexpr int NH = 8, NKV = 2, HD = 128, RH = 8, RDK = 64, RDV = 128, DFF = 2816, CHUNK = 128;
constexpr int MP = NB * SEQ, ML = DB * DSEQ, MT = MP + ML;
constexpr int DIN = 6656, SKV = DSEQ + PAST;
constexpr int NUP = 2 * DFF;
constexpr float EPS = 1e-6f;
constexpr int NCHUNK = MT / CHUNK;
constexpr int NITEM = NCHUNK * RH;

#define GAS __attribute__((address_space(1)))
#define LAS __attribute__((address_space(3)))
typedef unsigned short bf16_t;
typedef short bf16x8 __attribute__((ext_vector_type(8)));
typedef short s16x4 __attribute__((ext_vector_type(4)));
typedef float f32x4 __attribute__((ext_vector_type(4)));
typedef float f32x2 __attribute__((ext_vector_type(2)));
typedef float f32x16 __attribute__((ext_vector_type(16)));
typedef unsigned u32x4 __attribute__((ext_vector_type(4)));
typedef unsigned u32x2 __attribute__((ext_vector_type(2)));
typedef GAS unsigned gu32;

constexpr size_t MiB = 1u << 20;
constexpr size_t WS_CTL = 0, CTL_ZERO_BYTES = 16 * 1024;
constexpr size_t WS_MOD = 256 * 1024;
constexpr size_t MODQ = 5 * 6144;
constexpr size_t WS_MODF = 1 * MiB + 832 * 1024;
constexpr size_t WS_BUP = 768 * 1024;
constexpr size_t BUPQ = 5 * 5632;
constexpr size_t WS_BUPF = 1 * MiB + 384 * 1024;
constexpr size_t WS_SSQ1 = 1 * MiB + 256 * 1024;
constexpr size_t WS_XS = 1 * MiB + 512 * 1024;
constexpr size_t WS_CNT = 64 * 1024;
constexpr size_t WS_CNT1 = 152 * 1024;
constexpr int CNT_D2 = 0, CNT_D3 = 80, CNT_D4 = 160, CNT_X5 = 240, CNT_G3ALL = 320, CNT_R3Q = 321;
constexpr size_t WS_WA = 2 * MiB;
constexpr size_t WS_WB = 16 * MiB;
constexpr size_t WS_WC = 20 * MiB;
constexpr size_t WS_WD = 22 * MiB;
constexpr size_t WS_H = 28 * MiB;
constexpr size_t WS_Q = 68 * MiB;
constexpr size_t WS_KALL = 108 * MiB, WS_VALL = 117 * MiB, WS_KP = 126 * MiB, WS_VP = 128 * MiB;
constexpr size_t WS_RQ = 132 * MiB, WS_RK = 152 * MiB, WS_RV = 172 * MiB, WS_SRG = 212 * MiB, WS_END = 252 * MiB;
constexpr size_t WS_Y = WS_RQ;
constexpr size_t WS_X1B = WS_SRG;
constexpr size_t WS_ACT = WS_Q;
constexpr size_t WS_EDGE_U = 178 * MiB, WS_EDGE_UC = 182 * MiB;
static_assert((size_t)DIN * DM * 2 <= 14 * MiB && (size_t)MT * DM * 2 == 40 * MiB && (size_t)NITEM * 2 * RDK * RDV * 2 == 40 * MiB, "ws map");
static_assert((size_t)DB * NKV * SKV * HD * 2 <= 9 * MiB && (size_t)NB * NKV * SEQ * HD * 2 <= 2 * MiB, "ws map kv");
static_assert(WS_ACT + (size_t)MT * DFF * 2 <= WS_EDGE_U && (size_t)80 * 2 * NUP * 4 <= 4 * MiB && WS_EDGE_UC + 4 * MiB <= WS_X1B, "ws map act");
static_assert(WS_CNT + 322 * 256 <= WS_CNT1 && WS_CNT1 + (481 + 82) * 64 <= WS_MOD && WS_MOD + 4 * MODQ * 4 <= WS_BUP && WS_BUP + 4 * BUPQ * 4 <= WS_SSQ1 && WS_SSQ1 + (size_t)MT * 4 <= WS_BUPF
              && WS_BUPF + BUPQ * 4 <= WS_XS && WS_XS + (size_t)80 * 4 * 256 * 4 <= WS_MODF && WS_MODF + MODQ * 4 <= WS_WA, "ws map: small buffers");
constexpr size_t OUT_Y = 0, OUT_CK = (size_t)MT * DM, OUT_CV = OUT_CK + (size_t)NB * NKV * SEQ * HD, OUT_SF = OUT_CV + (size_t)NB * NKV * SEQ * HD, OUT_SB = OUT_SF + (size_t)NB * RH * RDK * RDV;

#define LDS_WAIT() asm volatile("s_waitcnt lgkmcnt(0)" ::: "memory")
#define VM_WAIT() asm volatile("s_waitcnt vmcnt(0)" ::: "memory")
#define RLX_AGENT __ATOMIC_RELAXED, __HIP_MEMORY_SCOPE_AGENT
typedef __bf16 bf16x2_t __attribute__((ext_vector_type(2)));
__device__ __forceinline__ unsigned pk2(float lo, float hi) { const f32x2 v = {lo, hi}; return __builtin_bit_cast(unsigned, __builtin_convertvector(v, bf16x2_t)); }
__device__ __forceinline__ unsigned f2bf(float f) { return pk2(f, 0.f) & 0xffffu; }
__device__ __forceinline__ float bflo(unsigned w) { return __builtin_bit_cast(float, w << 16); }
__device__ __forceinline__ float bfhi(unsigned w) { return __builtin_bit_cast(float, w & 0xffff0000u); }
__device__ __forceinline__ float bf2f(bf16_t h) { return __builtin_bit_cast(float, (unsigned)h << 16); }
__device__ __forceinline__ int swap25(int p) { return (p & ~0x24) | ((p & 4) << 3) | ((p & 32) >> 3); }
__device__ __forceinline__ float sigmoidf_(float x) { return __builtin_amdgcn_rcpf(1.0f + __builtin_amdgcn_exp2f(-1.4426950408889634f * x)); }
__device__ __forceinline__ float siluf_(float x) { return x * __builtin_amdgcn_rcpf(1.0f + __builtin_amdgcn_exp2f(-1.4426950408889634f * x)); }
__device__ __forceinline__ int lane_id_() { int l; asm volatile("v_mbcnt_lo_u32_b32 %0, -1, 0\n\tv_mbcnt_hi_u32_b32 %0, -1, %0" : "=v"(l)); return l; }
__device__ __forceinline__ f32x4 sum4q(const float* p, size_t q) { return (*(const f32x4*)p + *(const f32x4*)(p + q)) + (*(const f32x4*)(p + 2 * q) + *(const f32x4*)(p + 3 * q)); }
__device__ __forceinline__ float wave_sum(float v) {
#pragma unroll
    for (int o = 1; o < 64; o <<= 1) v += __shfl_xor(v, o);
    return v;
}
__device__ __forceinline__ void sincos_rev(float ang, float& c, float& s) {
    double rev = (double)ang * 0.15915494309189533577; rev -= __builtin_rint(rev);
    const float fr = (float)rev; s = __builtin_amdgcn_sinf(fr); c = __builtin_amdgcn_cosf(fr);
}
__device__ __forceinline__ float rope_inv(int i) { return exp2f(-(float)i * (13.287712379549449f / 32.0f)); }

#define XB_TMO      128
#define XB_XCNT(j)  (256  + 64 * (j))
#define XB_XSUB(j)  (1280 + 64 * (j))
#define XB_XGEN(j)  (2304 + 64 * (j))
#define XB_TOP      3328
#define XB_TOPGEN   3392
#define XCD_BAR_WORDS 3456
#define XB_SPIN_CAP (1u << 20)
__device__ __forceinline__ unsigned xb_ld(unsigned* p)              { return __hip_atomic_load(p, __ATOMIC_RELAXED, __HIP_MEMORY_SCOPE_AGENT); }
__device__ __forceinline__ unsigned xb_add(unsigned* p, unsigned v) { return __hip_atomic_fetch_add(p, v, __ATOMIC_RELAXED, __HIP_MEMORY_SCOPE_AGENT); }
__device__ __forceinline__ unsigned xb_xcc_id() { return (unsigned)__builtin_amdgcn_s_getreg((3 << 11) | 20) & 0xFu; }
#define XB_SPIN(cond, bar) do { unsigned _sp = 0; while (cond) { __builtin_amdgcn_s_sleep(1); \
    if ((++_sp & 255u) == 0u) { if (xb_ld(&(bar)[XB_TMO])) break; if (_sp > XB_SPIN_CAP) { atomicAdd(&(bar)[XB_TMO], 1u); break; } } } } while (0)
struct XcdBarrier { unsigned* bar; unsigned x; volatile LAS unsigned* st; int wave; };
__device__ __forceinline__ XcdBarrier xcd_barrier_post(unsigned* bar, volatile LAS unsigned* st, int wave) {
    XcdBarrier b; b.bar = bar; b.x = xb_xcc_id(); b.st = st; b.wave = wave;
    if (wave == 0 && lane_id_() == 0) (void)xb_add(&bar[XB_XCNT(b.x)], 1u);
    return b;
}
__device__ __forceinline__ void xcd_barrier_complete(unsigned* bar, unsigned x, unsigned& nloc, unsigned& nx) {
    const unsigned G = gridDim.x * gridDim.y * gridDim.z;
    unsigned sum, cnt, mine, sp = 0u;
    for (;;) {
        sum = 0u; cnt = 0u; mine = 0u;
#pragma unroll
        for (unsigned j = 0; j < 16; ++j) { const unsigned c = xb_ld(&bar[XB_XCNT(j)]); sum += c; cnt += (c > 0u) ? 1u : 0u; mine = (j == x) ? c : mine; }
        if (sum == G) break;
        __builtin_amdgcn_s_sleep(1);
        if ((++sp & 255u) == 0u) { if (xb_ld(&bar[XB_TMO])) break; if (sp > XB_SPIN_CAP) { atomicAdd(&bar[XB_TMO], 1u); break; } }
    }
    nloc = mine > 0u ? mine : 1u; nx = cnt > 0u ? cnt : 1u;
}
__device__ __forceinline__ void xcd_barrier(const XcdBarrier& b) {
    asm volatile("s_waitcnt vmcnt(0)" ::: "memory");
    __syncthreads();
    if (b.wave == 0 && lane_id_() == 0) {
        unsigned* bar = b.bar;
        __builtin_amdgcn_s_waitcnt(0);
        unsigned nloc = b.st[0], nx = b.st[1];
        if (nloc == 0u) { xcd_barrier_complete(bar, b.x, nloc, nx); b.st[0] = nloc; b.st[1] = nx; }
        const unsigned old = xb_add(&bar[XB_XSUB(b.x)], 1u);
        const unsigned gen = old / nloc;
        if (old + 1u == (gen + 1u) * nloc) {
            __builtin_amdgcn_fence(__ATOMIC_RELEASE, "agent");
            asm volatile("s_waitcnt vmcnt(0)" ::: "memory");
            const unsigned og = xb_add(&bar[XB_TOP], 1u);
            const unsigned tg = og / nx;
            if (og + 1u == (tg + 1u) * nx) xb_add(&bar[XB_TOPGEN], 1u);
            else XB_SPIN(xb_ld(&bar[XB_TOPGEN]) == tg, bar);
            __builtin_amdgcn_fence(__ATOMIC_ACQUIRE, "agent");
            xb_add(&bar[XB_XGEN(b.x)], 1u);
            asm volatile("s_waitcnt vmcnt(0)" ::: "memory");
        } else {
            XB_SPIN(xb_ld(&bar[XB_XGEN(b.x)]) == gen, bar);
            __builtin_amdgcn_fence(__ATOMIC_ACQUIRE, "agent");
            asm volatile("s_waitcnt vmcnt(0)" ::: "memory");
        }
    }
    __syncthreads();
}

namespace pg8 {
constexpr int BM = 256, BK = 64, HALF = 128, HTB = HALF * BK * 2, STAGE_BYTES = 8 * HTB, NXCD = 8, WGM = 8;
__host__ __device__ __forceinline__ int lds_byte(int r, int c) { const int st = (r >> 4) * 2 + (c >> 5), rr = r & 15, cc = c & 31, ob = rr * 64 + cc * 2; return st * 1024 + (ob ^ (((ob >> 9) & 1) << 5)); }
__host__ __device__ __forceinline__ void stage_rc(int b, int& R, int& C) { const int st = b / 1024, sb = b % 1024, swz = sb ^ (((sb >> 9) & 1) << 5); R = (st >> 1) * 16 + swz / 64; C = (st & 1) * 32 + (swz % 64) / 2; }
__host__ __device__ __forceinline__ int perm32(int rho) { const int n = rho >> 4, i = rho & 15; return 8 * (i >> 2) + 4 * n + (i & 3); }
struct Unit { int pm, pn; };
struct Gemm { const bf16_t* A; const bf16_t* Bt; int M, N, K, lda, ldb, jt; long jumpA; };
struct StaticOrder {
    int nM, nN, nwg, G, c; bool in_order;
    __host__ __device__ void init(int M, int N, int G_, int c_, bool io = false) { nM = M / BM; nN = N / BM; nwg = nM * nN; G = G_; c = c_; in_order = io; }
    __host__ __device__ bool next(int i, Unit& u) const {
        const long L = (long)i * G + c; if (L >= nwg) return false;
        int wgid = (int)L; { const int q = nwg / NXCD, r = nwg % NXCD, xcd = wgid % NXCD, off = wgid / NXCD; wgid = (xcd < r ? xcd * (q + 1) : r * (q + 1) + (xcd - r) * q) + off; }
        const int nig = WGM * nN, gid = wgid / nig, fm = gid * WGM, gsz = (nM - fm) < WGM ? (nM - fm) : WGM;
        u.pm = fm + ((wgid % nig) % gsz); u.pn = (wgid % nig) / gsz;
        if (in_order) u.pn = u.pn < 6 ? 8 + u.pn : u.pn < 14 ? u.pn - 6 : u.pn;
        return true;
    }
    __device__ __forceinline__ void a_ready(const Unit&, int) const {}
};
template <class Epi, class Sched>
__device__ __forceinline__ void gemm_phase(LAS unsigned char* lds, const Gemm g, const Sched& S, const Epi& E, const int wid) {
    const int lane = lane_id_(), tid = wid * 64 + lane, wr = wid >> 2, wc = wid & 3, fr = lane & 15, fq = lane >> 4;
    const int nt = g.K / BK;
    unsigned voffA[2], voffB[2];
#pragma unroll
    for (int i = 0; i < 2; ++i) { int R, C; stage_rc(tid * 16 + i * 8192, R, C); const int Rb = (R & ~31) + perm32(R & 31);
        voffA[i] = (unsigned)(R * g.lda + C) * 2u; voffB[i] = (unsigned)(Rb * g.ldb + C) * 2u; }
    const size_t kstep = (size_t)(BK * 2);
    const size_t hstepA = (size_t)HALF * g.lda * 2, hstepB = (size_t)HALF * g.ldb * 2;
    const size_t tstepA = 2 * hstepA, tstepB = 2 * hstepB;
    const unsigned ldsw = (unsigned)wid * 1024u;
    const int aoff = lds_byte(wr * 64 + fr, fq * 8), boff = lds_byte(wc * 32 + fr, fq * 8);
#define PG8_SA(b, h) (((b) * 2 + (h)) * HTB)
#define PG8_SB(b, h) ((4 + (b) * 2 + (h)) * HTB)
#define PG8_STAGE(bufoff, gbase, voff) do { _Pragma("unroll") for (int _i = 0; _i < 2; ++_i) \
        __builtin_amdgcn_global_load_lds((const unsigned*)((const char*)(gbase) + (voff)[_i]), (LAS unsigned*)(lds + (bufoff) + ldsw + _i * 8192), 16, 0, 0); } while (0)
#define PG8_LDA(dst, b, h) do { _Pragma("unroll") for (int m = 0; m < 4; ++m) _Pragma("unroll") for (int k = 0; k < 2; ++k) dst[m][k] = *(const LAS bf16x8*)(lds + PG8_SA(b, h) + aoff + m * 2048 + k * 1024); } while (0)
#define PG8_LDB(dst, b, h) do { _Pragma("unroll") for (int n = 0; n < 2; ++n) _Pragma("unroll") for (int k = 0; k < 2; ++k) dst[n][k] = *(const LAS bf16x8*)(lds + PG8_SB(b, h) + boff + n * 2048 + k * 1024); } while (0)
#define PG8_MMA(ai, bj, At, Bt) do { __builtin_amdgcn_s_setprio(1); _Pragma("unroll") for (int m = 0; m < 4; ++m) _Pragma("unroll") for (int n = 0; n < 2; ++n) _Pragma("unroll") for (int k = 0; k < 2; ++k) \
        acc[ai][bj][m][n] = __builtin_amdgcn_mfma_f32_16x16x32_bf16(Bt[n][k], At[m][k], acc[ai][bj][m][n], 0, 0, 0); __builtin_amdgcn_s_setprio(0); } while (0)
#define PG8_WAIT_V(n) asm volatile("s_waitcnt vmcnt(" #n ")" ::: "memory")
#define PG8_WAIT_L(n) asm volatile("s_waitcnt lgkmcnt(" #n ")" ::: "memory")
#define PG8_BAR __builtin_amdgcn_s_barrier()
#define PG8_SCHED __builtin_amdgcn_sched_barrier(0)
    Unit cur, nxt; int ui = 0;
    if (!S.next(0, cur)) return;
    f32x4 acc[2][2][4][2];
#pragma unroll
    for (int a = 0; a < 2; ++a)
#pragma unroll
        for (int b = 0; b < 2; ++b)
#pragma unroll
            for (int m = 0; m < 4; ++m)
#pragma unroll
                for (int n = 0; n < 2; ++n) acc[a][b][m][n] = (f32x4){0.f, 0.f, 0.f, 0.f};
    bf16x8 At[4][2], B0[2][2], B1[2][2];
    const char* cA = (const char*)g.A + (size_t)cur.pm * tstepA; const char* cB = (const char*)g.Bt + (size_t)cur.pn * tstepB;
    const int jt = g.jt; const long jumpA = g.jumpA;
    S.a_ready(cur, wid);
#define PG8_KA(base, t) ((base) + (size_t)(t) * kstep + ((t) >= jt ? jumpA : 0L))
    PG8_STAGE(PG8_SB(0, 0), cB, voffB); PG8_STAGE(PG8_SB(0, 1), cB + hstepB, voffB); PG8_STAGE(PG8_SA(0, 0), cA, voffA); PG8_STAGE(PG8_SA(0, 1), cA + hstepA, voffA);
    if (wr == 1) PG8_BAR;
    PG8_WAIT_V(2); PG8_BAR;
    PG8_STAGE(PG8_SB(1, 0), cB + kstep, voffB); PG8_STAGE(PG8_SA(1, 0), PG8_KA(cA, 1), voffA); PG8_STAGE(PG8_SB(1, 1), cB + hstepB + kstep, voffB);
    PG8_WAIT_V(6); PG8_BAR;
    for (;;) {
        const bool has_next = S.next(ui + 1, nxt);
        const char* nA = has_next ? (const char*)g.A + (size_t)nxt.pm * tstepA : cA; const char* nB = has_next ? (const char*)g.Bt + (size_t)nxt.pn * tstepB : cB;
        for (int seg = 0; seg < (Epi::MID_T >= 0 ? 2 : 1); ++seg) {
        const int tb = (Epi::MID_T >= 0 && seg == 1) ? Epi::MID_T : 0, te = (Epi::MID_T >= 0 && seg == 0) ? Epi::MID_T : nt;
        if constexpr (Epi::MID_T >= 0) { if (seg == 1) E.mid(acc, cur, wr, wc, fr, fq); }
        for (int t = tb; t < te; t += 2) {
            const bool last = (t == nt - 2);
            if (last && has_next) S.a_ready(nxt, wid);
            const char* a1 = PG8_KA(cA, t + 1);
            const char* a2 = last ? nA : PG8_KA(cA, t + 2); const char* b2 = last ? nB : cB + (size_t)(t + 2) * kstep;
            const char* a3 = last ? PG8_KA(nA, 1) : PG8_KA(cA, t + 3); const char* b3 = b2 + kstep;
            PG8_LDB(B0, 0, 0); PG8_LDB(B1, 0, 1); PG8_SCHED; PG8_LDA(At, 0, 0); PG8_STAGE(PG8_SA(1, 1), a1 + hstepA, voffA);
            PG8_WAIT_V(8); PG8_WAIT_L(0); PG8_BAR; PG8_MMA(0, 0, At, B0); PG8_MMA(0, 1, At, B1); PG8_BAR; PG8_SCHED;
            PG8_LDA(At, 0, 1); PG8_STAGE(PG8_SB(0, 0), b2, voffB); PG8_STAGE(PG8_SB(0, 1), b2 + hstepB, voffB); PG8_STAGE(PG8_SA(0, 0), a2, voffA);
            PG8_WAIT_V(8); PG8_WAIT_L(0); PG8_BAR; PG8_MMA(1, 0, At, B0); PG8_MMA(1, 1, At, B1); PG8_BAR; PG8_SCHED;
            PG8_LDB(B0, 1, 0); PG8_LDB(B1, 1, 1); PG8_SCHED; PG8_LDA(At, 1, 0); PG8_STAGE(PG8_SA(0, 1), a2 + hstepA, voffA);
            PG8_WAIT_V(8); PG8_WAIT_L(0); PG8_BAR; PG8_MMA(0, 0, At, B0); PG8_MMA(0, 1, At, B1); PG8_BAR; PG8_SCHED;
            PG8_LDA(At, 1, 1); PG8_STAGE(PG8_SB(1, 0), b3, voffB); PG8_STAGE(PG8_SB(1, 1), b3 + hstepB, voffB); PG8_STAGE(PG8_SA(1, 0), a3, voffA);
            PG8_WAIT_V(8); PG8_WAIT_L(0); PG8_BAR; PG8_MMA(1, 0, At, B0); PG8_MMA(1, 1, At, B1); PG8_BAR; PG8_SCHED;
        }
        }
        const typename Epi::Pre pf = E.pre(cur, wr, wc, fr, fq, wid, lane);
        if (wr == 0) PG8_BAR;
        E.epi(acc, cur, wr, wc, fr, fq, wid, lane, pf);
        if (!has_next) break;
#pragma unroll
        for (int a = 0; a < 2; ++a)
#pragma unroll
            for (int b = 0; b < 2; ++b)
#pragma unroll
                for (int m = 0; m < 4; ++m)
#pragma unroll
                    for (int n = 0; n < 2; ++n) acc[a][b][m][n] = (f32x4){0.f, 0.f, 0.f, 0.f};
        cur = nxt; cA = nA; cB = nB; ++ui;
        if (wr == 1) PG8_BAR;
    }
    PG8_WAIT_V(0);
    PG8_BAR;
#undef PG8_KA
#undef PG8_SA
#undef PG8_SB
#undef PG8_STAGE
#undef PG8_LDA
#undef PG8_LDB
#undef PG8_MMA
#undef PG8_WAIT_V
#undef PG8_WAIT_L
#undef PG8_BAR
#undef PG8_SCHED
}
}

typedef f32x4 AccT[2][2][4][2];
struct NoPre {};
#define PIN8(a, i, j) asm volatile("" : "+v"(a[i][j][0][0]), "+v"(a[i][j][0][1]), "+v"(a[i][j][1][0]), "+v"(a[i][j][1][1]), "+v"(a[i][j][2][0]), "+v"(a[i][j][2][1]), "+v"(a[i][j][3][0]), "+v"(a[i][j][3][1]))
#define PINACC(a) do { PIN8(a, 0, 0); PIN8(a, 0, 1); PIN8(a, 1, 0); PIN8(a, 1, 1); } while (0)
#define RAW_BAR() do { asm volatile("s_waitcnt lgkmcnt(0)" ::: "memory"); __builtin_amdgcn_s_barrier(); asm volatile("" ::: "memory"); } while (0)
__device__ __forceinline__ u32x4 pack8(const f32x4 a, const f32x4 b) { u32x4 w; w.x = pk2(a[0], a[1]); w.y = pk2(a[2], a[3]); w.z = pk2(b[0], b[1]); w.w = pk2(b[2], b[3]); return w; }
__device__ __forceinline__ void unpack8(const u32x4 w, f32x4& a, f32x4& b) { a = (f32x4){bflo(w.x), bfhi(w.x), bflo(w.y), bfhi(w.y)}; b = (f32x4){bflo(w.z), bfhi(w.z), bflo(w.w), bfhi(w.w)}; }

typedef __amdgpu_buffer_rsrc_t rsrc_t;
__device__ __forceinline__ rsrc_t mk_rsrc(const void* p, unsigned bytes) { return __builtin_amdgcn_make_buffer_rsrc((void*)p, (short)0, (int)bytes, 0x00020000); }
__device__ __forceinline__ void st16_wt(rsrc_t r, unsigned off, u32x4 v) { __builtin_amdgcn_raw_buffer_store_b128(v, r, off, 0, 16); }
__device__ __forceinline__ void st16_wt(rsrc_t r, unsigned off, f32x4 v) { __builtin_amdgcn_raw_buffer_store_b128(__builtin_bit_cast(u32x4, v), r, off, 0, 16); }

struct EpiIn {
    static constexpr int MID_T = -1;
    typedef NoPre Pre;
    __device__ __forceinline__ Pre pre(const pg8::Unit&, int, int, int, int, int, int) const { return Pre(); }
    bf16_t *Q, *KALL, *VALL, *KP, *VP, *RQ, *RK, *RV, *SRG, *GA, *GR; float *ock, *ocv; const float *qg, *kg; LAS float* P; unsigned* c1;
    __device__ __forceinline__ void mid(AccT&, const pg8::Unit&, int, int, int, int) const {}
    __device__ __forceinline__ void epi(AccT& acc, const pg8::Unit& u, int wr, int wc, int fr, int fq, int wid, int lane, const Pre&) const {
        asm volatile("" : "+v"(fr), "+v"(fq));
        const int pn = u.pn, pm = u.pm; const bool latent = pm >= 16;
        if (wid == 0 && lane == 0) { __hip_atomic_fetch_add(c1 + 16 * (481 + pm), 1u, RLX_AGENT); __hip_atomic_fetch_add(c1 + 16 * (481 + 80), 1u, RLX_AGENT); }
        const int lb = (pm - 16) >> 4, t0 = latent ? ((pm - 16) & 15) * 256 : 0;
        const int rl0 = 64 * wr + fr, cw8 = 32 * wc + 8 * fq;
        const size_t grow0 = (size_t)pm * 256;
        if (pn <= 4) {
#pragma unroll
            for (int ai = 0; ai < 2; ++ai)
#pragma unroll
                for (int m = 0; m < 4; ++m)
#pragma unroll
                    for (int bj = 0; bj < 2; ++bj) { const f32x4 a = acc[ai][bj][m][0], b = acc[ai][bj][m][1];
                        float s = (a[0] * a[0] + a[1] * a[1]) + (a[2] * a[2] + a[3] * a[3]) + (b[0] * b[0] + b[1] * b[1]) + (b[2] * b[2] + b[3] * b[3]);
                        s += __shfl_xor(s, 16); s += __shfl_xor(s, 32);
                        if (fq == 0) P[((128 * ai + rl0 + 16 * m) * 2 + bj) * 4 + wc] = s; }
            RAW_BAR();
            const float* gain = pn < 4 ? qg : kg;
            const int d0 = 64 * (wc >> 1) + 8 * fq + 4 * (wc & 1);
            const f32x4 g0 = *(const f32x4*)(gain + d0), g1 = *(const f32x4*)(gain + d0 + 32);
            float inv[4];
#pragma unroll
            for (int e = 0; e < 4; ++e) inv[e] = rope_inv(8 * fq + 4 * (wc & 1) + e);
#pragma unroll
            for (int ai = 0; ai < 2; ++ai)
#pragma unroll
                for (int m = 0; m < 4; ++m) { const int r = 128 * ai + rl0 + 16 * m, t = t0 + r;
                    f32x4 cs = {1.f, 1.f, 1.f, 1.f}, sn = {0.f, 0.f, 0.f, 0.f};
                    if (latent) { const float pos = (float)((wc >> 1) == 0 ? (t >> 6) : (t & 63));
#pragma unroll
                        for (int e = 0; e < 4; ++e) { float c_, s_; sincos_rev(pos * inv[e], c_, s_); cs[e] = c_; sn[e] = s_; } }
#pragma unroll
                    for (int bj = 0; bj < 2; ++bj) { const f32x4 pp = *(const LAS f32x4*)&P[(r * 2 + bj) * 4];
                        const float rstd = __builtin_amdgcn_rsqf(((pp[0] + pp[1]) + (pp[2] + pp[3])) * (1.0f / 128.0f) + EPS);
                        const f32x4 x1 = acc[ai][bj][m][0] * rstd * g0, x2 = acc[ai][bj][m][1] * rstd * g1;
                        const f32x4 o1 = x1 * cs - x2 * sn, o2 = x2 * cs + x1 * sn;
                        const u32x4 w = pack8(o1, o2);
                        if (pn < 4) { *(u32x4*)(Q + (grow0 + r) * 1024 + 128 * (2 * pn + bj) + cw8) = w; }
                        else if (latent) { *(u32x4*)(KALL + ((size_t)(lb * 2 + bj) * SKV + t) * 128 + cw8) = w; }
                        else { const size_t o = ((size_t)(pm * 2 + bj) * 256 + t) * 128;
                            *(u32x4*)(KP + o + cw8) = w; *(f32x4*)(ock + o + d0) = o1; *(f32x4*)(ock + o + d0 + 32) = o2; } } }
        } else if (pn == 5) {
#pragma unroll
            for (int ai = 0; ai < 2; ++ai)
#pragma unroll
                for (int m = 0; m < 4; ++m) { const int r = 128 * ai + rl0 + 16 * m, t = t0 + r;
#pragma unroll
                    for (int bj = 0; bj < 2; ++bj) { const f32x4 a = acc[ai][bj][m][0], b = acc[ai][bj][m][1]; const u32x4 w = pack8(a, b);
                        if (latent) { *(u32x4*)(VALL + ((size_t)(lb * 2 + bj) * SKV + t) * 128 + cw8) = w; }
                        else { const size_t o = ((size_t)(pm * 2 + bj) * 256 + t) * 128 + cw8;
                            *(u32x4*)(VP + o) = w; *(f32x4*)(ocv + o) = a; *(f32x4*)(ocv + o + 4) = b; } } }
        } else if (pn <= 9) {
            const float sc = pn >= 8 ? 0.125f : 1.0f; bf16_t* dst = RQ + (pn >= 8 ? (WS_RK - WS_RQ) / 2 : 0); const int cb = 256 * ((pn - 6) & 1);
            const rsrc_t rd = mk_rsrc(dst + grow0 * 512, 256 * 512 * 2);
            float inv[4];
#pragma unroll
            for (int e = 0; e < 4; ++e) inv[e] = rope_inv(8 * fq + 4 * (wc & 1) + e);
#pragma unroll
            for (int ai = 0; ai < 2; ++ai)
#pragma unroll
                for (int m = 0; m < 4; ++m) { const int r = 128 * ai + rl0 + 16 * m, t = t0 + r; const float pos = (float)(latent ? PAST + t : t);
                    f32x4 cs, sn;
#pragma unroll
                    for (int e = 0; e < 4; ++e) { float c_, s_; sincos_rev(pos * inv[e], c_, s_); cs[e] = c_ * sc; sn[e] = s_ * sc; }
#pragma unroll
                    for (int bj = 0; bj < 2; ++bj) { const f32x4 x1 = acc[ai][bj][m][0], x2 = acc[ai][bj][m][1];
                        st16_wt(rd, (unsigned)(((r * 512) + cb + 128 * bj + cw8) * 2), pack8(x1 * cs - x2 * sn, x2 * cs + x1 * sn)); } }
        } else if (pn < 18) {
            const int kind = (pn - 10) >> 2; bf16_t* dst = RV + (size_t)kind * ((WS_SRG - WS_RV) / 2); const int cb = 256 * ((pn - 10) & 3);
            const rsrc_t rd = mk_rsrc(dst + grow0 * 1024, 256 * 1024 * 2);
#pragma unroll
            for (int ai = 0; ai < 2; ++ai)
#pragma unroll
                for (int m = 0; m < 4; ++m) { const int r = 128 * ai + rl0 + 16 * m;
#pragma unroll
                    for (int bj = 0; bj < 2; ++bj) { f32x4 a = acc[ai][bj][m][0], b = acc[ai][bj][m][1];
                        if (kind == 1) { _Pragma("unroll") for (int e = 0; e < 4; ++e) { a[e] = siluf_(a[e]); b[e] = siluf_(b[e]); } }
                        st16_wt(rd, (unsigned)(((r * 1024) + cb + 128 * bj + cw8) * 2), pack8(a, b)); } }
        } else {
            const int cb = 128 * (pn - 18);
            const rsrc_t rra = mk_rsrc(GA + grow0 * 1024, 256 * 1024 * 2), rrg = mk_rsrc(GR + grow0 * 1024, 256 * 1024 * 2);
#pragma unroll
            for (int ai = 0; ai < 2; ++ai)
#pragma unroll
                for (int m = 0; m < 4; ++m) { const int r = 128 * ai + rl0 + 16 * m; f32x4 q0, q1, g0, g1;
#pragma unroll
                    for (int e = 0; e < 4; ++e) { g0[e] = sigmoidf_(acc[ai][1][m][0][e]); g1[e] = sigmoidf_(acc[ai][1][m][1][e]);
                        q0[e] = sigmoidf_(acc[ai][0][m][0][e]) * __builtin_amdgcn_rcpf(fmaxf(g0[e], 1e-30f)); q1[e] = sigmoidf_(acc[ai][0][m][1][e]) * __builtin_amdgcn_rcpf(fmaxf(g1[e], 1e-30f)); }
                    const unsigned o = (unsigned)(((r * 1024) + cb + cw8) * 2);
                    st16_wt(rra, o, pack8(q0, q1)); st16_wt(rrg, o, pack8(g0, g1)); }
        }
        if (pn >= 8 && pn <= 13) {
            asm volatile("s_waitcnt vmcnt(0)" ::: "memory");
            RAW_BAR();
            if (wid == 0 && lane == 0) { __hip_atomic_fetch_add(c1 + 16 * (pm * 6 + pn - 8), 1u, RLX_AGENT); __hip_atomic_fetch_add(c1 + 16 * 480, 1u, RLX_AGENT); } }
    }
};

struct EpiMix {
    static constexpr int MID_T = 16;
    typedef NoPre Pre;
    __device__ __forceinline__ Pre pre(const pg8::Unit&, int, int, int, int, int, int) const { return Pre(); }
    const bf16_t *GA, *GR; bf16_t* Y; unsigned* done;
    __device__ __forceinline__ void mid(AccT& acc, const pg8::Unit& u, int wr, int wc, int fr, int fq) const {
        unsigned lo = (unsigned)(((64 * wr + fr) * 1024 + 32 * wc + 8 * fq) * 2); asm volatile("" : "+v"(lo));
        const char* ga = (const char*)GA + ((size_t)u.pm * 256 * 1024 + 256 * u.pn) * 2;
        u32x4 q[8][2];
#pragma unroll
        for (int k = 0; k < 8; ++k)
#pragma unroll
            for (int bj = 0; bj < 2; ++bj) q[k][bj] = *(const u32x4*)(ga + lo + (unsigned)((((128 * (k >> 2) + 16 * (k & 3)) * 1024) + 128 * bj) * 2));
#pragma unroll
        for (int k = 0; k < 8; ++k)
#pragma unroll
            for (int bj = 0; bj < 2; ++bj) { f32x4 a0, a1; unpack8(q[k][bj], a0, a1); acc[k >> 2][bj][k & 3][0] *= a0; acc[k >> 2][bj][k & 3][1] *= a1; }
    }
    __device__ __forceinline__ void epi(AccT& acc, const pg8::Unit& u, int wr, int wc, int fr, int fq, int wid, int lane, const Pre&) const {
        unsigned lo = (unsigned)(((64 * wr + fr) * 1024 + 32 * wc + 8 * fq) * 2); asm volatile("" : "+v"(lo));
        const size_t ub = ((size_t)u.pm * 256 * 1024 + 256 * u.pn) * 2; const char* gr = (const char*)GR + ub; const rsrc_t ry = mk_rsrc((char*)Y + ub, 256 * 1024 * 2);
        u32x4 q[8][2];
#pragma unroll
        for (int k = 0; k < 8; ++k)
#pragma unroll
            for (int bj = 0; bj < 2; ++bj) q[k][bj] = *(const u32x4*)(gr + lo + (unsigned)((((128 * (k >> 2) + 16 * (k & 3)) * 1024) + 128 * bj) * 2));
#pragma unroll
        for (int k = 0; k < 8; ++k)
#pragma unroll
            for (int bj = 0; bj < 2; ++bj) { f32x4 r0, r1; unpack8(q[k][bj], r0, r1);
                st16_wt(ry, lo + (unsigned)((((128 * (k >> 2) + 16 * (k & 3)) * 1024) + 128 * bj) * 2), pack8(acc[k >> 2][bj][k & 3][0] * r0, acc[k >> 2][bj][k & 3][1] * r1)); }
        asm volatile("s_waitcnt vmcnt(0)" ::: "memory");
        RAW_BAR();
        if (wid == 0 && lane == 0) __hip_atomic_fetch_add(done + 64 * u.pm, 1u, RLX_AGENT);
    }
};

struct EpiRes1 {
    static constexpr int MID_T = -1;
    typedef NoPre Pre;
    __device__ __forceinline__ Pre pre(const pg8::Unit&, int, int, int, int, int, int) const { return Pre(); }
    const float *xp, *xs, *modf, *g2n; bf16_t* X1B; float* ssq; bf16_t* A2;
    __device__ __forceinline__ void mid(AccT&, const pg8::Unit&, int, int, int, int) const {}
    __device__ __forceinline__ void epi(AccT& acc, const pg8::Unit& u, int wr, int wc, int fr, int fq, int wid, int lane, const Pre&) const {
        asm volatile("" : "+v"(fr), "+v"(fq));
        const int pm = u.pm, v = pm < 16 ? 0 : 1 + ((pm - 16) >> 4);
        const float* mv = modf + (size_t)v * 6144; const float* xsrc = pm < 16 ? xp + (size_t)pm * 256 * 1024 : xs + (size_t)(pm - 16) * 256 * 1024;
        const unsigned cb = (unsigned)(256 * u.pn + 32 * wc + 8 * fq), rb = (unsigned)(64 * wr + fr);
        {   f32x4 g1[2][2];
#pragma unroll
            for (int bj = 0; bj < 2; ++bj)
#pragma unroll
                for (int n = 0; n < 2; ++n) g1[bj][n] = *(const f32x4*)(mv + 2048 + cb + 128 * bj + 4 * n);
#pragma unroll
            for (int h = 0; h < 4; ++h) { f32x4 xv[2][2][2];
#pragma unroll
                for (int mm = 0; mm < 2; ++mm)
#pragma unroll
                    for (int bj = 0; bj < 2; ++bj) { const float* p = xsrc + (size_t)(128 * (h >> 1) + 16 * (2 * (h & 1) + mm) + rb) * 1024 + cb + 128 * bj; xv[mm][bj][0] = *(const f32x4*)p; xv[mm][bj][1] = *(const f32x4*)(p + 4); }
#pragma unroll
                for (int mm = 0; mm < 2; ++mm)
#pragma unroll
                    for (int bj = 0; bj < 2; ++bj) { const int ai = h >> 1, m = 2 * (h & 1) + mm;
                        acc[ai][bj][m][0] = xv[mm][bj][0] + g1[bj][0] * acc[ai][bj][m][0]; acc[ai][bj][m][1] = xv[mm][bj][1] + g1[bj][1] * acc[ai][bj][m][1]; }
                {   const int ai = h >> 1, m0 = 2 * (h & 1);
                    asm volatile("" : "+v"(acc[ai][0][m0][0]), "+v"(acc[ai][0][m0][1]), "+v"(acc[ai][1][m0][0]), "+v"(acc[ai][1][m0][1]),
                                      "+v"(acc[ai][0][m0 + 1][0]), "+v"(acc[ai][0][m0 + 1][1]), "+v"(acc[ai][1][m0 + 1][0]), "+v"(acc[ai][1][m0 + 1][1]) :: "memory"); } } }
        f32x4 w2[2][2];
#pragma unroll
        for (int bj = 0; bj < 2; ++bj)
#pragma unroll
            for (int n = 0; n < 2; ++n) { const unsigned c = cb + 128 * bj + 4 * n; w2[bj][n] = *(const f32x4*)(g2n + c) * (*(const f32x4*)(mv + 4096 + c) + 1.0f); }
        const rsrc_t rx = mk_rsrc(X1B + (size_t)pm * 256 * 1024, 256 * 1024 * 2), ra = mk_rsrc(A2 + (size_t)pm * 256 * 1024, 256 * 1024 * 2);
#pragma unroll
        for (int ai = 0; ai < 2; ++ai)
#pragma unroll
            for (int m = 0; m < 4; ++m) { const unsigned r = 128 * ai + 16 * m + rb; float s = 0.f;
#pragma unroll
                for (int bj = 0; bj < 2; ++bj) { const unsigned o = r * 1024 + cb + 128 * bj; const f32x4 x0 = acc[ai][bj][m][0], x1 = acc[ai][bj][m][1];
                    st16_wt(rx, o * 2u, pack8(x0, x1));
                    st16_wt(ra, o * 2u, pack8(x0 * w2[bj][0], x1 * w2[bj][1]));
                    s += (x0[0] * x0[0] + x0[1] * x0[1]) + (x0[2] * x0[2] + x0[3] * x0[3]) + (x1[0] * x1[0] + x1[1] * x1[1]) + (x1[2] * x1[2] + x1[3] * x1[3]); }
                s += __shfl_xor(s, 16); s += __shfl_xor(s, 32);
                if (fq == 0) atomicAdd(ssq + (size_t)pm * 256 + r, s); }
    }
};

struct EpiRes2 {
    static constexpr int MID_T = -1;
    typedef NoPre Pre;
    __device__ __forceinline__ Pre pre(const pg8::Unit&, int, int, int, int, int, int) const { return Pre(); }
    const float *mod, *fg; const bf16_t* X1B; float* X; float* XS; unsigned* xcnt; LAS float* P;
    __device__ __forceinline__ void mid(AccT&, const pg8::Unit&, int, int, int, int) const {}
    __device__ __forceinline__ void epi(AccT& acc, const pg8::Unit& u, int wr, int wc, int fr, int fq, int wid, int lane, const Pre&) const {
        asm volatile("" : "+v"(fr), "+v"(fq));
        const int pm = u.pm, v = pm < 16 ? 0 : 1 + ((pm - 16) >> 4); const float* mv = mod + (size_t)v * 6144;
        const int cb = 256 * u.pn + 32 * wc + 8 * fq;
        {   f32x4 g2[2][2]; u32x4 xq[8][2];
#pragma unroll
            for (int bj = 0; bj < 2; ++bj)
#pragma unroll
                for (int n = 0; n < 2; ++n) g2[bj][n] = *(const f32x4*)(mv + 5120 + cb + 128 * bj + 4 * n);
#pragma unroll
            for (int k = 0; k < 8; ++k)
#pragma unroll
                for (int bj = 0; bj < 2; ++bj) xq[k][bj] = *(const u32x4*)(X1B + ((size_t)pm * 256 + 128 * (k >> 2) + 64 * wr + 16 * (k & 3) + fr) * 1024 + cb + 128 * bj);
#pragma unroll
            for (int k = 0; k < 8; ++k) { const int ai = k >> 2, m = k & 3, r = 128 * ai + 64 * wr + 16 * m + fr; float s = 0.f;
#pragma unroll
                for (int bj = 0; bj < 2; ++bj) { f32x4 xa, xb; unpack8(xq[k][bj], xa, xb);
                    const f32x4 x0 = xa + g2[bj][0] * acc[ai][bj][m][0], x1 = xb + g2[bj][1] * acc[ai][bj][m][1];
                    acc[ai][bj][m][0] = x0; acc[ai][bj][m][1] = x1;
                    s += (x0[0] * x0[0] + x0[1] * x0[1]) + (x0[2] * x0[2] + x0[3] * x0[3]) + (x1[0] * x1[0] + x1[1] * x1[1]) + (x1[2] * x1[2] + x1[3] * x1[3]); }
                s += __shfl_xor(s, 16); s += __shfl_xor(s, 32);
                if (fq == 0) P[r * 4 + wc] = s; } }
        RAW_BAR();
        const int tid = wid * 64 + lane;
        if (wid < 4) { const f32x4 pp = *(const LAS f32x4*)&P[tid * 4];
            __hip_atomic_store(XS + ((size_t)pm * 4 + u.pn) * 256 + tid, (pp[0] + pp[1]) + (pp[2] + pp[3]), RLX_AGENT);
            asm volatile("s_waitcnt vmcnt(0)" ::: "memory");
            if (lane == 0) __hip_atomic_fetch_add(xcnt + 64 * pm, 1u, RLX_AGENT); }
        if (wid == 0) { unsigned sp = 0;
            while ((unsigned)__builtin_amdgcn_readfirstlane(__hip_atomic_load(xcnt + 64 * pm, RLX_AGENT)) < 16u) { __builtin_amdgcn_s_sleep(2); if (++sp > (1u << 22)) break; } }
        RAW_BAR();
        if (wid < 4) { float t = 0.f;
#pragma unroll
            for (int k = 0; k < 4; ++k) t += __hip_atomic_load(XS + ((size_t)pm * 4 + k) * 256 + tid, RLX_AGENT);
            P[1024 + tid] = 1.0f / sqrtf(t * (1.0f / 1024.0f) + EPS); }
        RAW_BAR();
        {   f32x4 fgv[2][2];
#pragma unroll
            for (int bj = 0; bj < 2; ++bj)
#pragma unroll
                for (int n = 0; n < 2; ++n) fgv[bj][n] = *(const f32x4*)(fg + cb + 128 * bj + 4 * n);
#pragma unroll
            for (int ai = 0; ai < 2; ++ai)
#pragma unroll
                for (int m = 0; m < 4; ++m) { const int r = 128 * ai + 64 * wr + 16 * m + fr;
                    const float rs = P[1024 + r];
#pragma unroll
                    for (int bj = 0; bj < 2; ++bj) { float* p = X + ((size_t)pm * 256 + r) * 1024 + cb + 128 * bj;
                        *(f32x4*)p = acc[ai][bj][m][0] * rs * fgv[bj][0]; *(f32x4*)(p + 4) = acc[ai][bj][m][1] * rs * fgv[bj][1]; } } }
    }
};

__device__ __forceinline__ float dpp_up(float cur, float old) {
    return __builtin_bit_cast(float, __builtin_amdgcn_update_dpp(__builtin_bit_cast(int, old), __builtin_bit_cast(int, cur), 0x111, 0xF, 0xF, false)); }
__device__ __forceinline__ float dpp_dn(float cur, float old) {
    return __builtin_bit_cast(float, __builtin_amdgcn_update_dpp(__builtin_bit_cast(int, old), __builtin_bit_cast(int, cur), 0x101, 0xF, 0xF, false)); }
__device__ __forceinline__ float dpp_ror1(float x) {
    return __builtin_bit_cast(float, __builtin_amdgcn_update_dpp(0, __builtin_bit_cast(int, x), 0x121, 0xF, 0xF, false)); }
__device__ __forceinline__ float dpp_rol1(float x) {
    return __builtin_bit_cast(float, __builtin_amdgcn_update_dpp(0, __builtin_bit_cast(int, x), 0x12F, 0xF, 0xF, false)); }
struct EpiConv {
    static constexpr int MID_T = -1;
    const float *ssq, *bup, *cw, *cbias; bf16_t* ACT; float *EU, *EUC; LAS float* E; unsigned* done;
    struct Pre { float ss[8]; f32x4 bb[2][2]; float cwv[4]; };
    __device__ __forceinline__ void mid(AccT&, const pg8::Unit&, int, int, int, int) const {}
    __device__ __forceinline__ Pre pre(const pg8::Unit& u, int wr, int wc, int fr, int fq, int wid, int lane) const {
        Pre p; const int pm = u.pm, pn = u.pn, v = pm < 16 ? 0 : 1 + ((pm - 16) >> 4);
        const float* sp = ssq + (size_t)pm * 256 + 64 * wr + fr; const float* bp = bup + (size_t)v * NUP + 256 * pn + 32 * wc + 8 * fq;
#pragma unroll
        for (int k = 0; k < 8; ++k) p.ss[k] = sp[128 * (k >> 2) + 16 * (k & 3)];
#pragma unroll
        for (int bj = 0; bj < 2; ++bj)
#pragma unroll
            for (int n = 0; n < 2; ++n) p.bb[bj][n] = *(const f32x4*)(bp + 128 * bj + 4 * n);
        const int t = wid * 64 + lane, tc = t & 255, ch = (tc < 128 ? 0 : DFF - 128) + 128 * pn + tc;
        p.cwv[0] = cw[ch]; p.cwv[1] = cw[NUP + ch]; p.cwv[2] = cw[2 * NUP + ch]; p.cwv[3] = cbias[ch];
        return p;
    }
    __device__ __forceinline__ void epi(AccT& acc, const pg8::Unit& u, int wr, int wc, int fr, int fq, int wid, int lane, const Pre& pf) const {
        const int pm = u.pm, pn = u.pn; const bool latent = pm >= 16;
#if defined(PROBE_K0) && PROBE_K0 == 400
        const unsigned long long te0_ = __builtin_amdgcn_s_memrealtime();
#endif
        unsigned cw8 = (unsigned)(32 * wc + 8 * fq), rl = (unsigned)(64 * wr + fr); asm volatile("" : "+v"(cw8), "+v"(rl));
        LAS float* CW = E + 2048;
        {   const int t = wid * 64 + lane;
            if (t < 256) { CW[t] = pf.cwv[0]; CW[256 + t] = pf.cwv[1]; CW[512 + t] = pf.cwv[2]; CW[768 + t] = pf.cwv[3]; } }
#pragma unroll
        for (int ai = 0; ai < 2; ++ai)
#pragma unroll
            for (int m = 0; m < 4; ++m) { const float rs = __builtin_amdgcn_rsqf(pf.ss[4 * ai + m] * (1.0f / 1024.0f) + EPS);
#pragma unroll
                for (int bj = 0; bj < 2; ++bj)
#pragma unroll
                    for (int n = 0; n < 2; ++n) acc[ai][bj][m][n] = acc[ai][bj][m][n] * rs + pf.bb[bj][n]; }
        PINACC(acc);
        const rsrc_t reu = mk_rsrc(EU + (size_t)pm * 2 * NUP + 256 * pn, (NUP + 256) * 4), reuc = mk_rsrc(EUC + (size_t)pm * 2 * NUP + 256 * pn, (NUP + 256) * 4);
#pragma unroll
        for (int ai = 0; ai < 2; ++ai)
#pragma unroll
            for (int bj = 0; bj < 2; ++bj)
#pragma unroll
                for (int n = 0; n < 2; ++n) { const unsigned ci = 128 * bj + cw8 + 4 * n; const int grp = 2 * ai + wr;
                    if (fr == 0) { *(LAS f32x4*)&E[(grp * 2 + 0) * 256 + ci] = acc[ai][bj][0][n]; if (latent && grp == 0) st16_wt(reu, ci * 4u, acc[ai][bj][0][n]); }
                    if (fr == 15) { *(LAS f32x4*)&E[(grp * 2 + 1) * 256 + ci] = acc[ai][bj][3][n]; if (latent && grp == 3) st16_wt(reu, (NUP + ci) * 4u, acc[ai][bj][3][n]); } }
        RAW_BAR();
#if defined(PROBE_K0) && PROBE_K0 == 400 && defined(PROBE_SUB) && PROBE_SUB == 1
        if (wid == 0 && lane == 0 && (int)__builtin_amdgcn_workgroup_id_x() == PROBE_BID) atomicAdd((float*)((char*)EU - WS_EDGE_U + 32768), (float)(__builtin_amdgcn_s_memrealtime() - te0_));
#endif
        const rsrc_t ract = mk_rsrc((char*)ACT + ((size_t)pm * 256 * DFF + 128 * pn) * 2, 256 * DFF * 2);
#pragma unroll
        for (int ai = 0; ai < 2; ++ai) { const int grp = 2 * ai + wr;
#pragma unroll
            for (int n = 0; n < 2; ++n)
#pragma unroll
                for (int bj = 0; bj < 2; ++bj) { const unsigned ci = 128 * bj + cw8 + 4 * n;
                    const f32x4 w0 = *(const LAS f32x4*)&CW[ci], w1 = *(const LAS f32x4*)&CW[256 + ci], w2 = *(const LAS f32x4*)&CW[512 + ci], cb = *(const LAS f32x4*)&CW[768 + ci];
                    f32x4 pe = {0.f, 0.f, 0.f, 0.f}, ne = {0.f, 0.f, 0.f, 0.f};
                    if (grp > 0) pe = *(const LAS f32x4*)&E[((grp - 1) * 2 + 1) * 256 + ci];
                    if (grp < 3) ne = *(const LAS f32x4*)&E[((grp + 1) * 2 + 0) * 256 + ci];
#pragma unroll
                    for (int e = 0; e < 4; ++e) { const float u0 = acc[ai][bj][0][n][e], u1 = acc[ai][bj][1][n][e], u2 = acc[ai][bj][2][n][e], u3 = acc[ai][bj][3][n][e];
                        const float p0 = dpp_up(u0, pe[e]), p1 = dpp_up(u1, dpp_ror1(u0)), p2 = dpp_up(u2, dpp_ror1(u1)), p3 = dpp_up(u3, dpp_ror1(u2));
                        const float n0 = dpp_dn(u0, dpp_rol1(u1)), n1 = dpp_dn(u1, dpp_rol1(u2)), n2 = dpp_dn(u2, dpp_rol1(u3)), n3 = dpp_dn(u3, ne[e]);
                        acc[ai][bj][0][n][e] = w0[e] * p0 + w1[e] * u0 + w2[e] * n0 + cb[e]; acc[ai][bj][1][n][e] = w0[e] * p1 + w1[e] * u1 + w2[e] * n1 + cb[e];
                        acc[ai][bj][2][n][e] = w0[e] * p2 + w1[e] * u2 + w2[e] * n2 + cb[e]; acc[ai][bj][3][n][e] = w0[e] * p3 + w1[e] * u3 + w2[e] * n3 + cb[e]; }
                    if (latent) { if (fr == 0 && grp == 0) st16_wt(reuc, ci * 4u, acc[ai][bj][0][n]);
                                  if (fr == 15 && grp == 3) st16_wt(reuc, (NUP + ci) * 4u, acc[ai][bj][3][n]); }
                    asm volatile("" : "+v"(acc[ai][bj][0][n]), "+v"(acc[ai][bj][1][n]), "+v"(acc[ai][bj][2][n]), "+v"(acc[ai][bj][3][n]) :: "memory"); }
#pragma unroll
            for (int m = 0; m < 4; ++m) { f32x4 o0, o1;
#pragma unroll
                for (int e = 0; e < 4; ++e) { o0[e] = siluf_(acc[ai][1][m][0][e]) * acc[ai][0][m][0][e]; o1[e] = siluf_(acc[ai][1][m][1][e]) * acc[ai][0][m][1][e]; }
                st16_wt(ract, ((rl + 128 * ai + 16 * m) * DFF + cw8) * 2u, pack8(o0, o1)); asm volatile("" ::: "memory"); } }
#if defined(PROBE_K0) && PROBE_K0 == 400 && !defined(PROBE_SUB)
        if (wid == 0 && lane == 0 && (int)__builtin_amdgcn_workgroup_id_x() == PROBE_BID) atomicAdd((float*)((char*)EU - WS_EDGE_U + 32768), (float)(__builtin_amdgcn_s_memrealtime() - te0_));
#endif
    }
};

constexpr int NWAVES = 8, NTHR = 512;
constexpr int RING_BYTES = 131072, SPARE_OFF = RING_BYTES, SPARE_BYTES = 16384, MISC_OFF = SPARE_OFF + SPARE_BYTES, LDS_BYTES = MISC_OFF + 256;
struct Args {
    const float *x_prompt, *x_sample, *c, *cache_k, *cache_v, *st_f, *st_b, *c_ctx, *norm1_g, *norm2_g, *w_mod, *b_mod, *w_in, *q_g, *k_g, *dec_f, *dec_b,
                *w_att_o, *w_ret_o, *w_out, *w_up, *conv_w, *conv_b, *w_down, *final_g;
    float* out; unsigned char* ws; int ph_lo, ph_hi;
};
struct Frame { LAS unsigned char* lds; int tid, lane, wave, G, bid; };
typedef const __attribute__((address_space(4))) Args CArgs;

template <class F> __device__ __forceinline__ void transpose_item(const float* W, int ldw, bf16_t* WT, int ldd, int kofs, int k0, int n0, F srccol, LAS float* scr, int lane) {
    const int sc = srccol(n0 + (lane & 31));
#pragma unroll 8
    for (int i = 0; i < 32; ++i) { const int kk = 2 * i + (lane >> 5); scr[kk * 33 + (lane & 31)] = __builtin_nontemporal_load(W + (size_t)(k0 + kk) * ldw + sc); }
    LDS_WAIT(); asm volatile("" ::: "memory");
    const int c = lane & 7;
#pragma unroll
    for (int j = 0; j < 4; ++j) { const int n = (lane >> 3) + 8 * j; const LAS float* s = scr + (8 * c) * 33 + n;
        u32x4 o; o.x = pk2(s[0 * 33], s[1 * 33]); o.y = pk2(s[2 * 33], s[3 * 33]); o.z = pk2(s[4 * 33], s[5 * 33]); o.w = pk2(s[6 * 33], s[7 * 33]);
        *(u32x4*)(WT + (size_t)(n0 + n) * ldd + kofs + k0 + 8 * c) = o; }
    LDS_WAIT(); asm volatile("" ::: "memory");
}
struct ColId { __device__ int operator()(int n) const { return n; } };
struct ColIn { __device__ int operator()(int n) const {
    if (n >= 4608) { const int t = (n - 4608) >> 8, j = (n - 4608) & 255; return j < 128 ? 4608 + 128 * t + j : 5632 + 128 * t + (j - 128); }
    return (n < 1280 || (n >= 1536 && n < 2560)) ? swap25(n) : n; } };
struct ColUp { __device__ int operator()(int n) const { const int t = n >> 8, j = n & 255; return j < 128 ? 128 * t + j : DFF + 128 * t + (j - 128); } };

template <class F> __device__ __forceinline__ void gemv5_item(const Frame& F_, const float* W, int ldw, int n0, int k0, F srccol, const LAS float* a, LAS float* red, const float* bias, float* out, int ldo) {
    const int col0 = srccol(n0 + F_.lane), col1 = srccol(n0 + 64 + F_.lane); float acc[5][2];
#pragma unroll
    for (int v = 0; v < 5; ++v) { acc[v][0] = 0.f; acc[v][1] = 0.f; }
    const int kb = F_.wave * 32;
    const float* wp = W + (size_t)(k0 + kb) * ldw;
    float w0[32], w1[32];
#pragma unroll
    for (int j = 0; j < 32; ++j) { w0[j] = __builtin_nontemporal_load(wp + col0); w1[j] = __builtin_nontemporal_load(wp + col1); wp += ldw; }
#pragma unroll
    for (int j = 0; j < 32; ++j)
#pragma unroll
        for (int v = 0; v < 5; ++v) { const float av = a[v * 256 + kb + j]; acc[v][0] += av * w0[j]; acc[v][1] += av * w1[j]; }
#pragma unroll
    for (int v = 0; v < 5; ++v) { red[(F_.wave * 5 + v) * 128 + F_.lane] = acc[v][0]; red[(F_.wave * 5 + v) * 128 + 64 + F_.lane] = acc[v][1]; }
    __syncthreads();
    for (int t = F_.tid; t < 640; t += NTHR) { const int v = t >> 7, l = t & 127; float sum = (bias && k0 == 0) ? bias[n0 + l] : 0.f;
#pragma unroll
        for (int w8 = 0; w8 < 8; ++w8) sum += red[(w8 * 5 + v) * 128 + l];
        out[((size_t)(k0 >> 8) * 5 + v) * ldo + n0 + l] = sum; }
    __syncthreads();
}

__device__ __forceinline__ void phase0(const Frame& F, CArgs& A) {
    unsigned char* ws = A.ws;
    for (int it = F.bid; it < 48 * 4; it += F.G) {
        const int cgp = it % 48, kq = it / 48;
        LAS float* a = (LAS float*)F.lds; LAS float* red = a + 5 * 256;
        for (int i = F.tid; i < 5 * 256; i += NTHR) { const int v = i >> 8, k = kq * 256 + (i & 255); const float cv = v == 0 ? A.c_ctx[k] : A.c[(v - 1) * 1024 + k]; a[i] = siluf_(cv); }
        __syncthreads();
        gemv5_item(F, A.w_mod, 6144, cgp * 128, kq * 256, ColId(), a, red, A.b_mod, (float*)(ws + WS_MOD), 6144);
    }
    LAS float* scr = (LAS float*)(F.lds + 32768 + F.wave * 8704);
    const int gw = ((F.bid + 128) % F.G) * NWAVES + F.wave, NGW = F.G * NWAVES;
    constexpr int I_IN = 16 * (DIN / 32);
    for (int it = gw; it < I_IN; it += NGW) transpose_item(A.w_in, DIN, (bf16_t*)(ws + WS_WA), 1024, 0, 64 * (it / (DIN / 32)), 32 * (it % (DIN / 32)), ColIn(), scr, F.lane);
    const int gt = F.bid * NTHR + F.tid, NGT = F.G * NTHR;
    for (int i = gt; i < DB * NKV * PAST * 16; i += NGT) { const int c8 = i & 15, row = i >> 4, t = row % PAST, bk = row / PAST;
        const size_t so = (size_t)row * 128, dofs = ((size_t)bk * SKV + DSEQ + t) * 128 + c8 * 8;
        f32x4 k0, k1; { const int p0 = c8 * 8, d0 = swap25(p0), d1 = swap25(p0 + 4); k0 = *(const f32x4*)(A.cache_k + so + d0); k1 = *(const f32x4*)(A.cache_k + so + d1); }
        *(u32x4*)((bf16_t*)(ws + WS_KALL) + dofs) = pack8(k0, k1);
        const f32x4 v0 = *(const f32x4*)(A.cache_v + so + c8 * 8), v1 = *(const f32x4*)(A.cache_v + so + c8 * 8 + 4);
        *(u32x4*)((bf16_t*)(ws + WS_VALL) + dofs) = pack8(v0, v1); }
    for (int i = gt; i < MT; i += NGT) ((float*)(ws + WS_SSQ1))[i] = 0.f;
    for (int i = gt; i < 322 * 64; i += NGT) ((unsigned*)(ws + WS_CNT))[i] = 0u;
    for (int i = gt; i < (481 + 81) * 16; i += NGT) ((unsigned*)(ws + WS_CNT1))[i] = 0u;
#if defined(PROBE_K0) && PROBE_K0 == 400
    if (gt == 0) *(float*)(ws + 32768) = 0.f;
#endif
}

__device__ __forceinline__ void phase1(const Frame& F, CArgs& A) {
    unsigned char* ws = A.ws; const float* mod = (const float*)(ws + WS_MOD);
    for (int it = F.bid; it < (NUP / 128) * 4; it += F.G) {
        const int cgp = it % (NUP / 128), kq = it / (NUP / 128);
        LAS float* a = (LAS float*)F.lds; LAS float* red = a + 5 * 256;
        for (int i = F.tid; i < 5 * 256; i += NTHR) { const float* p = mod + (size_t)(i >> 8) * 6144 + 3072 + kq * 256 + (i & 255); a[i] = (p[0] + p[MODQ]) + (p[2 * MODQ] + p[3 * MODQ]); }
        __syncthreads();
        gemv5_item(F, A.w_up, NUP, cgp * 128, kq * 256, ColUp(), a, red, nullptr, (float*)(ws + WS_BUP), NUP);
    }
    for (int i = F.bid * NTHR + F.tid; i < 5 * 6144; i += F.G * NTHR) ((float*)(ws + WS_MODF))[i] = (mod[i] + mod[i + MODQ]) + (mod[i + 2 * MODQ] + mod[i + 3 * MODQ]);
    bf16_t* H = (bf16_t*)(ws + WS_H);
    constexpr int RPW = MT / (256 * NWAVES);
    const int row0 = (F.bid * NWAVES + F.wave) * RPW;
    int vcur = -1; f32x4 w1[4], s1[4];
#pragma unroll 1
    for (int rb = row0; rb < row0 + RPW; rb += 5) {
        f32x4 x[5][4];
#pragma unroll
        for (int i = 0; i < 5; ++i) { const int r = rb + i; const float* xr = r < MP ? A.x_prompt + (size_t)r * 1024 : A.x_sample + (size_t)(r - MP) * 1024;
#pragma unroll
            for (int j = 0; j < 4; ++j) x[i][j] = __builtin_nontemporal_load((const f32x4*)(xr + 8 * F.lane + 4 * (j & 1) + 512 * (j >> 1))); }
#pragma unroll
        for (int i = 0; i < 5; ++i) { const int r = rb + i;
            const int v = r < MP ? 0 : 1 + (r - MP) / DSEQ;
            if (v != vcur) { vcur = v; const float* mv = mod + (size_t)v * 6144;
#pragma unroll
                for (int j = 0; j < 4; ++j) { const int k = 8 * F.lane + 4 * (j & 1) + 512 * (j >> 1); w1[j] = *(const f32x4*)(A.norm1_g + k) * (sum4q(mv + 1024 + k, MODQ) + 1.0f); s1[j] = sum4q(mv + k, MODQ); } }
            float s = 0.f;
#pragma unroll
            for (int j = 0; j < 4; ++j) s += (x[i][j][0] * x[i][j][0] + x[i][j][1] * x[i][j][1]) + (x[i][j][2] * x[i][j][2] + x[i][j][3] * x[i][j][3]);
            const float rstd = __builtin_amdgcn_rsqf(wave_sum(s) * (1.0f / 1024.0f) + EPS);
#pragma unroll
            for (int jj = 0; jj < 2; ++jj) { const f32x4 h0 = x[i][2 * jj] * rstd * w1[2 * jj] + s1[2 * jj], h1 = x[i][2 * jj + 1] * rstd * w1[2 * jj + 1] + s1[2 * jj + 1];
                *(u32x4*)(H + (size_t)r * 1024 + 8 * F.lane + 512 * jj) = pack8(h0, h1); } }
    }
}

__device__ __forceinline__ float log_sigmoid_(float x) { return -log1pf(__expf(-x)); }
__device__ __forceinline__ s16x4 tr_read16(const LAS bf16_t* p) { typedef short v4s __attribute__((ext_vector_type(4))); return __builtin_bit_cast(s16x4, __builtin_amdgcn_ds_read_tr16_b64_v4i16((LAS v4s*)p)); }
#define MK8(L, H) (bf16x8){L[0], L[1], L[2], L[3], H[0], H[1], H[2], H[3]}
constexpr int KLD = 72, VLD = 136;
__device__ __forceinline__ int vsw(int r, int c8) { return 256 * r + 16 * (c8 ^ (((r & 3) << 1) | (((r >> 3) & 1) << 3))); }
__device__ __forceinline__ int vsw_tr(int R, int col) { return vsw(R, col >> 3) + 2 * (col & 7); }

__device__ const unsigned char R1_PORD[80] = {0, 1, 2, 3, 4, 5, 6, 7, 12, 13, 14, 15, 16, 17, 18, 19, 28, 29, 30, 31, 32, 33, 34, 35, 40, 41, 42, 43, 44, 45, 46, 47, 52, 53, 54, 55, 56, 57, 58, 59, 68, 69, 70, 71, 72, 73, 74, 75,
    8, 9, 10, 11, 20, 21, 22, 23, 24, 25, 26, 27, 36, 37, 38, 39, 48, 49, 50, 51, 60, 61, 62, 63, 64, 65, 66, 67, 76, 77, 78, 79};
__device__ __forceinline__ int r1_item_of(int i) { return (int)R1_PORD[i >> 4] * 16 + (i & 15); }
__device__ __forceinline__ void spin_ge(unsigned* p, unsigned need) { unsigned sp = 0;
    while ((unsigned)__builtin_amdgcn_readfirstlane(__hip_atomic_load(p, RLX_AGENT)) < need) { __builtin_amdgcn_s_sleep(2); if (++sp > (1u << 22)) break; } }
__device__ __forceinline__ void r1_wait(const Frame& F, unsigned* c1, int item, volatile LAS unsigned* alld) {
    if (F.wave == 0 && *alld == 0u) { const int pm = item >> 4, h = item & 7;
        const bool all = (unsigned)__builtin_amdgcn_readfirstlane(__hip_atomic_load(c1 + 16 * 480, RLX_AGENT)) >= 480u
                      && (unsigned)__builtin_amdgcn_readfirstlane(__hip_atomic_load(c1 + 16 * (481 + 80), RLX_AGENT)) >= 2080u;
        spin_ge(c1 + 16 * (pm * 6 + (h >> 2)), 1u); spin_ge(c1 + 16 * (pm * 6 + 2 + (h >> 1)), 1u);
        spin_ge(c1 + 16 * (481 + pm), 26u);
        __builtin_amdgcn_fence(__ATOMIC_ACQUIRE, "agent"); asm volatile("s_waitcnt vmcnt(0)" ::: "memory");
        if (all) *alld = 1u; }
    __syncthreads();
}
__device__ __forceinline__ void phase_r1(const Frame& F, CArgs& A) {
    unsigned char* ws = A.ws; unsigned* c1 = (unsigned*)(ws + WS_CNT1);
    volatile LAS unsigned* alld = (volatile LAS unsigned*)(F.lds + MISC_OFF) + 17;
    if (F.tid == 0) *alld = 0u;
    __syncthreads();
    const bf16_t* RKb = (const bf16_t*)(ws + WS_RK); const bf16_t* RVb = (const bf16_t*)(ws + WS_RV); bf16_t* KVS = (bf16_t*)(ws + WS_H);
    LAS bf16_t* kf = (LAS bf16_t*)F.lds; LAS bf16_t* kb = kf + 128 * KLD; LAS bf16_t* vl = kb + 128 * KLD; LAS bf16_t* ol = vl + 128 * 128 + F.wave * (16 * VLD);
    u32x4 pk_[2], pv_[4];
#define R1_LOAD(it) do { const int cg_ = (it) >> 3, h_ = (it) & 7; const size_t r0_ = (size_t)cg_ * 128; \
        _Pragma("unroll") for (int i = 0; i < 2; ++i) { const int ci = F.tid + i * NTHR; pk_[i] = *(const u32x4*)(RKb + (r0_ + (ci >> 3)) * 512 + 64 * h_ + 8 * (ci & 7)); } \
        _Pragma("unroll") for (int i = 0; i < 4; ++i) { const int ci = F.tid + i * NTHR; pv_[i] = *(const u32x4*)(RVb + (r0_ + (ci >> 4)) * 1024 + 128 * h_ + 8 * (ci & 15)); } } while (0)
    const int n1 = F.bid >= 32 ? (768 - (F.bid - 32) + 223) / 224 : 0, cntp = n1 + 2;
#define R1_POS(n) ((n) < n1 ? (F.bid - 32) + 224 * (n) : 768 + F.bid + 256 * ((n) - n1))
    { r1_wait(F, c1, r1_item_of(R1_POS(0)), alld); R1_LOAD(r1_item_of(R1_POS(0))); }
    for (int n = 0; n < cntp; ++n) { const int item = r1_item_of(R1_POS(n));
        const int h = item & 7;
        const float lgf = log_sigmoid_(A.dec_f[h]) * 1.4426950408889634f, lgb = log_sigmoid_(A.dec_b[h]) * 1.4426950408889634f;
#pragma unroll
        for (int i = 0; i < 2; ++i) { const int ci = F.tid + i * NTHR, j = ci >> 3, c8 = ci & 7;
            f32x4 a, b; unpack8(pk_[i], a, b);
            const float df = __builtin_amdgcn_exp2f(lgf * (float)(127 - j)), db = __builtin_amdgcn_exp2f(lgb * (float)j);
            *(LAS u32x4*)(kf + j * KLD + 8 * c8) = pack8(a * df, b * df); *(LAS u32x4*)(kb + j * KLD + 8 * c8) = pack8(a * db, b * db); }
#pragma unroll
        for (int i = 0; i < 4; ++i) { const int ci = F.tid + i * NTHR, j = ci >> 4, c8 = ci & 15; *(LAS u32x4*)((LAS char*)vl + vsw(j, c8)) = pv_[i]; }
        __syncthreads();
        if (n + 1 < cntp) { r1_wait(F, c1, r1_item_of(R1_POS(n + 1)), alld); R1_LOAD(r1_item_of(R1_POS(n + 1))); }
        const int dir = F.wave >> 2, mt = F.wave & 3, g = F.lane >> 4, q = (F.lane & 15) >> 2, p = F.lane & 3, l15 = F.lane & 15;
        const LAS bf16_t* ks = dir ? kb : kf;
        bf16x8 af[4];
#pragma unroll
        for (int s = 0; s < 4; ++s) { const LAS bf16_t* ap = ks + (32 * s + 8 * g + q) * KLD + 16 * mt + 4 * p; const s16x4 lo = tr_read16(ap), hi = tr_read16(ap + 4 * KLD); af[s] = MK8(lo, hi); }
#pragma unroll
        for (int nt = 0; nt < 8; ++nt) { f32x4 acc = {0.f, 0.f, 0.f, 0.f};
#pragma unroll
            for (int s = 0; s < 4; ++s) { const int R0 = 32 * s + 8 * g + q, col = 16 * nt + 4 * p;
                const s16x4 lo = tr_read16((const LAS bf16_t*)((const LAS char*)vl + vsw_tr(R0, col))), hi = tr_read16((const LAS bf16_t*)((const LAS char*)vl + vsw_tr(R0 + 4, col)));
                acc = __builtin_amdgcn_mfma_f32_16x16x32_bf16(af[s], MK8(lo, hi), acc, 0, 0, 0); }
#pragma unroll
            for (int e = 0; e < 4; ++e) ol[(4 * g + e) * VLD + 16 * nt + l15] = (bf16_t)f2bf(acc[e]); }
        LDS_WAIT(); asm volatile("" ::: "memory");
        bf16_t* dst = KVS + ((size_t)item * 2 + dir) * (64 * 128) + (size_t)(16 * mt + (F.lane >> 2)) * 128 + (F.lane & 3) * 32;
#pragma unroll
        for (int c = 0; c < 4; ++c) *(u32x4*)(dst + 8 * c) = *(const LAS u32x4*)(ol + (F.lane >> 2) * VLD + (F.lane & 3) * 32 + 8 * c);
        __syncthreads();
    }
#undef R1_LOAD
#undef R1_POS
}

__device__ __forceinline__ void phase_scan(const Frame& F, CArgs& A) {
    bf16_t* KVS = (bf16_t*)(A.ws + WS_H);
    const int gt = F.bid * NTHR + F.tid, NGT = F.G * NTHR;
    for (int i = gt; i < 5 * NUP; i += NGT) { const float* p = (const float*)(A.ws + WS_BUP) + i; ((float*)(A.ws + WS_BUPF))[i] = (p[0] + p[BUPQ]) + (p[2 * BUPQ] + p[3 * BUPQ]); }
    constexpr size_t CST = (size_t)8 * 2 * 8192;
    if (NGT * 4 == 256 * 2048) {
        u32x2 kv[4][2]; bf16_t* basep[4]; float decp[4];
#pragma unroll
        for (int k = 0; k < 4; ++k) { const int w = gt + k * NGT, e4 = (w & 2047) * 4, chain = w >> 11, dir = chain & 1, h = (chain >> 1) & 7, sq = chain >> 4;
            decp[k] = __expf(log_sigmoid_((dir ? A.dec_b : A.dec_f)[h]) * 128.0f);
            basep[k] = KVS + ((size_t)(2 * sq * 8 + h) * 2 + dir) * 8192 + e4;
            kv[k][0] = *(const u32x2*)(basep[k] + (size_t)(dir ? 1 : 0) * CST); kv[k][1] = *(const u32x2*)(basep[k] + (size_t)(dir ? 0 : 1) * CST); }
#pragma unroll
        for (int k = 0; k < 4; ++k) { const int w = gt + k * NGT, e4 = (w & 2047) * 4, chain = w >> 11, dir = chain & 1, h = (chain >> 1) & 7, sq = chain >> 4;
            const int pr = e4 >> 7, dv = e4 & 127, lr = swap25(pr);
            f32x4 st = {0.f, 0.f, 0.f, 0.f};
#pragma unroll
            for (int i = 0; i < 2; ++i) { u32x2 o; o.x = pk2(st[0], st[1]); o.y = pk2(st[2], st[3]); *(u32x2*)(basep[k] + (size_t)(dir ? 1 - i : i) * CST) = o;
                st = st * decp[k] + (f32x4){bflo(kv[k][i].x), bfhi(kv[k][i].x), bflo(kv[k][i].y), bfhi(kv[k][i].y)}; }
            *(f32x4*)(A.out + (dir ? OUT_SB : OUT_SF) + (((size_t)sq * 8 + h) * 64 + lr) * 128 + dv) = st; }
    }
    for (int w = (NGT * 4 == 256 * 2048) ? gt + 4 * NGT : gt; w < 320 * 2048; w += NGT) {
        const int e4 = (w & 2047) * 4, chain = w >> 11, dir = chain & 1, h = (chain >> 1) & 7, s = chain >> 4;
        const int nch = s < 16 ? 2 : 32, c0 = s < 16 ? 2 * s : 32 + 32 * (s - 16);
        const float lg = log_sigmoid_((dir ? A.dec_b : A.dec_f)[h]), dec = __expf(lg * 128.0f);
        const int pr = e4 >> 7, dv = e4 & 127, lr = swap25(pr);
        f32x4 st = {0.f, 0.f, 0.f, 0.f};
        if (s >= 16) st = *(const f32x4*)((dir ? A.st_b : A.st_f) + (((size_t)(s - 16) * 8 + h) * 64 + lr) * 128 + dv);
        bf16_t* base = KVS + ((size_t)(c0 * 8 + h) * 2 + dir) * 8192 + e4;
        if (s < 16) {
            u32x2 kv[2];
#pragma unroll
            for (int i = 0; i < 2; ++i) kv[i] = *(const u32x2*)(base + (size_t)(dir ? 1 - i : i) * CST);
#pragma unroll
            for (int i = 0; i < 2; ++i) { u32x2 o; o.x = pk2(st[0], st[1]); o.y = pk2(st[2], st[3]); *(u32x2*)(base + (size_t)(dir ? 1 - i : i) * CST) = o;
                st = st * dec + (f32x4){bflo(kv[i].x), bfhi(kv[i].x), bflo(kv[i].y), bfhi(kv[i].y)}; }
        } else {
            u32x2 kv[32];
#pragma unroll
            for (int i = 0; i < 32; ++i) kv[i] = *(const u32x2*)(base + (size_t)(dir ? 31 - i : i) * CST);
#pragma unroll
            for (int i = 0; i < 32; ++i) { u32x2 o; o.x = pk2(st[0], st[1]); o.y = pk2(st[2], st[3]); *(u32x2*)(base + (size_t)(dir ? 31 - i : i) * CST) = o;
                st = st * dec + (f32x4){bflo(kv[i].x), bfhi(kv[i].x), bflo(kv[i].y), bfhi(kv[i].y)}; }
        }
        if (s < 16) *(f32x4*)(A.out + (dir ? OUT_SB : OUT_SF) + (((size_t)s * 8 + h) * 64 + lr) * 128 + dv) = st;
    }
}

namespace att {
constexpr int D = 128, NW = 8, QBLK = 32, KVBLK = 64;
constexpr float SCALE = 0.088388347648318440f, THR = 8.f;
constexpr size_t SHM_V = KVBLK * D * 2, SHM_K = KVBLK * D * 2, SHM_ATTN = 2 * SHM_V + 2 * SHM_K + NW * 64 * 4;
#define KSWZ(row, colB) ((row) * 256 + ((colB) ^ (((row) & 7) << 4)))
#define SBAR() __builtin_amdgcn_sched_barrier(0)
__device__ __forceinline__ int crow(int r, int hi) { return (r & 3) + 8 * (r >> 2) + 4 * hi; }
__device__ __forceinline__ unsigned cvtpk(float lo, float hi) { unsigned r; asm volatile("v_cvt_pk_bf16_f32 %0, %1, %2" : "=v"(r) : "v"(lo), "v"(hi)); return r; }
__device__ __forceinline__ void partialSM(f32x16& p0, f32x16& p1, float& m_reg, float& mn, float& alpha) {
  constexpr float C = SCALE * 1.4426950408889634f;
  float pmax = p0[0]; for (int r = 1; r < 16; ++r) pmax = fmaxf(pmax, p0[r]); for (int r = 0; r < 16; ++r) pmax = fmaxf(pmax, p1[r]);
  { auto rr = __builtin_amdgcn_permlane32_swap(__float_as_uint(pmax), __float_as_uint(pmax), false, false);
    pmax = fmaxf(__uint_as_float(rr[0]), __uint_as_float(rr[1])); }
  if (__builtin_expect(__all(pmax - m_reg <= THR / SCALE), 1)) { mn = m_reg; alpha = 1.f; }
  else { mn = fmaxf(m_reg, pmax); alpha = __builtin_amdgcn_exp2f((m_reg - mn) * C); m_reg = mn; }
  float mnC = -mn * C;
  for (int r = 0; r < 16; ++r) p0[r] = fmaf(p0[r], C, mnC); for (int r = 0; r < 16; ++r) p1[r] = fmaf(p1[r], C, mnC);
  for (int r = 0; r < 16; ++r) p0[r] = __builtin_amdgcn_exp2f(p0[r]);
}
__device__ __forceinline__ void finishSM(f32x16& p0, f32x16& p1, float alpha, float& l_reg, bf16x8& pa0, bf16x8& pa1, bf16x8& pa2, bf16x8& pa3) {
  for (int r = 0; r < 16; ++r) p1[r] = __builtin_amdgcn_exp2f(p1[r]);
  float ps = 0; for (int r = 0; r < 16; ++r) ps += p0[r]; for (int r = 0; r < 16; ++r) ps += p1[r];
  { auto rr = __builtin_amdgcn_permlane32_swap(__float_as_uint(ps), __float_as_uint(ps), false, false);
    ps = __uint_as_float(rr[0]) + __uint_as_float(rr[1]); }
  l_reg = l_reg * alpha + ps;
#define PK4(P, BASE, OUT) do { unsigned a0 = cvtpk(P[BASE + 0], P[BASE + 1]), a1 = cvtpk(P[BASE + 2], P[BASE + 3]);   \
    unsigned b0 = cvtpk(P[BASE + 4], P[BASE + 5]), b1 = cvtpk(P[BASE + 6], P[BASE + 7]);                              \
    auto r0 = __builtin_amdgcn_permlane32_swap(a0, b0, false, false); auto r1 = __builtin_amdgcn_permlane32_swap(a1, b1, false, false); \
    u32x4 w = {r0[0], r1[0], r0[1], r1[1]}; OUT = *reinterpret_cast<bf16x8*>(&w); } while (0)
  PK4(p0, 0, pa0); PK4(p0, 8, pa1); PK4(p1, 0, pa2); PK4(p1, 8, pa3);
#undef PK4
}
__device__ __forceinline__ void qkt(f32x16& p0, f32x16& p1, const bf16_t* Ks, const bf16x8* qr, int r32, int hi) {
  p0 = f32x16{}; p1 = f32x16{};
  for (int d0 = 0; d0 < 8; ++d0) { int cb = (d0 * 16 + hi * 8) * 2;
    bf16x8 b0 = *reinterpret_cast<const bf16x8*>((const char*)Ks + KSWZ(r32, cb));
    bf16x8 b1 = *reinterpret_cast<const bf16x8*>((const char*)Ks + KSWZ(32 + r32, cb));
    p0 = __builtin_amdgcn_mfma_f32_32x32x16_bf16(b0, qr[d0], p0, 0, 0, 0);
    p1 = __builtin_amdgcn_mfma_f32_32x32x16_bf16(b1, qr[d0], p1, 0, 0, 0); }
}
__device__ __forceinline__ void qkt_finish(f32x16& q0, f32x16& q1, const bf16_t* Ks, const bf16x8* qr, int r32, int hi,
                                           f32x16& p0, f32x16& p1, float alpha, float& l_reg, bf16x8& pa0, bf16x8& pa1, bf16x8& pa2, bf16x8& pa3) {
  q0 = f32x16{}; q1 = f32x16{};
  bf16x8 ba[4], bb[4];
#define KLD2(B, D0) do { const int cb0_ = ((D0) * 16 + hi * 8) * 2, cb1_ = (((D0) + 1) * 16 + hi * 8) * 2;                          \
    B[0] = *reinterpret_cast<const bf16x8*>((const char*)Ks + KSWZ(r32, cb0_)); B[1] = *reinterpret_cast<const bf16x8*>((const char*)Ks + KSWZ(32 + r32, cb0_));   \
    B[2] = *reinterpret_cast<const bf16x8*>((const char*)Ks + KSWZ(r32, cb1_)); B[3] = *reinterpret_cast<const bf16x8*>((const char*)Ks + KSWZ(32 + r32, cb1_)); } while (0)
#define KMM2(B, D0) do { q0 = __builtin_amdgcn_mfma_f32_32x32x16_bf16(B[0], qr[D0], q0, 0, 0, 0); q1 = __builtin_amdgcn_mfma_f32_32x32x16_bf16(B[1], qr[D0], q1, 0, 0, 0);   \
    q0 = __builtin_amdgcn_mfma_f32_32x32x16_bf16(B[2], qr[(D0) + 1], q0, 0, 0, 0); q1 = __builtin_amdgcn_mfma_f32_32x32x16_bf16(B[3], qr[(D0) + 1], q1, 0, 0, 0); } while (0)
  KLD2(ba, 0); KLD2(bb, 2);
  KMM2(ba, 0); SBAR();
  KLD2(ba, 4); KMM2(bb, 2);
  for (int r = 0; r < 8; ++r) p1[r] = __builtin_amdgcn_exp2f(p1[r]);
  asm volatile("" : "+v"(p1)); SBAR();
  KLD2(bb, 6); KMM2(ba, 4);
  for (int r = 8; r < 16; ++r) p1[r] = __builtin_amdgcn_exp2f(p1[r]);
  asm volatile("" : "+v"(p1)); SBAR();
  KMM2(bb, 6);
#undef KLD2
#undef KMM2
  float ps = 0; for (int r = 0; r < 16; ++r) ps += p0[r]; for (int r = 0; r < 16; ++r) ps += p1[r];
  { auto rr = __builtin_amdgcn_permlane32_swap(__float_as_uint(ps), __float_as_uint(ps), false, false);
    ps = __uint_as_float(rr[0]) + __uint_as_float(rr[1]); }
  l_reg = l_reg * alpha + ps;
#define PK4(P, BASE, OUT) do { unsigned a0 = cvtpk(P[BASE + 0], P[BASE + 1]), a1 = cvtpk(P[BASE + 2], P[BASE + 3]);   \
    unsigned b0 = cvtpk(P[BASE + 4], P[BASE + 5]), b1 = cvtpk(P[BASE + 6], P[BASE + 7]);                              \
    auto r0 = __builtin_amdgcn_permlane32_swap(a0, b0, false, false); auto r1 = __builtin_amdgcn_permlane32_swap(a1, b1, false, false); \
    u32x4 w = {r0[0], r1[0], r0[1], r1[1]}; OUT = *reinterpret_cast<bf16x8*>(&w); } while (0)
  PK4(p0, 0, pa0); PK4(p0, 8, pa1); PK4(p1, 0, pa2); PK4(p1, 8, pa3);
#undef PK4
}
__device__ __forceinline__ int v_st(int k, int c) { const int kk = (k & ~0xC) | ((k & 4) << 1) | ((k & 8) >> 1); return ((kk >> 3) * 4 + (c >> 5)) * 512 + ((kk & 7) * 32 + (c & 31)) * 2; }
__device__ __forceinline__ int v_rd_base(int lane) { return ((lane & 3) << 3) | (((lane >> 2) & 3) << 6) | (((lane >> 4) & 1) << 5) | (((lane >> 5) & 1) << 8); }
constexpr int v_rd_off(int d0, int ks, int half) { return d0 * 512 + ks * 4096 + half * 2048; }
template <int OFF> __device__ __forceinline__ s16x4 tr_read(int vb) { s16x4 r; asm volatile("ds_read_b64_tr_b16 %0, %1 offset:%2" : "=&v"(r) : "v"(vb), "i"(OFF) : "memory"); return r; }
template <int D0> __device__ __forceinline__ void pv_one(f32x16& od, int vb, bf16x8 pa0, bf16x8 pa1, bf16x8 pa2, bf16x8 pa3) {
  const s16x4 l0 = tr_read<v_rd_off(D0, 0, 0)>(vb), h0 = tr_read<v_rd_off(D0, 0, 1)>(vb), l1 = tr_read<v_rd_off(D0, 1, 0)>(vb), h1 = tr_read<v_rd_off(D0, 1, 1)>(vb);
  const s16x4 l2 = tr_read<v_rd_off(D0, 2, 0)>(vb), h2 = tr_read<v_rd_off(D0, 2, 1)>(vb), l3 = tr_read<v_rd_off(D0, 3, 0)>(vb), h3 = tr_read<v_rd_off(D0, 3, 1)>(vb);
  asm volatile("s_waitcnt lgkmcnt(0)" ::: "memory"); SBAR();
  od = __builtin_amdgcn_mfma_f32_32x32x16_bf16(pa0, MK8(l0, h0), od, 0, 0, 0);
  od = __builtin_amdgcn_mfma_f32_32x32x16_bf16(pa1, MK8(l1, h1), od, 0, 0, 0);
  od = __builtin_amdgcn_mfma_f32_32x32x16_bf16(pa2, MK8(l2, h2), od, 0, 0, 0);
  od = __builtin_amdgcn_mfma_f32_32x32x16_bf16(pa3, MK8(l3, h3), od, 0, 0, 0);
}
__device__ __forceinline__ void pv_d0(f32x16* o, int vb, bf16x8 pa0, bf16x8 pa1, bf16x8 pa2, bf16x8 pa3) {
  pv_one<0>(o[0], vb, pa0, pa1, pa2, pa3); pv_one<1>(o[1], vb, pa0, pa1, pa2, pa3); pv_one<2>(o[2], vb, pa0, pa1, pa2, pa3); pv_one<3>(o[3], vb, pa0, pa1, pa2, pa3);
}
__device__ __forceinline__ void pv_partial(f32x16* o, int vb, bf16x8 pa0, bf16x8 pa1, bf16x8 pa2, bf16x8 pa3, f32x16& p0, f32x16& p1, float& m_reg, float& mn, float& alpha) {
  constexpr float C = SCALE * 1.4426950408889634f;
  pv_one<0>(o[0], vb, pa0, pa1, pa2, pa3);
  float pmax = p0[0]; for (int r = 1; r < 16; ++r) pmax = fmaxf(pmax, p0[r]); for (int r = 0; r < 16; ++r) pmax = fmaxf(pmax, p1[r]);
  { auto rr = __builtin_amdgcn_permlane32_swap(__float_as_uint(pmax), __float_as_uint(pmax), false, false);
    pmax = fmaxf(__uint_as_float(rr[0]), __uint_as_float(rr[1])); }
  asm volatile("" : "+v"(pmax));
  pv_one<1>(o[1], vb, pa0, pa1, pa2, pa3);
  { const bool keep = __all(pmax - m_reg <= THR / SCALE);
    mn = keep ? m_reg : fmaxf(m_reg, pmax); alpha = __builtin_amdgcn_exp2f((m_reg - mn) * C); m_reg = mn; }
  const float mnC = -mn * C;
  for (int r = 0; r < 16; ++r) p0[r] = fmaf(p0[r], C, mnC); for (int r = 0; r < 16; ++r) p1[r] = fmaf(p1[r], C, mnC);
  asm volatile("" : "+v"(p0), "+v"(p1), "+v"(alpha));
  pv_one<2>(o[2], vb, pa0, pa1, pa2, pa3);
  for (int r = 0; r < 8; ++r) p0[r] = __builtin_amdgcn_exp2f(p0[r]);
  asm volatile("" : "+v"(p0));
  pv_one<3>(o[3], vb, pa0, pa1, pa2, pa3);
  for (int r = 8; r < 16; ++r) p0[r] = __builtin_amdgcn_exp2f(p0[r]);
  asm volatile("" : "+v"(p0)); SBAR();
}
template <int LDQ>
__device__ __forceinline__ void attn_dense_body(const bf16_t* Qb, const bf16_t* __restrict__ Kh, const bf16_t* __restrict__ Vh, bf16_t* Ob, int seq, char* lds, const int wid) {
  constexpr int LDK = 128;
  const int lane = lane_id_(), tid = wid * 64 + lane, r32 = lane & 31, hi = lane >> 5;
  bf16_t* V_lds = (bf16_t*)lds; bf16_t* K_lds = (bf16_t*)(lds + 2 * SHM_V);
  float* ws = (float*)(lds + 2 * SHM_V + 2 * SHM_K) + wid * 64; float* li_l = ws; float* al_l = ws + 32;
  float m_reg = -1e30f, l_reg = 0; f32x16 o[4] = {}; bf16x8 qr[8];
  const bf16_t* Qw = Qb + (long)(wid * QBLK + r32) * LDQ + hi * 8;
#pragma unroll
  for (int d0 = 0; d0 < 8; ++d0) qr[d0] = *reinterpret_cast<const bf16x8*>(Qw + d0 * 16);
  const int sr = tid >> 4, sc = (tid & 15) * 8, vst0 = v_st(sr, sc), vst1 = v_st(32 + sr, sc);
  const int vb0 = (int)(uintptr_t)V_lds + v_rd_base(lane);
  struct { bf16x8 vs0, vs1, ks0, ks1; } sr_[2];
#define SLOAD(i, k0) do { sr_[i].vs0 = *(const bf16x8*)(&Vh[(long)((k0) + sr) * LDK + sc]); sr_[i].vs1 = *(const bf16x8*)(&Vh[(long)((k0) + 32 + sr) * LDK + sc]); \
    sr_[i].ks0 = *(const bf16x8*)(&Kh[(long)((k0) + sr) * LDK + sc]); sr_[i].ks1 = *(const bf16x8*)(&Kh[(long)((k0) + 32 + sr) * LDK + sc]); } while (0)
#define SWRITE(b, i) do { *(bf16x8*)((char*)V_lds + (b) * SHM_V + vst0) = sr_[i].vs0;          \
    *(bf16x8*)((char*)V_lds + (b) * SHM_V + vst1) = sr_[i].vs1; int kc = sc * 2;               \
    *(bf16x8*)((char*)K_lds + (b) * SHM_K + KSWZ(sr, kc)) = sr_[i].ks0;                       \
    *(bf16x8*)((char*)K_lds + (b) * SHM_K + KSWZ(32 + sr, kc)) = sr_[i].ks1; } while (0)
#define SWAIT() asm volatile("s_waitcnt vmcnt(4)" ::: "memory")
#define RESC(a) do { if (__any((a) < 1.f)) { if (hi == 0) al_l[r32] = (a); asm volatile("s_waitcnt lgkmcnt(0)" ::: "memory"); \
    for (int d = 0; d < 4; ++d) for (int r = 0; r < 16; ++r) o[d][r] *= al_l[crow(r, hi)]; } } while (0)
  f32x16 pA0, pA1, pB0, pB1; float mnA, mnB, alA, alB; bf16x8 pa0, pa1, pa2, pa3; const int NT = seq / KVBLK;
  constexpr int SE = 0, SO = 1;
  if (wid >= 4) __builtin_amdgcn_s_setprio(1);
  SLOAD(SE, 0); asm volatile("s_waitcnt vmcnt(0)" ::: "memory"); SWRITE(0, SE); __syncthreads();
  qkt(pA0, pA1, K_lds, qr, r32, hi); partialSM(pA0, pA1, m_reg, mnA, alA);
  SLOAD(SO, KVBLK); if (2 < NT) SLOAD(SE, 2 * KVBLK);
  SWAIT(); SWRITE(1, SO); __syncthreads();
  for (int j = 1; j + 1 < NT; j += 2) {
    SBAR(); qkt_finish(pB0, pB1, (bf16_t*)((char*)K_lds + SHM_K), qr, r32, hi, pA0, pA1, alA, l_reg, pa0, pa1, pa2, pa3); SBAR();
    SLOAD(SO, (j + 2) * KVBLK); SBAR();
    pv_partial(o, vb0, pa0, pa1, pa2, pa3, pB0, pB1, m_reg, mnB, alB);
    __syncthreads(); SWAIT(); SWRITE(0, SE);
    RESC(alB); __syncthreads();
    SBAR(); qkt_finish(pA0, pA1, K_lds, qr, r32, hi, pB0, pB1, alB, l_reg, pa0, pa1, pa2, pa3); SBAR();
    if (j + 3 < NT) SLOAD(SE, (j + 3) * KVBLK); SBAR();
    pv_partial(o, vb0 + (int)SHM_V, pa0, pa1, pa2, pa3, pA0, pA1, m_reg, mnA, alA);
    __syncthreads(); SWAIT(); SWRITE(1, SO);
    RESC(alA); __syncthreads();
  }
  SBAR(); qkt(pB0, pB1, (bf16_t*)((char*)K_lds + SHM_K), qr, r32, hi);
  finishSM(pA0, pA1, alA, l_reg, pa0, pa1, pa2, pa3); SBAR();
  pv_partial(o, vb0, pa0, pa1, pa2, pa3, pB0, pB1, m_reg, mnB, alB);
  __syncthreads(); RESC(alB);
  finishSM(pB0, pB1, alB, l_reg, pa0, pa1, pa2, pa3); SBAR();
  pv_d0(o, vb0 + (int)SHM_V, pa0, pa1, pa2, pa3);
  __builtin_amdgcn_s_setprio(0);
  if (hi == 0) li_l[r32] = l_reg; asm volatile("s_waitcnt lgkmcnt(0)" ::: "memory");
  float rli[16];
#pragma unroll
  for (int r = 0; r < 16; ++r) rli[r] = __builtin_amdgcn_rcpf(li_l[crow(r, hi)]);
  bf16_t* Ow = Ob + (long)(wid * QBLK) * LDQ;
#pragma unroll
  for (int r = 0; r < 16; ++r) { int orow = crow(r, hi);
    for (int d0 = 0; d0 < 4; ++d0) Ow[(long)orow * LDQ + d0 * 32 + r32] = (bf16_t)f2bf(o[d0][r] * rli[r]); }
  __syncthreads();
#undef SLOAD
#undef SWRITE
#undef SWAIT
#undef RESC
}
#undef KSWZ
#undef SBAR
}

struct R3Regs { u32x4 k[2], v[4], s[4], srg[4]; bf16x8 q[2]; };
__device__ __forceinline__ void r3_load(const Frame& F, CArgs& A, int item, R3Regs& R) {
    unsigned char* ws = A.ws;
    const bf16_t* RQb = (const bf16_t*)(ws + WS_RQ); const bf16_t* RKb = (const bf16_t*)(ws + WS_RK); const bf16_t* RVb = (const bf16_t*)(ws + WS_RV);
    const bf16_t* SRGb = (const bf16_t*)(ws + WS_SRG); const bf16_t* KVS = (const bf16_t*)(ws + WS_H);
    const int cg = item >> 3, h = item & 7; const size_t row0 = (size_t)cg * 128;
#pragma unroll
    for (int i = 0; i < 2; ++i) { const int ci = F.tid + i * NTHR; R.k[i] = *(const u32x4*)(RKb + (row0 + (ci >> 3)) * 512 + 64 * h + 8 * (ci & 7)); }
#pragma unroll
    for (int i = 0; i < 4; ++i) { const int ci = F.tid + i * NTHR, j = ci >> 4, c8 = ci & 15;
        R.v[i] = *(const u32x4*)(RVb + (row0 + j) * 1024 + 128 * h + 8 * c8);
        R.s[i] = *(const u32x4*)(KVS + (size_t)item * 2 * 8192 + (size_t)j * 128 + 8 * c8); }
    const size_t gofs = (row0 + 16 * F.wave + (F.lane >> 2)) * 1024 + 128 * h + (F.lane & 3) * 32;
#pragma unroll
    for (int c = 0; c < 4; ++c) R.srg[c] = *(const u32x4*)(SRGb + gofs + 8 * c);
#pragma unroll
    for (int s = 0; s < 2; ++s) R.q[s] = *(const bf16x8*)(RQb + (row0 + 16 * F.wave + (F.lane & 15)) * 512 + 64 * h + 32 * s + 8 * (F.lane >> 4));
}
__device__ __forceinline__ void r3_item(const Frame& F, CArgs& A, int item, int item_next, R3Regs& R, int after_next, LAS int* slot) {
    unsigned char* ws = A.ws; bf16_t* RVb = (bf16_t*)(ws + WS_RV);
    LAS bf16_t* kl = (LAS bf16_t*)F.lds; LAS bf16_t* vl = kl + 128 * KLD; LAS bf16_t* sl = vl + 128 * 128; LAS bf16_t* pl = sl + 128 * 128 + F.wave * (16 * VLD);
    const int cg = item >> 3, h = item & 7; const size_t row0 = (size_t)cg * 128;
    const float lgf = log_sigmoid_(A.dec_f[h]) * 1.4426950408889634f, lgb = log_sigmoid_(A.dec_b[h]) * 1.4426950408889634f;
#pragma unroll
    for (int i = 0; i < 2; ++i) { const int ci = F.tid + i * NTHR; *(LAS u32x4*)(kl + (ci >> 3) * KLD + 8 * (ci & 7)) = R.k[i]; }
#pragma unroll
    for (int i = 0; i < 4; ++i) { const int ci = F.tid + i * NTHR, j = ci >> 4, c8 = ci & 15; *(LAS u32x4*)((LAS char*)vl + vsw(j, c8)) = R.v[i]; *(LAS u32x4*)((LAS char*)sl + vsw(j, c8)) = R.s[i]; }
    int lane_ = F.lane; asm volatile("" : "+v"(lane_));
    const int g = lane_ >> 4, l15 = lane_ & 15, q = l15 >> 2, p = lane_ & 3, w = F.wave;
    const size_t gofs = (row0 + 16 * w + (lane_ >> 2)) * 1024 + 128 * h + (lane_ & 3) * 32;
    u32x4 srg_[4]; bf16x8 qf[2];
#pragma unroll
    for (int c = 0; c < 4; ++c) srg_[c] = R.srg[c];
#pragma unroll
    for (int s = 0; s < 2; ++s) qf[s] = R.q[s];
    __syncthreads();
    if (item_next >= 0) r3_load(F, A, item_next, R);
    float rf[4], rb[4];
#pragma unroll
    for (int e = 0; e < 4; ++e) { const float fi = (float)(16 * w + 4 * g + e); rf[e] = __builtin_amdgcn_exp2f(lgf * fi); rb[e] = __builtin_amdgcn_exp2f(-lgb * fi); }
#pragma unroll
    for (int nt = 0; nt < 8; ++nt) { f32x4 sacc = {0.f, 0.f, 0.f, 0.f};
#pragma unroll
        for (int s = 0; s < 2; ++s) { const bf16x8 kfr = *(const LAS bf16x8*)(kl + (16 * nt + l15) * KLD + 32 * s + 8 * g); sacc = __builtin_amdgcn_mfma_f32_16x16x32_bf16(qf[s], kfr, sacc, 0, 0, 0); }
        const int j = 16 * nt + l15;
        if (nt < w) {
            const float cf = __builtin_amdgcn_exp2f(-lgf * (float)j);
#pragma unroll
            for (int e = 0; e < 4; ++e) pl[(4 * g + e) * VLD + j] = (bf16_t)f2bf(sacc[e] * (rf[e] * cf));
        } else if (nt > w) {
            const float cb = __builtin_amdgcn_exp2f(lgb * (float)j);
#pragma unroll
            for (int e = 0; e < 4; ++e) pl[(4 * g + e) * VLD + j] = (bf16_t)f2bf(sacc[e] * (rb[e] * cb));
        } else {
            const float cf = __builtin_amdgcn_exp2f(-lgf * (float)j), cb = __builtin_amdgcn_exp2f(lgb * (float)j);
#pragma unroll
            for (int e = 0; e < 4; ++e) { const int df = 16 * w + 4 * g + e - j;
                const float dm = (df >= 0 ? rf[e] * cf : 0.f) + (df <= 0 ? rb[e] * cb : 0.f);
                pl[(4 * g + e) * VLD + j] = (bf16_t)f2bf(sacc[e] * dm); } } }
    LDS_WAIT(); asm volatile("" ::: "memory");
    bf16x8 pa[4], qa[4];
#pragma unroll
    for (int s = 0; s < 4; ++s) pa[s] = *(const LAS bf16x8*)(pl + l15 * VLD + 32 * s + 8 * g);
    { const int i = 16 * w + l15; const float qdf = __builtin_amdgcn_exp2f(lgf * (float)(i + 1)), qdb = __builtin_amdgcn_exp2f(lgb * (float)(128 - i));
#pragma unroll
      for (int s = 0; s < 2; ++s) { f32x4 a, b; unpack8(__builtin_bit_cast(u32x4, qf[s]), a, b); qa[s] = __builtin_bit_cast(bf16x8, pack8(a * qdf, b * qdf)); qa[2 + s] = __builtin_bit_cast(bf16x8, pack8(a * qdb, b * qdb)); } }
    f32x4 oacc[8];
#pragma unroll
    for (int nt = 0; nt < 8; ++nt) { f32x4 acc = {0.f, 0.f, 0.f, 0.f};
#pragma unroll
        for (int s = 0; s < 4; ++s) { const int R0 = 32 * s + 8 * g + q, col = 16 * nt + 4 * p;
            const s16x4 lo = tr_read16((const LAS bf16_t*)((const LAS char*)vl + vsw_tr(R0, col))), hi = tr_read16((const LAS bf16_t*)((const LAS char*)vl + vsw_tr(R0 + 4, col)));
            acc = __builtin_amdgcn_mfma_f32_16x16x32_bf16(pa[s], MK8(lo, hi), acc, 0, 0, 0); }
#pragma unroll
        for (int s = 0; s < 4; ++s) { const int R0 = 32 * s + 8 * g + q, col = 16 * nt + 4 * p;
            const s16x4 lo = tr_read16((const LAS bf16_t*)((const LAS char*)sl + vsw_tr(R0, col))), hi = tr_read16((const LAS bf16_t*)((const LAS char*)sl + vsw_tr(R0 + 4, col)));
            acc = __builtin_amdgcn_mfma_f32_16x16x32_bf16(qa[s], MK8(lo, hi), acc, 0, 0, 0); }
        oacc[nt] = acc; }
    f32x4 ss = {0.f, 0.f, 0.f, 0.f};
#pragma unroll
    for (int nt = 0; nt < 8; ++nt) ss += oacc[nt] * oacc[nt];
#pragma unroll
    for (int e = 0; e < 4; ++e) { float s = ss[e]; s += __shfl_xor(s, 1); s += __shfl_xor(s, 2); s += __shfl_xor(s, 4); s += __shfl_xor(s, 8); ss[e] = __builtin_amdgcn_rsqf(s * (1.0f / 128.0f) + EPS); }
#pragma unroll
    for (int nt = 0; nt < 8; ++nt)
#pragma unroll
        for (int e = 0; e < 4; ++e) pl[(4 * g + e) * VLD + 16 * nt + l15] = (bf16_t)f2bf(oacc[nt][e] * ss[e]);
    LDS_WAIT(); asm volatile("" ::: "memory");
#pragma unroll
    for (int c = 0; c < 4; ++c) { f32x4 o0, o1, g0, g1; unpack8(*(const LAS u32x4*)(pl + (lane_ >> 2) * VLD + (lane_ & 3) * 32 + 8 * c), o0, o1); unpack8(srg_[c], g0, g1);
        *(u32x4*)(RVb + gofs + 8 * c) = pack8(o0 * g0, o1 * g1); }
    if (F.tid == 0) *slot = after_next;
    __syncthreads();
}

__device__ __forceinline__ void phase_attn(const Frame& F, CArgs& A) {
    unsigned char* ws = A.ws; bf16_t* Q = (bf16_t*)(ws + WS_Q);
    {
        LAS float* scr = (LAS float*)(F.lds + F.wave * 8704);
        const int gw = F.bid * NWAVES + F.wave, NGW = F.G * NWAVES;
        constexpr int I_O = 16 * 32, NIT = 3 * I_O;
        for (int it = gw; it < NIT; it += NGW) {
            int r = it;
            if (r < I_O) { transpose_item(A.w_att_o, 1024, (bf16_t*)(ws + WS_WB), 2048, 0, 64 * (r / 32), 32 * (r % 32), ColId(), scr, F.lane); continue; } r -= I_O;
            if (r < I_O) { transpose_item(A.w_ret_o, 1024, (bf16_t*)(ws + WS_WB), 2048, 1024, 64 * (r / 32), 32 * (r % 32), ColId(), scr, F.lane); continue; } r -= I_O;
            transpose_item(A.w_out, 1024, (bf16_t*)(ws + WS_WC), 1024, 0, 64 * (r / 32), 32 * (r % 32), ColId(), scr, F.lane);
        }
        __syncthreads();
    }
    const int x = F.bid & 7, c = F.bid >> 3;
    const int nun = F.bid < NB * NH ? 3 : 2;
    unsigned* qctr = (unsigned*)(ws + WS_CNT) + 64 * CNT_R3Q; LAS int* slot = (LAS int*)(F.lds + 122880);
    int nxt_v = 0; if (F.tid == 0) nxt_v = (int)__hip_atomic_fetch_add(qctr, 1u, RLX_AGENT) + F.G;
#pragma nounroll
    for (int i = 0; i < nun; ++i) {
        const bf16_t *Kh, *Vh; bf16_t* Qb; int seq;
        if (i < 2) { const int lb = x >> 1, kvh = x & 1, uu = c + 32 * i, hq = kvh * 4 + (uu >> 4), qb = uu & 15;
            Kh = (const bf16_t*)(ws + WS_KALL) + (size_t)(lb * 2 + kvh) * SKV * 128; Vh = (const bf16_t*)(ws + WS_VALL) + (size_t)(lb * 2 + kvh) * SKV * 128;
            Qb = Q + ((size_t)MP + (size_t)lb * DSEQ + qb * 256) * 1024 + hq * 128; seq = SKV; }
        else { const int b = F.bid >> 3, hq = F.bid & 7, kvh = hq >> 2;
            Kh = (const bf16_t*)(ws + WS_KP) + (size_t)(b * 2 + kvh) * SEQ * 128; Vh = (const bf16_t*)(ws + WS_VP) + (size_t)(b * 2 + kvh) * SEQ * 128;
            Qb = Q + (size_t)b * SEQ * 1024 + hq * 128; seq = SEQ; }
        att::attn_dense_body<1024>(Qb, Kh, Vh, Qb, seq, (char*)F.lds, F.wave);
    }
    {
      constexpr int NIT3 = (MT / 128) * 8;
      Frame F2 = F; F2.lane = lane_id_(); F2.tid = F2.wave * 64 + F2.lane;
      if (F2.tid == 0) *slot = nxt_v;
      __syncthreads();
      int cur = F.bid, nxt = __builtin_amdgcn_readfirstlane(*slot); if (nxt >= NIT3) nxt = -1;
      R3Regs R; r3_load(F2, A, cur, R);
      while (cur >= 0) {
          int n2_v = -1; if (nxt >= 0 && F2.tid == 0) n2_v = (int)__hip_atomic_fetch_add(qctr, 1u, RLX_AGENT) + F.G;
          r3_item(F2, A, cur, nxt, R, n2_v, slot);
          cur = nxt; nxt = __builtin_amdgcn_readfirstlane(*slot); if (nxt >= NIT3) nxt = -1;
      }
    }
}

struct OneUnit { int pm, pn; __device__ __forceinline__ bool next(int i, pg8::Unit& u) const { if (i) return false; u.pm = pm; u.pn = pn; return true; }
    __device__ __forceinline__ void a_ready(const pg8::Unit&, int) const {} };
constexpr int NU2 = 0, NU3 = 320, NU4 = (MT / 256) * (NUP / 256), NU5 = 320, NUTOT = NU2 + NU3 + NU4 + NU5;
__device__ __forceinline__ void fix_panel(const Frame& F, CArgs& A, int pm) {
    unsigned char* ws = A.ws; const float* EU = (const float*)(ws + WS_EDGE_U); const float* EUC = (const float*)(ws + WS_EDGE_UC); bf16_t* ACT = (bf16_t*)(ws + WS_ACT);
    const int jt = (pm - 16) & 15;
    for (int i = F.tid; i < 2 * DFF; i += NTHR) { const int j = i % DFF, e = i / DFF;
        if ((e == 0 && jt == 0) || (e == 1 && jt == 15)) continue;
        const int pmn = e ? pm + 1 : pm - 1, na = 256 * (j >> 7) + (j & 127), ng = na + 128, tap = e ? 2 : 0;
        const float ua = EUC[((size_t)pm * 2 + e) * NUP + na] + A.conv_w[(size_t)tap * NUP + j] * EU[((size_t)pmn * 2 + (1 - e)) * NUP + na];
        const float ug = EUC[((size_t)pm * 2 + e) * NUP + ng] + A.conv_w[(size_t)tap * NUP + DFF + j] * EU[((size_t)pmn * 2 + (1 - e)) * NUP + ng];
        ACT[((size_t)pm * 256 + (e ? 255 : 0)) * DFF + j] = (bf16_t)f2bf(siluf_(ug) * ua); }
}
__device__ __forceinline__ void g3_unit(const Frame& F, CArgs& A, int idx) {
    unsigned char* ws = A.ws; unsigned* cnt = (unsigned*)(ws + WS_CNT); const int pm = idx >> 2, pn = idx & 3;
    OneUnit S{pm, pn};
    pg8::Gemm g{(const bf16_t*)(ws + WS_Y), (const bf16_t*)(ws + WS_WC), MT, DM, DM, DM, DM, 1 << 30, 0};
    EpiRes1 E{A.x_prompt, A.x_sample, (const float*)(ws + WS_MODF), A.norm2_g, (bf16_t*)(ws + WS_X1B), (float*)(ws + WS_SSQ1), (bf16_t*)(ws + WS_H)};
    pg8::gemm_phase(F.lds, g, S, E, F.wave);
    asm volatile("s_waitcnt vmcnt(0)" ::: "memory");
    __syncthreads();
    if (F.wave == 0 && lane_id_() == 0) { __hip_atomic_fetch_add(cnt + 64 * (CNT_D3 + pm), 1u, RLX_AGENT); __hip_atomic_fetch_add(cnt + 64 * CNT_G3ALL, 1u, RLX_AGENT); }
}
__device__ __forceinline__ void phase_mix(const Frame& F, CArgs& A) {
    unsigned char* ws = A.ws; unsigned* cnt = (unsigned*)(ws + WS_CNT);
    const int v = (F.bid & 7) * (F.G >> 3) + (F.bid >> 3);
#if defined(PROBE_K0) && (PROBE_K0 == 301 || PROBE_K0 == 302)
    const unsigned long long tmix0_ = __builtin_amdgcn_s_memrealtime();
#endif
    {   struct G2Run { int v, n; __device__ __forceinline__ bool next(int i, pg8::Unit& u) const { if (i >= n) return false; const int l = i == 0 ? v : 256 + v; u.pm = l >> 2; u.pn = l & 3; return true; }
            __device__ __forceinline__ void a_ready(const pg8::Unit&, int) const {} };
        G2Run S{v, v < 64 ? 2 : 1};
        pg8::Gemm g{(const bf16_t*)(ws + WS_Q), (const bf16_t*)(ws + WS_WB), MT, DM, 2 * DM, DM, 2 * DM, 16, (long)(WS_RV - WS_Q) - 16 * 128};
        EpiMix E{(const bf16_t*)A.out, (const bf16_t*)A.out + (size_t)MT * DM, (bf16_t*)(ws + WS_Y), cnt + 64 * CNT_D2};
        pg8::gemm_phase(F.lds, g, S, E, F.wave);
    }
#if defined(PROBE_K0) && PROBE_K0 == 300
    const unsigned long long t0_ = __builtin_amdgcn_s_memrealtime();
#endif
#if defined(PROBE_K0) && PROBE_K0 == 301
    if (v == PROBE_BID && F.tid == 0) *(float*)(ws + 32768) = (float)(__builtin_amdgcn_s_memrealtime() - tmix0_);
#endif
    if (v >= 64) { const int idx = v - 64, pm = idx >> 2;
        if (F.wave == 0) { spin_ge(cnt + 64 * (CNT_D2 + pm), 4u); __builtin_amdgcn_fence(__ATOMIC_ACQUIRE, "agent"); asm volatile("s_waitcnt vmcnt(0)" ::: "memory"); }
        __syncthreads();
        g3_unit(F, A, idx);
        __syncthreads();
        LAS float* scr = (LAS float*)(F.lds + F.wave * 8704);
        constexpr int I_DN = (DFF / 64) * 32, I_UP = 16 * (NUP / 32);
        for (int it = (v - 64) * NWAVES + F.wave; it < I_DN + I_UP; it += (F.G - 64) * NWAVES) {
            if (it < I_DN) transpose_item(A.w_down, 1024, (bf16_t*)(ws + WS_WD), DFF, 0, 64 * (it / 32), 32 * (it % 32), ColId(), scr, F.lane);
            else { const int r = it - I_DN; transpose_item(A.w_up, NUP, (bf16_t*)(ws + WS_WA), 1024, 0, 64 * (r / (NUP / 32)), 32 * (r % (NUP / 32)), ColUp(), scr, F.lane); } }
    }
#if defined(PROBE_K0) && PROBE_K0 == 300
    if (v == PROBE_BID && F.tid == 0) *(float*)(ws + 32768) = (float)(__builtin_amdgcn_s_memrealtime() - t0_);
#endif
#if defined(PROBE_K0) && PROBE_K0 == 302
    if (v == PROBE_BID && F.tid == 0) *(float*)(ws + 32768) = (float)(__builtin_amdgcn_s_memrealtime() - tmix0_);
#endif
}
__device__ __forceinline__ void phase_stream(const Frame& F, CArgs& A) {
    unsigned char* ws = A.ws; unsigned* cnt = (unsigned*)(ws + WS_CNT);
    LAS float* spare = (LAS float*)(F.lds + SPARE_OFF);
    const int NOJ = 1 << 30;
    const int v = (F.bid & 7) * (F.G >> 3) + (F.bid >> 3);
#if defined(PROBE_K0) && PROBE_K0 >= 100 && PROBE_K0 < 200
    unsigned long long tacc_ = 0, tl_ = __builtin_amdgcn_s_memrealtime();
#define SPROBE(cat) do { const unsigned long long tn_ = __builtin_amdgcn_s_memrealtime(); if ((cat) == PROBE_K0 - 100 || PROBE_K0 - 100 == 3) tacc_ += tn_ - tl_; tl_ = tn_; } while (0)
#else
#define SPROBE(cat) do { } while (0)
#endif
    const int nG4 = v < 64 ? 8 : v < 192 ? 7 : v < 224 ? 6 : 5, nG5 = v >= 192 ? 2 : 1;
    if (v >= 64 && v < 192) g3_unit(F, A, 192 + (v - 64));
    SPROBE(0);
    {   struct G4Run { int v, n; unsigned* d3; unsigned* g3all; volatile LAS unsigned* alld; unsigned* d4; mutable int p0, p1;
            __device__ __forceinline__ void publish(int pm) const {
                if (pm >= 0) { asm volatile("s_waitcnt vmcnt(0)" ::: "memory"); if (lane_id_() == 0) __hip_atomic_fetch_add(d4 + 64 * pm, 1u, RLX_AGENT); } }
            __device__ __forceinline__ bool next(int r, pg8::Unit& u) const { if (r >= n) return false;
                const int l = r < 5 ? 256 * r + v : r == 5 ? 1280 + v : r == 6 ? 1504 + v : 1696 + v;
                const int sr = l / 176, rem = l % 176, blk = rem < 160 ? rem >> 5 : 5, w = rem < 160 ? rem & 31 : rem - 160;
                u.pm = 8 * sr + (w & 7); u.pn = 4 * blk + (w >> 3); return true; }
            __device__ __forceinline__ void a_ready(const pg8::Unit& u, int wid) const {
                publish(p0); p0 = p1; p1 = u.pm;
                if (wid == 0 && *alld == 0u) {
                    const bool all = (unsigned)__builtin_amdgcn_readfirstlane(__hip_atomic_load(g3all, RLX_AGENT)) >= 320u;
                    spin_ge(d3 + 64 * u.pm, 4u);
                    if (u.pm >= 63) spin_ge(g3all, 320u);
                    __builtin_amdgcn_fence(__ATOMIC_ACQUIRE, "agent"); asm volatile("s_waitcnt vmcnt(0)" ::: "memory");
                    if (all) *alld = 1u; }
                asm volatile("" ::: "memory"); __builtin_amdgcn_s_barrier(); asm volatile("" ::: "memory"); } };
        volatile LAS unsigned* alld = (volatile LAS unsigned*)(F.lds + MISC_OFF) + 16;
        if (F.tid == 0) *alld = 0u;
        __syncthreads();
        G4Run S{v, nG4, cnt + 64 * CNT_D3, cnt + 64 * CNT_G3ALL, alld, cnt + 64 * CNT_D4, -1, -1};
        pg8::Gemm g{(const bf16_t*)(ws + WS_H), (const bf16_t*)(ws + WS_WA), MT, NUP, DM, DM, DM, NOJ, 0};
        EpiConv E{(const float*)(ws + WS_SSQ1), (const float*)(ws + WS_BUPF), A.conv_w, A.conv_b, (bf16_t*)(ws + WS_ACT), (float*)(ws + WS_EDGE_U), (float*)(ws + WS_EDGE_UC), spare, cnt + 64 * CNT_D4};
        pg8::gemm_phase(F.lds, g, S, E, F.wave);
        S.publish(S.p0); S.publish(S.p1);
    }
    SPROBE(1);
    for (int j = 0; j < nG5; ++j) { const int l = j == 0 ? ((v + 64) & 255) : 256 + (v - 192), pm = l >> 2, pn = l & 3;
        if (F.wave == 0) { spin_ge(cnt + 64 * (CNT_D4 + pm), 176u);
            if (pm >= 16) { const int jt = (pm - 16) & 15; if (jt > 0) spin_ge(cnt + 64 * (CNT_D4 + pm - 1), 176u); if (jt < 15) spin_ge(cnt + 64 * (CNT_D4 + pm + 1), 176u); }
            __builtin_amdgcn_fence(__ATOMIC_ACQUIRE, "agent"); asm volatile("s_waitcnt vmcnt(0)" ::: "memory"); }
        __syncthreads();
        if (pm >= 16) { fix_panel(F, A, pm); asm volatile("s_waitcnt vmcnt(0)" ::: "memory"); __syncthreads(); }
        SPROBE(0);
        OneUnit S{pm, pn};
        pg8::Gemm g{(const bf16_t*)(ws + WS_ACT), (const bf16_t*)(ws + WS_WD), MT, DM, DFF, DFF, DFF, NOJ, 0};
        EpiRes2 E{(const float*)(ws + WS_MODF), A.final_g, (const bf16_t*)(ws + WS_X1B), A.out, (float*)(ws + WS_XS), cnt + 64 * CNT_X5, spare};
        pg8::gemm_phase(F.lds, g, S, E, F.wave);
        SPROBE(2);
    }
#if defined(PROBE_K0) && PROBE_K0 >= 100 && PROBE_K0 < 200
    if (v == PROBE_BID && F.tid == 0) *(float*)(ws + 32768) = (float)tacc_;
#endif
}

constexpr int N_PHASES = 8;
__global__ void __launch_bounds__(NTHR, 2) fwd_kernel(Args A_) {
    CArgs& A = *(CArgs*)__builtin_amdgcn_kernarg_segment_ptr();
    extern __shared__ __attribute__((aligned(16))) unsigned char lds_raw[];
    Frame F; F.lds = (LAS unsigned char*)lds_raw; F.wave = __builtin_amdgcn_readfirstlane(threadIdx.x >> 6); F.lane = lane_id_(); F.tid = F.wave * 64 + F.lane; F.G = gridDim.x; F.bid = blockIdx.x;
    volatile LAS unsigned* MISC = (volatile LAS unsigned*)(F.lds + MISC_OFF);
    if (F.tid < 64) MISC[F.tid] = 0u;
    __syncthreads();
    unsigned char* ws = A.ws;
    XcdBarrier bar = xcd_barrier_post((unsigned*)(ws + WS_CTL), MISC + 8, F.wave);
    const int lo = A.ph_lo, hi = A.ph_hi;
#ifdef ONLY_PHASE
#define IN(k) ((k) == ONLY_PHASE)
#else
#define IN(k) (lo <= (k) && (k) < hi)
#endif
#ifdef PROBE_K0
    unsigned long long tA_ = __builtin_amdgcn_s_memrealtime();
#define PROBE_AT(k) do { if ((k) == PROBE_K0 - 1) tA_ = __builtin_amdgcn_s_memrealtime(); \
    if ((k) == PROBE_K1 && F.bid == 0 && F.tid == 0) { const unsigned long long tB_ = __builtin_amdgcn_s_memrealtime(); *(float*)(ws + 32768) = (float)(tB_ - tA_) - 100.0f * PROBE_OFS; } } while (0)
#else
#define PROBE_AT(k) do { } while (0)
#endif
#define SEAM(k) do { if (IN(k) && IN((k) + 1)) xcd_barrier(bar); F.lane = lane_id_(); F.tid = F.wave * 64 + F.lane; PROBE_AT(k); } while (0)
    LAS float* spare = (LAS float*)(F.lds + SPARE_OFF);
    const int NOJ = 1 << 30;
    if (IN(0)) { phase0(F, A); } SEAM(0);
    if (IN(1)) { phase1(F, A); } SEAM(1);
    if (IN(2)) {
        pg8::Gemm g{(const bf16_t*)(ws + WS_H), (const bf16_t*)(ws + WS_WA), MT, DIN, DM, DM, DM, NOJ, 0};
        pg8::StaticOrder S; S.init(MT, DIN, F.G, F.bid, true);
        EpiIn E{(bf16_t*)(ws + WS_Q), (bf16_t*)(ws + WS_KALL), (bf16_t*)(ws + WS_VALL), (bf16_t*)(ws + WS_KP), (bf16_t*)(ws + WS_VP), (bf16_t*)(ws + WS_RQ), (bf16_t*)(ws + WS_RK),
                (bf16_t*)(ws + WS_RV), (bf16_t*)(ws + WS_SRG), (bf16_t*)A.out, (bf16_t*)A.out + (size_t)MT * DM, A.out + OUT_CK, A.out + OUT_CV, A.q_g, A.k_g, spare, (unsigned*)(ws + WS_CNT1)};
        pg8::gemm_phase(F.lds, g, S, E, F.wave);
        phase_r1(F, A);
    } SEAM(2);
    if (IN(4)) { phase_scan(F, A); } SEAM(4);
    if (IN(5)) { phase_attn(F, A); } SEAM(5);
    if (IN(6)) { phase_mix(F, A); } SEAM(6);
    if (IN(7)) { phase_stream(F, A); }
#ifdef PROBE_K0
    {
        PROBE_AT(7);
        xcd_barrier(bar);
        const float sc_ = 1.0f + sqrtf(*(const float*)(ws + 32768) * 1e-7f);
        for (int i = F.bid * NTHR + F.tid; i < NB * NKV * SEQ * HD; i += F.G * NTHR) A.out[OUT_CV + i] *= sc_;
    }
#endif
#undef IN
#undef SEAM
}

#ifndef MK_SPLIT
#define MK_SPLIT 0
#endif
extern "C" void kernel_launch(void* const* d_in, const int* in_sizes, int n_in, void* d_out, int out_size, void* d_ws, size_t ws_size, hipStream_t stream) {
    static int grid = 0;
    if (grid == 0) {
        if (n_in != 25 || ws_size < WS_END) { fprintf(stderr, "kernel_launch: unexpected n_in %d / ws %zu\n", n_in, ws_size); grid = -1; return; }
        int dev = 0, cus = 0, per_cu = 0;
        hipGetDevice(&dev); hipDeviceGetAttribute(&cus, hipDeviceAttributeMultiprocessorCount, dev);
        if (hipFuncSetAttribute((const void*)fwd_kernel, hipFuncAttributeMaxDynamicSharedMemorySize, LDS_BYTES) != hipSuccess) { fprintf(stderr, "kernel_launch: hipFuncSetAttribute failed\n"); grid = -1; return; }
        hipOccupancyMaxActiveBlocksPerMultiprocessor(&per_cu, (const void*)fwd_kernel, NTHR, LDS_BYTES);
        (void)hipGetLastError();
        if (per_cu < 1) fprintf(stderr, "kernel_launch: occupancy query says %d blocks/CU\n", per_cu);
        grid = cus;
        if (grid != 256) fprintf(stderr, "kernel_launch: %d CUs (built for 256)\n", grid);
    }
    if (grid < 0) return;
    hipMemsetAsync((char*)d_ws + WS_CTL, 0, CTL_ZERO_BYTES, stream);
    Args a{};
    const float** pa = (const float**)&a;
    for (int i = 0; i < 25; ++i) pa[i] = (const float*)d_in[i];
    a.out = (float*)d_out; a.ws = (unsigned char*)d_ws;
#if MK_SPLIT
    for (int p = 0; p < N_PHASES; ++p) { a.ph_lo = p; a.ph_hi = p + 1; hipLaunchKernelGGL(fwd_kernel, dim3(grid), dim3(NTHR), LDS_BYTES, stream, a); }
#else
    a.ph_lo = 0; a.ph_hi = N_PHASES; hipLaunchKernelGGL(fwd_kernel, dim3(grid), dim3(NTHR), LDS_BYTES, stream, a);
#endif
    const hipError_t le = hipPeekAtLastError();
    if (le != hipSuccess) fprintf(stderr, "kernel_launch: launch failed: %s\n", hipGetErrorName(le));
}
```

```cpp
#include <hip/hip_runtime.h>
#include <hip/hip_bf16.h>
#include <cstdio>
#include <cstdint>

#ifndef PROBE_BID
#define PROBE_BID 100
#endif
#ifndef PROBE_OFS
#define PROBE_OFS 0
#endif
constexpr int DM = 1024, NB = 16, SEQ = 256, DB = 4, DSEQ = 4096, PAST = 512, GRIDW = 64;
constexpr int NH = 8, NKV = 2, HD = 128, RH = 8, RDK = 64, RDV = 128, DFF = 2816, CHUNK = 128;
constexpr int MP = NB * SEQ, ML = DB * DSEQ, MT = MP + ML;
constexpr int DIN = 6656, SKV = DSEQ + PAST;
constexpr int NUP = 2 * DFF;
constexpr float EPS = 1e-6f;
constexpr int NCHUNK = MT / CHUNK;
constexpr int NITEM = NCHUNK * RH;

#define GAS __attribute__((address_space(1)))
#define LAS __attribute__((address_space(3)))
typedef unsigned short bf16_t;
typedef short bf16x8 __attribute__((ext_vector_type(8)));
typedef short s16x4 __attribute__((ext_vector_type(4)));
typedef float f32x4 __attribute__((ext_vector_type(4)));
typedef float f32x2 __attribute__((ext_vector_type(2)));
typedef float f32x16 __attribute__((ext_vector_type(16)));
typedef unsigned u32x4 __attribute__((ext_vector_type(4)));
typedef unsigned u32x2 __attribute__((ext_vector_type(2)));
typedef GAS unsigned gu32;

constexpr size_t MiB = 1u << 20;
constexpr size_t WS_CTL = 0, CTL_ZERO_BYTES = 16 * 1024;
constexpr size_t WS_MOD = 256 * 1024;
constexpr size_t MODQ = 5 * 6144;
constexpr size_t WS_MODF = 1 * MiB + 832 * 1024;
constexpr size_t WS_BUP = 768 * 1024;
constexpr size_t BUPQ = 5 * 5632;
constexpr size_t WS_BUPF = 1 * MiB + 384 * 1024;
constexpr size_t WS_SSQ1 = 1 * MiB + 256 * 1024;
constexpr size_t WS_XS = 1 * MiB + 512 * 1024;
constexpr size_t WS_CNT = 64 * 1024;
constexpr size_t WS_CNT1 = 152 * 1024;
constexpr int CNT_D2 = 0, CNT_D3 = 80, CNT_D4 = 160, CNT_X5 = 240, CNT_G3ALL = 320, CNT_R3Q = 321;
constexpr size_t WS_WA = 2 * MiB;
constexpr size_t WS_WB = 16 * MiB;
constexpr size_t WS_WC = 20 * MiB;
constexpr size_t WS_WD = 22 * MiB;
constexpr size_t WS_H = 28 * MiB;
constexpr size_t WS_Q = 68 * MiB;
constexpr size_t WS_KALL = 108 * MiB, WS_VALL = 117 * MiB, WS_KP = 126 * MiB, WS_VP = 128 * MiB;
constexpr size_t WS_RQ = 132 * MiB, WS_RK = 152 * MiB, WS_RV = 172 * MiB, WS_SRG = 212 * MiB, WS_END = 252 * MiB;
constexpr size_t WS_Y = WS_RQ;
constexpr size_t WS_X1B = WS_SRG;
constexpr size_t WS_ACT = WS_Q;
constexpr size_t WS_EDGE_U = 178 * MiB, WS_EDGE_UC = 182 * MiB;
static_assert((size_t)DIN * DM * 2 <= 14 * MiB && (size_t)MT * DM * 2 == 40 * MiB && (size_t)NITEM * 2 * RDK * RDV * 2 == 40 * MiB, "ws map");
static_assert((size_t)DB * NKV * SKV * HD * 2 <= 9 * MiB && (size_t)NB * NKV * SEQ * HD * 2 <= 2 * MiB, "ws map kv");
static_assert(WS_ACT + (size_t)MT * DFF * 2 <= WS_EDGE_U && (size_t)80 * 2 * NUP * 4 <= 4 * MiB && WS_EDGE_UC + 4 * MiB <= WS_X1B, "ws map act");
static_assert(WS_CNT + 322 * 256 <= WS_CNT1 && WS_CNT1 + (481 + 82) * 64 <= WS_MOD && WS_MOD + 4 * MODQ * 4 <= WS_BUP && WS_BUP + 4 * BUPQ * 4 <= WS_SSQ1 && WS_SSQ1 + (size_t)MT * 4 <= WS_BUPF
              && WS_BUPF + BUPQ * 4 <= WS_XS && WS_XS + (size_t)80 * 4 * 256 * 4 <= WS_MODF && WS_MODF + MODQ * 4 <= WS_WA, "ws map: small buffers");
constexpr size_t OUT_Y = 0, OUT_CK = (size_t)MT * DM, OUT_CV = OUT_CK + (size_t)NB * NKV * SEQ * HD, OUT_SF = OUT_CV + (size_t)NB * NKV * SEQ * HD, OUT_SB = OUT_SF + (size_t)NB * RH * RDK * RDV;

#define LDS_WAIT() asm volatile("s_waitcnt lgkmcnt(0)" ::: "memory")
#define VM_WAIT() asm volatile("s_waitcnt vmcnt(0)" ::: "memory")
#define RLX_AGENT __ATOMIC_RELAXED, __HIP_MEMORY_SCOPE_AGENT
typedef __bf16 bf16x2_t __attribute__((ext_vector_type(2)));
__device__ __forceinline__ unsigned pk2(float lo, float hi) { const f32x2 v = {lo, hi}; return __builtin_bit_cast(unsigned, __builtin_convertvector(v, bf16x2_t)); }
__device__ __forceinline__ unsigned f2bf(float f) { return pk2(f, 0.f) & 0xffffu; }
__device__ __forceinline__ float bflo(unsigned w) { return __builtin_bit_cast(float, w << 16); }
__device__ __forceinline__ float bfhi(unsigned w) { return __builtin_bit_cast(float, w & 0xffff0000u); }
__device__ __forceinline__ float bf2f(bf16_t h) { return __builtin_bit_cast(float, (unsigned)h << 16); }
__device__ __forceinline__ int swap25(int p) { return (p & ~0x24) | ((p & 4) << 3) | ((p & 32) >> 3); }
__device__ __forceinline__ float sigmoidf_(float x) { return __builtin_amdgcn_rcpf(1.0f + __builtin_amdgcn_exp2f(-1.4426950408889634f * x)); }
__device__ __forceinline__ float siluf_(float x) { return x * __builtin_amdgcn_rcpf(1.0f + __builtin_amdgcn_exp2f(-1.4426950408889634f * x)); }
__device__ __forceinline__ int lane_id_() { int l; asm volatile("v_mbcnt_lo_u32_b32 %0, -1, 0\n\tv_mbcnt_hi_u32_b32 %0, -1, %0" : "=v"(l)); return l; }
__device__ __forceinline__ f32x4 sum4q(const float* p, size_t q) { return (*(const f32x4*)p + *(const f32x4*)(p + q)) + (*(const f32x4*)(p + 2 * q) + *(const f32x4*)(p + 3 * q)); }
__device__ __forceinline__ float wave_sum(float v) {
#pragma unroll
    for (int o = 1; o < 64; o <<= 1) v += __shfl_xor(v, o);
    return v;
}
__device__ __forceinline__ void sincos_rev(float ang, float& c, float& s) {
    const float fr = __builtin_amdgcn_fractf(ang * 0.15915494309189533577f);
    s = __builtin_amdgcn_sinf(fr); c = __builtin_amdgcn_cosf(fr);
}
__device__ __forceinline__ float rope_inv(int i) { return exp2f(-(float)i * (13.287712379549449f / 32.0f)); }

#define XB_TMO      128
#define XB_XCNT(j)  (256  + 64 * (j))
#define XB_XSUB(j)  (1280 + 64 * (j))
#define XB_XGEN(j)  (2304 + 64 * (j))
#define XB_TOP      3328
#define XB_TOPGEN   3392
#define XCD_BAR_WORDS 3456
#define XB_SPIN_CAP (1u << 20)
__device__ __forceinline__ unsigned xb_ld(unsigned* p)              { return __hip_atomic_load(p, __ATOMIC_RELAXED, __HIP_MEMORY_SCOPE_AGENT); }
__device__ __forceinline__ unsigned xb_add(unsigned* p, unsigned v) { return __hip_atomic_fetch_add(p, v, __ATOMIC_RELAXED, __HIP_MEMORY_SCOPE_AGENT); }
__device__ __forceinline__ unsigned xb_xcc_id() { return (unsigned)__builtin_amdgcn_s_getreg((3 << 11) | 20) & 0xFu; }
#define XB_SPIN(cond, bar) do { unsigned _sp = 0; while (cond) { __builtin_amdgcn_s_sleep(1); \
    if ((++_sp & 255u) == 0u) { if (xb_ld(&(bar)[XB_TMO])) break; if (_sp > XB_SPIN_CAP) { atomicAdd(&(bar)[XB_TMO], 1u); break; } } } } while (0)
struct XcdBarrier { unsigned* bar; unsigned x; volatile LAS unsigned* st; int wave; };
__device__ __forceinline__ XcdBarrier xcd_barrier_post(unsigned* bar, volatile LAS unsigned* st, int wave) {
    XcdBarrier b; b.bar = bar; b.x = xb_xcc_id(); b.st = st; b.wave = wave;
    if (wave == 0 && lane_id_() == 0) (void)xb_add(&bar[XB_XCNT(b.x)], 1u);
    return b;
}
__device__ __forceinline__ void xcd_barrier_complete(unsigned* bar, unsigned x, unsigned& nloc, unsigned& nx) {
    const unsigned G = gridDim.x * gridDim.y * gridDim.z;
    unsigned sum, cnt, mine, sp = 0u;
    for (;;) {
        sum = 0u; cnt = 0u; mine = 0u;
#pragma unroll
        for (unsigned j = 0; j < 16; ++j) { const unsigned c = xb_ld(&bar[XB_XCNT(j)]); sum += c; cnt += (c > 0u) ? 1u : 0u; mine = (j == x) ? c : mine; }
        if (sum == G) break;
        __builtin_amdgcn_s_sleep(1);
        if ((++sp & 255u) == 0u) { if (xb_ld(&bar[XB_TMO])) break; if (sp > XB_SPIN_CAP) { atomicAdd(&bar[XB_TMO], 1u); break; } }
    }
    nloc = mine > 0u ? mine : 1u; nx = cnt > 0u ? cnt : 1u;
}
__device__ __forceinline__ void xcd_barrier(const XcdBarrier& b) {
    asm volatile("s_waitcnt vmcnt(0)" ::: "memory");
    __syncthreads();
    if (b.wave == 0 && lane_id_() == 0) {
        unsigned* bar = b.bar;
        __builtin_amdgcn_s_waitcnt(0);
        unsigned nloc = b.st[0], nx = b.st[1];
        if (nloc == 0u) { xcd_barrier_complete(bar, b.x, nloc, nx); b.st[0] = nloc; b.st[1] = nx; }
        const unsigned old = xb_add(&bar[XB_XSUB(b.x)], 1u);
        const unsigned gen = old / nloc;
        if (old + 1u == (gen + 1u) * nloc) {
            __builtin_amdgcn_fence(__ATOMIC_RELEASE, "agent");
            asm volatile("s_waitcnt vmcnt(0)" ::: "memory");
            const unsigned og = xb_add(&bar[XB_TOP], 1u);
            const unsigned tg = og / nx;
            if (og + 1u == (tg + 1u) * nx) xb_add(&bar[XB_TOPGEN], 1u);
            else XB_SPIN(xb_ld(&bar[XB_TOPGEN]) == tg, bar);
            __builtin_amdgcn_fence(__ATOMIC_ACQUIRE, "agent");
            xb_add(&bar[XB_XGEN(b.x)], 1u);
            asm volatile("s_waitcnt vmcnt(0)" ::: "memory");
        } else {
            XB_SPIN(xb_ld(&bar[XB_XGEN(b.x)]) == gen, bar);
            __builtin_amdgcn_fence(__ATOMIC_ACQUIRE, "agent");
            asm volatile("s_waitcnt vmcnt(0)" ::: "memory");
        }
    }
    __syncthreads();
}

namespace pg8 {
constexpr int BM = 256, BK = 64, HALF = 128, HTB = HALF * BK * 2, STAGE_BYTES = 8 * HTB, NXCD = 8, WGM = 8;
__host__ __device__ __forceinline__ int lds_byte(int r, int c) { const int st = (r >> 4) * 2 + (c >> 5), rr = r & 15, cc = c & 31, ob = rr * 64 + cc * 2; return st * 1024 + (ob ^ (((ob >> 9) & 1) << 5)); }
__host__ __device__ __forceinline__ void stage_rc(int b, int& R, int& C) { const int st = b / 1024, sb = b % 1024, swz = sb ^ (((sb >> 9) & 1) << 5); R = (st >> 1) * 16 + swz / 64; C = (st & 1) * 32 + (swz % 64) / 2; }
__host__ __device__ __forceinline__ int perm32(int rho) { const int n = rho >> 4, i = rho & 15; return 8 * (i >> 2) + 4 * n + (i & 3); }
struct Unit { int pm, pn; };
struct Gemm { const bf16_t* A; const bf16_t* Bt; int M, N, K, lda, ldb, jt; long jumpA; };
struct StaticOrder {
    int nM, nN, nwg, G, c; bool in_order;
    __host__ __device__ void init(int M, int N, int G_, int c_, bool io = false) { nM = M / BM; nN = N / BM; nwg = nM * nN; G = G_; c = c_; in_order = io; }
    __host__ __device__ bool next(int i, Unit& u) const {
        const long L = (long)i * G + c; if (L >= nwg) return false;
        int wgid = (int)L; { const int q = nwg / NXCD, r = nwg % NXCD, xcd = wgid % NXCD, off = wgid / NXCD; wgid = (xcd < r ? xcd * (q + 1) : r * (q + 1) + (xcd - r) * q) + off; }
        const int nig = WGM * nN, gid = wgid / nig, fm = gid * WGM, gsz = (nM - fm) < WGM ? (nM - fm) : WGM;
        u.pm = fm + ((wgid % nig) % gsz); u.pn = (wgid % nig) / gsz;
        if (in_order) u.pn = u.pn < 6 ? 8 + u.pn : u.pn < 14 ? u.pn - 6 : u.pn;
        return true;
    }
    __device__ __forceinline__ void a_ready(const Unit&, int) const {}
};
template <class Epi, class Sched>
__device__ __forceinline__ void gemm_phase(LAS unsigned char* lds, const Gemm g, const Sched& S, const Epi& E, const int wid) {
    const int lane = lane_id_(), tid = wid * 64 + lane, wr = wid >> 2, wc = wid & 3, fr = lane & 15, fq = lane >> 4;
    const int nt = g.K / BK;
    unsigned voffA[2], voffB[2];
#pragma unroll
    for (int i = 0; i < 2; ++i) { int R, C; stage_rc(tid * 16 + i * 8192, R, C); const int Rb = (R & ~31) + perm32(R & 31);
        voffA[i] = (unsigned)(R * g.lda + C) * 2u; voffB[i] = (unsigned)(Rb * g.ldb + C) * 2u; }
    const size_t kstep = (size_t)(BK * 2);
    const size_t hstepA = (size_t)HALF * g.lda * 2, hstepB = (size_t)HALF * g.ldb * 2;
    const size_t tstepA = 2 * hstepA, tstepB = 2 * hstepB;
    const unsigned ldsw = (unsigned)wid * 1024u;
    const int aoff = lds_byte(wr * 64 + fr, fq * 8), boff = lds_byte(wc * 32 + fr, fq * 8);
#define PG8_SA(b, h) (((b) * 2 + (h)) * HTB)
#define PG8_SB(b, h) ((4 + (b) * 2 + (h)) * HTB)
#define PG8_STAGE(bufoff, gbase, voff) do { _Pragma("unroll") for (int _i = 0; _i < 2; ++_i) \
        __builtin_amdgcn_global_load_lds((const unsigned*)((const char*)(gbase) + (voff)[_i]), (LAS unsigned*)(lds + (bufoff) + ldsw + _i * 8192), 16, 0, 0); } while (0)
#define PG8_LDA(dst, b, h) do { _Pragma("unroll") for (int m = 0; m < 4; ++m) _Pragma("unroll") for (int k = 0; k < 2; ++k) dst[m][k] = *(const LAS bf16x8*)(lds + PG8_SA(b, h) + aoff + m * 2048 + k * 1024); } while (0)
#define PG8_LDB(dst, b, h) do { _Pragma("unroll") for (int n = 0; n < 2; ++n) _Pragma("unroll") for (int k = 0; k < 2; ++k) dst[n][k] = *(const LAS bf16x8*)(lds + PG8_SB(b, h) + boff + n * 2048 + k * 1024); } while (0)
#define PG8_MMA(ai, bj, At, Bt) do { __builtin_amdgcn_s_setprio(1); _Pragma("unroll") for (int m = 0; m < 4; ++m) _Pragma("unroll") for (int n = 0; n < 2; ++n) _Pragma("unroll") for (int k = 0; k < 2; ++k) \
        acc[ai][bj][m][n] = __builtin_amdgcn_mfma_f32_16x16x32_bf16(Bt[n][k], At[m][k], acc[ai][bj][m][n], 0, 0, 0); __builtin_amdgcn_s_setprio(0); } while (0)
#define PG8_WAIT_V(n) asm volatile("s_waitcnt vmcnt(" #n ")" ::: "memory")
#define PG8_WAIT_L(n) asm volatile("s_waitcnt lgkmcnt(" #n ")" ::: "memory")
#define PG8_BAR __builtin_amdgcn_s_barrier()
#define PG8_SCHED __builtin_amdgcn_sched_barrier(0)
    Unit cur, nxt; int ui = 0;
    if (!S.next(0, cur)) return;
    f32x4 acc[2][2][4][2];
#pragma unroll
    for (int a = 0; a < 2; ++a)
#pragma unroll
        for (int b = 0; b < 2; ++b)
#pragma unroll
            for (int m = 0; m < 4; ++m)
#pragma unroll
                for (int n = 0; n < 2; ++n) acc[a][b][m][n] = (f32x4){0.f, 0.f, 0.f, 0.f};
    bf16x8 At[4][2], B0[2][2], B1[2][2];
    const char* cA = (const char*)g.A + (size_t)cur.pm * tstepA; const char* cB = (const char*)g.Bt + (size_t)cur.pn * tstepB;
    const int jt = g.jt; const long jumpA = g.jumpA;
    S.a_ready(cur, wid);
#define PG8_KA(base, t) ((base) + (size_t)(t) * kstep + ((t) >= jt ? jumpA : 0L))
    PG8_STAGE(PG8_SB(0, 0), cB, voffB); PG8_STAGE(PG8_SB(0, 1), cB + hstepB, voffB); PG8_STAGE(PG8_SA(0, 0), cA, voffA); PG8_STAGE(PG8_SA(0, 1), cA + hstepA, voffA);
    if (wr == 1) PG8_BAR;
    PG8_WAIT_V(2); PG8_BAR;
    PG8_STAGE(PG8_SB(1, 0), cB + kstep, voffB); PG8_STAGE(PG8_SA(1, 0), PG8_KA(cA, 1), voffA); PG8_STAGE(PG8_SB(1, 1), cB + hstepB + kstep, voffB);
    PG8_WAIT_V(6); PG8_BAR;
    for (;;) {
        const bool has_next = S.next(ui + 1, nxt);
        const char* nA = has_next ? (const char*)g.A + (size_t)nxt.pm * tstepA : cA; const char* nB = has_next ? (const char*)g.Bt + (size_t)nxt.pn * tstepB : cB;
        for (int seg = 0; seg < (Epi::MID_T >= 0 ? 2 : 1); ++seg) {
        const int tb = (Epi::MID_T >= 0 && seg == 1) ? Epi::MID_T : 0, te = (Epi::MID_T >= 0 && seg == 0) ? Epi::MID_T : nt;
        if constexpr (Epi::MID_T >= 0) { if (seg == 1) E.mid(acc, cur, wr, wc, fr, fq); }
        for (int t = tb; t < te; t += 2) {
            const bool last = (t == nt - 2);
            if (last && has_next) S.a_ready(nxt, wid);
            const char* a1 = PG8_KA(cA, t + 1);
            const char* a2 = last ? nA : PG8_KA(cA, t + 2); const char* b2 = last ? nB : cB + (size_t)(t + 2) * kstep;
            const char* a3 = last ? PG8_KA(nA, 1) : PG8_KA(cA, t + 3); const char* b3 = b2 + kstep;
            PG8_LDB(B0, 0, 0); PG8_LDB(B1, 0, 1); PG8_SCHED; PG8_LDA(At, 0, 0); PG8_STAGE(PG8_SA(1, 1), a1 + hstepA, voffA);
            PG8_WAIT_V(8); PG8_WAIT_L(0); PG8_BAR; PG8_MMA(0, 0, At, B0); PG8_MMA(0, 1, At, B1); PG8_BAR; PG8_SCHED;
            PG8_LDA(At, 0, 1); PG8_STAGE(PG8_SB(0, 0), b2, voffB); PG8_STAGE(PG8_SB(0, 1), b2 + hstepB, voffB); PG8_STAGE(PG8_SA(0, 0), a2, voffA);
            PG8_WAIT_V(8); PG8_WAIT_L(0); PG8_BAR; PG8_MMA(1, 0, At, B0); PG8_MMA(1, 1, At, B1); PG8_BAR; PG8_SCHED;
            PG8_LDB(B0, 1, 0); PG8_LDB(B1, 1, 1); PG8_SCHED; PG8_LDA(At, 1, 0); PG8_STAGE(PG8_SA(0, 1), a2 + hstepA, voffA);
            PG8_WAIT_V(8); PG8_WAIT_L(0); PG8_BAR; PG8_MMA(0, 0, At, B0); PG8_MMA(0, 1, At, B1); PG8_BAR; PG8_SCHED;
            PG8_LDA(At, 1, 1); PG8_STAGE(PG8_SB(1, 0), b3, voffB); PG8_STAGE(PG8_SB(1, 1), b3 + hstepB, voffB); PG8_STAGE(PG8_SA(1, 0), a3, voffA);
            PG8_WAIT_V(8); PG8_WAIT_L(0); PG8_BAR; PG8_MMA(1, 0, At, B0); PG8_MMA(1, 1, At, B1); PG8_BAR; PG8_SCHED;
        }
        }
        const typename Epi::Pre pf = E.pre(cur, wr, wc, fr, fq, wid, lane);
        if (wr == 0) PG8_BAR;
        E.epi(acc, cur, wr, wc, fr, fq, wid, lane, pf);
        if (!has_next) break;
#pragma unroll
        for (int a = 0; a < 2; ++a)
#pragma unroll
            for (int b = 0; b < 2; ++b)
#pragma unroll
                for (int m = 0; m < 4; ++m)
#pragma unroll
                    for (int n = 0; n < 2; ++n) acc[a][b][m][n] = (f32x4){0.f, 0.f, 0.f, 0.f};
        cur = nxt; cA = nA; cB = nB; ++ui;
        if (wr == 1) PG8_BAR;
    }
    PG8_WAIT_V(0);
    PG8_BAR;
#undef PG8_KA
#undef PG8_SA
#undef PG8_SB
#undef PG8_STAGE
#undef PG8_LDA
#undef PG8_LDB
#undef PG8_MMA
#undef PG8_WAIT_V
#undef PG8_WAIT_L
#undef PG8_BAR
#undef PG8_SCHED
}
}

typedef f32x4 AccT[2][2][4][2];
struct NoPre {};
#define PIN8(a, i, j) asm volatile("" : "+v"(a[i][j][0][0]), "+v"(a[i][j][0][1]), "+v"(a[i][j][1][0]), "+v"(a[i][j][1][1]), "+v"(a[i][j][2][0]), "+v"(a[i][j][2][1]), "+v"(a[i][j][3][0]), "+v"(a[i][j][3][1]))
#define PINACC(a) do { PIN8(a, 0, 0); PIN8(a, 0, 1); PIN8(a, 1, 0); PIN8(a, 1, 1); } while (0)
#define RAW_BAR() do { asm volatile("s_waitcnt lgkmcnt(0)" ::: "memory"); __builtin_amdgcn_s_barrier(); asm volatile("" ::: "memory"); } while (0)
__device__ __forceinline__ u32x4 pack8(const f32x4 a, const f32x4 b) { u32x4 w; w.x = pk2(a[0], a[1]); w.y = pk2(a[2], a[3]); w.z = pk2(b[0], b[1]); w.w = pk2(b[2], b[3]); return w; }
__device__ __forceinline__ void unpack8(const u32x4 w, f32x4& a, f32x4& b) { a = (f32x4){bflo(w.x), bfhi(w.x), bflo(w.y), bfhi(w.y)}; b = (f32x4){bflo(w.z), bfhi(w.z), bflo(w.w), bfhi(w.w)}; }

typedef __amdgpu_buffer_rsrc_t rsrc_t;
__device__ __forceinline__ rsrc_t mk_rsrc(const void* p, unsigned bytes) { return __builtin_amdgcn_make_buffer_rsrc((void*)p, (short)0, (int)bytes, 0x00020000); }
__device__ __forceinline__ void st16_wt(rsrc_t r, unsigned off, u32x4 v) { __builtin_amdgcn_raw_buffer_store_b128(v, r, off, 0, 16); }
__device__ __forceinline__ void st16_wt(rsrc_t r, unsigned off, f32x4 v) { __builtin_amdgcn_raw_buffer_store_b128(__builtin_bit_cast(u32x4, v), r, off, 0, 16); }

struct EpiIn {
    static constexpr int MID_T = -1;
    typedef NoPre Pre;
    __device__ __forceinline__ Pre pre(const pg8::Unit&, int, int, int, int, int, int) const { return Pre(); }
    bf16_t *Q, *KALL, *VALL, *KP, *VP, *RQ, *RK, *RV, *SRG, *GA, *GR; float *ock, *ocv; const float *qg, *kg; LAS float* P; unsigned* c1;
    __device__ __forceinline__ void mid(AccT&, const pg8::Unit&, int, int, int, int) const {}
    __device__ __forceinline__ void epi(AccT& acc, const pg8::Unit& u, int wr, int wc, int fr, int fq, int wid, int lane, const Pre&) const {
        asm volatile("" : "+v"(fr), "+v"(fq));
        const int pn = u.pn, pm = u.pm; const bool latent = pm >= 16;
        if (wid == 0 && lane == 0) { __hip_atomic_fetch_add(c1 + 16 * (481 + pm), 1u, RLX_AGENT); __hip_atomic_fetch_add(c1 + 16 * (481 + 80), 1u, RLX_AGENT); }
        const int lb = (pm - 16) >> 4, t0 = latent ? ((pm - 16) & 15) * 256 : 0;
        const int rl0 = 64 * wr + fr, cw8 = 32 * wc + 8 * fq;
        const size_t grow0 = (size_t)pm * 256;
        if (pn <= 4) {
#pragma unroll
            for (int ai = 0; ai < 2; ++ai)
#pragma unroll
                for (int m = 0; m < 4; ++m)
#pragma unroll
                    for (int bj = 0; bj < 2; ++bj) { const f32x4 a = acc[ai][bj][m][0], b = acc[ai][bj][m][1];
                        float s = (a[0] * a[0] + a[1] * a[1]) + (a[2] * a[2] + a[3] * a[3]) + (b[0] * b[0] + b[1] * b[1]) + (b[2] * b[2] + b[3] * b[3]);
                        s += __shfl_xor(s, 16); s += __shfl_xor(s, 32);
                        if (fq == 0) P[((128 * ai + rl0 + 16 * m) * 2 + bj) * 4 + wc] = s; }
            RAW_BAR();
            const float* gain = pn < 4 ? qg : kg;
            const int d0 = 64 * (wc >> 1) + 8 * fq + 4 * (wc & 1);
            const f32x4 g0 = *(const f32x4*)(gain + d0), g1 = *(const f32x4*)(gain + d0 + 32);
            float inv[4];
#pragma unroll
            for (int e = 0; e < 4; ++e) inv[e] = rope_inv(8 * fq + 4 * (wc & 1) + e);
#pragma unroll
            for (int ai = 0; ai < 2; ++ai)
#pragma unroll
                for (int m = 0; m < 4; ++m) { const int r = 128 * ai + rl0 + 16 * m, t = t0 + r;
                    f32x4 cs = {1.f, 1.f, 1.f, 1.f}, sn = {0.f, 0.f, 0.f, 0.f};
                    if (latent) { const float pos = (float)((wc >> 1) == 0 ? (t >> 6) : (t & 63));
#pragma unroll
                        for (int e = 0; e < 4; ++e) { float c_, s_; sincos_rev(pos * inv[e], c_, s_); cs[e] = c_; sn[e] = s_; } }
#pragma unroll
                    for (int bj = 0; bj < 2; ++bj) { const f32x4 pp = *(const LAS f32x4*)&P[(r * 2 + bj) * 4];
                        const float rstd = __builtin_amdgcn_rsqf(((pp[0] + pp[1]) + (pp[2] + pp[3])) * (1.0f / 128.0f) + EPS);
                        const f32x4 x1 = acc[ai][bj][m][0] * rstd * g0, x2 = acc[ai][bj][m][1] * rstd * g1;
                        const f32x4 o1 = x1 * cs - x2 * sn, o2 = x2 * cs + x1 * sn;
                        const u32x4 w = pack8(o1, o2);
                        if (pn < 4) { *(u32x4*)(Q + (grow0 + r) * 1024 + 128 * (2 * pn + bj) + cw8) = w; }
                        else if (latent) { *(u32x4*)(KALL + ((size_t)(lb * 2 + bj) * SKV + t) * 128 + cw8) = w; }
                        else { const size_t o = ((size_t)(pm * 2 + bj) * 256 + t) * 128;
                            *(u32x4*)(KP + o + cw8) = w; *(f32x4*)(ock + o + d0) = o1; *(f32x4*)(ock + o + d0 + 32) = o2; } } }
        } else if (pn == 5) {
#pragma unroll
            for (int ai = 0; ai < 2; ++ai)
#pragma unroll
                for (int m = 0; m < 4; ++m) { const int r = 128 * ai + rl0 + 16 * m, t = t0 + r;
#pragma unroll
                    for (int bj = 0; bj < 2; ++bj) { const f32x4 a = acc[ai][bj][m][0], b = acc[ai][bj][m][1]; const u32x4 w = pack8(a, b);
                        if (latent) { *(u32x4*)(VALL + ((size_t)(lb * 2 + bj) * SKV + t) * 128 + cw8) = w; }
                        else { const size_t o = ((size_t)(pm * 2 + bj) * 256 + t) * 128 + cw8;
                            *(u32x4*)(VP + o) = w; *(f32x4*)(ocv + o) = a; *(f32x4*)(ocv + o + 4) = b; } } }
        } else if (pn <= 9) {
            const float sc = pn >= 8 ? 0.125f : 1.0f; bf16_t* dst = RQ + (pn >= 8 ? (WS_RK - WS_RQ) / 2 : 0); const int cb = 256 * ((pn - 6) & 1);
            const rsrc_t rd = mk_rsrc(dst + grow0 * 512, 256 * 512 * 2);
            float inv[4];
#pragma unroll
            for (int e = 0; e < 4; ++e) inv[e] = rope_inv(8 * fq + 4 * (wc & 1) + e);
#pragma unroll
            for (int ai = 0; ai < 2; ++ai)
#pragma unroll
                for (int m = 0; m < 4; ++m) { const int r = 128 * ai + rl0 + 16 * m, t = t0 + r; const float pos = (float)(latent ? PAST + t : t);
                    f32x4 cs, sn;
#pragma unroll
                    for (int e = 0; e < 4; ++e) { float c_, s_; sincos_rev(pos * inv[e], c_, s_); cs[e] = c_ * sc; sn[e] = s_ * sc; }
#pragma unroll
                    for (int bj = 0; bj < 2; ++bj) { const f32x4 x1 = acc[ai][bj][m][0], x2 = acc[ai][bj][m][1];
                        st16_wt(rd, (unsigned)(((r * 512) + cb + 128 * bj + cw8) * 2), pack8(x1 * cs - x2 * sn, x2 * cs + x1 * sn)); } }
        } else if (pn < 18) {
            const int kind = (pn - 10) >> 2; bf16_t* dst = RV + (size_t)kind * ((WS_SRG - WS_RV) / 2); const int cb = 256 * ((pn - 10) & 3);
            const rsrc_t rd = mk_rsrc(dst + grow0 * 1024, 256 * 1024 * 2);
#pragma unroll
            for (int ai = 0; ai < 2; ++ai)
#pragma unroll
                for (int m = 0; m < 4; ++m) { const int r = 128 * ai + rl0 + 16 * m;
#pragma unroll
                    for (int bj = 0; bj < 2; ++bj) { f32x4 a = acc[ai][bj][m][0], b = acc[ai][bj][m][1];
                        if (kind == 1) { _Pragma("unroll") for (int e = 0; e < 4; ++e) { a[e] = siluf_(a[e]); b[e] = siluf_(b[e]); } }
                        st16_wt(rd, (unsigned)(((r * 1024) + cb + 128 * bj + cw8) * 2), pack8(a, b)); } }
        } else {
            const int cb = 128 * (pn - 18);
            const rsrc_t rra = mk_rsrc(GA + grow0 * 1024, 256 * 1024 * 2), rrg = mk_rsrc(GR + grow0 * 1024, 256 * 1024 * 2);
#pragma unroll
            for (int ai = 0; ai < 2; ++ai)
#pragma unroll
                for (int m = 0; m < 4; ++m) { const int r = 128 * ai + rl0 + 16 * m; f32x4 q0, q1, g0, g1;
#pragma unroll
                    for (int e = 0; e < 4; ++e) { g0[e] = sigmoidf_(acc[ai][1][m][0][e]); g1[e] = sigmoidf_(acc[ai][1][m][1][e]);
                        q0[e] = sigmoidf_(acc[ai][0][m][0][e]) * __builtin_amdgcn_rcpf(fmaxf(g0[e], 1e-30f)); q1[e] = sigmoidf_(acc[ai][0][m][1][e]) * __builtin_amdgcn_rcpf(fmaxf(g1[e], 1e-30f)); }
                    const unsigned o = (unsigned)(((r * 1024) + cb + cw8) * 2);
                    st16_wt(rra, o, pack8(q0, q1)); st16_wt(rrg, o, pack8(g0, g1)); }
        }
        if (pn >= 8 && pn <= 13) {
            asm volatile("s_waitcnt vmcnt(0)" ::: "memory");
            RAW_BAR();
            if (wid == 0 && lane == 0) { __hip_atomic_fetch_add(c1 + 16 * (pm * 6 + pn - 8), 1u, RLX_AGENT); __hip_atomic_fetch_add(c1 + 16 * 480, 1u, RLX_AGENT); } }
    }
};

struct EpiMix {
    static constexpr int MID_T = 16;
    typedef NoPre Pre;
    __device__ __forceinline__ Pre pre(const pg8::Unit&, int, int, int, int, int, int) const { return Pre(); }
    const bf16_t *GA, *GR; bf16_t* Y; unsigned* done;
    __device__ __forceinline__ void mid(AccT& acc, const pg8::Unit& u, int wr, int wc, int fr, int fq) const {
        unsigned lo = (unsigned)(((64 * wr + fr) * 1024 + 32 * wc + 8 * fq) * 2); asm volatile("" : "+v"(lo));
        const char* ga = (const char*)GA + ((size_t)u.pm * 256 * 1024 + 256 * u.pn) * 2;
        u32x4 q[8][2];
#pragma unroll
        for (int k = 0; k < 8; ++k)
#pragma unroll
            for (int bj = 0; bj < 2; ++bj) q[k][bj] = *(const u32x4*)(ga + lo + (unsigned)((((128 * (k >> 2) + 16 * (k & 3)) * 1024) + 128 * bj) * 2));
#pragma unroll
        for (int k = 0; k < 8; ++k)
#pragma unroll
            for (int bj = 0; bj < 2; ++bj) { f32x4 a0, a1; unpack8(q[k][bj], a0, a1); acc[k >> 2][bj][k & 3][0] *= a0; acc[k >> 2][bj][k & 3][1] *= a1; }
    }
    __device__ __forceinline__ void epi(AccT& acc, const pg8::Unit& u, int wr, int wc, int fr, int fq, int wid, int lane, const Pre&) const {
        unsigned lo = (unsigned)(((64 * wr + fr) * 1024 + 32 * wc + 8 * fq) * 2); asm volatile("" : "+v"(lo));
        const size_t ub = ((size_t)u.pm * 256 * 1024 + 256 * u.pn) * 2; const char* gr = (const char*)GR + ub; const rsrc_t ry = mk_rsrc((char*)Y + ub, 256 * 1024 * 2);
        u32x4 q[8][2];
#pragma unroll
        for (int k = 0; k < 8; ++k)
#pragma unroll
            for (int bj = 0; bj < 2; ++bj) q[k][bj] = *(const u32x4*)(gr + lo + (unsigned)((((128 * (k >> 2) + 16 * (k & 3)) * 1024) + 128 * bj) * 2));
#pragma unroll
        for (int k = 0; k < 8; ++k)
#pragma unroll
            for (int bj = 0; bj < 2; ++bj) { f32x4 r0, r1; unpack8(q[k][bj], r0, r1);
                st16_wt(ry, lo + (unsigned)((((128 * (k >> 2) + 16 * (k & 3)) * 1024) + 128 * bj) * 2), pack8(acc[k >> 2][bj][k & 3][0] * r0, acc[k >> 2][bj][k & 3][1] * r1)); }
        asm volatile("s_waitcnt vmcnt(0)" ::: "memory");
        RAW_BAR();
        if (wid == 0 && lane == 0) __hip_atomic_fetch_add(done + 64 * u.pm, 1u, RLX_AGENT);
    }
};

struct EpiRes1 {
    static constexpr int MID_T = -1;
    typedef NoPre Pre;
    __device__ __forceinline__ Pre pre(const pg8::Unit&, int, int, int, int, int, int) const { return Pre(); }
    const float *xp, *xs, *modf, *g2n; bf16_t* X1B; float* ssq; bf16_t* A2;
    __device__ __forceinline__ void mid(AccT&, const pg8::Unit&, int, int, int, int) const {}
    __device__ __forceinline__ void epi(AccT& acc, const pg8::Unit& u, int wr, int wc, int fr, int fq, int wid, int lane, const Pre&) const {
        asm volatile("" : "+v"(fr), "+v"(fq));
        const int pm = u.pm, v = pm < 16 ? 0 : 1 + ((pm - 16) >> 4);
        const float* mv = modf + (size_t)v * 6144; const float* xsrc = pm < 16 ? xp + (size_t)pm * 256 * 1024 : xs + (size_t)(pm - 16) * 256 * 1024;
        const unsigned cb = (unsigned)(256 * u.pn + 32 * wc + 8 * fq), rb = (unsigned)(64 * wr + fr);
        {   f32x4 g1[2][2];
#pragma unroll
            for (int bj = 0; bj < 2; ++bj)
#pragma unroll
                for (int n = 0; n < 2; ++n) g1[bj][n] = *(const f32x4*)(mv + 2048 + cb + 128 * bj + 4 * n);
#pragma unroll
            for (int h = 0; h < 4; ++h) { f32x4 xv[2][2][2];
#pragma unroll
                for (int mm = 0; mm < 2; ++mm)
#pragma unroll
                    for (int bj = 0; bj < 2; ++bj) { const float* p = xsrc + (size_t)(128 * (h >> 1) + 16 * (2 * (h & 1) + mm) + rb) * 1024 + cb + 128 * bj; xv[mm][bj][0] = *(const f32x4*)p; xv[mm][bj][1] = *(const f32x4*)(p + 4); }
#pragma unroll
                for (int mm = 0; mm < 2; ++mm)
#pragma unroll
                    for (int bj = 0; bj < 2; ++bj) { const int ai = h >> 1, m = 2 * (h & 1) + mm;
                        acc[ai][bj][m][0] = xv[mm][bj][0] + g1[bj][0] * acc[ai][bj][m][0]; acc[ai][bj][m][1] = xv[mm][bj][1] + g1[bj][1] * acc[ai][bj][m][1]; }
                {   const int ai = h >> 1, m0 = 2 * (h & 1);
                    asm volatile("" : "+v"(acc[ai][0][m0][0]), "+v"(acc[ai][0][m0][1]), "+v"(acc[ai][1][m0][0]), "+v"(acc[ai][1][m0][1]),
                                      "+v"(acc[ai][0][m0 + 1][0]), "+v"(acc[ai][0][m0 + 1][1]), "+v"(acc[ai][1][m0 + 1][0]), "+v"(acc[ai][1][m0 + 1][1]) :: "memory"); } } }
        f32x4 w2[2][2];
#pragma unroll
        for (int bj = 0; bj < 2; ++bj)
#pragma unroll
            for (int n = 0; n < 2; ++n) { const unsigned c = cb + 128 * bj + 4 * n; w2[bj][n] = *(const f32x4*)(g2n + c) * (*(const f32x4*)(mv + 4096 + c) + 1.0f); }
        const rsrc_t rx = mk_rsrc(X1B + (size_t)pm * 256 * 1024, 256 * 1024 * 2), ra = mk_rsrc(A2 + (size_t)pm * 256 * 1024, 256 * 1024 * 2);
#pragma unroll
        for (int ai = 0; ai < 2; ++ai)
#pragma unroll
            for (int m = 0; m < 4; ++m) { const unsigned r = 128 * ai + 16 * m + rb; float s = 0.f;
#pragma unroll
                for (int bj = 0; bj < 2; ++bj) { const unsigned o = r * 1024 + cb + 128 * bj; const f32x4 x0 = acc[ai][bj][m][0], x1 = acc[ai][bj][m][1];
                    st16_wt(rx, o * 2u, pack8(x0, x1));
                    st16_wt(ra, o * 2u, pack8(x0 * w2[bj][0], x1 * w2[bj][1]));
                    s += (x0[0] * x0[0] + x0[1] * x0[1]) + (x0[2] * x0[2] + x0[3] * x0[3]) + (x1[0] * x1[0] + x1[1] * x1[1]) + (x1[2] * x1[2] + x1[3] * x1[3]); }
                s += __shfl_xor(s, 16); s += __shfl_xor(s, 32);
                if (fq == 0) atomicAdd(ssq + (size_t)pm * 256 + r, s); }
    }
};

struct EpiRes2 {
    static constexpr int MID_T = -1;
    typedef NoPre Pre;
    __device__ __forceinline__ Pre pre(const pg8::Unit&, int, int, int, int, int, int) const { return Pre(); }
    const float *mod, *fg; const bf16_t* X1B; float* X; float* XS; unsigned* xcnt; LAS float* P;
    __device__ __forceinline__ void mid(AccT&, const pg8::Unit&, int, int, int, int) const {}
    __device__ __forceinline__ void epi(AccT& acc, const pg8::Unit& u, int wr, int wc, int fr, int fq, int wid, int lane, const Pre&) const {
        asm volatile("" : "+v"(fr), "+v"(fq));
        const int pm = u.pm, v = pm < 16 ? 0 : 1 + ((pm - 16) >> 4); const float* mv = mod + (size_t)v * 6144;
        const int cb = 256 * u.pn + 32 * wc + 8 * fq;
        {   f32x4 g2[2][2]; u32x4 xq[8][2];
#pragma unroll
            for (int bj = 0; bj < 2; ++bj)
#pragma unroll
                for (int n = 0; n < 2; ++n) g2[bj][n] = *(const f32x4*)(mv + 5120 + cb + 128 * bj + 4 * n);
#pragma unroll
            for (int k = 0; k < 8; ++k)
#pragma unroll
                for (int bj = 0; bj < 2; ++bj) xq[k][bj] = *(const u32x4*)(X1B + ((size_t)pm * 256 + 128 * (k >> 2) + 64 * wr + 16 * (k & 3) + fr) * 1024 + cb + 128 * bj);
#pragma unroll
            for (int k = 0; k < 8; ++k) { const int ai = k >> 2, m = k & 3, r = 128 * ai + 64 * wr + 16 * m + fr; float s = 0.f;
#pragma unroll
                for (int bj = 0; bj < 2; ++bj) { f32x4 xa, xb; unpack8(xq[k][bj], xa, xb);
                    const f32x4 x0 = xa + g2[bj][0] * acc[ai][bj][m][0], x1 = xb + g2[bj][1] * acc[ai][bj][m][1];
                    acc[ai][bj][m][0] = x0; acc[ai][bj][m][1] = x1;
                    s += (x0[0] * x0[0] + x0[1] * x0[1]) + (x0[2] * x0[2] + x0[3] * x0[3]) + (x1[0] * x1[0] + x1[1] * x1[1]) + (x1[2] * x1[2] + x1[3] * x1[3]); }
                s += __shfl_xor(s, 16); s += __shfl_xor(s, 32);
                if (fq == 0) P[r * 4 + wc] = s; } }
        RAW_BAR();
        const int tid = wid * 64 + lane;
        if (wid < 4) { const f32x4 pp = *(const LAS f32x4*)&P[tid * 4];
            __hip_atomic_store(XS + ((size_t)pm * 4 + u.pn) * 256 + tid, (pp[0] + pp[1]) + (pp[2] + pp[3]), RLX_AGENT);
            asm volatile("s_waitcnt vmcnt(0)" ::: "memory");
            if (lane == 0) __hip_atomic_fetch_add(xcnt + 64 * pm, 1u, RLX_AGENT); }
        if (wid == 0) { unsigned sp = 0;
            while ((unsigned)__builtin_amdgcn_readfirstlane(__hip_atomic_load(xcnt + 64 * pm, RLX_AGENT)) < 16u) { __builtin_amdgcn_s_sleep(2); if (++sp > (1u << 22)) break; } }
        RAW_BAR();
        if (wid < 4) { float t = 0.f;
#pragma unroll
            for (int k = 0; k < 4; ++k) t += __hip_atomic_load(XS + ((size_t)pm * 4 + k) * 256 + tid, RLX_AGENT);
            P[1024 + tid] = 1.0f / sqrtf(t * (1.0f / 1024.0f) + EPS); }
        RAW_BAR();
        {   f32x4 fgv[2][2];
#pragma unroll
            for (int bj = 0; bj < 2; ++bj)
#pragma unroll
                for (int n = 0; n < 2; ++n) fgv[bj][n] = *(const f32x4*)(fg + cb + 128 * bj + 4 * n);
#pragma unroll
            for (int ai = 0; ai < 2; ++ai)
#pragma unroll
                for (int m = 0; m < 4; ++m) { const int r = 128 * ai + 64 * wr + 16 * m + fr;
                    const float rs = P[1024 + r];
#pragma unroll
                    for (int bj = 0; bj < 2; ++bj) { float* p = X + ((size_t)pm * 256 + r) * 1024 + cb + 128 * bj;
                        *(f32x4*)p = acc[ai][bj][m][0] * rs * fgv[bj][0]; *(f32x4*)(p + 4) = acc[ai][bj][m][1] * rs * fgv[bj][1]; } } }
    }
};

__device__ __forceinline__ float dpp_up(float cur, float old) {
    return __builtin_bit_cast(float, __builtin_amdgcn_update_dpp(__builtin_bit_cast(int, old), __builtin_bit_cast(int, cur), 0x111, 0xF, 0xF, false)); }
__device__ __forceinline__ float dpp_dn(float cur, float old) {
    return __builtin_bit_cast(float, __builtin_amdgcn_update_dpp(__builtin_bit_cast(int, old), __builtin_bit_cast(int, cur), 0x101, 0xF, 0xF, false)); }
__device__ __forceinline__ float dpp_ror1(float x) {
    return __builtin_bit_cast(float, __builtin_amdgcn_update_dpp(0, __builtin_bit_cast(int, x), 0x121, 0xF, 0xF, false)); }
__device__ __forceinline__ float dpp_rol1(float x) {
    return __builtin_bit_cast(float, __builtin_amdgcn_update_dpp(0, __builtin_bit_cast(int, x), 0x12F, 0xF, 0xF, false)); }
struct EpiConv {
    static constexpr int MID_T = -1;
    const float *ssq, *bup, *cw, *cbias; bf16_t* ACT; float *EU, *EUC; LAS float* E; unsigned* done;
    struct Pre { float ss[8]; f32x4 bb[2][2]; float cwv[4]; };
    __device__ __forceinline__ void mid(AccT&, const pg8::Unit&, int, int, int, int) const {}
    __device__ __forceinline__ Pre pre(const pg8::Unit& u, int wr, int wc, int fr, int fq, int wid, int lane) const {
        Pre p; const int pm = u.pm, pn = u.pn, v = pm < 16 ? 0 : 1 + ((pm - 16) >> 4);
        const float* sp = ssq + (size_t)pm * 256 + 64 * wr + fr; const float* bp = bup + (size_t)v * NUP + 256 * pn + 32 * wc + 8 * fq;
#pragma unroll
        for (int k = 0; k < 8; ++k) p.ss[k] = sp[128 * (k >> 2) + 16 * (k & 3)];
#pragma unroll
        for (int bj = 0; bj < 2; ++bj)
#pragma unroll
            for (int n = 0; n < 2; ++n) p.bb[bj][n] = *(const f32x4*)(bp + 128 * bj + 4 * n);
        const int t = wid * 64 + lane, tc = t & 255, ch = (tc < 128 ? 0 : DFF - 128) + 128 * pn + tc;
        p.cwv[0] = cw[ch]; p.cwv[1] = cw[NUP + ch]; p.cwv[2] = cw[2 * NUP + ch]; p.cwv[3] = cbias[ch];
        return p;
    }
    __device__ __forceinline__ void epi(AccT& acc, const pg8::Unit& u, int wr, int wc, int fr, int fq, int wid, int lane, const Pre& pf) const {
        const int pm = u.pm, pn = u.pn; const bool latent = pm >= 16;
#if defined(PROBE_K0) && PROBE_K0 == 400
        const unsigned long long te0_ = __builtin_amdgcn_s_memrealtime();
#endif
        unsigned cw8 = (unsigned)(32 * wc + 8 * fq), rl = (unsigned)(64 * wr + fr); asm volatile("" : "+v"(cw8), "+v"(rl));
        LAS float* CW = E + 2048;
        {   const int t = wid * 64 + lane;
            if (t < 256) { CW[t] = pf.cwv[0]; CW[256 + t] = pf.cwv[1]; CW[512 + t] = pf.cwv[2]; CW[768 + t] = pf.cwv[3]; } }
#pragma unroll
        for (int ai = 0; ai < 2; ++ai)
#pragma unroll
            for (int m = 0; m < 4; ++m) { const float rs = __builtin_amdgcn_rsqf(pf.ss[4 * ai + m] * (1.0f / 1024.0f) + EPS);
#pragma unroll
                for (int bj = 0; bj < 2; ++bj)
#pragma unroll
                    for (int n = 0; n < 2; ++n) acc[ai][bj][m][n] = acc[ai][bj][m][n] * rs + pf.bb[bj][n]; }
        PINACC(acc);
        const rsrc_t reu = mk_rsrc(EU + (size_t)pm * 2 * NUP + 256 * pn, (NUP + 256) * 4), reuc = mk_rsrc(EUC + (size_t)pm * 2 * NUP + 256 * pn, (NUP + 256) * 4);
#pragma unroll
        for (int ai = 0; ai < 2; ++ai)
#pragma unroll
            for (int bj = 0; bj < 2; ++bj)
#pragma unroll
                for (int n = 0; n < 2; ++n) { const unsigned ci = 128 * bj + cw8 + 4 * n; const int grp = 2 * ai + wr;
                    if (fr == 0) { *(LAS f32x4*)&E[(grp * 2 + 0) * 256 + ci] = acc[ai][bj][0][n]; if (latent && grp == 0) st16_wt(reu, ci * 4u, acc[ai][bj][0][n]); }
                    if (fr == 15) { *(LAS f32x4*)&E[(grp * 2 + 1) * 256 + ci] = acc[ai][bj][3][n]; if (latent && grp == 3) st16_wt(reu, (NUP + ci) * 4u, acc[ai][bj][3][n]); } }
        RAW_BAR();
#if defined(PROBE_K0) && PROBE_K0 == 400 && defined(PROBE_SUB) && PROBE_SUB == 1
        if (wid == 0 && lane == 0 && (int)__builtin_amdgcn_workgroup_id_x() == PROBE_BID) atomicAdd((float*)((char*)EU - WS_EDGE_U + 32768), (float)(__builtin_amdgcn_s_memrealtime() - te0_));
#endif
        const rsrc_t ract = mk_rsrc((char*)ACT + ((size_t)pm * 256 * DFF + 128 * pn) * 2, 256 * DFF * 2);
#pragma unroll
        for (int ai = 0; ai < 2; ++ai) { const int grp = 2 * ai + wr;
#pragma unroll
            for (int n = 0; n < 2; ++n)
#pragma unroll
                for (int bj = 0; bj < 2; ++bj) { const unsigned ci = 128 * bj + cw8 + 4 * n;
                    const f32x4 w0 = *(const LAS f32x4*)&CW[ci], w1 = *(const LAS f32x4*)&CW[256 + ci], w2 = *(const LAS f32x4*)&CW[512 + ci], cb = *(const LAS f32x4*)&CW[768 + ci];
                    f32x4 pe = {0.f, 0.f, 0.f, 0.f}, ne = {0.f, 0.f, 0.f, 0.f};
                    if (grp > 0) pe = *(const LAS f32x4*)&E[((grp - 1) * 2 + 1) * 256 + ci];
                    if (grp < 3) ne = *(const LAS f32x4*)&E[((grp + 1) * 2 + 0) * 256 + ci];
#pragma unroll
                    for (int e = 0; e < 4; ++e) { const float u0 = acc[ai][bj][0][n][e], u1 = acc[ai][bj][1][n][e], u2 = acc[ai][bj][2][n][e], u3 = acc[ai][bj][3][n][e];
                        const float p0 = dpp_up(u0, pe[e]), p1 = dpp_up(u1, dpp_ror1(u0)), p2 = dpp_up(u2, dpp_ror1(u1)), p3 = dpp_up(u3, dpp_ror1(u2));
                        const float n0 = dpp_dn(u0, dpp_rol1(u1)), n1 = dpp_dn(u1, dpp_rol1(u2)), n2 = dpp_dn(u2, dpp_rol1(u3)), n3 = dpp_dn(u3, ne[e]);
                        acc[ai][bj][0][n][e] = w0[e] * p0 + w1[e] * u0 + w2[e] * n0 + cb[e]; acc[ai][bj][1][n][e] = w0[e] * p1 + w1[e] * u1 + w2[e] * n1 + cb[e];
                        acc[ai][bj][2][n][e] = w0[e] * p2 + w1[e] * u2 + w2[e] * n2 + cb[e]; acc[ai][bj][3][n][e] = w0[e] * p3 + w1[e] * u3 + w2[e] * n3 + cb[e]; }
                    if (latent) { if (fr == 0 && grp == 0) st16_wt(reuc, ci * 4u, acc[ai][bj][0][n]);
                                  if (fr == 15 && grp == 3) st16_wt(reuc, (NUP + ci) * 4u, acc[ai][bj][3][n]); }
                    asm volatile("" : "+v"(acc[ai][bj][0][n]), "+v"(acc[ai][bj][1][n]), "+v"(acc[ai][bj][2][n]), "+v"(acc[ai][bj][3][n]) :: "memory"); }
#pragma unroll
            for (int m = 0; m < 4; ++m) { f32x4 o0, o1;
#pragma unroll
                for (int e = 0; e < 4; ++e) { o0[e] = siluf_(acc[ai][1][m][0][e]) * acc[ai][0][m][0][e]; o1[e] = siluf_(acc[ai][1][m][1][e]) * acc[ai][0][m][1][e]; }
                st16_wt(ract, ((rl + 128 * ai + 16 * m) * DFF + cw8) * 2u, pack8(o0, o1)); asm volatile("" ::: "memory"); } }
#if defined(PROBE_K0) && PROBE_K0 == 400 && !defined(PROBE_SUB)
        if (wid == 0 && lane == 0 && (int)__builtin_amdgcn_workgroup_id_x() == PROBE_BID) atomicAdd((float*)((char*)EU - WS_EDGE_U + 32768), (float)(__builtin_amdgcn_s_memrealtime() - te0_));
#endif
    }
};

constexpr int NWAVES = 8, NTHR = 512;
constexpr int RING_BYTES = 131072, SPARE_OFF = RING_BYTES, SPARE_BYTES = 16384, MISC_OFF = SPARE_OFF + SPARE_BYTES, LDS_BYTES = MISC_OFF + 256;
struct Args {
    const float *x_prompt, *x_sample, *c, *cache_k, *cache_v, *st_f, *st_b, *c_ctx, *norm1_g, *norm2_g, *w_mod, *b_mod, *w_in, *q_g, *k_g, *dec_f, *dec_b,
                *w_att_o, *w_ret_o, *w_out, *w_up, *conv_w, *conv_b, *w_down, *final_g;
    float* out; unsigned char* ws; int ph_lo, ph_hi;
};
struct Frame { LAS unsigned char* lds; int tid, lane, wave, G, bid; };
typedef const __attribute__((address_space(4))) Args CArgs;

template <class F> __device__ __forceinline__ void transpose_item(const float* W, int ldw, bf16_t* WT, int ldd, int kofs, int k0, int n0, F srccol, LAS float* scr, int lane) {
    const int sc = srccol(n0 + (lane & 31));
#pragma unroll 8
    for (int i = 0; i < 32; ++i) { const int kk = 2 * i + (lane >> 5); scr[kk * 33 + (lane & 31)] = __builtin_nontemporal_load(W + (size_t)(k0 + kk) * ldw + sc); }
    LDS_WAIT(); asm volatile("" ::: "memory");
    const int c = lane & 7;
#pragma unroll
    for (int j = 0; j < 4; ++j) { const int n = (lane >> 3) + 8 * j; const LAS float* s = scr + (8 * c) * 33 + n;
        u32x4 o; o.x = pk2(s[0 * 33], s[1 * 33]); o.y = pk2(s[2 * 33], s[3 * 33]); o.z = pk2(s[4 * 33], s[5 * 33]); o.w = pk2(s[6 * 33], s[7 * 33]);
        *(u32x4*)(WT + (size_t)(n0 + n) * ldd + kofs + k0 + 8 * c) = o; }
    LDS_WAIT(); asm volatile("" ::: "memory");
}
struct ColId { __device__ int operator()(int n) const { return n; } };
struct ColIn { __device__ int operator()(int n) const {
    if (n >= 4608) { const int t = (n - 4608) >> 8, j = (n - 4608) & 255; return j < 128 ? 4608 + 128 * t + j : 5632 + 128 * t + (j - 128); }
    return (n < 1280 || (n >= 1536 && n < 2560)) ? swap25(n) : n; } };
struct ColUp { __device__ int operator()(int n) const { const int t = n >> 8, j = n & 255; return j < 128 ? 128 * t + j : DFF + 128 * t + (j - 128); } };

template <class F> __device__ __forceinline__ void gemv5_item(const Frame& F_, const float* W, int ldw, int n0, int k0, F srccol, const LAS float* a, LAS float* red, const float* bias, float* out, int ldo) {
    const int col0 = srccol(n0 + F_.lane), col1 = srccol(n0 + 64 + F_.lane); float acc[5][2];
#pragma unroll
    for (int v = 0; v < 5; ++v) { acc[v][0] = 0.f; acc[v][1] = 0.f; }
    const int kb = F_.wave * 32;
    const float* wp = W + (size_t)(k0 + kb) * ldw;
    float w0[32], w1[32];
#pragma unroll
    for (int j = 0; j < 32; ++j) { w0[j] = __builtin_nontemporal_load(wp + col0); w1[j] = __builtin_nontemporal_load(wp + col1); wp += ldw; }
#pragma unroll
    for (int j = 0; j < 32; ++j)
#pragma unroll
        for (int v = 0; v < 5; ++v) { const float av = a[v * 256 + kb + j]; acc[v][0] += av * w0[j]; acc[v][1] += av * w1[j]; }
#pragma unroll
    for (int v = 0; v < 5; ++v) { red[(F_.wave * 5 + v) * 128 + F_.lane] = acc[v][0]; red[(F_.wave * 5 + v) * 128 + 64 + F_.lane] = acc[v][1]; }
    __syncthreads();
    for (int t = F_.tid; t < 640; t += NTHR) { const int v = t >> 7, l = t & 127; float sum = (bias && k0 == 0) ? bias[n0 + l] : 0.f;
#pragma unroll
        for (int w8 = 0; w8 < 8; ++w8) sum += red[(w8 * 5 + v) * 128 + l];
        out[((size_t)(k0 >> 8) * 5 + v) * ldo + n0 + l] = sum; }
    __syncthreads();
}

__device__ __forceinline__ void phase0(const Frame& F, CArgs& A) {
    unsigned char* ws = A.ws;
    for (int it = F.bid; it < 48 * 4; it += F.G) {
        const int cgp = it % 48, kq = it / 48;
        LAS float* a = (LAS float*)F.lds; LAS float* red = a + 5 * 256;
        for (int i = F.tid; i < 5 * 256; i += NTHR) { const int v = i >> 8, k = kq * 256 + (i & 255); const float cv = v == 0 ? A.c_ctx[k] : A.c[(v - 1) * 1024 + k]; a[i] = siluf_(cv); }
        __syncthreads();
        gemv5_item(F, A.w_mod, 6144, cgp * 128, kq * 256, ColId(), a, red, A.b_mod, (float*)(ws + WS_MOD), 6144);
    }
    LAS float* scr = (LAS float*)(F.lds + 32768 + F.wave * 8704);
    const int gw = ((F.bid + 128) % F.G) * NWAVES + F.wave, NGW = F.G * NWAVES;
    constexpr int I_IN = 16 * (DIN / 32);
    for (int it = gw; it < I_IN; it += NGW) transpose_item(A.w_in, DIN, (bf16_t*)(ws + WS_WA), 1024, 0, 64 * (it / (DIN / 32)), 32 * (it % (DIN / 32)), ColIn(), scr, F.lane);
    const int gt = F.bid * NTHR + F.tid, NGT = F.G * NTHR;
    for (int i = gt; i < DB * NKV * PAST * 16; i += NGT) { const int c8 = i & 15, row = i >> 4, t = row % PAST, bk = row / PAST;
        const size_t so = (size_t)row * 128, dofs = ((size_t)bk * SKV + DSEQ + t) * 128 + c8 * 8;
        f32x4 k0, k1; { const int p0 = c8 * 8, d0 = swap25(p0), d1 = swap25(p0 + 4); k0 = *(const f32x4*)(A.cache_k + so + d0); k1 = *(const f32x4*)(A.cache_k + so + d1); }
        *(u32x4*)((bf16_t*)(ws + WS_KALL) + dofs) = pack8(k0, k1);
        const f32x4 v0 = *(const f32x4*)(A.cache_v + so + c8 * 8), v1 = *(const f32x4*)(A.cache_v + so + c8 * 8 + 4);
        *(u32x4*)((bf16_t*)(ws + WS_VALL) + dofs) = pack8(v0, v1); }
    for (int i = gt; i < MT; i += NGT) ((float*)(ws + WS_SSQ1))[i] = 0.f;
    for (int i = gt; i < 322 * 64; i += NGT) ((unsigned*)(ws + WS_CNT))[i] = 0u;
    for (int i = gt; i < (481 + 81) * 16; i += NGT) ((unsigned*)(ws + WS_CNT1))[i] = 0u;
#if defined(PROBE_K0) && PROBE_K0 == 400
    if (gt == 0) *(float*)(ws + 32768) = 0.f;
#endif
}

__device__ __forceinline__ void phase1(const Frame& F, CArgs& A) {
    unsigned char* ws = A.ws; const float* mod = (const float*)(ws + WS_MOD);
    for (int it = F.bid; it < (NUP / 128) * 4; it += F.G) {
        const int cgp = it % (NUP / 128), kq = it / (NUP / 128);
        LAS float* a = (LAS float*)F.lds; LAS float* red = a + 5 * 256;
        for (int i = F.tid; i < 5 * 256; i += NTHR) { const float* p = mod + (size_t)(i >> 8) * 6144 + 3072 + kq * 256 + (i & 255); a[i] = (p[0] + p[MODQ]) + (p[2 * MODQ] + p[3 * MODQ]); }
        __syncthreads();
        gemv5_item(F, A.w_up, NUP, cgp * 128, kq * 256, ColUp(), a, red, nullptr, (float*)(ws + WS_BUP), NUP);
    }
    for (int i = F.bid * NTHR + F.tid; i < 5 * 6144; i += F.G * NTHR) ((float*)(ws + WS_MODF))[i] = (mod[i] + mod[i + MODQ]) + (mod[i + 2 * MODQ] + mod[i + 3 * MODQ]);
    bf16_t* H = (bf16_t*)(ws + WS_H);
    constexpr int RPW = MT / (256 * NWAVES);
    const int row0 = (F.bid * NWAVES + F.wave) * RPW;
    int vcur = -1; f32x4 w1[4], s1[4];
#pragma unroll 1
    for (int rb = row0; rb < row0 + RPW; rb += 5) {
        f32x4 x[5][4];
#pragma unroll
        for (int i = 0; i < 5; ++i) { const int r = rb + i; const float* xr = r < MP ? A.x_prompt + (size_t)r * 1024 : A.x_sample + (size_t)(r - MP) * 1024;
#pragma unroll
            for (int j = 0; j < 4; ++j) x[i][j] = __builtin_nontemporal_load((const f32x4*)(xr + 8 * F.lane + 4 * (j & 1) + 512 * (j >> 1))); }
#pragma unroll
        for (int i = 0; i < 5; ++i) { const int r = rb + i;
            const int v = r < MP ? 0 : 1 + (r - MP) / DSEQ;
            if (v != vcur) { vcur = v; const float* mv = mod + (size_t)v * 6144;
#pragma unroll
                for (int j = 0; j < 4; ++j) { const int k = 8 * F.lane + 4 * (j & 1) + 512 * (j >> 1); w1[j] = *(const f32x4*)(A.norm1_g + k) * (sum4q(mv + 1024 + k, MODQ) + 1.0f); s1[j] = sum4q(mv + k, MODQ); } }
            float s = 0.f;
#pragma unroll
            for (int j = 0; j < 4; ++j) s += (x[i][j][0] * x[i][j][0] + x[i][j][1] * x[i][j][1]) + (x[i][j][2] * x[i][j][2] + x[i][j][3] * x[i][j][3]);
            const float rstd = __builtin_amdgcn_rsqf(wave_sum(s) * (1.0f / 1024.0f) + EPS);
#pragma unroll
            for (int jj = 0; jj < 2; ++jj) { const f32x4 h0 = x[i][2 * jj] * rstd * w1[2 * jj] + s1[2 * jj], h1 = x[i][2 * jj + 1] * rstd * w1[2 * jj + 1] + s1[2 * jj + 1];
                *(u32x4*)(H + (size_t)r * 1024 + 8 * F.lane + 512 * jj) = pack8(h0, h1); } }
    }
}

__device__ __forceinline__ float log_sigmoid_(float x) { return -log1pf(__expf(-x)); }
__device__ __forceinline__ s16x4 tr_read16(const LAS bf16_t* p) { typedef short v4s __attribute__((ext_vector_type(4))); return __builtin_bit_cast(s16x4, __builtin_amdgcn_ds_read_tr16_b64_v4i16((LAS v4s*)p)); }
#define MK8(L, H) (bf16x8){L[0], L[1], L[2], L[3], H[0], H[1], H[2], H[3]}
constexpr int KLD = 72, VLD = 136;
__device__ __forceinline__ int vsw(int r, int c8) { return 256 * r + 16 * (c8 ^ (((r & 3) << 1) | (((r >> 3) & 1) << 3))); }
__device__ __forceinline__ int vsw_tr(int R, int col) { return vsw(R, col >> 3) + 2 * (col & 7); }

__device__ const unsigned char R1_PORD[80] = {0, 1, 2, 3, 4, 5, 6, 7, 12, 13, 14, 15, 16, 17, 18, 19, 28, 29, 30, 31, 32, 33, 34, 35, 40, 41, 42, 43, 44, 45, 46, 47, 52, 53, 54, 55, 56, 57, 58, 59, 68, 69, 70, 71, 72, 73, 74, 75,
    8, 9, 10, 11, 20, 21, 22, 23, 24, 25, 26, 27, 36, 37, 38, 39, 48, 49, 50, 51, 60, 61, 62, 63, 64, 65, 66, 67, 76, 77, 78, 79};
__device__ __forceinline__ int r1_item_of(int i) { return (int)R1_PORD[i >> 4] * 16 + (i & 15); }
__device__ __forceinline__ void spin_ge(unsigned* p, unsigned need) { unsigned sp = 0;
    while ((unsigned)__builtin_amdgcn_readfirstlane(__hip_atomic_load(p, RLX_AGENT)) < need) { __builtin_amdgcn_s_sleep(2); if (++sp > (1u << 22)) break; } }
__device__ __forceinline__ void r1_wait(const Frame& F, unsigned* c1, int item, volatile LAS unsigned* alld) {
    if (F.wave == 0 && *alld == 0u) { const int pm = item >> 4, h = item & 7;
        const bool all = (unsigned)__builtin_amdgcn_readfirstlane(__hip_atomic_load(c1 + 16 * 480, RLX_AGENT)) >= 480u
                      && (unsigned)__builtin_amdgcn_readfirstlane(__hip_atomic_load(c1 + 16 * (481 + 80), RLX_AGENT)) >= 2080u;
        spin_ge(c1 + 16 * (pm * 6 + (h >> 2)), 1u); spin_ge(c1 + 16 * (pm * 6 + 2 + (h >> 1)), 1u);
        spin_ge(c1 + 16 * (481 + pm), 26u);
        __builtin_amdgcn_fence(__ATOMIC_ACQUIRE, "agent"); asm volatile("s_waitcnt vmcnt(0)" ::: "memory");
        if (all) *alld = 1u; }
    __syncthreads();
}
__device__ __forceinline__ void phase_r1(const Frame& F, CArgs& A) {
    unsigned char* ws = A.ws; unsigned* c1 = (unsigned*)(ws + WS_CNT1);
    volatile LAS unsigned* alld = (volatile LAS unsigned*)(F.lds + MISC_OFF) + 17;
    if (F.tid == 0) *alld = 0u;
    __syncthreads();
    const bf16_t* RKb = (const bf16_t*)(ws + WS_RK); const bf16_t* RVb = (const bf16_t*)(ws + WS_RV); bf16_t* KVS = (bf16_t*)(ws + WS_H);
    LAS bf16_t* kf = (LAS bf16_t*)F.lds; LAS bf16_t* kb = kf + 128 * KLD; LAS bf16_t* vl = kb + 128 * KLD; LAS bf16_t* ol = vl + 128 * 128 + F.wave * (16 * VLD);
    u32x4 pk_[2], pv_[4];
#define R1_LOAD(it) do { const int cg_ = (it) >> 3, h_ = (it) & 7; const size_t r0_ = (size_t)cg_ * 128; \
        _Pragma("unroll") for (int i = 0; i < 2; ++i) { const int ci = F.tid + i * NTHR; pk_[i] = *(const u32x4*)(RKb + (r0_ + (ci >> 3)) * 512 + 64 * h_ + 8 * (ci & 7)); } \
        _Pragma("unroll") for (int i = 0; i < 4; ++i) { const int ci = F.tid + i * NTHR; pv_[i] = *(const u32x4*)(RVb + (r0_ + (ci >> 4)) * 1024 + 128 * h_ + 8 * (ci & 15)); } } while (0)
    const int n1 = F.bid >= 32 ? (768 - (F.bid - 32) + 223) / 224 : 0, cntp = n1 + 2;
#define R1_POS(n) ((n) < n1 ? (F.bid - 32) + 224 * (n) : 768 + F.bid + 256 * ((n) - n1))
    { r1_wait(F, c1, r1_item_of(R1_POS(0)), alld); R1_LOAD(r1_item_of(R1_POS(0))); }
    for (int n = 0; n < cntp; ++n) { const int item = r1_item_of(R1_POS(n));
        const int h = item & 7;
        const float lgf = log_sigmoid_(A.dec_f[h]) * 1.4426950408889634f, lgb = log_sigmoid_(A.dec_b[h]) * 1.4426950408889634f;
#pragma unroll
        for (int i = 0; i < 2; ++i) { const int ci = F.tid + i * NTHR, j = ci >> 3, c8 = ci & 7;
            f32x4 a, b; unpack8(pk_[i], a, b);
            const float df = __builtin_amdgcn_exp2f(lgf * (float)(127 - j)), db = __builtin_amdgcn_exp2f(lgb * (float)j);
            *(LAS u32x4*)(kf + j * KLD + 8 * c8) = pack8(a * df, b * df); *(LAS u32x4*)(kb + j * KLD + 8 * c8) = pack8(a * db, b * db); }
#pragma unroll
        for (int i = 0; i < 4; ++i) { const int ci = F.tid + i * NTHR, j = ci >> 4, c8 = ci & 15; *(LAS u32x4*)((LAS char*)vl + vsw(j, c8)) = pv_[i]; }
        __syncthreads();
        if (n + 1 < cntp) { r1_wait(F, c1, r1_item_of(R1_POS(n + 1)), alld); R1_LOAD(r1_item_of(R1_POS(n + 1))); }
        const int dir = F.wave >> 2, mt = F.wave & 3, g = F.lane >> 4, q = (F.lane & 15) >> 2, p = F.lane & 3, l15 = F.lane & 15;
        const LAS bf16_t* ks = dir ? kb : kf;
        bf16x8 af[4];
#pragma unroll
        for (int s = 0; s < 4; ++s) { const LAS bf16_t* ap = ks + (32 * s + 8 * g + q) * KLD + 16 * mt + 4 * p; const s16x4 lo = tr_read16(ap), hi = tr_read16(ap + 4 * KLD); af[s] = MK8(lo, hi); }
#pragma unroll
        for (int nt = 0; nt < 8; ++nt) { f32x4 acc = {0.f, 0.f, 0.f, 0.f};
#pragma unroll
            for (int s = 0; s < 4; ++s) { const int R0 = 32 * s + 8 * g + q, col = 16 * nt + 4 * p;
                const s16x4 lo = tr_read16((const LAS bf16_t*)((const LAS char*)vl + vsw_tr(R0, col))), hi = tr_read16((const LAS bf16_t*)((const LAS char*)vl + vsw_tr(R0 + 4, col)));
                acc = __builtin_amdgcn_mfma_f32_16x16x32_bf16(af[s], MK8(lo, hi), acc, 0, 0, 0); }
#pragma unroll
            for (int e = 0; e < 4; ++e) ol[(4 * g + e) * VLD + 16 * nt + l15] = (bf16_t)f2bf(acc[e]); }
        LDS_WAIT(); asm volatile("" ::: "memory");
        bf16_t* dst = KVS + ((size_t)item * 2 + dir) * (64 * 128) + (size_t)(16 * mt + (F.lane >> 2)) * 128 + (F.lane & 3) * 32;
#pragma unroll
        for (int c = 0; c < 4; ++c) *(u32x4*)(dst + 8 * c) = *(const LAS u32x4*)(ol + (F.lane >> 2) * VLD + (F.lane & 3) * 32 + 8 * c);
        __syncthreads();
    }
#undef R1_LOAD
#undef R1_POS
}

__device__ __forceinline__ void phase_scan(const Frame& F, CArgs& A) {
    bf16_t* KVS = (bf16_t*)(A.ws + WS_H);
    const int gt = F.bid * NTHR + F.tid, NGT = F.G * NTHR;
    for (int i = gt; i < 5 * NUP; i += NGT) { const float* p = (const float*)(A.ws + WS_BUP) + i; ((float*)(A.ws + WS_BUPF))[i] = (p[0] + p[BUPQ]) + (p[2 * BUPQ] + p[3 * BUPQ]); }
    constexpr size_t CST = (size_t)8 * 2 * 8192;
    if (NGT * 4 == 256 * 2048) {
        u32x2 kv[4][2]; bf16_t* basep[4]; float decp[4];
#pragma unroll
        for (int k = 0; k < 4; ++k) { const int w = gt + k * NGT, e4 = (w & 2047) * 4, chain = w >> 11, dir = chain & 1, h = (chain >> 1) & 7, sq = chain >> 4;
            decp[k] = __expf(log_sigmoid_((dir ? A.dec_b : A.dec_f)[h]) * 128.0f);
            basep[k] = KVS + ((size_t)(2 * sq * 8 + h) * 2 + dir) * 8192 + e4;
            kv[k][0] = *(const u32x2*)(basep[k] + (size_t)(dir ? 1 : 0) * CST); kv[k][1] = *(const u32x2*)(basep[k] + (size_t)(dir ? 0 : 1) * CST); }
#pragma unroll
        for (int k = 0; k < 4; ++k) { const int w = gt + k * NGT, e4 = (w & 2047) * 4, chain = w >> 11, dir = chain & 1, h = (chain >> 1) & 7, sq = chain >> 4;
            const int pr = e4 >> 7, dv = e4 & 127, lr = swap25(pr);
            f32x4 st = {0.f, 0.f, 0.f, 0.f};
#pragma unroll
            for (int i = 0; i < 2; ++i) { u32x2 o; o.x = pk2(st[0], st[1]); o.y = pk2(st[2], st[3]); *(u32x2*)(basep[k] + (size_t)(dir ? 1 - i : i) * CST) = o;
                st = st * decp[k] + (f32x4){bflo(kv[k][i].x), bfhi(kv[k][i].x), bflo(kv[k][i].y), bfhi(kv[k][i].y)}; }
            *(f32x4*)(A.out + (dir ? OUT_SB : OUT_SF) + (((size_t)sq * 8 + h) * 64 + lr) * 128 + dv) = st; }
    }
    for (int w = (NGT * 4 == 256 * 2048) ? gt + 4 * NGT : gt; w < 320 * 2048; w += NGT) {
        const int e4 = (w & 2047) * 4, chain = w >> 11, dir = chain & 1, h = (chain >> 1) & 7, s = chain >> 4;
        const int nch = s < 16 ? 2 : 32, c0 = s < 16 ? 2 * s : 32 + 32 * (s - 16);
        const float lg = log_sigmoid_((dir ? A.dec_b : A.dec_f)[h]), dec = __expf(lg * 128.0f);
        const int pr = e4 >> 7, dv = e4 & 127, lr = swap25(pr);
        f32x4 st = {0.f, 0.f, 0.f, 0.f};
        if (s >= 16) st = *(const f32x4*)((dir ? A.st_b : A.st_f) + (((size_t)(s - 16) * 8 + h) * 64 + lr) * 128 + dv);
        bf16_t* base = KVS + ((size_t)(c0 * 8 + h) * 2 + dir) * 8192 + e4;
        if (s < 16) {
            u32x2 kv[2];
#pragma unroll
            for (int i = 0; i < 2; ++i) kv[i] = *(const u32x2*)(base + (size_t)(dir ? 1 - i : i) * CST);
#pragma unroll
            for (int i = 0; i < 2; ++i) { u32x2 o; o.x = pk2(st[0], st[1]); o.y = pk2(st[2], st[3]); *(u32x2*)(base + (size_t)(dir ? 1 - i : i) * CST) = o;
                st = st * dec + (f32x4){bflo(kv[i].x), bfhi(kv[i].x), bflo(kv[i].y), bfhi(kv[i].y)}; }
        } else {
            u32x2 kv[32];
#pragma unroll
            for (int i = 0; i < 32; ++i) kv[i] = *(const u32x2*)(base + (size_t)(dir ? 31 - i : i) * CST);
#pragma unroll
            for (int i = 0; i < 32; ++i) { u32x2 o; o.x = pk2(st[0], st[1]); o.y = pk2(st[2], st[3]); *(u32x2*)(base + (size_t)(dir ? 31 - i : i) * CST) = o;
                st = st * dec + (f32x4){bflo(kv[i].x), bfhi(kv[i].x), bflo(kv[i].y), bfhi(kv[i].y)}; }
        }
        if (s < 16) *(f32x4*)(A.out + (dir ? OUT_SB : OUT_SF) + (((size_t)s * 8 + h) * 64 + lr) * 128 + dv) = st;
    }
}

namespace att {
constexpr int D = 128, NW = 8, QBLK = 32, KVBLK = 64;
constexpr float SCALE = 0.088388347648318440f, THR = 8.f;
constexpr size_t SHM_V = KVBLK * D * 2, SHM_K = KVBLK * D * 2, SHM_ATTN = 2 * SHM_V + 2 * SHM_K + NW * 64 * 4;
#define KSWZ(row, colB) ((row) * 256 + ((colB) ^ (((row) & 7) << 4)))
#define SBAR() __builtin_amdgcn_sched_barrier(0)
__device__ __forceinline__ int crow(int r, int hi) { return (r & 3) + 8 * (r >> 2) + 4 * hi; }
__device__ __forceinline__ unsigned cvtpk(float lo, float hi) { unsigned r; asm volatile("v_cvt_pk_bf16_f32 %0, %1, %2" : "=v"(r) : "v"(lo), "v"(hi)); return r; }
__device__ __forceinline__ void partialSM(f32x16& p0, f32x16& p1, float& m_reg, float& mn, float& alpha) {
  constexpr float C = SCALE * 1.4426950408889634f;
  float pmax = p0[0]; for (int r = 1; r < 16; ++r) pmax = fmaxf(pmax, p0[r]); for (int r = 0; r < 16; ++r) pmax = fmaxf(pmax, p1[r]);
  { auto rr = __builtin_amdgcn_permlane32_swap(__float_as_uint(pmax), __float_as_uint(pmax), false, false);
    pmax = fmaxf(__uint_as_float(rr[0]), __uint_as_float(rr[1])); }
  if (__builtin_expect(__all(pmax - m_reg <= THR / SCALE), 1)) { mn = m_reg; alpha = 1.f; }
  else { mn = fmaxf(m_reg, pmax); alpha = __builtin_amdgcn_exp2f((m_reg - mn) * C); m_reg = mn; }
  float mnC = -mn * C;
  for (int r = 0; r < 16; ++r) p0[r] = fmaf(p0[r], C, mnC); for (int r = 0; r < 16; ++r) p1[r] = fmaf(p1[r], C, mnC);
  for (int r = 0; r < 16; ++r) p0[r] = __builtin_amdgcn_exp2f(p0[r]);
}
__device__ __forceinline__ void finishSM(f32x16& p0, f32x16& p1, float alpha, float& l_reg, bf16x8& pa0, bf16x8& pa1, bf16x8& pa2, bf16x8& pa3) {
  for (int r = 0; r < 16; ++r) p1[r] = __builtin_amdgcn_exp2f(p1[r]);
  float ps = 0; for (int r = 0; r < 16; ++r) ps += p0[r]; for (int r = 0; r < 16; ++r) ps += p1[r];
  { auto rr = __builtin_amdgcn_permlane32_swap(__float_as_uint(ps), __float_as_uint(ps), false, false);
    ps = __uint_as_float(rr[0]) + __uint_as_float(rr[1]); }
  l_reg = l_reg * alpha + ps;
#define PK4(P, BASE, OUT) do { unsigned a0 = cvtpk(P[BASE + 0], P[BASE + 1]), a1 = cvtpk(P[BASE + 2], P[BASE + 3]);   \
    unsigned b0 = cvtpk(P[BASE + 4], P[BASE + 5]), b1 = cvtpk(P[BASE + 6], P[BASE + 7]);                              \
    auto r0 = __builtin_amdgcn_permlane32_swap(a0, b0, false, false); auto r1 = __builtin_amdgcn_permlane32_swap(a1, b1, false, false); \
    u32x4 w = {r0[0], r1[0], r0[1], r1[1]}; OUT = *reinterpret_cast<bf16x8*>(&w); } while (0)
  PK4(p0, 0, pa0); PK4(p0, 8, pa1); PK4(p1, 0, pa2); PK4(p1, 8, pa3);
#undef PK4
}
__device__ __forceinline__ void qkt(f32x16& p0, f32x16& p1, const bf16_t* Ks, const bf16x8* qr, int r32, int hi) {
  p0 = f32x16{}; p1 = f32x16{};
  for (int d0 = 0; d0 < 8; ++d0) { int cb = (d0 * 16 + hi * 8) * 2;
    bf16x8 b0 = *reinterpret_cast<const bf16x8*>((const char*)Ks + KSWZ(r32, cb));
    bf16x8 b1 = *reinterpret_cast<const bf16x8*>((const char*)Ks + KSWZ(32 + r32, cb));
    p0 = __builtin_amdgcn_mfma_f32_32x32x16_bf16(b0, qr[d0], p0, 0, 0, 0);
    p1 = __builtin_amdgcn_mfma_f32_32x32x16_bf16(b1, qr[d0], p1, 0, 0, 0); }
}
__device__ __forceinline__ void qkt_finish(f32x16& q0, f32x16& q1, const bf16_t* Ks, const bf16x8* qr, int r32, int hi,
                                           f32x16& p0, f32x16& p1, float alpha, float& l_reg, bf16x8& pa0, bf16x8& pa1, bf16x8& pa2, bf16x8& pa3) {
  q0 = f32x16{}; q1 = f32x16{};
  bf16x8 ba[4], bb[4];
#define KLD2(B, D0) do { const int cb0_ = ((D0) * 16 + hi * 8) * 2, cb1_ = (((D0) + 1) * 16 + hi * 8) * 2;                          \
    B[0] = *reinterpret_cast<const bf16x8*>((const char*)Ks + KSWZ(r32, cb0_)); B[1] = *reinterpret_cast<const bf16x8*>((const char*)Ks + KSWZ(32 + r32, cb0_));   \
    B[2] = *reinterpret_cast<const bf16x8*>((const char*)Ks + KSWZ(r32, cb1_)); B[3] = *reinterpret_cast<const bf16x8*>((const char*)Ks + KSWZ(32 + r32, cb1_)); } while (0)
#define KMM2(B, D0) do { q0 = __builtin_amdgcn_mfma_f32_32x32x16_bf16(B[0], qr[D0], q0, 0, 0, 0); q1 = __builtin_amdgcn_mfma_f32_32x32x16_bf16(B[1], qr[D0], q1, 0, 0, 0);   \
    q0 = __builtin_amdgcn_mfma_f32_32x32x16_bf16(B[2], qr[(D0) + 1], q0, 0, 0, 0); q1 = __builtin_amdgcn_mfma_f32_32x32x16_bf16(B[3], qr[(D0) + 1], q1, 0, 0, 0); } while (0)
  KLD2(ba, 0); KLD2(bb, 2);
  KMM2(ba, 0); SBAR();
  KLD2(ba, 4); KMM2(bb, 2);
  for (int r = 0; r < 8; ++r) p1[r] = __builtin_amdgcn_exp2f(p1[r]);
  asm volatile("" : "+v"(p1)); SBAR();
  KLD2(bb, 6); KMM2(ba, 4);
  for (int r = 8; r < 16; ++r) p1[r] = __builtin_amdgcn_exp2f(p1[r]);
  asm volatile("" : "+v"(p1)); SBAR();
  KMM2(bb, 6);
#undef KLD2
#undef KMM2
  float ps = 0; for (int r = 0; r < 16; ++r) ps += p0[r]; for (int r = 0; r < 16; ++r) ps += p1[r];
  { auto rr = __builtin_amdgcn_permlane32_swap(__float_as_uint(ps), __float_as_uint(ps), false, false);
    ps = __uint_as_float(rr[0]) + __uint_as_float(rr[1]); }
  l_reg = l_reg * alpha + ps;
#define PK4(P, BASE, OUT) do { unsigned a0 = cvtpk(P[BASE + 0], P[BASE + 1]), a1 = cvtpk(P[BASE + 2], P[BASE + 3]);   \
    unsigned b0 = cvtpk(P[BASE + 4], P[BASE + 5]), b1 = cvtpk(P[BASE + 6], P[BASE + 7]);                              \
    auto r0 = __builtin_amdgcn_permlane32_swap(a0, b0, false, false); auto r1 = __builtin_amdgcn_permlane32_swap(a1, b1, false, false); \
    u32x4 w = {r0[0], r1[0], r0[1], r1[1]}; OUT = *reinterpret_cast<bf16x8*>(&w); } while (0)
  PK4(p0, 0, pa0); PK4(p0, 8, pa1); PK4(p1, 0, pa2); PK4(p1, 8, pa3);
#undef PK4
}
__device__ __forceinline__ int v_st(int k, int c) { const int kk = (k & ~0xC) | ((k & 4) << 1) | ((k & 8) >> 1); return ((kk >> 3) * 4 + (c >> 5)) * 512 + ((kk & 7) * 32 + (c & 31)) * 2; }
__device__ __forceinline__ int v_rd_base(int lane) { return ((lane & 3) << 3) | (((lane >> 2) & 3) << 6) | (((lane >> 4) & 1) << 5) | (((lane >> 5) & 1) << 8); }
constexpr int v_rd_off(int d0, int ks, int half) { return d0 * 512 + ks * 4096 + half * 2048; }
template <int OFF> __device__ __forceinline__ s16x4 tr_read(int vb) { s16x4 r; asm volatile("ds_read_b64_tr_b16 %0, %1 offset:%2" : "=&v"(r) : "v"(vb), "i"(OFF) : "memory"); return r; }
template <int D0> __device__ __forceinline__ void pv_one(f32x16& od, int vb, bf16x8 pa0, bf16x8 pa1, bf16x8 pa2, bf16x8 pa3) {
  const s16x4 l0 = tr_read<v_rd_off(D0, 0, 0)>(vb), h0 = tr_read<v_rd_off(D0, 0, 1)>(vb), l1 = tr_read<v_rd_off(D0, 1, 0)>(vb), h1 = tr_read<v_rd_off(D0, 1, 1)>(vb);
  const s16x4 l2 = tr_read<v_rd_off(D0, 2, 0)>(vb), h2 = tr_read<v_rd_off(D0, 2, 1)>(vb), l3 = tr_read<v_rd_off(D0, 3, 0)>(vb), h3 = tr_read<v_rd_off(D0, 3, 1)>(vb);
  asm volatile("s_waitcnt lgkmcnt(0)" ::: "memory"); SBAR();
  od = __builtin_amdgcn_mfma_f32_32x32x16_bf16(pa0, MK8(l0, h0), od, 0, 0, 0);
  od = __builtin_amdgcn_mfma_f32_32x32x16_bf16(pa1, MK8(l1, h1), od, 0, 0, 0);
  od = __builtin_amdgcn_mfma_f32_32x32x16_bf16(pa2, MK8(l2, h2), od, 0, 0, 0);
  od = __builtin_amdgcn_mfma_f32_32x32x16_bf16(pa3, MK8(l3, h3), od, 0, 0, 0);
}
__device__ __forceinline__ void pv_d0(f32x16* o, int vb, bf16x8 pa0, bf16x8 pa1, bf16x8 pa2, bf16x8 pa3) {
  pv_one<0>(o[0], vb, pa0, pa1, pa2, pa3); pv_one<1>(o[1], vb, pa0, pa1, pa2, pa3); pv_one<2>(o[2], vb, pa0, pa1, pa2, pa3); pv_one<3>(o[3], vb, pa0, pa1, pa2, pa3);
}
__device__ __forceinline__ void pv_partial(f32x16* o, int vb, bf16x8 pa0, bf16x8 pa1, bf16x8 pa2, bf16x8 pa3, f32x16& p0, f32x16& p1, float& m_reg, float& mn, float& alpha) {
  constexpr float C = SCALE * 1.4426950408889634f;
  pv_one<0>(o[0], vb, pa0, pa1, pa2, pa3);
  float pmax = p0[0]; for (int r = 1; r < 16; ++r) pmax = fmaxf(pmax, p0[r]); for (int r = 0; r < 16; ++r) pmax = fmaxf(pmax, p1[r]);
  { auto rr = __builtin_amdgcn_permlane32_swap(__float_as_uint(pmax), __float_as_uint(pmax), false, false);
    pmax = fmaxf(__uint_as_float(rr[0]), __uint_as_float(rr[1])); }
  asm volatile("" : "+v"(pmax));
  pv_one<1>(o[1], vb, pa0, pa1, pa2, pa3);
  { const bool keep = __all(pmax - m_reg <= THR / SCALE);
    mn = keep ? m_reg : fmaxf(m_reg, pmax); alpha = __builtin_amdgcn_exp2f((m_reg - mn) * C); m_reg = mn; }
  const float mnC = -mn * C;
  for (int r = 0; r < 16; ++r) p0[r] = fmaf(p0[r], C, mnC); for (int r = 0; r < 16; ++r) p1[r] = fmaf(p1[r], C, mnC);
  asm volatile("" : "+v"(p0), "+v"(p1), "+v"(alpha));
  pv_one<2>(o[2], vb, pa0, pa1, pa2, pa3);
  for (int r = 0; r < 8; ++r) p0[r] = __builtin_amdgcn_exp2f(p0[r]);
  asm volatile("" : "+v"(p0));
  pv_one<3>(o[3], vb, pa0, pa1, pa2, pa3);
  for (int r = 8; r < 16; ++r) p0[r] = __builtin_amdgcn_exp2f(p0[r]);
  asm volatile("" : "+v"(p0)); SBAR();
}
template <int LDQ>
__device__ __forceinline__ void attn_dense_body(const bf16_t* Qb, const bf16_t* __restrict__ Kh, const bf16_t* __restrict__ Vh, bf16_t* Ob, int seq, char* lds, const int wid) {
  constexpr int LDK = 128;
  const int lane = lane_id_(), tid = wid * 64 + lane, r32 = lane & 31, hi = lane >> 5;
  bf16_t* V_lds = (bf16_t*)lds; bf16_t* K_lds = (bf16_t*)(lds + 2 * SHM_V);
  float* ws = (float*)(lds + 2 * SHM_V + 2 * SHM_K) + wid * 64; float* li_l = ws; float* al_l = ws + 32;
  float m_reg = -1e30f, l_reg = 0; f32x16 o[4] = {}; bf16x8 qr[8];
  const bf16_t* Qw = Qb + (long)(wid * QBLK + r32) * LDQ + hi * 8;
#pragma unroll
  for (int d0 = 0; d0 < 8; ++d0) qr[d0] = *reinterpret_cast<const bf16x8*>(Qw + d0 * 16);
  const int sr = tid >> 4, sc = (tid & 15) * 8, vst0 = v_st(sr, sc), vst1 = v_st(32 + sr, sc);
  const int vb0 = (int)(uintptr_t)V_lds + v_rd_base(lane);
  struct { bf16x8 vs0, vs1, ks0, ks1; } sr_[2];
#define SLOAD(i, k0) do { sr_[i].vs0 = *(const bf16x8*)(&Vh[(long)((k0) + sr) * LDK + sc]); sr_[i].vs1 = *(const bf16x8*)(&Vh[(long)((k0) + 32 + sr) * LDK + sc]); \
    sr_[i].ks0 = *(const bf16x8*)(&Kh[(long)((k0) + sr) * LDK + sc]); sr_[i].ks1 = *(const bf16x8*)(&Kh[(long)((k0) + 32 + sr) * LDK + sc]); } while (0)
#define SWRITE(b, i) do { *(bf16x8*)((char*)V_lds + (b) * SHM_V + vst0) = sr_[i].vs0;          \
    *(bf16x8*)((char*)V_lds + (b) * SHM_V + vst1) = sr_[i].vs1; int kc = sc * 2;               \
    *(bf16x8*)((char*)K_lds + (b) * SHM_K + KSWZ(sr, kc)) = sr_[i].ks0;                       \
    *(bf16x8*)((char*)K_lds + (b) * SHM_K + KSWZ(32 + sr, kc)) = sr_[i].ks1; } while (0)
#define SWAIT() asm volatile("s_waitcnt vmcnt(4)" ::: "memory")
#define RESC(a) do { if (__any((a) < 1.f)) { if (hi == 0) al_l[r32] = (a); asm volatile("s_waitcnt lgkmcnt(0)" ::: "memory"); \
    for (int d = 0; d < 4; ++d) for (int r = 0; r < 16; ++r) o[d][r] *= al_l[crow(r, hi)]; } } while (0)
  f32x16 pA0, pA1, pB0, pB1; float mnA, mnB, alA, alB; bf16x8 pa0, pa1, pa2, pa3; const int NT = seq / KVBLK;
  constexpr int SE = 0, SO = 1;
  if (wid >= 4) __builtin_amdgcn_s_setprio(1);
  SLOAD(SE, 0); asm volatile("s_waitcnt vmcnt(0)" ::: "memory"); SWRITE(0, SE); __syncthreads();
  qkt(pA0, pA1, K_lds, qr, r32, hi); partialSM(pA0, pA1, m_reg, mnA, alA);
  SLOAD(SO, KVBLK); if (2 < NT) SLOAD(SE, 2 * KVBLK);
  SWAIT(); SWRITE(1, SO); __syncthreads();
  for (int j = 1; j + 1 < NT; j += 2) {
    SBAR(); qkt_finish(pB0, pB1, (bf16_t*)((char*)K_lds + SHM_K), qr, r32, hi, pA0, pA1, alA, l_reg, pa0, pa1, pa2, pa3); SBAR();
    SLOAD(SO, (j + 2) * KVBLK); SBAR();
    pv_partial(o, vb0, pa0, pa1, pa2, pa3, pB0, pB1, m_reg, mnB, alB);
    __syncthreads(); SWAIT(); SWRITE(0, SE);
    RESC(alB); __syncthreads();
    SBAR(); qkt_finish(pA0, pA1, K_lds, qr, r32, hi, pB0, pB1, alB, l_reg, pa0, pa1, pa2, pa3); SBAR();
    if (j + 3 < NT) SLOAD(SE, (j + 3) * KVBLK); SBAR();
    pv_partial(o, vb0 + (int)SHM_V, pa0, pa1, pa2, pa3, pA0, pA1, m_reg, mnA, alA);
    __syncthreads(); SWAIT(); SWRITE(1, SO);
    RESC(alA); __syncthreads();
  }
  SBAR(); qkt(pB0, pB1, (bf16_t*)((char*)K_lds + SHM_K), qr, r32, hi);
  finishSM(pA0, pA1, alA, l_reg, pa0, pa1, pa2, pa3); SBAR();
  pv_partial(o, vb0, pa0, pa1, pa2, pa3, pB0, pB1, m_reg, mnB, alB);
  __syncthreads(); RESC(alB);
  finishSM(pB0, pB1, alB, l_reg, pa0, pa1, pa2, pa3); SBAR();
  pv_d0(o, vb0 + (int)SHM_V, pa0, pa1, pa2, pa3);
  __builtin_amdgcn_s_setprio(0);
  if (hi == 0) li_l[r32] = l_reg; asm volatile("s_waitcnt lgkmcnt(0)" ::: "memory");
  float rli[16];
#pragma unroll
  for (int r = 0; r < 16; ++r) rli[r] = __builtin_amdgcn_rcpf(li_l[crow(r, hi)]);
  bf16_t* Ow = Ob + (long)(wid * QBLK) * LDQ;
#pragma unroll
  for (int r = 0; r < 16; ++r) { int orow = crow(r, hi);
    for (int d0 = 0; d0 < 4; ++d0) Ow[(long)orow * LDQ + d0 * 32 + r32] = (bf16_t)f2bf(o[d0][r] * rli[r]); }
  __syncthreads();
#undef SLOAD
#undef SWRITE
#undef SWAIT
#undef RESC
}
#undef KSWZ
#undef SBAR
}

struct R3Regs { u32x4 k[2], v[4], s[4], srg[4]; bf16x8 q[2]; };
__device__ __forceinline__ void r3_load(const Frame& F, CArgs& A, int item, R3Regs& R) {
    unsigned char* ws = A.ws;
    const bf16_t* RQb = (const bf16_t*)(ws + WS_RQ); const bf16_t* RKb = (const bf16_t*)(ws + WS_RK); const bf16_t* RVb = (const bf16_t*)(ws + WS_RV);
    const bf16_t* SRGb = (const bf16_t*)(ws + WS_SRG); const bf16_t* KVS = (const bf16_t*)(ws + WS_H);
    const int cg = item >> 3, h = item & 7; const size_t row0 = (size_t)cg * 128;
#pragma unroll
    for (int i = 0; i < 2; ++i) { const int ci = F.tid + i * NTHR; R.k[i] = *(const u32x4*)(RKb + (row0 + (ci >> 3)) * 512 + 64 * h + 8 * (ci & 7)); }
#pragma unroll
    for (int i = 0; i < 4; ++i) { const int ci = F.tid + i * NTHR, j = ci >> 4, c8 = ci & 15;
        R.v[i] = *(const u32x4*)(RVb + (row0 + j) * 1024 + 128 * h + 8 * c8);
        R.s[i] = *(const u32x4*)(KVS + (size_t)item * 2 * 8192 + (size_t)j * 128 + 8 * c8); }
    const size_t gofs = (row0 + 16 * F.wave + (F.lane >> 2)) * 1024 + 128 * h + (F.lane & 3) * 32;
#pragma unroll
    for (int c = 0; c < 4; ++c) R.srg[c] = *(const u32x4*)(SRGb + gofs + 8 * c);
#pragma unroll
    for (int s = 0; s < 2; ++s) R.q[s] = *(const bf16x8*)(RQb + (row0 + 16 * F.wave + (F.lane & 15)) * 512 + 64 * h + 32 * s + 8 * (F.lane >> 4));
}
__device__ __forceinline__ void r3_item(const Frame& F, CArgs& A, int item, int item_next, R3Regs& R, int after_next, LAS int* slot) {
    unsigned char* ws = A.ws; bf16_t* RVb = (bf16_t*)(ws + WS_RV);
    LAS bf16_t* kl = (LAS bf16_t*)F.lds; LAS bf16_t* vl = kl + 128 * KLD; LAS bf16_t* sl = vl + 128 * 128; LAS bf16_t* pl = sl + 128 * 128 + F.wave * (16 * VLD);
    const int cg = item >> 3, h = item & 7; const size_t row0 = (size_t)cg * 128;
    const float lgf = log_sigmoid_(A.dec_f[h]) * 1.4426950408889634f, lgb = log_sigmoid_(A.dec_b[h]) * 1.4426950408889634f;
#pragma unroll
    for (int i = 0; i < 2; ++i) { const int ci = F.tid + i * NTHR; *(LAS u32x4*)(kl + (ci >> 3) * KLD + 8 * (ci & 7)) = R.k[i]; }
#pragma unroll
    for (int i = 0; i < 4; ++i) { const int ci = F.tid + i * NTHR, j = ci >> 4, c8 = ci & 15; *(LAS u32x4*)((LAS char*)vl + vsw(j, c8)) = R.v[i]; *(LAS u32x4*)((LAS char*)sl + vsw(j, c8)) = R.s[i]; }
    int lane_ = F.lane; asm volatile("" : "+v"(lane_));
    const int g = lane_ >> 4, l15 = lane_ & 15, q = l15 >> 2, p = lane_ & 3, w = F.wave;
    const size_t gofs = (row0 + 16 * w + (lane_ >> 2)) * 1024 + 128 * h + (lane_ & 3) * 32;
    u32x4 srg_[4]; bf16x8 qf[2];
#pragma unroll
    for (int c = 0; c < 4; ++c) srg_[c] = R.srg[c];
#pragma unroll
    for (int s = 0; s < 2; ++s) qf[s] = R.q[s];
    __syncthreads();
    if (item_next >= 0) r3_load(F, A, item_next, R);
    float rf[4], rb[4];
#pragma unroll
    for (int e = 0; e < 4; ++e) { const float fi = (float)(16 * w + 4 * g + e); rf[e] = __builtin_amdgcn_exp2f(lgf * fi); rb[e] = __builtin_amdgcn_exp2f(-lgb * fi); }
#pragma unroll
    for (int nt = 0; nt < 8; ++nt) { f32x4 sacc = {0.f, 0.f, 0.f, 0.f};
#pragma unroll
        for (int s = 0; s < 2; ++s) { const bf16x8 kfr = *(const LAS bf16x8*)(kl + (16 * nt + l15) * KLD + 32 * s + 8 * g); sacc = __builtin_amdgcn_mfma_f32_16x16x32_bf16(qf[s], kfr, sacc, 0, 0, 0); }
        const int j = 16 * nt + l15;
        if (nt < w) {
            const float cf = __builtin_amdgcn_exp2f(-lgf * (float)j);
#pragma unroll
            for (int e = 0; e < 4; ++e) pl[(4 * g + e) * VLD + j] = (bf16_t)f2bf(sacc[e] * (rf[e] * cf));
        } else if (nt > w) {
            const float cb = __builtin_amdgcn_exp2f(lgb * (float)j);
#pragma unroll
            for (int e = 0; e < 4; ++e) pl[(4 * g + e) * VLD + j] = (bf16_t)f2bf(sacc[e] * (rb[e] * cb));
        } else {
            const float cf = __builtin_amdgcn_exp2f(-lgf * (float)j), cb = __builtin_amdgcn_exp2f(lgb * (float)j);
#pragma unroll
            for (int e = 0; e < 4; ++e) { const int df = 16 * w + 4 * g + e - j;
                const float dm = (df >= 0 ? rf[e] * cf : 0.f) + (df <= 0 ? rb[e] * cb : 0.f);
                pl[(4 * g + e) * VLD + j] = (bf16_t)f2bf(sacc[e] * dm); } } }
    LDS_WAIT(); asm volatile("" ::: "memory");
    bf16x8 pa[4], qa[4];
#pragma unroll
    for (int s = 0; s < 4; ++s) pa[s] = *(const LAS bf16x8*)(pl + l15 * VLD + 32 * s + 8 * g);
    { const int i = 16 * w + l15; const float qdf = __builtin_amdgcn_exp2f(lgf * (float)(i + 1)), qdb = __builtin_amdgcn_exp2f(lgb * (float)(128 - i));
#pragma unroll
      for (int s = 0; s < 2; ++s) { f32x4 a, b; unpack8(__builtin_bit_cast(u32x4, qf[s]), a, b); qa[s] = __builtin_bit_cast(bf16x8, pack8(a * qdf, b * qdf)); qa[2 + s] = __builtin_bit_cast(bf16x8, pack8(a * qdb, b * qdb)); } }
    f32x4 oacc[8];
#pragma unroll
    for (int nt = 0; nt < 8; ++nt) { f32x4 acc = {0.f, 0.f, 0.f, 0.f};
#pragma unroll
        for (int s = 0; s < 4; ++s) { const int R0 = 32 * s + 8 * g + q, col = 16 * nt + 4 * p;
            const s16x4 lo = tr_read16((const LAS bf16_t*)((const LAS char*)vl + vsw_tr(R0, col))), hi = tr_read16((const LAS bf16_t*)((const LAS char*)vl + vsw_tr(R0 + 4, col)));
            acc = __builtin_amdgcn_mfma_f32_16x16x32_bf16(pa[s], MK8(lo, hi), acc, 0, 0, 0); }
#pragma unroll
        for (int s = 0; s < 4; ++s) { const int R0 = 32 * s + 8 * g + q, col = 16 * nt + 4 * p;
            const s16x4 lo = tr_read16((const LAS bf16_t*)((const LAS char*)sl + vsw_tr(R0, col))), hi = tr_read16((const LAS bf16_t*)((const LAS char*)sl + vsw_tr(R0 + 4, col)));
            acc = __builtin_amdgcn_mfma_f32_16x16x32_bf16(qa[s], MK8(lo, hi), acc, 0, 0, 0); }
        oacc[nt] = acc; }
    f32x4 ss = {0.f, 0.f, 0.f, 0.f};
#pragma unroll
    for (int nt = 0; nt < 8; ++nt) ss += oacc[nt] * oacc[nt];
#pragma unroll
    for (int e = 0; e < 4; ++e) { float s = ss[e]; s += __shfl_xor(s, 1); s += __shfl_xor(s, 2); s += __shfl_xor(s, 4); s += __shfl_xor(s, 8); ss[e] = __builtin_amdgcn_rsqf(s * (1.0f / 128.0f) + EPS); }
#pragma unroll
    for (int nt = 0; nt < 8; ++nt)
#pragma unroll
        for (int e = 0; e < 4; ++e) pl[(4 * g + e) * VLD + 16 * nt + l15] = (bf16_t)f2bf(oacc[nt][e] * ss[e]);
    LDS_WAIT(); asm volatile("" ::: "memory");
#pragma unroll
    for (int c = 0; c < 4; ++c) { f32x4 o0, o1, g0, g1; unpack8(*(const LAS u32x4*)(pl + (lane_ >> 2) * VLD + (lane_ & 3) * 32 + 8 * c), o0, o1); unpack8(srg_[c], g0, g1);
        *(u32x4*)(RVb + gofs + 8 * c) = pack8(o0 * g0, o1 * g1); }
    if (F.tid == 0) *slot = after_next;
    __syncthreads();
}

__device__ __forceinline__ void phase_attn(const Frame& F, CArgs& A) {
    unsigned char* ws = A.ws; bf16_t* Q = (bf16_t*)(ws + WS_Q);
    {
        LAS float* scr = (LAS float*)(F.lds + F.wave * 8704);
        const int gw = F.bid * NWAVES + F.wave, NGW = F.G * NWAVES;
        constexpr int I_O = 16 * 32, NIT = 3 * I_O;
        for (int it = gw; it < NIT; it += NGW) {
            int r = it;
            if (r < I_O) { transpose_item(A.w_att_o, 1024, (bf16_t*)(ws + WS_WB), 2048, 0, 64 * (r / 32), 32 * (r % 32), ColId(), scr, F.lane); continue; } r -= I_O;
            if (r < I_O) { transpose_item(A.w_ret_o, 1024, (bf16_t*)(ws + WS_WB), 2048, 1024, 64 * (r / 32), 32 * (r % 32), ColId(), scr, F.lane); continue; } r -= I_O;
            transpose_item(A.w_out, 1024, (bf16_t*)(ws + WS_WC), 1024, 0, 64 * (r / 32), 32 * (r % 32), ColId(), scr, F.lane);
        }
        __syncthreads();
    }
    const int x = F.bid & 7, c = F.bid >> 3;
    const int nun = F.bid < NB * NH ? 3 : 2;
    unsigned* qctr = (unsigned*)(ws + WS_CNT) + 64 * CNT_R3Q; LAS int* slot = (LAS int*)(F.lds + 122880);
    int nxt_v = 0; if (F.tid == 0) nxt_v = (int)__hip_atomic_fetch_add(qctr, 1u, RLX_AGENT) + F.G;
#pragma nounroll
    for (int i = 0; i < nun; ++i) {
        const bf16_t *Kh, *Vh; bf16_t* Qb; int seq;
        if (i < 2) { const int lb = x >> 1, kvh = x & 1, uu = c + 32 * i, hq = kvh * 4 + (uu >> 4), qb = uu & 15;
            Kh = (const bf16_t*)(ws + WS_KALL) + (size_t)(lb * 2 + kvh) * SKV * 128; Vh = (const bf16_t*)(ws + WS_VALL) + (size_t)(lb * 2 + kvh) * SKV * 128;
            Qb = Q + ((size_t)MP + (size_t)lb * DSEQ + qb * 256) * 1024 + hq * 128; seq = SKV; }
        else { const int b = F.bid >> 3, hq = F.bid & 7, kvh = hq >> 2;
            Kh = (const bf16_t*)(ws + WS_KP) + (size_t)(b * 2 + kvh) * SEQ * 128; Vh = (const bf16_t*)(ws + WS_VP) + (size_t)(b * 2 + kvh) * SEQ * 128;
            Qb = Q + (size_t)b * SEQ * 1024 + hq * 128; seq = SEQ; }
        att::attn_dense_body<1024>(Qb, Kh, Vh, Qb, seq, (char*)F.lds, F.wave);
    }
    {
      constexpr int NIT3 = (MT / 128) * 8;
      Frame F2 = F; F2.lane = lane_id_(); F2.tid = F2.wave * 64 + F2.lane;
      if (F2.tid == 0) *slot = nxt_v;
      __syncthreads();
      int cur = F.bid, nxt = __builtin_amdgcn_readfirstlane(*slot); if (nxt >= NIT3) nxt = -1;
      R3Regs R; r3_load(F2, A, cur, R);
      while (cur >= 0) {
          int n2_v = -1; if (nxt >= 0 && F2.tid == 0) n2_v = (int)__hip_atomic_fetch_add(qctr, 1u, RLX_AGENT) + F.G;
          r3_item(F2, A, cur, nxt, R, n2_v, slot);
          cur = nxt; nxt = __builtin_amdgcn_readfirstlane(*slot); if (nxt >= NIT3) nxt = -1;
      }
    }
}

struct OneUnit { int pm, pn; __device__ __forceinline__ bool next(int i, pg8::Unit& u) const { if (i) return false; u.pm = pm; u.pn = pn; return true; }
    __device__ __forceinline__ void a_ready(const pg8::Unit&, int) const {} };
constexpr int NU2 = 0, NU3 = 320, NU4 = (MT / 256) * (NUP / 256), NU5 = 320, NUTOT = NU2 + NU3 + NU4 + NU5;
__device__ __forceinline__ void fix_panel(const Frame& F, CArgs& A, int pm) {
    unsigned char* ws = A.ws; const float* EU = (const float*)(ws + WS_EDGE_U); const float* EUC = (const float*)(ws + WS_EDGE_UC); bf16_t* ACT = (bf16_t*)(ws + WS_ACT);
    const int jt = (pm - 16) & 15;
    for (int i = F.tid; i < 2 * DFF; i += NTHR) { const int j = i % DFF, e = i / DFF;
        if ((e == 0 && jt == 0) || (e == 1 && jt == 15)) continue;
        const int pmn = e ? pm + 1 : pm - 1, na = 256 * (j >> 7) + (j & 127), ng = na + 128, tap = e ? 2 : 0;
        const float ua = EUC[((size_t)pm * 2 + e) * NUP + na] + A.conv_w[(size_t)tap * NUP + j] * EU[((size_t)pmn * 2 + (1 - e)) * NUP + na];
        const float ug = EUC[((size_t)pm * 2 + e) * NUP + ng] + A.conv_w[(size_t)tap * NUP + DFF + j] * EU[((size_t)pmn * 2 + (1 - e)) * NUP + ng];
        ACT[((size_t)pm * 256 + (e ? 255 : 0)) * DFF + j] = (bf16_t)f2bf(siluf_(ug) * ua); }
}
__device__ __forceinline__ void g3_unit(const Frame& F, CArgs& A, int idx) {
    unsigned char* ws = A.ws; unsigned* cnt = (unsigned*)(ws + WS_CNT); const int pm = idx >> 2, pn = idx & 3;
    OneUnit S{pm, pn};
    pg8::Gemm g{(const bf16_t*)(ws + WS_Y), (const bf16_t*)(ws + WS_WC), MT, DM, DM, DM, DM, 1 << 30, 0};
    EpiRes1 E{A.x_prompt, A.x_sample, (const float*)(ws + WS_MODF), A.norm2_g, (bf16_t*)(ws + WS_X1B), (float*)(ws + WS_SSQ1), (bf16_t*)(ws + WS_H)};
    pg8::gemm_phase(F.lds, g, S, E, F.wave);
    asm volatile("s_waitcnt vmcnt(0)" ::: "memory");
    __syncthreads();
    if (F.wave == 0 && lane_id_() == 0) { __hip_atomic_fetch_add(cnt + 64 * (CNT_D3 + pm), 1u, RLX_AGENT); __hip_atomic_fetch_add(cnt + 64 * CNT_G3ALL, 1u, RLX_AGENT); }
}
__device__ __forceinline__ void phase_mix(const Frame& F, CArgs& A) {
    unsigned char* ws = A.ws; unsigned* cnt = (unsigned*)(ws + WS_CNT);
    const int v = (F.bid & 7) * (F.G >> 3) + (F.bid >> 3);
#if defined(PROBE_K0) && (PROBE_K0 == 301 || PROBE_K0 == 302)
    const unsigned long long tmix0_ = __builtin_amdgcn_s_memrealtime();
#endif
    {   struct G2Run { int v, n; __device__ __forceinline__ bool next(int i, pg8::Unit& u) const { if (i >= n) return false; const int l = i == 0 ? v : 256 + v; u.pm = l >> 2; u.pn = l & 3; return true; }
            __device__ __forceinline__ void a_ready(const pg8::Unit&, int) const {} };
        G2Run S{v, v < 64 ? 2 : 1};
        pg8::Gemm g{(const bf16_t*)(ws + WS_Q), (const bf16_t*)(ws + WS_WB), MT, DM, 2 * DM, DM, 2 * DM, 16, (long)(WS_RV - WS_Q) - 16 * 128};
        EpiMix E{(const bf16_t*)A.out, (const bf16_t*)A.out + (size_t)MT * DM, (bf16_t*)(ws + WS_Y), cnt + 64 * CNT_D2};
        pg8::gemm_phase(F.lds, g, S, E, F.wave);
    }
#if defined(PROBE_K0) && PROBE_K0 == 300
    const unsigned long long t0_ = __builtin_amdgcn_s_memrealtime();
#endif
#if defined(PROBE_K0) && PROBE_K0 == 301
    if (v == PROBE_BID && F.tid == 0) *(float*)(ws + 32768) = (float)(__builtin_amdgcn_s_memrealtime() - tmix0_);
#endif
    if (v >= 64) { const int idx = v - 64, pm = idx >> 2;
        if (F.wave == 0) { spin_ge(cnt + 64 * (CNT_D2 + pm), 4u); __builtin_amdgcn_fence(__ATOMIC_ACQUIRE, "agent"); asm volatile("s_waitcnt vmcnt(0)" ::: "memory"); }
        __syncthreads();
        g3_unit(F, A, idx);
        __syncthreads();
        LAS float* scr = (LAS float*)(F.lds + F.wave * 8704);
        constexpr int I_DN = (DFF / 64) * 32, I_UP = 16 * (NUP / 32);
        for (int it = (v - 64) * NWAVES + F.wave; it < I_DN + I_UP; it += (F.G - 64) * NWAVES) {
            if (it < I_DN) transpose_item(A.w_down, 1024, (bf16_t*)(ws + WS_WD), DFF, 0, 64 * (it / 32), 32 * (it % 32), ColId(), scr, F.lane);
            else { const int r = it - I_DN; transpose_item(A.w_up, NUP, (bf16_t*)(ws + WS_WA), 1024, 0, 64 * (r / (NUP / 32)), 32 * (r % (NUP / 32)), ColUp(), scr, F.lane); } }
    }
#if defined(PROBE_K0) && PROBE_K0 == 300
    if (v == PROBE_BID && F.tid == 0) *(float*)(ws + 32768) = (float)(__builtin_amdgcn_s_memrealtime() - t0_);
#endif
#if defined(PROBE_K0) && PROBE_K0 == 302
    if (v == PROBE_BID && F.tid == 0) *(float*)(ws + 32768) = (float)(__builtin_amdgcn_s_memrealtime() - tmix0_);
#endif
}
__device__ __forceinline__ void phase_stream(const Frame& F, CArgs& A) {
    unsigned char* ws = A.ws; unsigned* cnt = (unsigned*)(ws + WS_CNT);
    LAS float* spare = (LAS float*)(F.lds + SPARE_OFF);
    const int NOJ = 1 << 30;
    const int v = (F.bid & 7) * (F.G >> 3) + (F.bid >> 3);
#if defined(PROBE_K0) && PROBE_K0 >= 100 && PROBE_K0 < 200
    unsigned long long tacc_ = 0, tl_ = __builtin_amdgcn_s_memrealtime();
#define SPROBE(cat) do { const unsigned long long tn_ = __builtin_amdgcn_s_memrealtime(); if ((cat) == PROBE_K0 - 100 || PROBE_K0 - 100 == 3) tacc_ += tn_ - tl_; tl_ = tn_; } while (0)
#else
#define SPROBE(cat) do { } while (0)
#endif
    const int nG4 = v < 64 ? 8 : v < 192 ? 7 : v < 224 ? 6 : 5, nG5 = v >= 192 ? 2 : 1;
    if (v >= 64 && v < 192) g3_unit(F, A, 192 + (v - 64));
    SPROBE(0);
    {   struct G4Run { int v, n; unsigned* d3; unsigned* g3all; volatile LAS unsigned* alld; unsigned* d4; mutable int p0, p1;
            __device__ __forceinline__ void publish(int pm) const {
                if (pm >= 0) { asm volatile("s_waitcnt vmcnt(0)" ::: "memory"); if (lane_id_() == 0) __hip_atomic_fetch_add(d4 + 64 * pm, 1u, RLX_AGENT); } }
            __device__ __forceinline__ bool next(int r, pg8::Unit& u) const { if (r >= n) return false;
                const int l = r < 5 ? 256 * r + v : r == 5 ? 1280 + v : r == 6 ? 1504 + v : 1696 + v;
                const int sr = l / 176, rem = l % 176, blk = rem < 160 ? rem >> 5 : 5, w = rem < 160 ? rem & 31 : rem - 160;
                u.pm = 8 * sr + (w & 7); u.pn = 4 * blk + (w >> 3); return true; }
            __device__ __forceinline__ void a_ready(const pg8::Unit& u, int wid) const {
                publish(p0); p0 = p1; p1 = u.pm;
                if (wid == 0 && *alld == 0u) {
                    const bool all = (unsigned)__builtin_amdgcn_readfirstlane(__hip_atomic_load(g3all, RLX_AGENT)) >= 320u;
                    spin_ge(d3 + 64 * u.pm, 4u);
                    if (u.pm >= 63) spin_ge(g3all, 320u);
                    __builtin_amdgcn_fence(__ATOMIC_ACQUIRE, "agent"); asm volatile("s_waitcnt vmcnt(0)" ::: "memory");
                    if (all) *alld = 1u; }
                asm volatile("" ::: "memory"); __builtin_amdgcn_s_barrier(); asm volatile("" ::: "memory"); } };
        volatile LAS unsigned* alld = (volatile LAS unsigned*)(F.lds + MISC_OFF) + 16;
        if (F.tid == 0) *alld = 0u;
        __syncthreads();
        G4Run S{v, nG4, cnt + 64 * CNT_D3, cnt + 64 * CNT_G3ALL, alld, cnt + 64 * CNT_D4, -1, -1};
        pg8::Gemm g{(const bf16_t*)(ws + WS_H), (const bf16_t*)(ws + WS_WA), MT, NUP, DM, DM, DM, NOJ, 0};
        EpiConv E{(const float*)(ws + WS_SSQ1), (const float*)(ws + WS_BUPF), A.conv_w, A.conv_b, (bf16_t*)(ws + WS_ACT), (float*)(ws + WS_EDGE_U), (float*)(ws + WS_EDGE_UC), spare, cnt + 64 * CNT_D4};
        pg8::gemm_phase(F.lds, g, S, E, F.wave);
        S.publish(S.p0); S.publish(S.p1);
    }
    SPROBE(1);
    for (int j = 0; j < nG5; ++j) { const int l = j == 0 ? ((v + 64) & 255) : 256 + (v - 192), pm = l >> 2, pn = l & 3;
        if (F.wave == 0) { spin_ge(cnt + 64 * (CNT_D4 + pm), 176u);
            if (pm >= 16) { const int jt = (pm - 16) & 15; if (jt > 0) spin_ge(cnt + 64 * (CNT_D4 + pm - 1), 176u); if (jt < 15) spin_ge(cnt + 64 * (CNT_D4 + pm + 1), 176u); }
            __builtin_amdgcn_fence(__ATOMIC_ACQUIRE, "agent"); asm volatile("s_waitcnt vmcnt(0)" ::: "memory"); }
        __syncthreads();
        if (pm >= 16) { fix_panel(F, A, pm); asm volatile("s_waitcnt vmcnt(0)" ::: "memory"); __syncthreads(); }
        SPROBE(0);
        OneUnit S{pm, pn};
        pg8::Gemm g{(const bf16_t*)(ws + WS_ACT), (const bf16_t*)(ws + WS_WD), MT, DM, DFF, DFF, DFF, NOJ, 0};
        EpiRes2 E{(const float*)(ws + WS_MODF), A.final_g, (const bf16_t*)(ws + WS_X1B), A.out, (float*)(ws + WS_XS), cnt + 64 * CNT_X5, spare};
        pg8::gemm_phase(F.lds, g, S, E, F.wave);
        SPROBE(2);
    }
#if defined(PROBE_K0) && PROBE_K0 >= 100 && PROBE_K0 < 200
    if (v == PROBE_BID && F.tid == 0) *(float*)(ws + 32768) = (float)tacc_;
#endif
}

constexpr int N_PHASES = 8;
__global__ void __launch_bounds__(NTHR, 2) fwd_kernel(Args A_) {
    CArgs& A = *(CArgs*)__builtin_amdgcn_kernarg_segment_ptr();
    extern __shared__ __attribute__((aligned(16))) unsigned char lds_raw[];
    Frame F; F.lds = (LAS unsigned char*)lds_raw; F.wave = __builtin_amdgcn_readfirstlane(threadIdx.x >> 6); F.lane = lane_id_(); F.tid = F.wave * 64 + F.lane; F.G = gridDim.x; F.bid = blockIdx.x;
    volatile LAS unsigned* MISC = (volatile LAS unsigned*)(F.lds + MISC_OFF);
    if (F.tid < 64) MISC[F.tid] = 0u;
    __syncthreads();
    unsigned char* ws = A.ws;
    XcdBarrier bar = xcd_barrier_post((unsigned*)(ws + WS_CTL), MISC + 8, F.wave);
    const int lo = A.ph_lo, hi = A.ph_hi;
#ifdef ONLY_PHASE
#define IN(k) ((k) == ONLY_PHASE)
#else
#define IN(k) (lo <= (k) && (k) < hi)
#endif
#ifdef PROBE_K0
    unsigned long long tA_ = __builtin_amdgcn_s_memrealtime();
#define PROBE_AT(k) do { if ((k) == PROBE_K0 - 1) tA_ = __builtin_amdgcn_s_memrealtime(); \
    if ((k) == PROBE_K1 && F.bid == 0 && F.tid == 0) { const unsigned long long tB_ = __builtin_amdgcn_s_memrealtime(); *(float*)(ws + 32768) = (float)(tB_ - tA_) - 100.0f * PROBE_OFS; } } while (0)
#else
#define PROBE_AT(k) do { } while (0)
#endif
#define SEAM(k) do { if (IN(k) && IN((k) + 1)) xcd_barrier(bar); F.lane = lane_id_(); F.tid = F.wave * 64 + F.lane; PROBE_AT(k); } while (0)
    LAS float* spare = (LAS float*)(F.lds + SPARE_OFF);
    const int NOJ = 1 << 30;
    if (IN(0)) { phase0(F, A); } SEAM(0);
    if (IN(1)) { phase1(F, A); } SEAM(1);
    if (IN(2)) {
        pg8::Gemm g{(const bf16_t*)(ws + WS_H), (const bf16_t*)(ws + WS_WA), MT, DIN, DM, DM, DM, NOJ, 0};
        pg8::StaticOrder S; S.init(MT, DIN, F.G, F.bid, true);
        EpiIn E{(bf16_t*)(ws + WS_Q), (bf16_t*)(ws + WS_KALL), (bf16_t*)(ws + WS_VALL), (bf16_t*)(ws + WS_KP), (bf16_t*)(ws + WS_VP), (bf16_t*)(ws + WS_RQ), (bf16_t*)(ws + WS_RK),
                (bf16_t*)(ws + WS_RV), (bf16_t*)(ws + WS_SRG), (bf16_t*)A.out, (bf16_t*)A.out + (size_t)MT * DM, A.out + OUT_CK, A.out + OUT_CV, A.q_g, A.k_g, spare, (unsigned*)(ws + WS_CNT1)};
        pg8::gemm_phase(F.lds, g, S, E, F.wave);
        phase_r1(F, A);
    } SEAM(2);
    if (IN(4)) { phase_scan(F, A); } SEAM(4);
    if (IN(5)) { phase_attn(F, A); } SEAM(5);
    if (IN(6)) { phase_mix(F, A); } SEAM(6);
    if (IN(7)) { phase_stream(F, A); }
#ifdef PROBE_K0
    {
        PROBE_AT(7);
        xcd_barrier(bar);
        const float sc_ = 1.0f + sqrtf(*(const float*)(ws + 32768) * 1e-7f);
        for (int i = F.bid * NTHR + F.tid; i < NB * NKV * SEQ * HD; i += F.G * NTHR) A.out[OUT_CV + i] *= sc_;
    }
#endif
#undef IN
#undef SEAM
}

#ifndef MK_SPLIT
#define MK_SPLIT 0
#endif
extern "C" void kernel_launch(void* const* d_in, const int* in_sizes, int n_in, void* d_out, int out_size, void* d_ws, size_t ws_size, hipStream_t stream) {
    static int grid = 0;
    if (grid == 0) {
        if (n_in != 25 || ws_size < WS_END) { fprintf(stderr, "kernel_launch: unexpected n_in %d / ws %zu\n", n_in, ws_size); grid = -1; return; }
        int dev = 0, cus = 0, per_cu = 0;
        hipGetDevice(&dev); hipDeviceGetAttribute(&cus, hipDeviceAttributeMultiprocessorCount, dev);
        if (hipFuncSetAttribute((const void*)fwd_kernel, hipFuncAttributeMaxDynamicSharedMemorySize, LDS_BYTES) != hipSuccess) { fprintf(stderr, "kernel_launch: hipFuncSetAttribute failed\n"); grid = -1; return; }
        hipOccupancyMaxActiveBlocksPerMultiprocessor(&per_cu, (const void*)fwd_kernel, NTHR, LDS_BYTES);
        (void)hipGetLastError();
        if (per_cu < 1) fprintf(stderr, "kernel_launch: occupancy query says %d blocks/CU\n", per_cu);
        grid = cus;
        if (grid != 256) fprintf(stderr, "kernel_launch: %d CUs (built for 256)\n", grid);
    }
    if (grid < 0) return;
    hipMemsetAsync((char*)d_ws + WS_CTL, 0, CTL_ZERO_BYTES, stream);
    Args a{};
    const float** pa = (const float**)&a;
    for (int i = 0; i < 25; ++i) pa[i] = (const float*)d_in[i];
    a.out = (float*)d_out; a.ws = (unsigned char*)d_ws;
#if MK_SPLIT
    for (int p = 0; p < N_PHASES; ++p) { a.ph_lo = p; a.ph_hi = p + 1; hipLaunchKernelGGL(fwd_kernel, dim3(grid), dim3(NTHR), LDS_BYTES, stream, a); }
#else
    a.ph_lo = 0; a.ph_hi = N_PHASES; hipLaunchKernelGGL(fwd_kernel, dim3(grid), dim3(NTHR), LDS_BYTES, stream, a);
#endif
    const hipError_t le = hipPeekAtLastError();
    if (le != hipSuccess) fprintf(stderr, "kernel_launch: launch failed: %s\n", hipGetErrorName(le));
}
```
